# Optimizing an MI355X kernel written in HIP

```python
import math
import jax, jax.numpy as jnp
from jax import lax
import numpy as np

D_MODEL = 1024
BATCH = 8
SEQ = 4096
DEPTH = 1

CHUNK = 64
MIX_A_WIDTH = D_MODEL // 2
MIX_B_WIDTH = D_MODEL - MIX_A_WIDTH
A_GROUPS = 8
A_GROUP_DIM = MIX_A_WIDTH // A_GROUPS
A_BLOCK = 128
B_HEADS = 8
B_HEAD_DIM = MIX_B_WIDTH // B_HEADS
B_LEFT_CHUNKS = 8
B_BAND = (B_LEFT_CHUNKS + 1) * CHUNK
REL_CLIP = 128
PEER_HEADS = 8
PEER_NKEYS = 128
PEER_EXPERTS = PEER_NKEYS * PEER_NKEYS
PEER_QDIM = 256
PEER_HALF = PEER_QDIM // 2
PEER_TOPK = 16
PEER_TOKEN_BLOCK = 128
IN_COLS = 2 * MIX_A_WIDTH + 3 * MIX_B_WIDTH
EPS = 1e-6
NEG_INF = -1e30

kernel_name = "hybrid_gmlp_chunkattn_peer_block"


def rms_norm(x, g):
    xf = x.astype(jnp.float32)
    y = xf * lax.rsqrt(jnp.mean(xf * xf, axis=-1, keepdims=True) + EPS)
    return (y * g.astype(jnp.float32)).astype(x.dtype)


def gmlp_spatial_gating(u, v, norm_g, w_s, b_s):
    bsz, s, _ = u.shape
    u = jax.nn.gelu(u)
    v = rms_norm(jax.nn.gelu(v), norm_g)
    nblk = s // A_BLOCK
    v = v.reshape(bsz, nblk, A_BLOCK, A_GROUPS, A_GROUP_DIM)
    pos = jnp.arange(A_BLOCK)
    mask = (pos[None, :] // CHUNK) <= (pos[:, None] // CHUNK)
    w = jnp.where(mask[None], w_s, jnp.zeros_like(w_s)).astype(v.dtype)
    sp = jnp.einsum('gij,bnjgc->bnigc', w, v) + b_s.T.astype(v.dtype)[None, None, :, :, None]
    return u * sp.reshape(bsz, s, MIX_A_WIDTH)


def banded_chunk_attention(q, k, v, q_g, k_g, rel_bias):
    bsz, s, _ = q.shape
    nc = s // CHUNK
    pad = B_LEFT_CHUNKS * CHUNK
    q = rms_norm(q.reshape(bsz, nc, CHUNK, B_HEADS, B_HEAD_DIM), q_g)
    k = rms_norm(k.reshape(bsz, s, B_HEADS, B_HEAD_DIM), k_g)
    v = v.reshape(bsz, s, B_HEADS, B_HEAD_DIM)
    padw = ((0, 0), (pad, 0), (0, 0), (0, 0))
    kp = jnp.pad(k, padw).reshape(bsz, nc + B_LEFT_CHUNKS, CHUNK, B_HEADS, B_HEAD_DIM)
    vp = jnp.pad(v, padw).reshape(bsz, nc + B_LEFT_CHUNKS, CHUNK, B_HEADS, B_HEAD_DIM)
    band_idx = jnp.arange(nc)[:, None] + jnp.arange(B_LEFT_CHUNKS + 1)[None, :]
    kb = kp[:, band_idx].reshape(bsz, nc, B_BAND, B_HEADS, B_HEAD_DIM)
    vb = vp[:, band_idx].reshape(bsz, nc, B_BAND, B_HEADS, B_HEAD_DIM)
    scores = jnp.einsum('bcihd,bcjhd->bhcij', q, kb).astype(jnp.float32) * (B_HEAD_DIM ** -0.5)
    qi = jnp.arange(CHUNK)[:, None] + pad
    kj = jnp.arange(B_BAND)[None, :]
    rel_idx = jnp.clip(qi - kj, -REL_CLIP, REL_CLIP) + REL_CLIP
    bias = rel_bias.astype(jnp.float32)[:, rel_idx]
    valid = kj >= (pad - jnp.arange(nc)[:, None] * CHUNK)
    scores = scores + bias[None, :, None]
    scores = jnp.where(valid[None, None, :, None, :], scores, NEG_INF)
    p = jax.nn.softmax(scores, axis=-1).astype(v.dtype)
    out = jnp.einsum('bhcij,bcjhd->bcihd', p, vb)
    return out.reshape(bsz, s, MIX_B_WIDTH)


def peer_ffn(x, w_query, sub_keys, expert_u, expert_v):
    bsz, s, d = x.shape
    tokens = x.reshape(-1, PEER_TOKEN_BLOCK, d)

    def block(xb):
        q = (xb @ w_query).reshape(PEER_TOKEN_BLOCK, PEER_HEADS, 2, PEER_HALF)
        sc = jnp.einsum('thpd,hpkd->thpk', q, sub_keys).astype(jnp.float32)
        s_top, i_top = lax.top_k(sc, PEER_TOPK)
        cand = s_top[:, :, 0, :, None] + s_top[:, :, 1, None, :]
        cand_idx = i_top[:, :, 0, :, None] * PEER_NKEYS + i_top[:, :, 1, None, :]
        cand = cand.reshape(PEER_TOKEN_BLOCK, PEER_HEADS, PEER_TOPK * PEER_TOPK)
        cand_idx = cand_idx.reshape(PEER_TOKEN_BLOCK, PEER_HEADS, PEER_TOPK * PEER_TOPK)
        best, pos = lax.top_k(cand, PEER_TOPK)
        eidx = jnp.take_along_axis(cand_idx, pos, axis=-1)
        g = jax.nn.softmax(best, axis=-1)
        u = jnp.take(expert_u, eidx, axis=0)
        h = jax.nn.gelu(jnp.einsum('thkd,td->thk', u, xb))
        vv = jnp.take(expert_v, eidx, axis=0)
        return jnp.einsum('thk,thkd->td', (g * h.astype(jnp.float32)).astype(xb.dtype), vv)

    return lax.map(block, tokens).reshape(bsz, s, d)


def setup_inputs(seed: int = 0) -> dict:
    key = jax.random.key(seed)
    ks = jax.random.split(key, 16)
    f32 = jnp.float32
    nrm = lambda k, shape, sc: jax.random.normal(k, shape, f32) * sc
    return {
        "x": nrm(ks[0], (BATCH, SEQ, D_MODEL), 1.0),
        "ln_mix_g": 1.0 + nrm(ks[1], (DEPTH, D_MODEL), 0.02),
        "w_in": nrm(ks[2], (DEPTH, D_MODEL, IN_COLS), D_MODEL ** -0.5),
        "gmlp_norm_g": 1.0 + nrm(ks[3], (DEPTH, MIX_A_WIDTH), 0.02),
        "gmlp_w_s": nrm(ks[4], (DEPTH, A_GROUPS, A_BLOCK, A_BLOCK), A_BLOCK ** -0.5),
        "gmlp_b_s": 1.0 + nrm(ks[5], (DEPTH, A_GROUPS, A_BLOCK), 0.1),
        "q_norm_g": 1.0 + nrm(ks[6], (DEPTH, B_HEAD_DIM), 0.02),
        "k_norm_g": 1.0 + nrm(ks[7], (DEPTH, B_HEAD_DIM), 0.02),
        "rel_bias": nrm(ks[8], (DEPTH, B_HEADS, 2 * REL_CLIP + 1), 0.1),
        "w_out": nrm(ks[9], (DEPTH, D_MODEL, D_MODEL), D_MODEL ** -0.5),
        "ln_ffn_g": 1.0 + nrm(ks[10], (DEPTH, D_MODEL), 0.02),
        "peer_w_query": nrm(ks[11], (DEPTH, D_MODEL, PEER_HEADS * PEER_QDIM), D_MODEL ** -0.5),
        "peer_sub_keys": nrm(ks[12], (DEPTH, PEER_HEADS, 2, PEER_NKEYS, PEER_HALF), PEER_HALF ** -0.5),
        "peer_u": nrm(ks[13], (DEPTH, PEER_EXPERTS, D_MODEL), D_MODEL ** -0.5),
        "peer_v": nrm(ks[14], (DEPTH, PEER_EXPERTS, D_MODEL), 0.1),
    }


def reference(x, ln_mix_g, w_in, gmlp_norm_g, gmlp_w_s, gmlp_b_s, q_norm_g, k_norm_g, rel_bias,
              w_out, ln_ffn_g, peer_w_query, peer_sub_keys, peer_u, peer_v):
    a0, a1 = MIX_A_WIDTH, 2 * MIX_A_WIDTH
    q0, k0, v0 = a1, a1 + MIX_B_WIDTH, a1 + 2 * MIX_B_WIDTH
    for l in range(DEPTH):
        xn = rms_norm(x, ln_mix_g[l])
        proj = xn @ w_in[l]
        a_out = gmlp_spatial_gating(proj[..., :a0], proj[..., a0:a1],
                                    gmlp_norm_g[l], gmlp_w_s[l], gmlp_b_s[l])
        b_out = banded_chunk_attention(proj[..., q0:k0], proj[..., k0:v0], proj[..., v0:],
                                       q_norm_g[l], k_norm_g[l], rel_bias[l])
        x = x + jnp.concatenate([a_out, b_out], axis=-1) @ w_out[l]
        x = x + peer_ffn(rms_norm(x, ln_ffn_g[l]), peer_w_query[l], peer_sub_keys[l],
                         peer_u[l], peer_v[l])
    return x
```

```cpp
#include <hip/hip_runtime.h>
#include <hip/hip_cooperative_groups.h>
#include <cstdio>
namespace cg = cooperative_groups;

#ifndef FUSED
#define FUSED 1
#endif

typedef unsigned short u16;
using bf16x8 = __attribute__((ext_vector_type(8))) short;
using s16x4 = __attribute__((ext_vector_type(4))) short;
using f32x4 = __attribute__((ext_vector_type(4))) float;
using bf16x2 = __attribute__((ext_vector_type(2))) __bf16;

constexpr int T = 32768, DM = 1024, SEQ = 4096;
constexpr float EPS = 1e-6f;
constexpr size_t MiB = 1u << 20;
constexpr size_t OFF_XB = 0, OFF_WINT = 64 * MiB, OFF_WOUTT = 69 * MiB, OFF_WQT = 71 * MiB, OFF_KEYS = 75 * MiB,
                 OFF_RS = 76 * MiB, OFF_VSS = 76 * MiB + 512 * 1024, OFF_EU = 77 * MiB, OFF_EV = 109 * MiB,
                 OFF_U = 141 * MiB, OFF_GVT = 173 * MiB, OFF_QK = 205 * MiB, OFF_VT = 269 * MiB, OFF_AB = 301 * MiB,
                 OFF_HB = 365 * MiB, OFF_PQ = 141 * MiB  , OFF_EIDX = 429 * MiB,
                 OFF_BEST = 445 * MiB;

struct Params {
  const float *x, *ln_mix_g, *w_in, *gmlp_norm_g, *gmlp_w_s, *gmlp_b_s, *q_norm_g, *k_norm_g, *rel_bias, *w_out,
      *ln_ffn_g, *w_query, *sub_keys, *peer_u, *peer_v;
  float* out;
  char* ws;
};

constexpr int LDS_BYTES = 73728;
constexpr int LSTR = 144;
constexpr int OPER_BYTES = 128 * LSTR;

__device__ __forceinline__ u16 f2bf(float f) {
  unsigned u = __float_as_uint(f);
  u += 0x7fffu + ((u >> 16) & 1u);
  return (u16)(u >> 16);
}
__device__ __forceinline__ unsigned pack2(float lo, float hi) { return (unsigned)f2bf(lo) | ((unsigned)f2bf(hi) << 16); }
__device__ __forceinline__ float bf_lo(unsigned u) { return __uint_as_float(u << 16); }
__device__ __forceinline__ float bf_hi(unsigned u) { return __uint_as_float(u & 0xffff0000u); }
__device__ __forceinline__ float bf2f(u16 v) { return __uint_as_float(((unsigned)v) << 16); }
__device__ __forceinline__ float gelu_f(float x) {
  float z = 0.7978845608028654f * (x + 0.044715f * x * x * x);
  float e = __expf(2.f * z);
  float th = 1.f - 2.f / (1.f + e);
  return 0.5f * x * (1.f + th);
}
__device__ __forceinline__ float dot2(unsigned a, unsigned b, float acc) {
  return __builtin_amdgcn_fdot2_f32_bf16(__builtin_bit_cast(bf16x2, a), __builtin_bit_cast(bf16x2, b), acc, false);
}
__device__ __forceinline__ f32x4 mfma16(bf16x8 a, bf16x8 b, f32x4 c) {
  return __builtin_amdgcn_mfma_f32_16x16x32_bf16(a, b, c, 0, 0, 0);
}
__device__ __forceinline__ bf16x8 mk8(unsigned a, unsigned b, unsigned c, unsigned d) {
  uint4 u = make_uint4(a, b, c, d);
  return __builtin_bit_cast(bf16x8, u);
}
__device__ __forceinline__ unsigned okey(float x) {
  unsigned u = __float_as_uint(x);
  return (u & 0x80000000u) ? ~u : (u | 0x80000000u);
}


__device__ __forceinline__ int tid_() { int t = threadIdx.x; asm volatile("" : "+v"(t)); return t; }
__device__ __forceinline__ int bid_() { int b = blockIdx.x; asm volatile("" : "+s"(b)); return b; }
__device__ __forceinline__ void gemm_core(const u16* __restrict__ A, const u16* __restrict__ Bt, int K, int m0, int n0,
                                          char* lds, f32x4 (&acc)[4][4]) {
  const int tid = tid_(), lane = tid & 63, wave = tid >> 6;
  const int wr = wave >> 1, wc = wave & 1, l15 = lane & 15, g = lane >> 4;
#pragma unroll
  for (int i = 0; i < 4; ++i)
#pragma unroll
    for (int j = 0; j < 4; ++j) acc[i][j] = f32x4{0.f, 0.f, 0.f, 0.f};
  const int lrow = tid >> 3, kc = tid & 7;
  const u16* ap = A + (size_t)(m0 + lrow) * K + kc * 8;
  const u16* bp = Bt + (size_t)(n0 + lrow) * K + kc * 8;
  uint4 ra[4], rb[4];
#pragma unroll
  for (int i = 0; i < 4; ++i) {
    ra[i] = *(const uint4*)(ap + (size_t)(32 * i) * K);
    rb[i] = *(const uint4*)(bp + (size_t)(32 * i) * K);
  }
  char* As = lds;
  char* Bs = lds + 2 * OPER_BYTES;
  const int woff = lrow * LSTR + kc * 16;
#pragma unroll
  for (int i = 0; i < 4; ++i) {
    *(uint4*)(As + woff + i * 32 * LSTR) = ra[i];
    *(uint4*)(Bs + woff + i * 32 * LSTR) = rb[i];
  }
  __syncthreads();
  const int nk = K >> 6;
  for (int kt = 0; kt < nk; ++kt) {
    const int buf = kt & 1;
    if (kt + 1 < nk) {
#pragma unroll
      for (int i = 0; i < 4; ++i) {
        ra[i] = *(const uint4*)(ap + (size_t)(32 * i) * K + (kt + 1) * 64);
        rb[i] = *(const uint4*)(bp + (size_t)(32 * i) * K + (kt + 1) * 64);
      }
    }
    const char* Ab = As + buf * OPER_BYTES + (wr * 64 + l15) * LSTR + g * 16;
    const char* Bb = Bs + buf * OPER_BYTES + (wc * 64 + l15) * LSTR + g * 16;
#pragma unroll
    for (int ks = 0; ks < 2; ++ks) {
      bf16x8 af[4], bfr[4];
#pragma unroll
      for (int i = 0; i < 4; ++i) {
        af[i] = *(const bf16x8*)(Ab + i * 16 * LSTR + ks * 64);
        bfr[i] = *(const bf16x8*)(Bb + i * 16 * LSTR + ks * 64);
      }
#pragma unroll
      for (int i = 0; i < 4; ++i)
#pragma unroll
        for (int j = 0; j < 4; ++j) acc[i][j] = mfma16(af[i], bfr[j], acc[i][j]);
    }
    if (kt + 1 < nk) {
#pragma unroll
      for (int i = 0; i < 4; ++i) {
        *(uint4*)(As + (buf ^ 1) * OPER_BYTES + woff + i * 32 * LSTR) = ra[i];
        *(uint4*)(Bs + (buf ^ 1) * OPER_BYTES + woff + i * 32 * LSTR) = rb[i];
      }
    }
    __syncthreads();
  }
}

__device__ __forceinline__ void phase0(const Params& p, char* lds) {
  const int tid = tid_(), lane = tid & 63, wave = tid >> 6;
  const int nblk = gridDim.x, blk = bid_();
  u16* XB = (u16*)(p.ws + OFF_XB);
  float* RS = (float*)(p.ws + OFF_RS);
  float* VSS = (float*)(p.ws + OFF_VSS);
  for (int row = blk * 4 + wave; row < T; row += nblk * 4) {
    const float4* xr = (const float4*)(p.x + (size_t)row * DM);
    float4 v[4];
    float ss = 0.f;
#pragma unroll
    for (int i = 0; i < 4; ++i) {
      v[i] = xr[lane + 64 * i];
      ss += v[i].x * v[i].x + v[i].y * v[i].y + v[i].z * v[i].z + v[i].w * v[i].w;
    }
#pragma unroll
    for (int o = 1; o < 64; o <<= 1) ss += __shfl_xor(ss, o);
    if (lane == 0) RS[row] = rsqrtf(ss * (1.f / 1024.f) + EPS);
#pragma unroll
    for (int i = 0; i < 4; ++i) {
      uint2 o2 = make_uint2(pack2(v[i].x, v[i].y), pack2(v[i].z, v[i].w));
      *(uint2*)(XB + (size_t)row * DM + (lane + 64 * i) * 4) = o2;
    }
  }
  {
    u16* EU = (u16*)(p.ws + OFF_EU);
    u16* EV = (u16*)(p.ws + OFF_EV);
    const int NCH = 16384 * 128;
    for (int ch = blk * 256 + tid; ch < 2 * NCH; ch += nblk * 256) {
      const int which = ch >= NCH;
      const int idx = ch - which * NCH;
      const float4* src = (const float4*)((which ? p.peer_v : p.peer_u) + (size_t)idx * 8);
      float4 a = src[0], b = src[1];
      if (!which) {
        const float4* gp = (const float4*)(p.ln_ffn_g + (idx & 127) * 8);
        float4 g0 = gp[0], g1 = gp[1];
        a.x *= g0.x; a.y *= g0.y; a.z *= g0.z; a.w *= g0.w;
        b.x *= g1.x; b.y *= g1.y; b.z *= g1.z; b.w *= g1.w;
      }
      uint4 o = make_uint4(pack2(a.x, a.y), pack2(a.z, a.w), pack2(b.x, b.y), pack2(b.z, b.w));
      *(uint4*)((which ? EV : EU) + (size_t)idx * 8) = o;
    }
  }
  {
    float* tile = (float*)lds;
    for (int tl = blk; tl < 1408; tl += nblk) {
      const float* W; const float* gain; u16* dst; int N, kt, nt;
      if (tl < 640) { W = p.w_in; gain = p.ln_mix_g; dst = (u16*)(p.ws + OFF_WINT); N = 2560; kt = tl / 40; nt = tl % 40; }
      else if (tl < 896) { int t2 = tl - 640; W = p.w_out; gain = nullptr; dst = (u16*)(p.ws + OFF_WOUTT); N = 1024; kt = t2 / 16; nt = t2 % 16; }
      else { int t2 = tl - 896; W = p.w_query; gain = p.ln_ffn_g; dst = (u16*)(p.ws + OFF_WQT); N = 2048; kt = t2 / 32; nt = t2 % 32; }
      __syncthreads();
#pragma unroll 4
      for (int i = 0; i < 16; ++i) {
        const int kk = i * 4 + wave;
        const float gk = gain ? gain[kt * 64 + kk] : 1.f;
        tile[kk * 65 + lane] = W[(size_t)(kt * 64 + kk) * N + nt * 64 + lane] * gk;
      }
      __syncthreads();
#pragma unroll 4
      for (int i = 0; i < 16; ++i) {
        const int nn = i * 4 + wave;
        dst[(size_t)(nt * 64 + nn) * 1024 + kt * 64 + lane] = f2bf(tile[lane * 65 + nn]);
      }
    }
    __syncthreads();
  }
  {
    u16* KEYS = (u16*)(p.ws + OFF_KEYS);
    for (int i = blk * 256 + tid; i < 262144 / 4; i += nblk * 256) {
      float4 a = ((const float4*)p.sub_keys)[i];
      *(uint2*)(KEYS + (size_t)i * 4) = make_uint2(pack2(a.x, a.y), pack2(a.z, a.w));
    }
  }
  for (int i = blk * 256 + tid; i < T; i += nblk * 256) VSS[i] = 0.f;
}

__device__ __forceinline__ void phase1(const Params& p, char* lds) {
  const int tid = tid_(), lane = tid & 63, wave = tid >> 6;
  const int wr = wave >> 1, wc = wave & 1, l15 = lane & 15, g = lane >> 4;
  const u16* XB = (const u16*)(p.ws + OFF_XB);
  const u16* WINT = (const u16*)(p.ws + OFF_WINT);
  const float* RS = (const float*)(p.ws + OFF_RS);
  float* VSS = (float*)(p.ws + OFF_VSS);
  u16* U = (u16*)(p.ws + OFF_U);
  u16* GVT = (u16*)(p.ws + OFF_GVT);
  u16* QK = (u16*)(p.ws + OFF_QK);
  u16* VT = (u16*)(p.ws + OFF_VT);
  for (int tl = bid_(); tl < 256 * 20; tl += gridDim.x) {
    const int m0 = (tl / 20) * 128, n0 = (tl % 20) * 128;
    f32x4 acc[4][4];
    gemm_core(XB, WINT, 1024, m0, n0, lds, acc);
    const int region = n0 >> 9;
#pragma unroll
    for (int mi = 0; mi < 4; ++mi) {
      const int mb = m0 + wr * 64 + mi * 16 + g * 4;
      const float4 r4 = *(const float4*)(RS + mb);
      const float r[4] = {r4.x, r4.y, r4.z, r4.w};
      const int b = mb >> 12, s = mb & 4095;
      float ss[4] = {0.f, 0.f, 0.f, 0.f};
#pragma unroll
      for (int ni = 0; ni < 4; ++ni) {
        const int n = n0 + wc * 64 + ni * 16 + l15;
        float v[4];
#pragma unroll
        for (int j = 0; j < 4; ++j) v[j] = acc[mi][ni][j] * r[j];
        if (region == 0) {
#pragma unroll
          for (int j = 0; j < 4; ++j) U[(size_t)(mb + j) * 512 + n] = f2bf(gelu_f(v[j]));
        } else if (region == 1) {
#pragma unroll
          for (int j = 0; j < 4; ++j) { v[j] = gelu_f(v[j]); ss[j] += v[j] * v[j]; }
          *(uint2*)(GVT + ((size_t)b * 512 + (n - 512)) * SEQ + s) = make_uint2(pack2(v[0], v[1]), pack2(v[2], v[3]));
        } else if (region < 4) {
#pragma unroll
          for (int j = 0; j < 4; ++j) QK[(size_t)(mb + j) * 1024 + (n - 1024)] = f2bf(v[j]);
        } else {
          *(uint2*)(VT + ((size_t)b * 512 + (n - 2048)) * SEQ + s) = make_uint2(pack2(v[0], v[1]), pack2(v[2], v[3]));
        }
      }
      if (region == 1) {
#pragma unroll
        for (int j = 0; j < 4; ++j) {
          float sv = ss[j];
          sv += __shfl_xor(sv, 1); sv += __shfl_xor(sv, 2); sv += __shfl_xor(sv, 4); sv += __shfl_xor(sv, 8);
          if (l15 == 0) atomicAdd(VSS + mb + j, sv);
        }
      }
    }
  }
}

__device__ __forceinline__ void gmlp_item(const Params& p, int item) {
  const int tid = tid_(), lane = tid & 63, wave = tid >> 6, l15 = lane & 15, g = lane >> 4;
  const int gr = item & 7, n = (item >> 3) & 31, b = item >> 8;
  const int t0 = b * SEQ + n * 128;
  const float* VSS = (const float*)(p.ws + OFF_VSS);
  const u16* GVT = (const u16*)(p.ws + OFF_GVT);
  const u16* U = (const u16*)(p.ws + OFF_U);
  u16* AB = (u16*)(p.ws + OFF_AB);
  f32x4 acc[2][4];
#pragma unroll
  for (int i = 0; i < 2; ++i)
#pragma unroll
    for (int j = 0; j < 4; ++j) acc[i][j] = f32x4{0.f, 0.f, 0.f, 0.f};
  const int i_base = wave * 32;
  const int nks = (wave < 2) ? 2 : 4;
  for (int ks = 0; ks < nks; ++ks) {
    const int j0 = ks * 32 + g * 8;
    const float4 s0 = *(const float4*)(VSS + t0 + j0), s1 = *(const float4*)(VSS + t0 + j0 + 4);
    float r[8] = {s0.x, s0.y, s0.z, s0.w, s1.x, s1.y, s1.z, s1.w};
#pragma unroll
    for (int q = 0; q < 8; ++q) r[q] = rsqrtf(r[q] * (1.f / 512.f) + EPS);
    bf16x8 af[2];
#pragma unroll
    for (int mi = 0; mi < 2; ++mi) {
      const int i = i_base + mi * 16 + l15;
      const float* wp = p.gmlp_w_s + ((size_t)(gr * 128 + i)) * 128 + j0;
      const float4 w0 = *(const float4*)wp, w1 = *(const float4*)(wp + 4);
      af[mi] = mk8(pack2(w0.x * r[0], w0.y * r[1]), pack2(w0.z * r[2], w0.w * r[3]), pack2(w1.x * r[4], w1.y * r[5]),
                   pack2(w1.z * r[6], w1.w * r[7]));
    }
#pragma unroll
    for (int ni = 0; ni < 4; ++ni) {
      const int c = ni * 16 + l15;
      const bf16x8 bfr = *(const bf16x8*)(GVT + ((size_t)b * 512 + gr * 64 + c) * SEQ + n * 128 + j0);
#pragma unroll
      for (int mi = 0; mi < 2; ++mi) acc[mi][ni] = mfma16(af[mi], bfr, acc[mi][ni]);
    }
  }
#pragma unroll
  for (int mi = 0; mi < 2; ++mi) {
#pragma unroll
    for (int ni = 0; ni < 4; ++ni) {
      const int c = ni * 16 + l15, ch = gr * 64 + c;
      const float ng = p.gmlp_norm_g[ch];
#pragma unroll
      for (int j = 0; j < 4; ++j) {
        const int i = i_base + mi * 16 + g * 4 + j;
        const size_t t = (size_t)t0 + i;
        const float sp = acc[mi][ni][j] * ng + p.gmlp_b_s[gr * 128 + i];
        AB[t * 1024 + ch] = f2bf(bf2f(U[t * 512 + ch]) * sp);
      }
    }
  }
}

__device__ __forceinline__ void attn_item(const Params& p, int item, char* lds) {
  const int tid = tid_(), lane = tid & 63, wave = tid >> 6, l15 = lane & 15, g = lane >> 4;
  const int c = item & 63, h = (item >> 6) & 7, b = item >> 9;
  const u16* QK = (const u16*)(p.ws + OFF_QK);
  const u16* VT = (const u16*)(p.ws + OFF_VT);
  u16* AB = (u16*)(p.ws + OFF_AB);
  char* Ks = lds;
  char* Vs = lds + 64 * LSTR;
  float* bias_s = (float*)(lds + 2 * 64 * LSTR);
  __syncthreads();
  for (int i = tid; i < 257; i += 256) bias_s[i] = p.rel_bias[h * 257 + i];
  const size_t tq = (size_t)b * SEQ + c * 64 + wave * 16 + l15;
  bf16x8 qb0, qb1;
  {
    const u16* qp = QK + tq * 1024 + h * 64 + g * 8;
    const uint4 q0 = *(const uint4*)qp, q1 = *(const uint4*)(qp + 32);
    float f[16] = {bf_lo(q0.x), bf_hi(q0.x), bf_lo(q0.y), bf_hi(q0.y), bf_lo(q0.z), bf_hi(q0.z), bf_lo(q0.w), bf_hi(q0.w),
                   bf_lo(q1.x), bf_hi(q1.x), bf_lo(q1.y), bf_hi(q1.y), bf_lo(q1.z), bf_hi(q1.z), bf_lo(q1.w), bf_hi(q1.w)};
    float ss = 0.f;
#pragma unroll
    for (int i = 0; i < 16; ++i) ss += f[i] * f[i];
    ss += __shfl_xor(ss, 16); ss += __shfl_xor(ss, 32);
    const float rq = rsqrtf(ss * (1.f / 64.f) + EPS) * 0.125f;
    const float4 ga = *(const float4*)(p.q_norm_g + g * 8), gb = *(const float4*)(p.q_norm_g + g * 8 + 4);
    const float4 gc = *(const float4*)(p.q_norm_g + 32 + g * 8), gd = *(const float4*)(p.q_norm_g + 32 + g * 8 + 4);
    const float gg[16] = {ga.x, ga.y, ga.z, ga.w, gb.x, gb.y, gb.z, gb.w, gc.x, gc.y, gc.z, gc.w, gd.x, gd.y, gd.z, gd.w};
#pragma unroll
    for (int i = 0; i < 16; ++i) f[i] *= rq * gg[i];
    qb0 = mk8(pack2(f[0], f[1]), pack2(f[2], f[3]), pack2(f[4], f[5]), pack2(f[6], f[7]));
    qb1 = mk8(pack2(f[8], f[9]), pack2(f[10], f[11]), pack2(f[12], f[13]), pack2(f[14], f[15]));
  }
  f32x4 o[4];
#pragma unroll
  for (int i = 0; i < 4; ++i) o[i] = f32x4{0.f, 0.f, 0.f, 0.f};
  float m_run = -1e30f, l_run = 0.f;
  const int srow = tid >> 2, spart = tid & 3;
  float kg[16];
  {
    const float4* kgp = (const float4*)(p.k_norm_g + spart * 16);
    const float4 a = kgp[0], bq = kgp[1], cq = kgp[2], d = kgp[3];
    kg[0] = a.x; kg[1] = a.y; kg[2] = a.z; kg[3] = a.w; kg[4] = bq.x; kg[5] = bq.y; kg[6] = bq.z; kg[7] = bq.w;
    kg[8] = cq.x; kg[9] = cq.y; kg[10] = cq.z; kg[11] = cq.w; kg[12] = d.x; kg[13] = d.y; kg[14] = d.z; kg[15] = d.w;
  }
  const int kc_lo = (c >= 8) ? 0 : (8 - c);
  for (int kc = kc_lo; kc <= 8; ++kc) {
    const int kchunk = c - 8 + kc;
    __syncthreads();
    {
      const size_t tk = (size_t)b * SEQ + kchunk * 64 + srow;
      const u16* kp = QK + tk * 1024 + 512 + h * 64 + spart * 16;
      const uint4 k0 = *(const uint4*)kp, k1 = *(const uint4*)(kp + 8);
      const u16* vp = VT + ((size_t)b * 512 + h * 64 + srow) * SEQ + kchunk * 64 + spart * 16;
      const uint4 v0 = *(const uint4*)vp, v1 = *(const uint4*)(vp + 8);
      float f[16] = {bf_lo(k0.x), bf_hi(k0.x), bf_lo(k0.y), bf_hi(k0.y), bf_lo(k0.z), bf_hi(k0.z), bf_lo(k0.w), bf_hi(k0.w),
                     bf_lo(k1.x), bf_hi(k1.x), bf_lo(k1.y), bf_hi(k1.y), bf_lo(k1.z), bf_hi(k1.z), bf_lo(k1.w), bf_hi(k1.w)};
      float ss = 0.f;
#pragma unroll
      for (int i = 0; i < 16; ++i) ss += f[i] * f[i];
      ss += __shfl_xor(ss, 1); ss += __shfl_xor(ss, 2);
      const float rk = rsqrtf(ss * (1.f / 64.f) + EPS);
#pragma unroll
      for (int i = 0; i < 16; ++i) f[i] *= rk * kg[i];
      char* kd = Ks + srow * LSTR + spart * 32;
      *(uint4*)kd = make_uint4(pack2(f[0], f[1]), pack2(f[2], f[3]), pack2(f[4], f[5]), pack2(f[6], f[7]));
      *(uint4*)(kd + 16) = make_uint4(pack2(f[8], f[9]), pack2(f[10], f[11]), pack2(f[12], f[13]), pack2(f[14], f[15]));
      char* vd = Vs + srow * LSTR + spart * 32;
      *(uint4*)vd = v0;
      *(uint4*)(vd + 16) = v1;
    }
    __syncthreads();
    f32x4 s[4];
#pragma unroll
    for (int mt = 0; mt < 4; ++mt) {
      const char* kr = Ks + (mt * 16 + l15) * LSTR + g * 16;
      const bf16x8 a0 = *(const bf16x8*)kr, a1 = *(const bf16x8*)(kr + 64);
      s[mt] = mfma16(a0, qb0, f32x4{0.f, 0.f, 0.f, 0.f});
      s[mt] = mfma16(a1, qb1, s[mt]);
    }
    if (kc <= 5) {
      const float bc = bias_s[256];
#pragma unroll
      for (int mt = 0; mt < 4; ++mt)
#pragma unroll
        for (int j = 0; j < 4; ++j) s[mt][j] += bc;
    } else {
      const int qi = wave * 16 + l15 + 64 * (8 - kc);
#pragma unroll
      for (int mt = 0; mt < 4; ++mt)
#pragma unroll
        for (int j = 0; j < 4; ++j) {
          int rel = qi - (mt * 16 + g * 4 + j);
          rel = rel > 128 ? 128 : rel;
          s[mt][j] += bias_s[rel + 128];
        }
    }
    float mx = s[0][0];
#pragma unroll
    for (int mt = 0; mt < 4; ++mt)
#pragma unroll
      for (int j = 0; j < 4; ++j) mx = fmaxf(mx, s[mt][j]);
    mx = fmaxf(mx, __shfl_xor(mx, 16));
    mx = fmaxf(mx, __shfl_xor(mx, 32));
    const float m_new = fmaxf(m_run, mx);
    const float alpha = __expf(m_run - m_new);
    m_run = m_new;
    float ls = 0.f;
#pragma unroll
    for (int mt = 0; mt < 4; ++mt)
#pragma unroll
      for (int j = 0; j < 4; ++j) { s[mt][j] = __expf(s[mt][j] - m_new); ls += s[mt][j]; }
    l_run = l_run * alpha + ls;
#pragma unroll
    for (int mt = 0; mt < 4; ++mt)
#pragma unroll
      for (int j = 0; j < 4; ++j) o[mt][j] *= alpha;
#pragma unroll
    for (int k2 = 0; k2 < 2; ++k2) {
      const bf16x8 pb = mk8(pack2(s[2 * k2][0], s[2 * k2][1]), pack2(s[2 * k2][2], s[2 * k2][3]),
                            pack2(s[2 * k2 + 1][0], s[2 * k2 + 1][1]), pack2(s[2 * k2 + 1][2], s[2 * k2 + 1][3]));
#pragma unroll
      for (int mt = 0; mt < 4; ++mt) {
        const char* vr = Vs + (mt * 16 + l15) * LSTR + (32 * k2 + 4 * g) * 2;
        const uint2 va = *(const uint2*)vr, vb = *(const uint2*)(vr + 32);
        o[mt] = mfma16(mk8(va.x, va.y, vb.x, vb.y), pb, o[mt]);
      }
    }
  }
  float l = l_run;
  l += __shfl_xor(l, 16); l += __shfl_xor(l, 32);
  const float inv = 1.f / l;
#pragma unroll
  for (int mt = 0; mt < 4; ++mt) {
    *(uint2*)(AB + tq * 1024 + 512 + h * 64 + mt * 16 + g * 4) =
        make_uint2(pack2(o[mt][0] * inv, o[mt][1] * inv), pack2(o[mt][2] * inv, o[mt][3] * inv));
  }
}

__device__ __forceinline__ void phase2(const Params& p, char* lds) {
  for (int it = bid_(); it < 4096 + 2048; it += gridDim.x) {
    if (it < 4096) attn_item(p, it, lds);
    else gmlp_item(p, it - 4096);
  }
}

__device__ __forceinline__ void phase3(const Params& p, char* lds) {
  const int tid = tid_(), lane = tid & 63, wave = tid >> 6;
  const int wr = wave >> 1, wc = wave & 1, l15 = lane & 15, g = lane >> 4;
  const u16* AB = (const u16*)(p.ws + OFF_AB);
  const u16* WOUTT = (const u16*)(p.ws + OFF_WOUTT);
  u16* HB = (u16*)(p.ws + OFF_HB);
  for (int tl = bid_(); tl < 256 * 8; tl += gridDim.x) {
    const int m0 = (tl >> 3) * 128, n0 = (tl & 7) * 128;
    f32x4 acc[4][4];
    gemm_core(AB, WOUTT, 1024, m0, n0, lds, acc);
#pragma unroll
    for (int mi = 0; mi < 4; ++mi) {
      const int mb = m0 + wr * 64 + mi * 16 + g * 4;
      asm volatile("" ::: "memory");
#pragma unroll
      for (int ni = 0; ni < 4; ++ni) {
        const int n = n0 + wc * 64 + ni * 16 + l15;
#pragma unroll
        for (int j = 0; j < 4; ++j) {
          const size_t idx = (size_t)(mb + j) * 1024 + n;
          const float hv = p.x[idx] + acc[mi][ni][j];
          p.out[idx] = hv;
          HB[idx] = f2bf(hv);
        }
      }
    }
  }
}

__device__ __forceinline__ void phase4(const Params& p, char* lds) {
  const int tid = tid_(), lane = tid & 63, wave = tid >> 6;
  const int wr = wave >> 1, wc = wave & 1, l15 = lane & 15, g = lane >> 4;
  const u16* HB = (const u16*)(p.ws + OFF_HB);
  const u16* WQT = (const u16*)(p.ws + OFF_WQT);
  u16* PQ = (u16*)(p.ws + OFF_PQ);
  for (int tl = bid_(); tl < 256 * 16; tl += gridDim.x) {
    const int m0 = (tl >> 4) * 128, n0 = (tl & 15) * 128;
    f32x4 acc[4][4];
    gemm_core(HB, WQT, 1024, m0, n0, lds, acc);
#pragma unroll
    for (int mi = 0; mi < 4; ++mi) {
      const int mb = m0 + wr * 64 + mi * 16 + g * 4;
#pragma unroll
      for (int ni = 0; ni < 4; ++ni) {
        const int n = n0 + wc * 64 + ni * 16 + l15;
#pragma unroll
        for (int j = 0; j < 4; ++j) PQ[(size_t)(mb + j) * 2048 + n] = f2bf(acc[mi][ni][j]);
      }
    }
  }
}

#define INS16(KEY)                                            \
  do {                                                        \
    unsigned _k = (KEY);                                      \
    _Pragma("unroll") for (int _q = 0; _q < 16; ++_q) {       \
      const unsigned _hi = max(tv[_q], _k);                   \
      _k = min(tv[_q], _k);                                   \
      tv[_q] = _hi;                                           \
    }                                                         \
  } while (0)

__device__ __forceinline__ void select_item(const Params& p, int item, char* lds) {
  const int tid = tid_(), lane = tid & 63, wave = tid >> 6, l15 = lane & 15, g = lane >> 4;
  const int h = item & 7, t0 = (item >> 3) * 64;
  const u16* PQ = (const u16*)(p.ws + OFF_PQ);
  const u16* KEYS = (const u16*)(p.ws + OFF_KEYS);
  int* EIDX = (int*)(p.ws + OFF_EIDX);
  float* BEST = (float*)(p.ws + OFF_BEST);
  float* sc = (float*)lds;
  __syncthreads();
  {
    const u16* qp = PQ + (size_t)(t0 + wave * 16 + l15) * 2048 + h * 256 + g * 8;
#pragma unroll
    for (int pp = 0; pp < 2; ++pp) {
      bf16x8 qf[4];
#pragma unroll
      for (int ks = 0; ks < 4; ++ks) qf[ks] = *(const bf16x8*)(qp + pp * 128 + ks * 32);
#pragma unroll
      for (int nt = 0; nt < 8; ++nt) {
        const u16* kp = KEYS + ((size_t)((h * 2 + pp) * 128 + nt * 16 + l15)) * 128 + g * 8;
        f32x4 a = f32x4{0.f, 0.f, 0.f, 0.f};
#pragma unroll
        for (int ks = 0; ks < 4; ++ks) a = mfma16(qf[ks], *(const bf16x8*)(kp + ks * 32), a);
#pragma unroll
        for (int j = 0; j < 4; ++j) sc[(wave * 16 + g * 4 + j) * 257 + pp * 128 + nt * 16 + l15] = a[j];
      }
    }
  }
  __syncthreads();
  if (tid < 128) {
    const int row = tid & 63, pp = tid >> 6;
    float* srow = sc + row * 257 + pp * 128;
    unsigned tv[16];
#pragma unroll
    for (int q = 0; q < 16; ++q) tv[q] = 0u;
#pragma unroll 4
    for (int k = 0; k < 128; ++k) {
      const unsigned key = (okey(srow[k]) & ~127u) | (unsigned)(127 - k);
      INS16(key);
    }
    float vals[16];
    int idxs[16];
#pragma unroll
    for (int q = 0; q < 16; ++q) { idxs[q] = 127 - (int)(tv[q] & 127u); vals[q] = srow[idxs[q]]; }
#pragma unroll
    for (int q = 0; q < 16; ++q) { srow[q] = vals[q]; ((int*)srow)[16 + q] = idxs[q]; }
  }
  __syncthreads();
  if (tid < 64) {
    const int row = tid;
    const float* r0 = sc + row * 257;
    const float* r1 = r0 + 128;
    float s0[16], s1[16];
#pragma unroll
    for (int q = 0; q < 16; ++q) { s0[q] = r0[q]; s1[q] = r1[q]; }
    unsigned tv[16];
#pragma unroll
    for (int q = 0; q < 16; ++q) tv[q] = 0u;
#pragma unroll
    for (int a = 0; a < 16; ++a) {
#pragma unroll
      for (int bb = 0; bb < 16; ++bb) {
        if ((a + 1) * (bb + 1) <= 16) {
          const unsigned key = (okey(s0[a] + s1[bb]) & ~255u) | (unsigned)(255 - (a * 16 + bb));
          INS16(key);
        }
      }
    }
    const size_t ob = ((size_t)(t0 + row) * 8 + h) * 16;
#pragma unroll
    for (int q = 0; q < 16; ++q) {
      const int code = 255 - (int)(tv[q] & 255u);
      const int a = code >> 4, bb = code & 15;
      const float best = r0[a] + r1[bb];
      const int e = ((const int*)r0)[16 + a] * 128 + ((const int*)r1)[16 + bb];
      EIDX[ob + q] = e;
      BEST[ob + q] = best;
    }
  }
}

__device__ __forceinline__ void phase5(const Params& p, char* lds) {
  for (int it = bid_(); it < 512 * 8; it += gridDim.x) select_item(p, it, lds);
}

__device__ __forceinline__ void phase6(const Params& p, char* lds) {
  const int tid = tid_(), lane = tid & 63, wave = tid >> 6, l15 = lane & 15, g = lane >> 4;
  const u16* HB = (const u16*)(p.ws + OFF_HB);
  const u16* EU = (const u16*)(p.ws + OFF_EU);
  const u16* EV = (const u16*)(p.ws + OFF_EV);
  const int* EIDX = (const int*)(p.ws + OFF_EIDX);
  const float* BEST = (const float*)(p.ws + OFF_BEST);
  float* wl = (float*)lds + wave * 128;
  for (int t = bid_() * 4 + wave; t < T; t += gridDim.x * 4) {
    uint4 hv[8];
    {
      const u16* hrow = HB + (size_t)t * 1024 + l15 * 8;
#pragma unroll
      for (int i = 0; i < 8; ++i) hv[i] = *(const uint4*)(hrow + i * 128);
    }
    float ss = 0.f;
#pragma unroll
    for (int i = 0; i < 8; ++i) {
      ss = dot2(hv[i].x, hv[i].x, ss); ss = dot2(hv[i].y, hv[i].y, ss);
      ss = dot2(hv[i].z, hv[i].z, ss); ss = dot2(hv[i].w, hv[i].w, ss);
    }
    ss += __shfl_xor(ss, 1); ss += __shfl_xor(ss, 2); ss += __shfl_xor(ss, 4); ss += __shfl_xor(ss, 8);
    const float rs2 = rsqrtf(ss * (1.f / 1024.f) + EPS);
    const int ea = EIDX[(size_t)t * 128 + lane], eb = EIDX[(size_t)t * 128 + 64 + lane];
    float ga, gb;
    {
      const float ba = BEST[(size_t)t * 128 + lane] * rs2, bb = BEST[(size_t)t * 128 + 64 + lane] * rs2;
      float ma = ba, mb = bb;
#pragma unroll
      for (int o = 1; o < 16; o <<= 1) { ma = fmaxf(ma, __shfl_xor(ma, o)); mb = fmaxf(mb, __shfl_xor(mb, o)); }
      const float xa = __expf(ba - ma), xb = __expf(bb - mb);
      float sa = xa, sb = xb;
#pragma unroll
      for (int o = 1; o < 16; o <<= 1) { sa += __shfl_xor(sa, o); sb += __shfl_xor(sb, o); }
      ga = xa / sa; gb = xb / sb;
    }
#pragma unroll 2
    for (int it = 0; it < 32; ++it) {
      const int k = it * 4 + g;
      const int e = __shfl((it < 16) ? ea : eb, k & 63);
      const float gk = __shfl((it < 16) ? ga : gb, k & 63);
      const u16* urow = EU + (size_t)e * 1024 + l15 * 8;
      uint4 uv[8];
#pragma unroll
      for (int i = 0; i < 8; ++i) uv[i] = *(const uint4*)(urow + i * 128);
      float d0 = 0.f, d1 = 0.f;
#pragma unroll
      for (int i = 0; i < 8; ++i) {
        d0 = dot2(uv[i].x, hv[i].x, d0); d1 = dot2(uv[i].y, hv[i].y, d1);
        d0 = dot2(uv[i].z, hv[i].z, d0); d1 = dot2(uv[i].w, hv[i].w, d1);
      }
      float d = d0 + d1;
      d += __shfl_xor(d, 1); d += __shfl_xor(d, 2); d += __shfl_xor(d, 4); d += __shfl_xor(d, 8);
      const float hk = gelu_f(d * rs2);
      if (l15 == 0) wl[k] = gk * hk;
    }
    float acc[64];
#pragma unroll
    for (int i = 0; i < 64; ++i) acc[i] = 0.f;
#pragma unroll 2
    for (int it = 0; it < 32; ++it) {
      const int k = it * 4 + g;
      const int e = __shfl((it < 16) ? ea : eb, k & 63);
      const float wk = wl[k];
      const u16* vrow = EV + (size_t)e * 1024 + l15 * 8;
      uint4 vv[8];
#pragma unroll
      for (int i = 0; i < 8; ++i) vv[i] = *(const uint4*)(vrow + i * 128);
#pragma unroll
      for (int i = 0; i < 8; ++i) {
        acc[i * 8 + 0] += wk * bf_lo(vv[i].x); acc[i * 8 + 1] += wk * bf_hi(vv[i].x);
        acc[i * 8 + 2] += wk * bf_lo(vv[i].y); acc[i * 8 + 3] += wk * bf_hi(vv[i].y);
        acc[i * 8 + 4] += wk * bf_lo(vv[i].z); acc[i * 8 + 5] += wk * bf_hi(vv[i].z);
        acc[i * 8 + 6] += wk * bf_lo(vv[i].w); acc[i * 8 + 7] += wk * bf_hi(vv[i].w);
      }
    }
    float r1[32];
    const bool hi2 = (g & 2) != 0;
#pragma unroll
    for (int i = 0; i < 32; ++i) {
      const float send = hi2 ? acc[i] : acc[i + 32];
      const float keep = hi2 ? acc[i + 32] : acc[i];
      r1[i] = keep + __shfl_xor(send, 32);
    }
    float r2[16];
    const bool hi1 = (g & 1) != 0;
#pragma unroll
    for (int i = 0; i < 16; ++i) {
      const float send = hi1 ? r1[i] : r1[i + 16];
      const float keep = hi1 ? r1[i + 16] : r1[i];
      r2[i] = keep + __shfl_xor(send, 16);
    }
    const int ci = (g >> 1) * 4 + (g & 1) * 2;
    float* orow = p.out + (size_t)t * 1024 + l15 * 8;
#pragma unroll
    for (int q = 0; q < 2; ++q) {
      float4* op = (float4*)(orow + (ci + q) * 128);
      float4 a = op[0], b = op[1];
      a.x += r2[q * 8 + 0]; a.y += r2[q * 8 + 1]; a.z += r2[q * 8 + 2]; a.w += r2[q * 8 + 3];
      b.x += r2[q * 8 + 4]; b.y += r2[q * 8 + 5]; b.z += r2[q * 8 + 6]; b.w += r2[q * 8 + 7];
      op[0] = a; op[1] = b;
    }
  }
}

__global__ void __launch_bounds__(256, 2) mega(Params p, int ph_lo, int ph_hi) {
  __shared__ __attribute__((aligned(16))) char lds[LDS_BYTES];
  cg::grid_group grid = cg::this_grid();
  for (int ph = ph_lo; ph < ph_hi; ++ph) {
    if (ph != ph_lo) grid.sync();
    switch (ph) {
#ifndef PMASK
#define PMASK 127
#endif
      case 0: if (PMASK & 1) phase0(p, lds); break;
      case 1: if (PMASK & 2) phase1(p, lds); break;
      case 2: if (PMASK & 4) phase2(p, lds); break;
      case 3: if (PMASK & 8) phase3(p, lds); break;
      case 4: if (PMASK & 16) phase4(p, lds); break;
      case 5: if (PMASK & 32) phase5(p, lds); break;
      default: if (PMASK & 64) phase6(p, lds); break;
    }
  }
}

extern "C" void kernel_launch(void* const* d_in, const int* in_sizes, int n_in, void* d_out, int out_size, void* d_ws,
                              size_t ws_size, hipStream_t stream) {
  static int grid_blocks = 0;
  if (!grid_blocks) {
    int dev = 0, cus = 0, per_cu = 0;
    hipGetDevice(&dev);
    hipDeviceGetAttribute(&cus, hipDeviceAttributeMultiprocessorCount, dev);
    hipOccupancyMaxActiveBlocksPerMultiprocessor(&per_cu, mega, 256, 0);
    if (per_cu > 2) per_cu = 2;
    grid_blocks = cus * per_cu;
  }
  Params p{};
  p.x = (const float*)d_in[0]; p.ln_mix_g = (const float*)d_in[1]; p.w_in = (const float*)d_in[2];
  p.gmlp_norm_g = (const float*)d_in[3]; p.gmlp_w_s = (const float*)d_in[4]; p.gmlp_b_s = (const float*)d_in[5];
  p.q_norm_g = (const float*)d_in[6]; p.k_norm_g = (const float*)d_in[7]; p.rel_bias = (const float*)d_in[8];
  p.w_out = (const float*)d_in[9]; p.ln_ffn_g = (const float*)d_in[10]; p.w_query = (const float*)d_in[11];
  p.sub_keys = (const float*)d_in[12]; p.peer_u = (const float*)d_in[13]; p.peer_v = (const float*)d_in[14];
  p.out = (float*)d_out; p.ws = (char*)d_ws;
#if FUSED
  int lo = 0, hi = 7;
  void* args[] = {&p, &lo, &hi};
  hipError_t e = hipLaunchCooperativeKernel((void*)mega, dim3(grid_blocks), dim3(256), args, 0, stream);
  if (e != hipSuccess) fprintf(stderr, "cooperative launch failed: %s (grid %d)\n", hipGetErrorString(e), grid_blocks);
#else
  for (int ph = 0; ph < 7; ++ph) mega<<<dim3(grid_blocks), dim3(256), 0, stream>>>(p, ph, ph + 1);
#endif
}
```

```cpp
#include <hip/hip_runtime.h>
#include <hip/hip_cooperative_groups.h>
#include <cstdio>
namespace cg = cooperative_groups;

#ifndef FUSED
#define FUSED 1
#endif

typedef unsigned short u16;
using bf16x8 = __attribute__((ext_vector_type(8))) short;
using s16x4 = __attribute__((ext_vector_type(4))) short;
using f32x4 = __attribute__((ext_vector_type(4))) float;
using bf16x2 = __attribute__((ext_vector_type(2))) __bf16;
using f32x2 = __attribute__((ext_vector_type(2))) float;

constexpr int T = 32768, DM = 1024, SEQ = 4096;
constexpr float EPS = 1e-6f;
constexpr size_t MiB = 1u << 20;
constexpr size_t OFF_XB = 0, OFF_WINT = 64 * MiB, OFF_WOUTT = 69 * MiB, OFF_WQT = 71 * MiB, OFF_KEYS = 75 * MiB,
                 OFF_RS = 76 * MiB, OFF_VSS = 76 * MiB + 512 * 1024, OFF_EU = 77 * MiB, OFF_EV = 109 * MiB,
                 OFF_U = 141 * MiB, OFF_GVT = 173 * MiB, OFF_QK = 205 * MiB, OFF_VT = 269 * MiB, OFF_AB = 301 * MiB,
                 OFF_HB = 365 * MiB, OFF_PQ = 141 * MiB  , OFF_EIDX = 429 * MiB,
                 OFF_BEST = 445 * MiB, OFF_ESC = 461 * MiB  ;

struct Params {
  const float *x, *ln_mix_g, *w_in, *gmlp_norm_g, *gmlp_w_s, *gmlp_b_s, *q_norm_g, *k_norm_g, *rel_bias, *w_out,
      *ln_ffn_g, *w_query, *sub_keys, *peer_u, *peer_v;
  float* out;
  char* ws;
};

constexpr int LDS_BYTES = 73728;
constexpr int LSTR = 144;
constexpr int OPER_BYTES = 128 * LSTR;

__device__ __forceinline__ u16 f2bf(float f) {
  unsigned u = __float_as_uint(f);
  u += 0x7fffu + ((u >> 16) & 1u);
  return (u16)(u >> 16);
}
__device__ __forceinline__ unsigned pack2(float lo, float hi) { return (unsigned)f2bf(lo) | ((unsigned)f2bf(hi) << 16); }
__device__ __forceinline__ float bf_lo(unsigned u) { return __uint_as_float(u << 16); }
__device__ __forceinline__ float bf_hi(unsigned u) { return __uint_as_float(u & 0xffff0000u); }
__device__ __forceinline__ float bf2f(u16 v) { return __uint_as_float(((unsigned)v) << 16); }
__device__ __forceinline__ float gelu_f(float x) {
  float z = 0.7978845608028654f * (x + 0.044715f * x * x * x);
  float e = __expf(2.f * z);
  float th = 1.f - 2.f / (1.f + e);
  return 0.5f * x * (1.f + th);
}
__device__ __forceinline__ float dot2(unsigned a, unsigned b, float acc) {
  return __builtin_amdgcn_fdot2_f32_bf16(__builtin_bit_cast(bf16x2, a), __builtin_bit_cast(bf16x2, b), acc, false);
}
__device__ __forceinline__ f32x4 mfma16(bf16x8 a, bf16x8 b, f32x4 c) {
  return __builtin_amdgcn_mfma_f32_16x16x32_bf16(a, b, c, 0, 0, 0);
}
__device__ __forceinline__ bf16x8 mk8(unsigned a, unsigned b, unsigned c, unsigned d) {
  uint4 u = make_uint4(a, b, c, d);
  return __builtin_bit_cast(bf16x8, u);
}
__device__ __forceinline__ unsigned pack4_fp8(float a, float b, float c, float d) {
  int r = 0;
  r = __builtin_amdgcn_cvt_pk_fp8_f32(a, b, r, false);
  r = __builtin_amdgcn_cvt_pk_fp8_f32(c, d, r, true);
  return (unsigned)r;
}
__device__ __forceinline__ unsigned okey(float x) {
  unsigned u = __float_as_uint(x);
  return (u & 0x80000000u) ? ~u : (u | 0x80000000u);
}


__device__ __forceinline__ int tid_() { int t = threadIdx.x; asm volatile("" : "+v"(t)); return t; }
__device__ __forceinline__ int bid_() { int b = blockIdx.x; asm volatile("" : "+s"(b)); return b; }
__device__ __forceinline__ void gemm_core(const u16* __restrict__ A, const u16* __restrict__ Bt, int K, int m0, int n0,
                                          char* lds, f32x4 (&acc)[4][4]) {
  const int tid = tid_(), lane = tid & 63, wave = tid >> 6;
  const int wr = wave >> 1, wc = wave & 1, l15 = lane & 15, g = lane >> 4;
#pragma unroll
  for (int i = 0; i < 4; ++i)
#pragma unroll
    for (int j = 0; j < 4; ++j) acc[i][j] = f32x4{0.f, 0.f, 0.f, 0.f};
  const int lrow = tid >> 3, kc = tid & 7;
  const u16* ap = A + (size_t)(m0 + lrow) * K + kc * 8;
  const u16* bp = Bt + (size_t)(n0 + lrow) * K + kc * 8;
  uint4 ra[4], rb[4];
#pragma unroll
  for (int i = 0; i < 4; ++i) {
    ra[i] = *(const uint4*)(ap + (size_t)(32 * i) * K);
    rb[i] = *(const uint4*)(bp + (size_t)(32 * i) * K);
  }
  char* As = lds;
  char* Bs = lds + 2 * OPER_BYTES;
  const int woff = lrow * LSTR + kc * 16;
#pragma unroll
  for (int i = 0; i < 4; ++i) {
    *(uint4*)(As + woff + i * 32 * LSTR) = ra[i];
    *(uint4*)(Bs + woff + i * 32 * LSTR) = rb[i];
  }
  __syncthreads();
  const int nk = K >> 6;
  for (int kt = 0; kt < nk; ++kt) {
    const int buf = kt & 1;
    if (kt + 1 < nk) {
#pragma unroll
      for (int i = 0; i < 4; ++i) {
        ra[i] = *(const uint4*)(ap + (size_t)(32 * i) * K + (kt + 1) * 64);
        rb[i] = *(const uint4*)(bp + (size_t)(32 * i) * K + (kt + 1) * 64);
      }
    }
    const char* Ab = As + buf * OPER_BYTES + (wr * 64 + l15) * LSTR + g * 16;
    const char* Bb = Bs + buf * OPER_BYTES + (wc * 64 + l15) * LSTR + g * 16;
#pragma unroll
    for (int ks = 0; ks < 2; ++ks) {
      bf16x8 af[4], bfr[4];
#pragma unroll
      for (int i = 0; i < 4; ++i) {
        af[i] = *(const bf16x8*)(Ab + i * 16 * LSTR + ks * 64);
        bfr[i] = *(const bf16x8*)(Bb + i * 16 * LSTR + ks * 64);
      }
#pragma unroll
      for (int i = 0; i < 4; ++i)
#pragma unroll
        for (int j = 0; j < 4; ++j) acc[i][j] = mfma16(af[i], bfr[j], acc[i][j]);
    }
    if (kt + 1 < nk) {
#pragma unroll
      for (int i = 0; i < 4; ++i) {
        *(uint4*)(As + (buf ^ 1) * OPER_BYTES + woff + i * 32 * LSTR) = ra[i];
        *(uint4*)(Bs + (buf ^ 1) * OPER_BYTES + woff + i * 32 * LSTR) = rb[i];
      }
    }
    __syncthreads();
  }
}

__device__ __forceinline__ void phase0(const Params& p, char* lds) {
  const int tid = tid_(), lane = tid & 63, wave = tid >> 6;
  const int nblk = gridDim.x, blk = bid_();
  u16* XB = (u16*)(p.ws + OFF_XB);
  float* RS = (float*)(p.ws + OFF_RS);
  float* VSS = (float*)(p.ws + OFF_VSS);
  for (int row = blk * 4 + wave; row < T; row += nblk * 4) {
    const float4* xr = (const float4*)(p.x + (size_t)row * DM);
    float4 v[4];
    float ss = 0.f;
#pragma unroll
    for (int i = 0; i < 4; ++i) {
      v[i] = xr[lane + 64 * i];
      ss += v[i].x * v[i].x + v[i].y * v[i].y + v[i].z * v[i].z + v[i].w * v[i].w;
    }
#pragma unroll
    for (int o = 1; o < 64; o <<= 1) ss += __shfl_xor(ss, o);
    if (lane == 0) RS[row] = rsqrtf(ss * (1.f / 1024.f) + EPS);
#pragma unroll
    for (int i = 0; i < 4; ++i) {
      uint2 o2 = make_uint2(pack2(v[i].x, v[i].y), pack2(v[i].z, v[i].w));
      *(uint2*)(XB + (size_t)row * DM + (lane + 64 * i) * 4) = o2;
    }
  }
  {
    unsigned char* EU8 = (unsigned char*)(p.ws + OFF_EU);
    unsigned char* EV8 = (unsigned char*)(p.ws + OFF_EV);
    float* ESC = (float*)(p.ws + OFF_ESC);
    for (int row = blk * 4 + wave; row < 32768; row += nblk * 4) {
      const bool isv = row >= 16384;
      const int e = row & 16383;
      const float4* src = (const float4*)((isv ? p.peer_v : p.peer_u) + (size_t)e * 1024);
      float4 v[4];
      float am = 0.f;
#pragma unroll
      for (int i = 0; i < 4; ++i) {
        v[i] = src[i * 64 + lane];
        if (!isv) {
          const float4 g4 = ((const float4*)p.ln_ffn_g)[i * 64 + lane];
          v[i].x *= g4.x; v[i].y *= g4.y; v[i].z *= g4.z; v[i].w *= g4.w;
        }
        am = fmaxf(am, fmaxf(fmaxf(fabsf(v[i].x), fabsf(v[i].y)), fmaxf(fabsf(v[i].z), fabsf(v[i].w))));
      }
#pragma unroll
      for (int o = 1; o < 64; o <<= 1) am = fmaxf(am, __shfl_xor(am, o));
      const int ex = (int)((__float_as_uint(am) >> 23) & 255u) - 127;
      const bool ok = (am > 1e-30f);
      const float scale = ok ? __uint_as_float((unsigned)(127 + 7 - ex) << 23) : 1.f;
      const float inv = ok ? __uint_as_float((unsigned)(127 - 7 + ex) << 23) : 1.f;
      unsigned* dst = (unsigned*)((isv ? EV8 : EU8) + (size_t)e * 1024);
#pragma unroll
      for (int i = 0; i < 4; ++i)
        dst[i * 64 + lane] = pack4_fp8(v[i].x * scale, v[i].y * scale, v[i].z * scale, v[i].w * scale);
      if (lane == 0) ESC[row] = inv;
    }
  }
  {
    float* tile = (float*)lds;
    for (int tl = blk; tl < 1408; tl += nblk) {
      const float* W; const float* gain; u16* dst; int N, kt, nt;
      if (tl < 640) { W = p.w_in; gain = p.ln_mix_g; dst = (u16*)(p.ws + OFF_WINT); N = 2560; kt = tl / 40; nt = tl % 40; }
      else if (tl < 896) { int t2 = tl - 640; W = p.w_out; gain = nullptr; dst = (u16*)(p.ws + OFF_WOUTT); N = 1024; kt = t2 / 16; nt = t2 % 16; }
      else { int t2 = tl - 896; W = p.w_query; gain = p.ln_ffn_g; dst = (u16*)(p.ws + OFF_WQT); N = 2048; kt = t2 / 32; nt = t2 % 32; }
      __syncthreads();
#pragma unroll 4
      for (int i = 0; i < 16; ++i) {
        const int kk = i * 4 + wave;
        const float gk = gain ? gain[kt * 64 + kk] : 1.f;
        tile[kk * 65 + lane] = W[(size_t)(kt * 64 + kk) * N + nt * 64 + lane] * gk;
      }
      __syncthreads();
#pragma unroll 4
      for (int i = 0; i < 16; ++i) {
        const int nn = i * 4 + wave;
        dst[(size_t)(nt * 64 + nn) * 1024 + kt * 64 + lane] = f2bf(tile[lane * 65 + nn]);
      }
    }
    __syncthreads();
  }
  {
    u16* KEYS = (u16*)(p.ws + OFF_KEYS);
    for (int i = blk * 256 + tid; i < 262144 / 4; i += nblk * 256) {
      float4 a = ((const float4*)p.sub_keys)[i];
      *(uint2*)(KEYS + (size_t)i * 4) = make_uint2(pack2(a.x, a.y), pack2(a.z, a.w));
    }
  }
  for (int i = blk * 256 + tid; i < T; i += nblk * 256) VSS[i] = 0.f;
}

__device__ __forceinline__ void phase1(const Params& p, char* lds) {
  const int tid = tid_(), lane = tid & 63, wave = tid >> 6;
  const int wr = wave >> 1, wc = wave & 1, l15 = lane & 15, g = lane >> 4;
  const u16* XB = (const u16*)(p.ws + OFF_XB);
  const u16* WINT = (const u16*)(p.ws + OFF_WINT);
  const float* RS = (const float*)(p.ws + OFF_RS);
  float* VSS = (float*)(p.ws + OFF_VSS);
  u16* U = (u16*)(p.ws + OFF_U);
  u16* GVT = (u16*)(p.ws + OFF_GVT);
  u16* QK = (u16*)(p.ws + OFF_QK);
  u16* VT = (u16*)(p.ws + OFF_VT);
  for (int tl = bid_(); tl < 256 * 20; tl += gridDim.x) {
    const int m0 = (tl / 20) * 128, n0 = (tl % 20) * 128;
    f32x4 acc[4][4];
    gemm_core(XB, WINT, 1024, m0, n0, lds, acc);
    const int region = n0 >> 9;
#pragma unroll
    for (int mi = 0; mi < 4; ++mi) {
      const int mb = m0 + wr * 64 + mi * 16 + g * 4;
      const float4 r4 = *(const float4*)(RS + mb);
      const float r[4] = {r4.x, r4.y, r4.z, r4.w};
      const int b = mb >> 12, s = mb & 4095;
      float ss[4] = {0.f, 0.f, 0.f, 0.f};
#pragma unroll
      for (int ni = 0; ni < 4; ++ni) {
        const int n = n0 + wc * 64 + ni * 16 + l15;
        float v[4];
#pragma unroll
        for (int j = 0; j < 4; ++j) v[j] = acc[mi][ni][j] * r[j];
        if (region == 0) {
#pragma unroll
          for (int j = 0; j < 4; ++j) U[(size_t)(mb + j) * 512 + n] = f2bf(gelu_f(v[j]));
        } else if (region == 1) {
#pragma unroll
          for (int j = 0; j < 4; ++j) { v[j] = gelu_f(v[j]); ss[j] += v[j] * v[j]; }
          *(uint2*)(GVT + ((size_t)b * 512 + (n - 512)) * SEQ + s) = make_uint2(pack2(v[0], v[1]), pack2(v[2], v[3]));
        } else if (region < 4) {
#pragma unroll
          for (int j = 0; j < 4; ++j) QK[(size_t)(mb + j) * 1024 + (n - 1024)] = f2bf(v[j]);
        } else {
          *(uint2*)(VT + ((size_t)b * 512 + (n - 2048)) * SEQ + s) = make_uint2(pack2(v[0], v[1]), pack2(v[2], v[3]));
        }
      }
      if (region == 1) {
#pragma unroll
        for (int j = 0; j < 4; ++j) {
          float sv = ss[j];
          sv += __shfl_xor(sv, 1); sv += __shfl_xor(sv, 2); sv += __shfl_xor(sv, 4); sv += __shfl_xor(sv, 8);
          if (l15 == 0) atomicAdd(VSS + mb + j, sv);
        }
      }
    }
  }
}

__device__ __forceinline__ void gmlp_item(const Params& p, int item) {
  const int tid = tid_(), lane = tid & 63, wave = tid >> 6, l15 = lane & 15, g = lane >> 4;
  const int gr = item & 7, n = (item >> 3) & 31, b = item >> 8;
  const int t0 = b * SEQ + n * 128;
  const float* VSS = (const float*)(p.ws + OFF_VSS);
  const u16* GVT = (const u16*)(p.ws + OFF_GVT);
  const u16* U = (const u16*)(p.ws + OFF_U);
  u16* AB = (u16*)(p.ws + OFF_AB);
  f32x4 acc[2][4];
#pragma unroll
  for (int i = 0; i < 2; ++i)
#pragma unroll
    for (int j = 0; j < 4; ++j) acc[i][j] = f32x4{0.f, 0.f, 0.f, 0.f};
  const int i_base = wave * 32;
  const int nks = (wave < 2) ? 2 : 4;
  for (int ks = 0; ks < nks; ++ks) {
    const int j0 = ks * 32 + g * 8;
    const float4 s0 = *(const float4*)(VSS + t0 + j0), s1 = *(const float4*)(VSS + t0 + j0 + 4);
    float r[8] = {s0.x, s0.y, s0.z, s0.w, s1.x, s1.y, s1.z, s1.w};
#pragma unroll
    for (int q = 0; q < 8; ++q) r[q] = rsqrtf(r[q] * (1.f / 512.f) + EPS);
    bf16x8 af[2];
#pragma unroll
    for (int mi = 0; mi < 2; ++mi) {
      const int i = i_base + mi * 16 + l15;
      const float* wp = p.gmlp_w_s + ((size_t)(gr * 128 + i)) * 128 + j0;
      const float4 w0 = *(const float4*)wp, w1 = *(const float4*)(wp + 4);
      af[mi] = mk8(pack2(w0.x * r[0], w0.y * r[1]), pack2(w0.z * r[2], w0.w * r[3]), pack2(w1.x * r[4], w1.y * r[5]),
                   pack2(w1.z * r[6], w1.w * r[7]));
    }
#pragma unroll
    for (int ni = 0; ni < 4; ++ni) {
      const int c = ni * 16 + l15;
      const bf16x8 bfr = *(const bf16x8*)(GVT + ((size_t)b * 512 + gr * 64 + c) * SEQ + n * 128 + j0);
#pragma unroll
      for (int mi = 0; mi < 2; ++mi) acc[mi][ni] = mfma16(af[mi], bfr, acc[mi][ni]);
    }
  }
#pragma unroll
  for (int mi = 0; mi < 2; ++mi) {
#pragma unroll
    for (int ni = 0; ni < 4; ++ni) {
      const int c = ni * 16 + l15, ch = gr * 64 + c;
      const float ng = p.gmlp_norm_g[ch];
#pragma unroll
      for (int j = 0; j < 4; ++j) {
        const int i = i_base + mi * 16 + g * 4 + j;
        const size_t t = (size_t)t0 + i;
        const float sp = acc[mi][ni][j] * ng + p.gmlp_b_s[gr * 128 + i];
        AB[t * 1024 + ch] = f2bf(bf2f(U[t * 512 + ch]) * sp);
      }
    }
  }
}

__device__ __forceinline__ void attn_item(const Params& p, int item, char* lds) {
  const int tid = tid_(), lane = tid & 63, wave = tid >> 6, l15 = lane & 15, g = lane >> 4;
  const int c = item & 63, h = (item >> 6) & 7, b = item >> 9;
  const u16* QK = (const u16*)(p.ws + OFF_QK);
  const u16* VT = (const u16*)(p.ws + OFF_VT);
  u16* AB = (u16*)(p.ws + OFF_AB);
  char* Ks = lds;
  char* Vs = lds + 64 * LSTR;
  float* bias_s = (float*)(lds + 2 * 64 * LSTR);
  __syncthreads();
  for (int i = tid; i < 257; i += 256) bias_s[i] = p.rel_bias[h * 257 + i];
  const size_t tq = (size_t)b * SEQ + c * 64 + wave * 16 + l15;
  bf16x8 qb0, qb1;
  {
    const u16* qp = QK + tq * 1024 + h * 64 + g * 8;
    const uint4 q0 = *(const uint4*)qp, q1 = *(const uint4*)(qp + 32);
    float f[16] = {bf_lo(q0.x), bf_hi(q0.x), bf_lo(q0.y), bf_hi(q0.y), bf_lo(q0.z), bf_hi(q0.z), bf_lo(q0.w), bf_hi(q0.w),
                   bf_lo(q1.x), bf_hi(q1.x), bf_lo(q1.y), bf_hi(q1.y), bf_lo(q1.z), bf_hi(q1.z), bf_lo(q1.w), bf_hi(q1.w)};
    float ss = 0.f;
#pragma unroll
    for (int i = 0; i < 16; ++i) ss += f[i] * f[i];
    ss += __shfl_xor(ss, 16); ss += __shfl_xor(ss, 32);
    const float rq = rsqrtf(ss * (1.f / 64.f) + EPS) * 0.125f;
    const float4 ga = *(const float4*)(p.q_norm_g + g * 8), gb = *(const float4*)(p.q_norm_g + g * 8 + 4);
    const float4 gc = *(const float4*)(p.q_norm_g + 32 + g * 8), gd = *(const float4*)(p.q_norm_g + 32 + g * 8 + 4);
    const float gg[16] = {ga.x, ga.y, ga.z, ga.w, gb.x, gb.y, gb.z, gb.w, gc.x, gc.y, gc.z, gc.w, gd.x, gd.y, gd.z, gd.w};
#pragma unroll
    for (int i = 0; i < 16; ++i) f[i] *= rq * gg[i];
    qb0 = mk8(pack2(f[0], f[1]), pack2(f[2], f[3]), pack2(f[4], f[5]), pack2(f[6], f[7]));
    qb1 = mk8(pack2(f[8], f[9]), pack2(f[10], f[11]), pack2(f[12], f[13]), pack2(f[14], f[15]));
  }
  f32x4 o[4];
#pragma unroll
  for (int i = 0; i < 4; ++i) o[i] = f32x4{0.f, 0.f, 0.f, 0.f};
  float m_run = -1e30f, l_run = 0.f;
  const int srow = tid >> 2, spart = tid & 3;
  float kg[16];
  {
    const float4* kgp = (const float4*)(p.k_norm_g + spart * 16);
    const float4 a = kgp[0], bq = kgp[1], cq = kgp[2], d = kgp[3];
    kg[0] = a.x; kg[1] = a.y; kg[2] = a.z; kg[3] = a.w; kg[4] = bq.x; kg[5] = bq.y; kg[6] = bq.z; kg[7] = bq.w;
    kg[8] = cq.x; kg[9] = cq.y; kg[10] = cq.z; kg[11] = cq.w; kg[12] = d.x; kg[13] = d.y; kg[14] = d.z; kg[15] = d.w;
  }
  const int kc_lo = (c >= 8) ? 0 : (8 - c);
  for (int kc = kc_lo; kc <= 8; ++kc) {
    const int kchunk = c - 8 + kc;
    __syncthreads();
    {
      const size_t tk = (size_t)b * SEQ + kchunk * 64 + srow;
      const u16* kp = QK + tk * 1024 + 512 + h * 64 + spart * 16;
      const uint4 k0 = *(const uint4*)kp, k1 = *(const uint4*)(kp + 8);
      const u16* vp = VT + ((size_t)b * 512 + h * 64 + srow) * SEQ + kchunk * 64 + spart * 16;
      const uint4 v0 = *(const uint4*)vp, v1 = *(const uint4*)(vp + 8);
      float f[16] = {bf_lo(k0.x), bf_hi(k0.x), bf_lo(k0.y), bf_hi(k0.y), bf_lo(k0.z), bf_hi(k0.z), bf_lo(k0.w), bf_hi(k0.w),
                     bf_lo(k1.x), bf_hi(k1.x), bf_lo(k1.y), bf_hi(k1.y), bf_lo(k1.z), bf_hi(k1.z), bf_lo(k1.w), bf_hi(k1.w)};
      float ss = 0.f;
#pragma unroll
      for (int i = 0; i < 16; ++i) ss += f[i] * f[i];
      ss += __shfl_xor(ss, 1); ss += __shfl_xor(ss, 2);
      const float rk = rsqrtf(ss * (1.f / 64.f) + EPS);
#pragma unroll
      for (int i = 0; i < 16; ++i) f[i] *= rk * kg[i];
      char* kd = Ks + srow * LSTR + spart * 32;
      *(uint4*)kd = make_uint4(pack2(f[0], f[1]), pack2(f[2], f[3]), pack2(f[4], f[5]), pack2(f[6], f[7]));
      *(uint4*)(kd + 16) = make_uint4(pack2(f[8], f[9]), pack2(f[10], f[11]), pack2(f[12], f[13]), pack2(f[14], f[15]));
      char* vd = Vs + srow * LSTR + spart * 32;
      *(uint4*)vd = v0;
      *(uint4*)(vd + 16) = v1;
    }
    __syncthreads();
    f32x4 s[4];
#pragma unroll
    for (int mt = 0; mt < 4; ++mt) {
      const char* kr = Ks + (mt * 16 + l15) * LSTR + g * 16;
      const bf16x8 a0 = *(const bf16x8*)kr, a1 = *(const bf16x8*)(kr + 64);
      s[mt] = mfma16(a0, qb0, f32x4{0.f, 0.f, 0.f, 0.f});
      s[mt] = mfma16(a1, qb1, s[mt]);
    }
    if (kc <= 5) {
      const float bc = bias_s[256];
#pragma unroll
      for (int mt = 0; mt < 4; ++mt)
#pragma unroll
        for (int j = 0; j < 4; ++j) s[mt][j] += bc;
    } else {
      const int qi = wave * 16 + l15 + 64 * (8 - kc);
#pragma unroll
      for (int mt = 0; mt < 4; ++mt)
#pragma unroll
        for (int j = 0; j < 4; ++j) {
          int rel = qi - (mt * 16 + g * 4 + j);
          rel = rel > 128 ? 128 : rel;
          s[mt][j] += bias_s[rel + 128];
        }
    }
    float mx = s[0][0];
#pragma unroll
    for (int mt = 0; mt < 4; ++mt)
#pragma unroll
      for (int j = 0; j < 4; ++j) mx = fmaxf(mx, s[mt][j]);
    mx = fmaxf(mx, __shfl_xor(mx, 16));
    mx = fmaxf(mx, __shfl_xor(mx, 32));
    const float m_new = fmaxf(m_run, mx);
    const float alpha = __expf(m_run - m_new);
    m_run = m_new;
    float ls = 0.f;
#pragma unroll
    for (int mt = 0; mt < 4; ++mt)
#pragma unroll
      for (int j = 0; j < 4; ++j) { s[mt][j] = __expf(s[mt][j] - m_new); ls += s[mt][j]; }
    l_run = l_run * alpha + ls;
#pragma unroll
    for (int mt = 0; mt < 4; ++mt)
#pragma unroll
      for (int j = 0; j < 4; ++j) o[mt][j] *= alpha;
#pragma unroll
    for (int k2 = 0; k2 < 2; ++k2) {
      const bf16x8 pb = mk8(pack2(s[2 * k2][0], s[2 * k2][1]), pack2(s[2 * k2][2], s[2 * k2][3]),
                            pack2(s[2 * k2 + 1][0], s[2 * k2 + 1][1]), pack2(s[2 * k2 + 1][2], s[2 * k2 + 1][3]));
#pragma unroll
      for (int mt = 0; mt < 4; ++mt) {
        const char* vr = Vs + (mt * 16 + l15) * LSTR + (32 * k2 + 4 * g) * 2;
        const uint2 va = *(const uint2*)vr, vb = *(const uint2*)(vr + 32);
        o[mt] = mfma16(mk8(va.x, va.y, vb.x, vb.y), pb, o[mt]);
      }
    }
  }
  float l = l_run;
  l += __shfl_xor(l, 16); l += __shfl_xor(l, 32);
  const float inv = 1.f / l;
#pragma unroll
  for (int mt = 0; mt < 4; ++mt) {
    *(uint2*)(AB + tq * 1024 + 512 + h * 64 + mt * 16 + g * 4) =
        make_uint2(pack2(o[mt][0] * inv, o[mt][1] * inv), pack2(o[mt][2] * inv, o[mt][3] * inv));
  }
}

__device__ __forceinline__ void phase2(const Params& p, char* lds) {
  for (int it = bid_(); it < 4096 + 2048; it += gridDim.x) {
    if (it < 4096) attn_item(p, it, lds);
    else gmlp_item(p, it - 4096);
  }
}

__device__ __forceinline__ void phase3(const Params& p, char* lds) {
  const int tid = tid_(), lane = tid & 63, wave = tid >> 6;
  const int wr = wave >> 1, wc = wave & 1, l15 = lane & 15, g = lane >> 4;
  const u16* AB = (const u16*)(p.ws + OFF_AB);
  const u16* WOUTT = (const u16*)(p.ws + OFF_WOUTT);
  u16* HB = (u16*)(p.ws + OFF_HB);
  for (int tl = bid_(); tl < 256 * 8; tl += gridDim.x) {
    const int m0 = (tl >> 3) * 128, n0 = (tl & 7) * 128;
    f32x4 acc[4][4];
    gemm_core(AB, WOUTT, 1024, m0, n0, lds, acc);
#pragma unroll
    for (int mi = 0; mi < 4; ++mi) {
      const int mb = m0 + wr * 64 + mi * 16 + g * 4;
      asm volatile("" ::: "memory");
#pragma unroll
      for (int ni = 0; ni < 4; ++ni) {
        const int n = n0 + wc * 64 + ni * 16 + l15;
#pragma unroll
        for (int j = 0; j < 4; ++j) {
          const size_t idx = (size_t)(mb + j) * 1024 + n;
          const float hv = p.x[idx] + acc[mi][ni][j];
          p.out[idx] = hv;
          HB[idx] = f2bf(hv);
        }
      }
    }
  }
}

__device__ __forceinline__ void phase4(const Params& p, char* lds) {
  const int tid = tid_(), lane = tid & 63, wave = tid >> 6;
  const int wr = wave >> 1, wc = wave & 1, l15 = lane & 15, g = lane >> 4;
  const u16* HB = (const u16*)(p.ws + OFF_HB);
  const u16* WQT = (const u16*)(p.ws + OFF_WQT);
  u16* PQ = (u16*)(p.ws + OFF_PQ);
  for (int tl = bid_(); tl < 256 * 16; tl += gridDim.x) {
    const int m0 = (tl >> 4) * 128, n0 = (tl & 15) * 128;
    f32x4 acc[4][4];
    gemm_core(HB, WQT, 1024, m0, n0, lds, acc);
#pragma unroll
    for (int mi = 0; mi < 4; ++mi) {
      const int mb = m0 + wr * 64 + mi * 16 + g * 4;
#pragma unroll
      for (int ni = 0; ni < 4; ++ni) {
        const int n = n0 + wc * 64 + ni * 16 + l15;
#pragma unroll
        for (int j = 0; j < 4; ++j) PQ[(size_t)(mb + j) * 2048 + n] = f2bf(acc[mi][ni][j]);
      }
    }
  }
}

#define INS16(KEY)                                            \
  do {                                                        \
    unsigned _k = (KEY);                                      \
    _Pragma("unroll") for (int _q = 0; _q < 16; ++_q) {       \
      const unsigned _hi = max(tv[_q], _k);                   \
      _k = min(tv[_q], _k);                                   \
      tv[_q] = _hi;                                           \
    }                                                         \
  } while (0)

__device__ __forceinline__ void select_item(const Params& p, int item, char* lds) {
  const int tid = tid_(), lane = tid & 63, wave = tid >> 6, l15 = lane & 15, g = lane >> 4;
  const int h = item & 7, t0 = (item >> 3) * 64;
  const u16* PQ = (const u16*)(p.ws + OFF_PQ);
  const u16* KEYS = (const u16*)(p.ws + OFF_KEYS);
  int* EIDX = (int*)(p.ws + OFF_EIDX);
  float* BEST = (float*)(p.ws + OFF_BEST);
  float* sc = (float*)lds;
  __syncthreads();
  {
    const u16* qp = PQ + (size_t)(t0 + wave * 16 + l15) * 2048 + h * 256 + g * 8;
#pragma unroll
    for (int pp = 0; pp < 2; ++pp) {
      bf16x8 qf[4];
#pragma unroll
      for (int ks = 0; ks < 4; ++ks) qf[ks] = *(const bf16x8*)(qp + pp * 128 + ks * 32);
#pragma unroll
      for (int nt = 0; nt < 8; ++nt) {
        const u16* kp = KEYS + ((size_t)((h * 2 + pp) * 128 + nt * 16 + l15)) * 128 + g * 8;
        f32x4 a = f32x4{0.f, 0.f, 0.f, 0.f};
#pragma unroll
        for (int ks = 0; ks < 4; ++ks) a = mfma16(qf[ks], *(const bf16x8*)(kp + ks * 32), a);
#pragma unroll
        for (int j = 0; j < 4; ++j) sc[(wave * 16 + g * 4 + j) * 257 + pp * 128 + nt * 16 + l15] = a[j];
      }
    }
  }
  __syncthreads();
  if (tid < 128) {
    const int row = tid & 63, pp = tid >> 6;
    float* srow = sc + row * 257 + pp * 128;
    unsigned tv[16];
#pragma unroll
    for (int q = 0; q < 16; ++q) tv[q] = 0u;
#pragma unroll 4
    for (int k = 0; k < 128; ++k) {
      const unsigned key = (okey(srow[k]) & ~127u) | (unsigned)(127 - k);
      INS16(key);
    }
    float vals[16];
    int idxs[16];
#pragma unroll
    for (int q = 0; q < 16; ++q) { idxs[q] = 127 - (int)(tv[q] & 127u); vals[q] = srow[idxs[q]]; }
#pragma unroll
    for (int q = 0; q < 16; ++q) { srow[q] = vals[q]; ((int*)srow)[16 + q] = idxs[q]; }
  }
  __syncthreads();
  if (tid < 64) {
    const int row = tid;
    const float* r0 = sc + row * 257;
    const float* r1 = r0 + 128;
    float s0[16], s1[16];
#pragma unroll
    for (int q = 0; q < 16; ++q) { s0[q] = r0[q]; s1[q] = r1[q]; }
    unsigned tv[16];
#pragma unroll
    for (int q = 0; q < 16; ++q) tv[q] = 0u;
#pragma unroll
    for (int a = 0; a < 16; ++a) {
#pragma unroll
      for (int bb = 0; bb < 16; ++bb) {
        if ((a + 1) * (bb + 1) <= 16) {
          const unsigned key = (okey(s0[a] + s1[bb]) & ~255u) | (unsigned)(255 - (a * 16 + bb));
          INS16(key);
        }
      }
    }
    const size_t ob = ((size_t)(t0 + row) * 8 + h) * 16;
#pragma unroll
    for (int q = 0; q < 16; ++q) {
      const int code = 255 - (int)(tv[q] & 255u);
      const int a = code >> 4, bb = code & 15;
      const float best = r0[a] + r1[bb];
      const int e = ((const int*)r0)[16 + a] * 128 + ((const int*)r1)[16 + bb];
      EIDX[ob + q] = e;
      BEST[ob + q] = best;
    }
  }
}

__device__ __forceinline__ void phase5(const Params& p, char* lds) {
  for (int it = bid_(); it < 512 * 8; it += gridDim.x) select_item(p, it, lds);
}

#define CVT_LO(w) __builtin_amdgcn_cvt_pk_f32_fp8((int)(w), false)
#define CVT_HI(w) __builtin_amdgcn_cvt_pk_f32_fp8((int)(w), true)
__device__ __forceinline__ void phase6(const Params& p, char* lds) {
  const int tid = tid_(), lane = tid & 63, wave = tid >> 6, l15 = lane & 15, g = lane >> 4;
  const u16* HB = (const u16*)(p.ws + OFF_HB);
  const unsigned char* EU8 = (const unsigned char*)(p.ws + OFF_EU);
  const unsigned char* EV8 = (const unsigned char*)(p.ws + OFF_EV);
  const float* ESC = (const float*)(p.ws + OFF_ESC);
  const int* EIDX = (const int*)(p.ws + OFF_EIDX);
  const float* BEST = (const float*)(p.ws + OFF_BEST);
  float* wl = (float*)lds + wave * 128;
  for (int t = bid_() * 4 + wave; t < T; t += gridDim.x * 4) {
    f32x2 hf[32];
    {
      const u16* hrow = HB + (size_t)t * 1024 + l15 * 16;
#pragma unroll
      for (int i = 0; i < 4; ++i) {
        const uint4 a = *(const uint4*)(hrow + i * 256), b = *(const uint4*)(hrow + i * 256 + 8);
        hf[i * 8 + 0] = f32x2{bf_lo(a.x), bf_hi(a.x)}; hf[i * 8 + 1] = f32x2{bf_lo(a.y), bf_hi(a.y)};
        hf[i * 8 + 2] = f32x2{bf_lo(a.z), bf_hi(a.z)}; hf[i * 8 + 3] = f32x2{bf_lo(a.w), bf_hi(a.w)};
        hf[i * 8 + 4] = f32x2{bf_lo(b.x), bf_hi(b.x)}; hf[i * 8 + 5] = f32x2{bf_lo(b.y), bf_hi(b.y)};
        hf[i * 8 + 6] = f32x2{bf_lo(b.z), bf_hi(b.z)}; hf[i * 8 + 7] = f32x2{bf_lo(b.w), bf_hi(b.w)};
      }
    }
    float ss;
    {
      f32x2 s2 = f32x2{0.f, 0.f};
#pragma unroll
      for (int i = 0; i < 32; ++i) s2 = __builtin_elementwise_fma(hf[i], hf[i], s2);
      ss = s2.x + s2.y;
    }
    ss += __shfl_xor(ss, 1); ss += __shfl_xor(ss, 2); ss += __shfl_xor(ss, 4); ss += __shfl_xor(ss, 8);
    const float rs2 = rsqrtf(ss * (1.f / 1024.f) + EPS);
    const int ea = EIDX[(size_t)t * 128 + lane], eb = EIDX[(size_t)t * 128 + 64 + lane];
    float ga, gb;
    {
      const float ba = BEST[(size_t)t * 128 + lane] * rs2, bb = BEST[(size_t)t * 128 + 64 + lane] * rs2;
      float ma = ba, mb = bb;
#pragma unroll
      for (int o = 1; o < 16; o <<= 1) { ma = fmaxf(ma, __shfl_xor(ma, o)); mb = fmaxf(mb, __shfl_xor(mb, o)); }
      const float xa = __expf(ba - ma), xb = __expf(bb - mb);
      float sa = xa, sb = xb;
#pragma unroll
      for (int o = 1; o < 16; o <<= 1) { sa += __shfl_xor(sa, o); sb += __shfl_xor(sb, o); }
      ga = xa / sa; gb = xb / sb;
    }
#pragma unroll 2
    for (int it = 0; it < 32; ++it) {
      const int k = it * 4 + g;
      const int e = __shfl((it < 16) ? ea : eb, k & 63);
      const float gk = __shfl((it < 16) ? ga : gb, k & 63);
      const unsigned char* urow = EU8 + (size_t)e * 1024 + l15 * 16;
      uint4 uv[4];
#pragma unroll
      for (int i = 0; i < 4; ++i) uv[i] = *(const uint4*)(urow + i * 256);
      const float usc = ESC[e], vsc = ESC[16384 + e];
      f32x2 d0 = f32x2{0.f, 0.f}, d1 = f32x2{0.f, 0.f};
#pragma unroll
      for (int i = 0; i < 4; ++i) {
        d0 = __builtin_elementwise_fma(CVT_LO(uv[i].x), hf[i * 8 + 0], d0); d1 = __builtin_elementwise_fma(CVT_HI(uv[i].x), hf[i * 8 + 1], d1);
        d0 = __builtin_elementwise_fma(CVT_LO(uv[i].y), hf[i * 8 + 2], d0); d1 = __builtin_elementwise_fma(CVT_HI(uv[i].y), hf[i * 8 + 3], d1);
        d0 = __builtin_elementwise_fma(CVT_LO(uv[i].z), hf[i * 8 + 4], d0); d1 = __builtin_elementwise_fma(CVT_HI(uv[i].z), hf[i * 8 + 5], d1);
        d0 = __builtin_elementwise_fma(CVT_LO(uv[i].w), hf[i * 8 + 6], d0); d1 = __builtin_elementwise_fma(CVT_HI(uv[i].w), hf[i * 8 + 7], d1);
      }
      float d = (d0.x + d0.y) + (d1.x + d1.y);
      d += __shfl_xor(d, 1); d += __shfl_xor(d, 2); d += __shfl_xor(d, 4); d += __shfl_xor(d, 8);
      const float hk = gelu_f(d * rs2 * usc);
      if (l15 == 0) wl[k] = gk * hk * vsc;
    }
    f32x2 acc[32];
#pragma unroll
    for (int i = 0; i < 32; ++i) acc[i] = f32x2{0.f, 0.f};
#pragma unroll 2
    for (int it = 0; it < 32; ++it) {
      const int k = it * 4 + g;
      const int e = __shfl((it < 16) ? ea : eb, k & 63);
      const float wk = wl[k];
      const f32x2 w2 = f32x2{wk, wk};
      const unsigned char* vrow = EV8 + (size_t)e * 1024 + l15 * 16;
      uint4 vv[4];
#pragma unroll
      for (int i = 0; i < 4; ++i) vv[i] = *(const uint4*)(vrow + i * 256);
#pragma unroll
      for (int i = 0; i < 4; ++i) {
        acc[i * 8 + 0] = __builtin_elementwise_fma(CVT_LO(vv[i].x), w2, acc[i * 8 + 0]); acc[i * 8 + 1] = __builtin_elementwise_fma(CVT_HI(vv[i].x), w2, acc[i * 8 + 1]);
        acc[i * 8 + 2] = __builtin_elementwise_fma(CVT_LO(vv[i].y), w2, acc[i * 8 + 2]); acc[i * 8 + 3] = __builtin_elementwise_fma(CVT_HI(vv[i].y), w2, acc[i * 8 + 3]);
        acc[i * 8 + 4] = __builtin_elementwise_fma(CVT_LO(vv[i].z), w2, acc[i * 8 + 4]); acc[i * 8 + 5] = __builtin_elementwise_fma(CVT_HI(vv[i].z), w2, acc[i * 8 + 5]);
        acc[i * 8 + 6] = __builtin_elementwise_fma(CVT_LO(vv[i].w), w2, acc[i * 8 + 6]); acc[i * 8 + 7] = __builtin_elementwise_fma(CVT_HI(vv[i].w), w2, acc[i * 8 + 7]);
      }
    }
    f32x2 r1[16];
    const bool hi2 = (g & 2) != 0;
#pragma unroll
    for (int i = 0; i < 16; ++i) {
      const f32x2 send = hi2 ? acc[i] : acc[i + 16];
      const f32x2 keep = hi2 ? acc[i + 16] : acc[i];
      r1[i] = f32x2{keep.x + __shfl_xor(send.x, 32), keep.y + __shfl_xor(send.y, 32)};
    }
    f32x2 r2[8];
    const bool hi1 = (g & 1) != 0;
#pragma unroll
    for (int i = 0; i < 8; ++i) {
      const f32x2 send = hi1 ? r1[i] : r1[i + 8];
      const f32x2 keep = hi1 ? r1[i + 8] : r1[i];
      r2[i] = f32x2{keep.x + __shfl_xor(send.x, 16), keep.y + __shfl_xor(send.y, 16)};
    }
    float4* op = (float4*)(p.out + (size_t)t * 1024 + g * 256 + l15 * 16);
#pragma unroll
    for (int q = 0; q < 4; ++q) {
      float4 a = op[q];
      a.x += r2[q * 2].x; a.y += r2[q * 2].y; a.z += r2[q * 2 + 1].x; a.w += r2[q * 2 + 1].y;
      op[q] = a;
    }
  }
}

#define PROG 0x6543210ull
#define NPROG 7
__global__ void __launch_bounds__(256, 2) mega(Params p, int ph_lo, int ph_hi) {
  __shared__ __attribute__((aligned(16))) char lds[LDS_BYTES];
  cg::grid_group grid = cg::this_grid();
  for (int st = ph_lo; st < ph_hi; ++st) {
    if (st != ph_lo) grid.sync();
    const int ph = (int)((PROG >> (4 * st)) & 15ull);
    switch (ph) {
      case 0: phase0(p, lds); break;
      case 1: phase1(p, lds); break;
      case 2: phase2(p, lds); break;
      case 3: phase3(p, lds); break;
      case 4: phase4(p, lds); break;
      case 5: phase5(p, lds); break;
      case 6: phase6(p, lds); break;
      default: break;
    }
  }
}

extern "C" void kernel_launch(void* const* d_in, const int* in_sizes, int n_in, void* d_out, int out_size, void* d_ws,
                              size_t ws_size, hipStream_t stream) {
  static int grid_blocks = 0;
  if (!grid_blocks) {
    int dev = 0, cus = 0, per_cu = 0;
    hipGetDevice(&dev);
    hipDeviceGetAttribute(&cus, hipDeviceAttributeMultiprocessorCount, dev);
    hipOccupancyMaxActiveBlocksPerMultiprocessor(&per_cu, mega, 256, 0);
    if (per_cu > 2) per_cu = 2;
    grid_blocks = cus * per_cu;
  }
  Params p{};
  p.x = (const float*)d_in[0]; p.ln_mix_g = (const float*)d_in[1]; p.w_in = (const float*)d_in[2];
  p.gmlp_norm_g = (const float*)d_in[3]; p.gmlp_w_s = (const float*)d_in[4]; p.gmlp_b_s = (const float*)d_in[5];
  p.q_norm_g = (const float*)d_in[6]; p.k_norm_g = (const float*)d_in[7]; p.rel_bias = (const float*)d_in[8];
  p.w_out = (const float*)d_in[9]; p.ln_ffn_g = (const float*)d_in[10]; p.w_query = (const float*)d_in[11];
  p.sub_keys = (const float*)d_in[12]; p.peer_u = (const float*)d_in[13]; p.peer_v = (const float*)d_in[14];
  p.out = (float*)d_out; p.ws = (char*)d_ws;
#if FUSED
  int lo = 0, hi = NPROG;
  void* args[] = {&p, &lo, &hi};
  hipError_t e = hipLaunchCooperativeKernel((void*)mega, dim3(grid_blocks), dim3(256), args, 0, stream);
  if (e != hipSuccess) fprintf(stderr, "cooperative launch failed: %s (grid %d)\n", hipGetErrorString(e), grid_blocks);
#else
  for (int ph = 0; ph < NPROG; ++ph) mega<<<dim3(grid_blocks), dim3(256), 0, stream>>>(p, ph, ph + 1);
#endif
}
```

```cpp
#include <hip/hip_runtime.h>
#include <hip/hip_cooperative_groups.h>
#include <cstdio>
namespace cg = cooperative_groups;

#ifndef FUSED
#define FUSED 1
#endif

typedef unsigned short u16;
using bf16x8 = __attribute__((ext_vector_type(8))) short;
using s16x4 = __attribute__((ext_vector_type(4))) short;
using f32x4 = __attribute__((ext_vector_type(4))) float;
using bf16x2 = __attribute__((ext_vector_type(2))) __bf16;
using f32x2 = __attribute__((ext_vector_type(2))) float;

constexpr int T = 32768, DM = 1024, SEQ = 4096;
constexpr float EPS = 1e-6f;
constexpr size_t MiB = 1u << 20;
constexpr size_t OFF_XB = 0, OFF_WINT = 64 * MiB  , OFF_WB = 67 * MiB  , OFF_WOUTT = 69 * MiB, OFF_WQT = 71 * MiB, OFF_KEYS = 75 * MiB,
                 OFF_RS = 76 * MiB, OFF_VSS = 76 * MiB + 512 * 1024, OFF_EU = 77 * MiB, OFF_EV = 109 * MiB,
                 OFF_U = 141 * MiB, OFF_GVT = 173 * MiB, OFF_QK = 205 * MiB, OFF_VT = 269 * MiB, OFF_AB = 301 * MiB,
                 OFF_HB = 365 * MiB, OFF_PQ = 141 * MiB  , OFF_EIDX = 429 * MiB,
                 OFF_BEST = 445 * MiB, OFF_ESC = 461 * MiB  ;

struct Params {
  const float *x, *ln_mix_g, *w_in, *gmlp_norm_g, *gmlp_w_s, *gmlp_b_s, *q_norm_g, *k_norm_g, *rel_bias, *w_out,
      *ln_ffn_g, *w_query, *sub_keys, *peer_u, *peer_v;
  float* out;
  char* ws;
};

constexpr int LDS_BYTES = 131584;
constexpr int NTHR = 512, NWAVE = 8;
constexpr int LSTR = 144;
constexpr int OPER_BYTES = 128 * LSTR;

__device__ __forceinline__ u16 f2bf(float f) {
  unsigned u = __float_as_uint(f);
  u += 0x7fffu + ((u >> 16) & 1u);
  return (u16)(u >> 16);
}
__device__ __forceinline__ unsigned pack2(float lo, float hi) { return (unsigned)f2bf(lo) | ((unsigned)f2bf(hi) << 16); }
__device__ __forceinline__ float bf_lo(unsigned u) { return __uint_as_float(u << 16); }
__device__ __forceinline__ float bf_hi(unsigned u) { return __uint_as_float(u & 0xffff0000u); }
__device__ __forceinline__ float bf2f(u16 v) { return __uint_as_float(((unsigned)v) << 16); }
__device__ __forceinline__ float gelu_f(float x) {
  float z = 0.7978845608028654f * (x + 0.044715f * x * x * x);
  float e = __expf(2.f * z);
  float th = 1.f - 2.f / (1.f + e);
  return 0.5f * x * (1.f + th);
}
__device__ __forceinline__ float dot2(unsigned a, unsigned b, float acc) {
  return __builtin_amdgcn_fdot2_f32_bf16(__builtin_bit_cast(bf16x2, a), __builtin_bit_cast(bf16x2, b), acc, false);
}
__device__ __forceinline__ f32x4 mfma16(bf16x8 a, bf16x8 b, f32x4 c) {
  return __builtin_amdgcn_mfma_f32_16x16x32_bf16(a, b, c, 0, 0, 0);
}
__device__ __forceinline__ bf16x8 mk8(unsigned a, unsigned b, unsigned c, unsigned d) {
  uint4 u = make_uint4(a, b, c, d);
  return __builtin_bit_cast(bf16x8, u);
}
__device__ __forceinline__ unsigned pack4_fp8(float a, float b, float c, float d) {
  int r = 0;
  r = __builtin_amdgcn_cvt_pk_fp8_f32(a, b, r, false);
  r = __builtin_amdgcn_cvt_pk_fp8_f32(c, d, r, true);
  return (unsigned)r;
}
__device__ __forceinline__ unsigned okey(float x) {
  unsigned u = __float_as_uint(x);
  return (u & 0x80000000u) ? ~u : (u | 0x80000000u);
}


__device__ __forceinline__ int tid_() { int t = threadIdx.x; asm volatile("" : "+v"(t)); return t; }
__device__ __forceinline__ int bid_() { int b = blockIdx.x; asm volatile("" : "+s"(b)); return b; }
namespace pg8 {
#define PG8_LAS __attribute__((address_space(3)))
typedef unsigned short bf16_t;
typedef short bf16x8 __attribute__((ext_vector_type(8)));
typedef float f32x4 __attribute__((ext_vector_type(4)));
typedef unsigned u32x4 __attribute__((ext_vector_type(4)));
constexpr int BM = 256, BK = 64, HALF = 128, HTB = HALF * BK * 2  , STAGE_BYTES = 8 * HTB, NXCD = 8, WGM = 8;

__host__ __device__ __forceinline__ int lds_byte(int r, int c) { const int st = (r >> 4) * 2 + (c >> 5), rr = r & 15, cc = c & 31, ob = rr * 64 + cc * 2; return st * 1024 + (ob ^ (((ob >> 9) & 1) << 5)); }
__host__ __device__ __forceinline__ void stage_rc(int b, int& R, int& C) { const int st = b / 1024, sb = b % 1024, swz = sb ^ (((sb >> 9) & 1) << 5); R = (st >> 1) * 16 + swz / 64; C = (st & 1) * 32 + (swz % 64) / 2; }
__host__ __device__ __forceinline__ int perm32(int rho) { const int n = rho >> 4, i = rho & 15; return 8 * (i >> 2) + 4 * n + (i & 3); }

struct Unit { int pm, pn; };
struct Gemm { const bf16_t* A; const bf16_t* Bt; int M, N, K; };

struct StaticOrder {
    int nM, nN, nwg, G, c;
    __host__ __device__ void init(int M, int N, int G_, int c_) { nM = M / BM; nN = N / BM; nwg = nM * nN; G = G_; c = c_; }
    __host__ __device__ bool next(int i, Unit& u) const {
        const long L = (long)i * G + c; if (L >= nwg) return false;
        int wgid = (int)L; { const int q = nwg / NXCD, r = nwg % NXCD, xcd = wgid % NXCD, off = wgid / NXCD; wgid = (xcd < r ? xcd * (q + 1) : r * (q + 1) + (xcd - r) * q) + off; }
        const int nig = WGM * nN, gid = wgid / nig, fm = gid * WGM, gsz = (nM - fm) < WGM ? (nM - fm) : WGM;
        u.pm = fm + ((wgid % nig) % gsz); u.pn = (wgid % nig) / gsz; return true;
    }
    __device__ __forceinline__ void a_ready(const Unit&) const {}
    __device__ __forceinline__ void done(const Unit&) const {}
};

__device__ __forceinline__ unsigned cvt_pk_bf16(float lo, float hi) { unsigned r; asm volatile("v_cvt_pk_bf16_f32 %0, %1, %2" : "=v"(r) : "v"(lo), "v"(hi)); return r; }
template <class Epi, class Sched, bool ALIGN_EPI = false, bool SP2 = false>
__device__ __forceinline__ void gemm_phase(PG8_LAS unsigned char* lds, const Gemm g, const Sched& S, const Epi& E) {
    const int tid = threadIdx.x, wid = __builtin_amdgcn_readfirstlane(tid >> 6), lane = tid & 63, wr = wid >> 2, wc = wid & 3, fr = lane & 15, fq = lane >> 4;
    const int K = g.K, nt = K / BK;
    unsigned voffA[2], voffB[2];
#pragma unroll
    for (int i = 0; i < 2; ++i) { int R, C; stage_rc(tid * 16 + i * 8192, R, C); const int Rb = Epi::PERM ? ((R & ~31) + perm32(R & 31)) : R;
        voffA[i] = (unsigned)(R * K + C) * 2u; voffB[i] = (unsigned)(Rb * K + C) * 2u; }
    const size_t kstep = (size_t)(BK * 2);
    const size_t hstep = (size_t)HALF * K * 2;
    const size_t tstep = 2 * hstep;
    const unsigned ldsw = (unsigned)wid * 1024u;
    const int aoff = lds_byte(wr * 64 + fr, fq * 8), boff = lds_byte(wc * 32 + fr, fq * 8);
#define PG8_SA(b, h) (((b) * 2 + (h)) * HTB)
#define PG8_SB(b, h) ((4 + (b) * 2 + (h)) * HTB)
#define PG8_STAGE(bufoff, gbase, voff) do { _Pragma("unroll") for (int _i = 0; _i < 2; ++_i) \
        __builtin_amdgcn_global_load_lds((const unsigned*)((const char*)(gbase) + (voff)[_i]), (PG8_LAS unsigned*)(lds + (bufoff) + ldsw + _i * 8192), 16, 0, 0); } while (0)
#define PG8_LDA(dst, b, h) do { _Pragma("unroll") for (int m = 0; m < 4; ++m) _Pragma("unroll") for (int k = 0; k < 2; ++k) dst[m][k] = *(const PG8_LAS bf16x8*)(lds + PG8_SA(b, h) + aoff + m * 2048 + k * 1024); } while (0)
#define PG8_LDB(dst, b, h) do { _Pragma("unroll") for (int n = 0; n < 2; ++n) _Pragma("unroll") for (int k = 0; k < 2; ++k) dst[n][k] = *(const PG8_LAS bf16x8*)(lds + PG8_SB(b, h) + boff + n * 2048 + k * 1024); } while (0)
#define PG8_MMA(ai, bj, At, Bt) do { __builtin_amdgcn_s_setprio(1); _Pragma("unroll") for (int m = 0; m < 4; ++m) _Pragma("unroll") for (int n = 0; n < 2; ++n) _Pragma("unroll") for (int k = 0; k < 2; ++k) \
        acc[ai][bj][m][n] = __builtin_amdgcn_mfma_f32_16x16x32_bf16(Bt[n][k], At[m][k], acc[ai][bj][m][n], 0, 0, 0); __builtin_amdgcn_s_setprio(0); } while (0)
#define PG8_WAIT_V(n) asm volatile("s_waitcnt vmcnt(" #n ")" ::: "memory")
#define PG8_WAIT_L(n) asm volatile("s_waitcnt lgkmcnt(" #n ")" ::: "memory")
#define PG8_BAR __builtin_amdgcn_s_barrier()
#define PG8_SCHED __builtin_amdgcn_sched_barrier(0)
    Unit cur, nxt; int ui = 0;
    if (!S.next(0, cur)) return;
    f32x4 acc[2][2][4][2];
#pragma unroll
    for (int a = 0; a < 2; ++a)
#pragma unroll
        for (int b = 0; b < 2; ++b)
#pragma unroll
            for (int m = 0; m < 4; ++m)
#pragma unroll
                for (int n = 0; n < 2; ++n) acc[a][b][m][n] = (f32x4){0.f, 0.f, 0.f, 0.f};
    bf16x8 At[4][2], B0[2][2], B1[2][2];
    const char* cA = (const char*)g.A + (size_t)cur.pm * tstep; const char* cB = (const char*)g.Bt + (size_t)cur.pn * tstep;
    S.a_ready(cur);
    if constexpr (SP2) {
        PG8_STAGE(PG8_SB(0, 0), cB, voffB); PG8_STAGE(PG8_SB(0, 1), cB + hstep, voffB); PG8_STAGE(PG8_SA(0, 0), cA, voffA); PG8_STAGE(PG8_SA(0, 1), cA + hstep, voffA);
        if (wr == 1) PG8_BAR;
        PG8_WAIT_V(2); PG8_BAR;
        PG8_STAGE(PG8_SB(1, 0), cB + kstep, voffB); PG8_STAGE(PG8_SA(1, 0), cA + kstep, voffA); PG8_STAGE(PG8_SB(1, 1), cB + hstep + kstep, voffB);
        PG8_WAIT_V(6); PG8_BAR;
    } else {
        PG8_STAGE(PG8_SB(0, 0), cB, voffB); PG8_STAGE(PG8_SA(0, 0), cA, voffA); PG8_STAGE(PG8_SB(0, 1), cB + hstep, voffB); PG8_STAGE(PG8_SA(0, 1), cA + hstep, voffA);
        if (wr == 1) PG8_BAR;
        PG8_WAIT_V(4); PG8_BAR;
        PG8_STAGE(PG8_SB(1, 0), cB + kstep, voffB); PG8_STAGE(PG8_SA(1, 0), cA + kstep, voffA); PG8_STAGE(PG8_SB(1, 1), cB + hstep + kstep, voffB);
        PG8_WAIT_V(6); PG8_BAR;
    }
    for (;;) {
        const bool has_next = S.next(ui + 1, nxt);
        const char* nA = has_next ? (const char*)g.A + (size_t)nxt.pm * tstep : cA; const char* nB = has_next ? (const char*)g.Bt + (size_t)nxt.pn * tstep : cB;
        for (int t = 0; t < nt; t += 2) {
            const bool last = (t == nt - 2);
            const char* a1 = cA + (size_t)(t + 1) * kstep;
            const char* a2 = last ? nA : cA + (size_t)(t + 2) * kstep; const char* b2 = last ? nB : cB + (size_t)(t + 2) * kstep;
            const char* a3 = a2 + kstep; const char* b3 = b2 + kstep;
            if (last && has_next) S.a_ready(nxt);
            if constexpr (SP2) {
            PG8_LDB(B0, 0, 0); PG8_LDB(B1, 0, 1); PG8_SCHED; PG8_LDA(At, 0, 0); PG8_STAGE(PG8_SA(1, 1), a1 + hstep, voffA);
            PG8_WAIT_V(8); PG8_WAIT_L(0); PG8_BAR; PG8_MMA(0, 0, At, B0); PG8_MMA(0, 1, At, B1); PG8_BAR; PG8_SCHED;
            PG8_LDA(At, 0, 1); PG8_STAGE(PG8_SB(0, 0), b2, voffB); PG8_STAGE(PG8_SB(0, 1), b2 + hstep, voffB); PG8_STAGE(PG8_SA(0, 0), a2, voffA);
            PG8_WAIT_V(8); PG8_WAIT_L(0); PG8_BAR; PG8_MMA(1, 0, At, B0); PG8_MMA(1, 1, At, B1); PG8_BAR; PG8_SCHED;
            PG8_LDB(B0, 1, 0); PG8_LDB(B1, 1, 1); PG8_SCHED; PG8_LDA(At, 1, 0); PG8_STAGE(PG8_SA(0, 1), a2 + hstep, voffA);
            PG8_WAIT_V(8); PG8_WAIT_L(0); PG8_BAR; PG8_MMA(0, 0, At, B0); PG8_MMA(0, 1, At, B1); PG8_BAR; PG8_SCHED;
            PG8_LDA(At, 1, 1); PG8_STAGE(PG8_SB(1, 0), b3, voffB); PG8_STAGE(PG8_SB(1, 1), b3 + hstep, voffB); PG8_STAGE(PG8_SA(1, 0), a3, voffA);
            PG8_WAIT_V(8); PG8_WAIT_L(0); PG8_BAR; PG8_MMA(1, 0, At, B0); PG8_MMA(1, 1, At, B1); PG8_BAR; PG8_SCHED;
            } else {
            PG8_LDB(B0, 0, 0); PG8_SCHED; PG8_LDA(At, 0, 0); PG8_STAGE(PG8_SA(1, 1), a1 + hstep, voffA);
            PG8_WAIT_L(8); PG8_BAR; PG8_WAIT_L(0); PG8_MMA(0, 0, At, B0); PG8_BAR; PG8_SCHED;
            PG8_LDB(B1, 0, 1); PG8_STAGE(PG8_SB(0, 0), b2, voffB);
            PG8_BAR; PG8_WAIT_L(0); PG8_MMA(0, 1, At, B1); PG8_BAR;
            PG8_LDA(At, 0, 1); PG8_STAGE(PG8_SA(0, 0), a2, voffA);
            PG8_BAR; PG8_WAIT_L(0); PG8_MMA(1, 0, At, B0); PG8_BAR; PG8_SCHED;
            PG8_STAGE(PG8_SB(0, 1), b2 + hstep, voffB);
            PG8_WAIT_V(6); PG8_BAR; PG8_MMA(1, 1, At, B1); PG8_BAR;
            PG8_LDB(B0, 1, 0); PG8_SCHED; PG8_LDA(At, 1, 0); PG8_STAGE(PG8_SA(0, 1), a2 + hstep, voffA);
            PG8_WAIT_L(8); PG8_BAR; PG8_WAIT_L(0); PG8_MMA(0, 0, At, B0); PG8_BAR; PG8_SCHED;
            PG8_LDB(B1, 1, 1); PG8_STAGE(PG8_SB(1, 0), b3, voffB);
            PG8_BAR; PG8_WAIT_L(0); PG8_MMA(0, 1, At, B1); PG8_BAR;
            PG8_LDA(At, 1, 1); PG8_STAGE(PG8_SA(1, 0), a3, voffA);
            PG8_BAR; PG8_WAIT_L(0); PG8_MMA(1, 0, At, B0); PG8_BAR; PG8_SCHED;
            PG8_STAGE(PG8_SB(1, 1), b3 + hstep, voffB);
            PG8_WAIT_V(6); PG8_BAR; PG8_MMA(1, 1, At, B1); PG8_BAR;
            }
        }
        if constexpr (ALIGN_EPI) { if (wr == 0) PG8_BAR; }
        if constexpr (!Epi::AFTER_DRAIN) { E(acc, cur, wr, wc, fr, fq); S.done(cur); }
        if (!has_next) break;
#pragma unroll
        for (int a = 0; a < 2; ++a)
#pragma unroll
            for (int b = 0; b < 2; ++b)
#pragma unroll
                for (int m = 0; m < 4; ++m)
#pragma unroll
                    for (int n = 0; n < 2; ++n) acc[a][b][m][n] = (f32x4){0.f, 0.f, 0.f, 0.f};
        cur = nxt; cA = nA; cB = nB; ++ui;
        if constexpr (ALIGN_EPI) { if (wr == 1) PG8_BAR; }
    }
    PG8_WAIT_V(0);
    if constexpr (!ALIGN_EPI) { if (wr == 0) PG8_BAR; }
    PG8_BAR;
    if constexpr (Epi::AFTER_DRAIN) { E.fused(acc, cur, wr, wc, fr, fq, lds, wid, lane); S.done(cur); }
#undef PG8_SA
#undef PG8_SB
#undef PG8_STAGE
#undef PG8_LDA
#undef PG8_LDB
#undef PG8_MMA
#undef PG8_WAIT_V
#undef PG8_WAIT_L
#undef PG8_BAR
#undef PG8_SCHED
}
}

#define EPI_V8(v, A, s) float v[8] = {A[0][0] * (s), A[0][1] * (s), A[0][2] * (s), A[0][3] * (s), A[1][0] * (s), A[1][1] * (s), A[1][2] * (s), A[1][3] * (s)}
__device__ __forceinline__ uint4 pk8(const float (&v)[8]) {
  return make_uint4(pg8::cvt_pk_bf16(v[0], v[1]), pg8::cvt_pk_bf16(v[2], v[3]), pg8::cvt_pk_bf16(v[4], v[5]), pg8::cvt_pk_bf16(v[6], v[7]));
}
struct EpiIn {
  static constexpr bool PERM = true, AFTER_DRAIN = false;
  u16* U; u16* QK; const float* RS;
  __device__ __forceinline__ void operator()(const pg8::f32x4 (&acc)[2][2][4][2], const pg8::Unit& u, int wr, int wc, int fr, int fq) const {
    const int row0 = u.pm * 256 + wr * 64 + fr, colt = u.pn * 256, c0 = colt + wc * 32 + 8 * fq;
    const bool isu = colt < 512;
#pragma unroll
    for (int ai = 0; ai < 2; ++ai)
#pragma unroll
      for (int m = 0; m < 4; ++m) {
        const int row = row0 + ai * 128 + m * 16;
        const float r = RS[row];
#pragma unroll
        for (int bj = 0; bj < 2; ++bj) {
          const int col = c0 + bj * 128;
          EPI_V8(v, acc[ai][bj][m], r);
          if (isu) {
#pragma unroll
            for (int j = 0; j < 8; ++j) v[j] = gelu_f(v[j]);
            *(uint4*)(U + (size_t)row * 512 + col) = pk8(v);
          } else {
            *(uint4*)(QK + (size_t)row * 1024 + (col - 512)) = pk8(v);
          }
        }
      }
  }
};
struct EpiInT {
  static constexpr bool PERM = true, AFTER_DRAIN = false;
  u16* GVT; u16* VT; const float* RS; float* VSS;
  __device__ __forceinline__ void operator()(const pg8::f32x4 (&acc)[2][2][4][2], const pg8::Unit& u, int wr, int wc, int fr, int fq) const {
    const int ch0 = u.pm * 256 + wr * 64 + fr, t0 = u.pn * 256 + wc * 32 + 8 * fq;
    const bool isg = u.pm < 2;
#pragma unroll
    for (int bj = 0; bj < 2; ++bj) {
      const int t = t0 + bj * 128, b = t >> 12, s = t & 4095;
      const float4 ra = *(const float4*)(RS + t), rb = *(const float4*)(RS + t + 4);
      const float rr[8] = {ra.x, ra.y, ra.z, ra.w, rb.x, rb.y, rb.z, rb.w};
      float ss[8] = {0.f, 0.f, 0.f, 0.f, 0.f, 0.f, 0.f, 0.f};
#pragma unroll
      for (int ai = 0; ai < 2; ++ai)
#pragma unroll
        for (int m = 0; m < 4; ++m) {
          const int ch = ch0 + ai * 128 + m * 16;
          float v[8];
#pragma unroll
          for (int j = 0; j < 8; ++j) v[j] = acc[ai][bj][m][j >> 2][j & 3] * rr[j];
          if (isg) {
#pragma unroll
            for (int j = 0; j < 8; ++j) { v[j] = gelu_f(v[j]); ss[j] += v[j] * v[j]; }
            *(uint4*)(GVT + ((size_t)b * 512 + ch) * SEQ + s) = pk8(v);
          } else {
            *(uint4*)(VT + ((size_t)b * 512 + (ch - 512)) * SEQ + s) = pk8(v);
          }
        }
      if (isg) {
#pragma unroll
        for (int j = 0; j < 8; ++j) {
          float sv = ss[j];
          sv += __shfl_xor(sv, 1); sv += __shfl_xor(sv, 2); sv += __shfl_xor(sv, 4); sv += __shfl_xor(sv, 8);
          if (fr == 0) atomicAdd(VSS + t + j, sv);
        }
      }
    }
  }
};
struct EpiOut {
  static constexpr bool PERM = true, AFTER_DRAIN = false;
  const float* X; float* OUT; u16* HB;
  __device__ __forceinline__ void operator()(const pg8::f32x4 (&acc)[2][2][4][2], const pg8::Unit& u, int wr, int wc, int fr, int fq) const {
    const int row0 = u.pm * 256 + wr * 64 + fr, c0 = u.pn * 256 + wc * 32 + 8 * fq;
#pragma unroll
    for (int ai = 0; ai < 2; ++ai)
#pragma unroll
      for (int m = 0; m < 4; ++m) {
        const int row = row0 + ai * 128 + m * 16;
#pragma unroll
        for (int bj = 0; bj < 2; ++bj) {
          const size_t idx = (size_t)row * 1024 + c0 + bj * 128;
          const float4 xa = *(const float4*)(X + idx), xb = *(const float4*)(X + idx + 4);
          float v[8] = {xa.x + acc[ai][bj][m][0][0], xa.y + acc[ai][bj][m][0][1], xa.z + acc[ai][bj][m][0][2], xa.w + acc[ai][bj][m][0][3],
                        xb.x + acc[ai][bj][m][1][0], xb.y + acc[ai][bj][m][1][1], xb.z + acc[ai][bj][m][1][2], xb.w + acc[ai][bj][m][1][3]};
          *(float4*)(OUT + idx) = make_float4(v[0], v[1], v[2], v[3]);
          *(float4*)(OUT + idx + 4) = make_float4(v[4], v[5], v[6], v[7]);
          *(uint4*)(HB + idx) = pk8(v);
        }
      }
  }
};
struct EpiQ {
  static constexpr bool PERM = true, AFTER_DRAIN = false;
  u16* PQ;
  __device__ __forceinline__ void operator()(const pg8::f32x4 (&acc)[2][2][4][2], const pg8::Unit& u, int wr, int wc, int fr, int fq) const {
    const int row0 = u.pm * 256 + wr * 64 + fr, c0 = u.pn * 256 + wc * 32 + 8 * fq;
#pragma unroll
    for (int ai = 0; ai < 2; ++ai)
#pragma unroll
      for (int m = 0; m < 4; ++m) {
        const int row = row0 + ai * 128 + m * 16;
#pragma unroll
        for (int bj = 0; bj < 2; ++bj) {
          EPI_V8(v, acc[ai][bj][m], 1.f);
          *(uint4*)(PQ + (size_t)row * 2048 + c0 + bj * 128) = pk8(v);
        }
      }
  }
};
#define LDS3(p) ((__attribute__((address_space(3))) unsigned char*)(p))

__device__ __forceinline__ void phase0(const Params& p, char* lds) {
  const int tid = tid_(), lane = tid & 63, wave = tid >> 6;
  const int nblk = gridDim.x, blk = bid_();
  u16* XB = (u16*)(p.ws + OFF_XB);
  float* RS = (float*)(p.ws + OFF_RS);
  float* VSS = (float*)(p.ws + OFF_VSS);
  for (int row = blk * NWAVE + wave; row < T; row += nblk * NWAVE) {
    const float4* xr = (const float4*)(p.x + (size_t)row * DM);
    float4 v[4];
    float ss = 0.f;
#pragma unroll
    for (int i = 0; i < 4; ++i) {
      v[i] = xr[lane + 64 * i];
      ss += v[i].x * v[i].x + v[i].y * v[i].y + v[i].z * v[i].z + v[i].w * v[i].w;
    }
#pragma unroll
    for (int o = 1; o < 64; o <<= 1) ss += __shfl_xor(ss, o);
    if (lane == 0) RS[row] = rsqrtf(ss * (1.f / 1024.f) + EPS);
#pragma unroll
    for (int i = 0; i < 4; ++i) {
      uint2 o2 = make_uint2(pack2(v[i].x, v[i].y), pack2(v[i].z, v[i].w));
      *(uint2*)(XB + (size_t)row * DM + (lane + 64 * i) * 4) = o2;
    }
  }
  {
    unsigned char* EU8 = (unsigned char*)(p.ws + OFF_EU);
    unsigned char* EV8 = (unsigned char*)(p.ws + OFF_EV);
    float* ESC = (float*)(p.ws + OFF_ESC);
    for (int row = blk * NWAVE + wave; row < 32768; row += nblk * NWAVE) {
      const bool isv = row >= 16384;
      const int e = row & 16383;
      const float4* src = (const float4*)((isv ? p.peer_v : p.peer_u) + (size_t)e * 1024);
      float4 v[4];
      float am = 0.f;
#pragma unroll
      for (int i = 0; i < 4; ++i) {
        v[i] = src[i * 64 + lane];
        if (!isv) {
          const float4 g4 = ((const float4*)p.ln_ffn_g)[i * 64 + lane];
          v[i].x *= g4.x; v[i].y *= g4.y; v[i].z *= g4.z; v[i].w *= g4.w;
        }
        am = fmaxf(am, fmaxf(fmaxf(fabsf(v[i].x), fabsf(v[i].y)), fmaxf(fabsf(v[i].z), fabsf(v[i].w))));
      }
#pragma unroll
      for (int o = 1; o < 64; o <<= 1) am = fmaxf(am, __shfl_xor(am, o));
      const int ex = (int)((__float_as_uint(am) >> 23) & 255u) - 127;
      const bool ok = (am > 1e-30f);
      const float scale = ok ? __uint_as_float((unsigned)(127 + 7 - ex) << 23) : 1.f;
      const float inv = ok ? __uint_as_float((unsigned)(127 - 7 + ex) << 23) : 1.f;
      unsigned* dst = (unsigned*)((isv ? EV8 : EU8) + (size_t)e * 1024);
#pragma unroll
      for (int i = 0; i < 4; ++i)
        dst[i * 64 + lane] = pack4_fp8(v[i].x * scale, v[i].y * scale, v[i].z * scale, v[i].w * scale);
      if (lane == 0) ESC[row] = inv;
    }
  }
  {
    const int half = wave >> 2, w4 = wave & 3;
    float* tile = (float*)lds + half * (64 * 65);
    for (int tp = blk; tp < 704; tp += nblk) {
      const int tl = tp * 2 + half;
      const float* W; const float* gain; u16* dst; int N, kt, nt, drow;
      if (tl < 640) {
        W = p.w_in; gain = p.ln_mix_g; N = 2560; kt = tl / 40; nt = tl % 40;
        const int n0 = nt * 64;
        if (n0 < 512) { dst = (u16*)(p.ws + OFF_WINT); drow = n0; }
        else if (n0 < 1024) { dst = (u16*)(p.ws + OFF_WB); drow = n0 - 512; }
        else if (n0 < 2048) { dst = (u16*)(p.ws + OFF_WINT); drow = n0 - 512; }
        else { dst = (u16*)(p.ws + OFF_WB); drow = n0 - 2048 + 512; }
      } else if (tl < 896) { int t2 = tl - 640; W = p.w_out; gain = nullptr; dst = (u16*)(p.ws + OFF_WOUTT); N = 1024; kt = t2 / 16; nt = t2 % 16; drow = nt * 64; }
      else { int t2 = tl - 896; W = p.w_query; gain = p.ln_ffn_g; dst = (u16*)(p.ws + OFF_WQT); N = 2048; kt = t2 / 32; nt = t2 % 32; drow = nt * 64; }
      __syncthreads();
#pragma unroll 4
      for (int i = 0; i < 16; ++i) {
        const int kk = i * 4 + w4;
        const float gk = gain ? gain[kt * 64 + kk] : 1.f;
        tile[kk * 65 + lane] = W[(size_t)(kt * 64 + kk) * N + nt * 64 + lane] * gk;
      }
      __syncthreads();
#pragma unroll 4
      for (int i = 0; i < 16; ++i) {
        const int nn = i * 4 + w4;
        dst[(size_t)(drow + nn) * 1024 + kt * 64 + lane] = f2bf(tile[lane * 65 + nn]);
      }
    }
    __syncthreads();
  }
  {
    u16* KEYS = (u16*)(p.ws + OFF_KEYS);
    for (int i = blk * NTHR + tid; i < 262144 / 4; i += nblk * NTHR) {
      float4 a = ((const float4*)p.sub_keys)[i];
      *(uint2*)(KEYS + (size_t)i * 4) = make_uint2(pack2(a.x, a.y), pack2(a.z, a.w));
    }
  }
  for (int i = blk * NTHR + tid; i < T; i += nblk * NTHR) VSS[i] = 0.f;
}

__device__ __forceinline__ void phase1(const Params& p, char* lds) {
  const u16* XB = (const u16*)(p.ws + OFF_XB);
  const float* RS = (const float*)(p.ws + OFF_RS);
  {
    pg8::Gemm g{XB, (const u16*)(p.ws + OFF_WINT), T, 1536, 1024};
    pg8::StaticOrder S; S.init(T, 1536, (int)gridDim.x, (int)blockIdx.x);
    EpiIn E{(u16*)(p.ws + OFF_U), (u16*)(p.ws + OFF_QK), RS};
    pg8::gemm_phase<EpiIn, pg8::StaticOrder, true, true>(LDS3(lds), g, S, E);
  }
  {
    pg8::Gemm g{(const u16*)(p.ws + OFF_WB), XB, 1024, T, 1024};
    pg8::StaticOrder S; S.init(1024, T, (int)gridDim.x, (int)blockIdx.x);
    EpiInT E{(u16*)(p.ws + OFF_GVT), (u16*)(p.ws + OFF_VT), RS, (float*)(p.ws + OFF_VSS)};
    pg8::gemm_phase<EpiInT, pg8::StaticOrder, true, true>(LDS3(lds), g, S, E);
  }
}

__device__ __forceinline__ void gmlp_item(const Params& p, int item) {
  const int tid = tid_() & 255, lane = tid & 63, wave = tid >> 6, l15 = lane & 15, g = lane >> 4;
  const int gr = item & 7, n = (item >> 3) & 31, b = item >> 8;
  const int t0 = b * SEQ + n * 128;
  const float* VSS = (const float*)(p.ws + OFF_VSS);
  const u16* GVT = (const u16*)(p.ws + OFF_GVT);
  const u16* U = (const u16*)(p.ws + OFF_U);
  u16* AB = (u16*)(p.ws + OFF_AB);
  f32x4 acc[2][4];
#pragma unroll
  for (int i = 0; i < 2; ++i)
#pragma unroll
    for (int j = 0; j < 4; ++j) acc[i][j] = f32x4{0.f, 0.f, 0.f, 0.f};
  const int i_base = wave * 32;
  const int nks = (wave < 2) ? 2 : 4;
  for (int ks = 0; ks < nks; ++ks) {
    const int j0 = ks * 32 + g * 8;
    const float4 s0 = *(const float4*)(VSS + t0 + j0), s1 = *(const float4*)(VSS + t0 + j0 + 4);
    float r[8] = {s0.x, s0.y, s0.z, s0.w, s1.x, s1.y, s1.z, s1.w};
#pragma unroll
    for (int q = 0; q < 8; ++q) r[q] = rsqrtf(r[q] * (1.f / 512.f) + EPS);
    bf16x8 af[2];
#pragma unroll
    for (int mi = 0; mi < 2; ++mi) {
      const int i = i_base + mi * 16 + l15;
      const float* wp = p.gmlp_w_s + ((size_t)(gr * 128 + i)) * 128 + j0;
      const float4 w0 = *(const float4*)wp, w1 = *(const float4*)(wp + 4);
      af[mi] = mk8(pack2(w0.x * r[0], w0.y * r[1]), pack2(w0.z * r[2], w0.w * r[3]), pack2(w1.x * r[4], w1.y * r[5]),
                   pack2(w1.z * r[6], w1.w * r[7]));
    }
#pragma unroll
    for (int ni = 0; ni < 4; ++ni) {
      const int c = ni * 16 + l15;
      const bf16x8 bfr = *(const bf16x8*)(GVT + ((size_t)b * 512 + gr * 64 + c) * SEQ + n * 128 + j0);
#pragma unroll
      for (int mi = 0; mi < 2; ++mi) acc[mi][ni] = mfma16(af[mi], bfr, acc[mi][ni]);
    }
  }
#pragma unroll
  for (int mi = 0; mi < 2; ++mi) {
#pragma unroll
    for (int ni = 0; ni < 4; ++ni) {
      const int c = ni * 16 + l15, ch = gr * 64 + c;
      const float ng = p.gmlp_norm_g[ch];
#pragma unroll
      for (int j = 0; j < 4; ++j) {
        const int i = i_base + mi * 16 + g * 4 + j;
        const size_t t = (size_t)t0 + i;
        const float sp = acc[mi][ni][j] * ng + p.gmlp_b_s[gr * 128 + i];
        AB[t * 1024 + ch] = f2bf(bf2f(U[t * 512 + ch]) * sp);
      }
    }
  }
}

__device__ __forceinline__ void attn_item(const Params& p, int item, char* lds) {
  const int tid = tid_() & 255, lane = tid & 63, wave = tid >> 6, l15 = lane & 15, g = lane >> 4;
  const int c = item & 63, h = (item >> 6) & 7, b = item >> 9;
  const u16* QK = (const u16*)(p.ws + OFF_QK);
  const u16* VT = (const u16*)(p.ws + OFF_VT);
  u16* AB = (u16*)(p.ws + OFF_AB);
  char* Ks = lds;
  char* Vs = lds + 64 * LSTR;
  float* bias_s = (float*)(lds + 2 * 64 * LSTR);
  __syncthreads();
  for (int i = tid; i < 257; i += 256) bias_s[i] = p.rel_bias[h * 257 + i];
  const size_t tq = (size_t)b * SEQ + c * 64 + wave * 16 + l15;
  bf16x8 qb0, qb1;
  {
    const u16* qp = QK + tq * 1024 + h * 64 + g * 8;
    const uint4 q0 = *(const uint4*)qp, q1 = *(const uint4*)(qp + 32);
    float f[16] = {bf_lo(q0.x), bf_hi(q0.x), bf_lo(q0.y), bf_hi(q0.y), bf_lo(q0.z), bf_hi(q0.z), bf_lo(q0.w), bf_hi(q0.w),
                   bf_lo(q1.x), bf_hi(q1.x), bf_lo(q1.y), bf_hi(q1.y), bf_lo(q1.z), bf_hi(q1.z), bf_lo(q1.w), bf_hi(q1.w)};
    float ss = 0.f;
#pragma unroll
    for (int i = 0; i < 16; ++i) ss += f[i] * f[i];
    ss += __shfl_xor(ss, 16); ss += __shfl_xor(ss, 32);
    const float rq = rsqrtf(ss * (1.f / 64.f) + EPS) * 0.125f;
    const float4 ga = *(const float4*)(p.q_norm_g + g * 8), gb = *(const float4*)(p.q_norm_g + g * 8 + 4);
    const float4 gc = *(const float4*)(p.q_norm_g + 32 + g * 8), gd = *(const float4*)(p.q_norm_g + 32 + g * 8 + 4);
    const float gg[16] = {ga.x, ga.y, ga.z, ga.w, gb.x, gb.y, gb.z, gb.w, gc.x, gc.y, gc.z, gc.w, gd.x, gd.y, gd.z, gd.w};
#pragma unroll
    for (int i = 0; i < 16; ++i) f[i] *= rq * gg[i];
    qb0 = mk8(pack2(f[0], f[1]), pack2(f[2], f[3]), pack2(f[4], f[5]), pack2(f[6], f[7]));
    qb1 = mk8(pack2(f[8], f[9]), pack2(f[10], f[11]), pack2(f[12], f[13]), pack2(f[14], f[15]));
  }
  f32x4 o[4];
#pragma unroll
  for (int i = 0; i < 4; ++i) o[i] = f32x4{0.f, 0.f, 0.f, 0.f};
  float m_run = -1e30f, l_run = 0.f;
  const int srow = tid >> 2, spart = tid & 3;
  float kg[16];
  {
    const float4* kgp = (const float4*)(p.k_norm_g + spart * 16);
    const float4 a = kgp[0], bq = kgp[1], cq = kgp[2], d = kgp[3];
    kg[0] = a.x; kg[1] = a.y; kg[2] = a.z; kg[3] = a.w; kg[4] = bq.x; kg[5] = bq.y; kg[6] = bq.z; kg[7] = bq.w;
    kg[8] = cq.x; kg[9] = cq.y; kg[10] = cq.z; kg[11] = cq.w; kg[12] = d.x; kg[13] = d.y; kg[14] = d.z; kg[15] = d.w;
  }
  const int kc_lo = (c >= 8) ? 0 : (8 - c);
  for (int kc = kc_lo; kc <= 8; ++kc) {
    const int kchunk = c - 8 + kc;
    __syncthreads();
    {
      const size_t tk = (size_t)b * SEQ + kchunk * 64 + srow;
      const u16* kp = QK + tk * 1024 + 512 + h * 64 + spart * 16;
      const uint4 k0 = *(const uint4*)kp, k1 = *(const uint4*)(kp + 8);
      const u16* vp = VT + ((size_t)b * 512 + h * 64 + srow) * SEQ + kchunk * 64 + spart * 16;
      const uint4 v0 = *(const uint4*)vp, v1 = *(const uint4*)(vp + 8);
      float f[16] = {bf_lo(k0.x), bf_hi(k0.x), bf_lo(k0.y), bf_hi(k0.y), bf_lo(k0.z), bf_hi(k0.z), bf_lo(k0.w), bf_hi(k0.w),
                     bf_lo(k1.x), bf_hi(k1.x), bf_lo(k1.y), bf_hi(k1.y), bf_lo(k1.z), bf_hi(k1.z), bf_lo(k1.w), bf_hi(k1.w)};
      float ss = 0.f;
#pragma unroll
      for (int i = 0; i < 16; ++i) ss += f[i] * f[i];
      ss += __shfl_xor(ss, 1); ss += __shfl_xor(ss, 2);
      const float rk = rsqrtf(ss * (1.f / 64.f) + EPS);
#pragma unroll
      for (int i = 0; i < 16; ++i) f[i] *= rk * kg[i];
      char* kd = Ks + srow * LSTR + spart * 32;
      *(uint4*)kd = make_uint4(pack2(f[0], f[1]), pack2(f[2], f[3]), pack2(f[4], f[5]), pack2(f[6], f[7]));
      *(uint4*)(kd + 16) = make_uint4(pack2(f[8], f[9]), pack2(f[10], f[11]), pack2(f[12], f[13]), pack2(f[14], f[15]));
      char* vd = Vs + srow * LSTR + spart * 32;
      *(uint4*)vd = v0;
      *(uint4*)(vd + 16) = v1;
    }
    __syncthreads();
    f32x4 s[4];
#pragma unroll
    for (int mt = 0; mt < 4; ++mt) {
      const char* kr = Ks + (mt * 16 + l15) * LSTR + g * 16;
      const bf16x8 a0 = *(const bf16x8*)kr, a1 = *(const bf16x8*)(kr + 64);
      s[mt] = mfma16(a0, qb0, f32x4{0.f, 0.f, 0.f, 0.f});
      s[mt] = mfma16(a1, qb1, s[mt]);
    }
    if (kc <= 5) {
      const float bc = bias_s[256];
#pragma unroll
      for (int mt = 0; mt < 4; ++mt)
#pragma unroll
        for (int j = 0; j < 4; ++j) s[mt][j] += bc;
    } else {
      const int qi = wave * 16 + l15 + 64 * (8 - kc);
#pragma unroll
      for (int mt = 0; mt < 4; ++mt)
#pragma unroll
        for (int j = 0; j < 4; ++j) {
          int rel = qi - (mt * 16 + g * 4 + j);
          rel = rel > 128 ? 128 : rel;
          s[mt][j] += bias_s[rel + 128];
        }
    }
    float mx = s[0][0];
#pragma unroll
    for (int mt = 0; mt < 4; ++mt)
#pragma unroll
      for (int j = 0; j < 4; ++j) mx = fmaxf(mx, s[mt][j]);
    mx = fmaxf(mx, __shfl_xor(mx, 16));
    mx = fmaxf(mx, __shfl_xor(mx, 32));
    const float m_new = fmaxf(m_run, mx);
    const float alpha = __expf(m_run - m_new);
    m_run = m_new;
    float ls = 0.f;
#pragma unroll
    for (int mt = 0; mt < 4; ++mt)
#pragma unroll
      for (int j = 0; j < 4; ++j) { s[mt][j] = __expf(s[mt][j] - m_new); ls += s[mt][j]; }
    l_run = l_run * alpha + ls;
#pragma unroll
    for (int mt = 0; mt < 4; ++mt)
#pragma unroll
      for (int j = 0; j < 4; ++j) o[mt][j] *= alpha;
#pragma unroll
    for (int k2 = 0; k2 < 2; ++k2) {
      const bf16x8 pb = mk8(pack2(s[2 * k2][0], s[2 * k2][1]), pack2(s[2 * k2][2], s[2 * k2][3]),
                            pack2(s[2 * k2 + 1][0], s[2 * k2 + 1][1]), pack2(s[2 * k2 + 1][2], s[2 * k2 + 1][3]));
#pragma unroll
      for (int mt = 0; mt < 4; ++mt) {
        const char* vr = Vs + (mt * 16 + l15) * LSTR + (32 * k2 + 4 * g) * 2;
        const uint2 va = *(const uint2*)vr, vb = *(const uint2*)(vr + 32);
        o[mt] = mfma16(mk8(va.x, va.y, vb.x, vb.y), pb, o[mt]);
      }
    }
  }
  float l = l_run;
  l += __shfl_xor(l, 16); l += __shfl_xor(l, 32);
  const float inv = 1.f / l;
#pragma unroll
  for (int mt = 0; mt < 4; ++mt) {
    *(uint2*)(AB + tq * 1024 + 512 + h * 64 + mt * 16 + g * 4) =
        make_uint2(pack2(o[mt][0] * inv, o[mt][1] * inv), pack2(o[mt][2] * inv, o[mt][3] * inv));
  }
}

__device__ __forceinline__ void phase2(const Params& p, char* lds) {
  const int sub = tid_() >> 8;
  for (int it = bid_(); it < 2048 + 1024; it += gridDim.x) {
    if (it < 2048) {
      const int b = it >> 8, hp = (it >> 6) & 3, c = ((it & 63) + 8 * b) & 63;
      attn_item(p, (b << 9) | ((hp * 2 + sub) << 6) | c, lds + sub * 20480);
    } else {
      gmlp_item(p, (it - 2048) * 2 + sub);
    }
  }
}

__device__ __forceinline__ void phase3(const Params& p, char* lds) {
  pg8::Gemm g{(const u16*)(p.ws + OFF_AB), (const u16*)(p.ws + OFF_WOUTT), T, 1024, 1024};
  pg8::StaticOrder S; S.init(T, 1024, (int)gridDim.x, (int)blockIdx.x);
  EpiOut E{p.x, p.out, (u16*)(p.ws + OFF_HB)};
  pg8::gemm_phase<EpiOut, pg8::StaticOrder, true, true>(LDS3(lds), g, S, E);
}
__device__ __forceinline__ void phase4(const Params& p, char* lds) {
  pg8::Gemm g{(const u16*)(p.ws + OFF_HB), (const u16*)(p.ws + OFF_WQT), T, 2048, 1024};
  pg8::StaticOrder S; S.init(T, 2048, (int)gridDim.x, (int)blockIdx.x);
  EpiQ E{(u16*)(p.ws + OFF_PQ)};
  pg8::gemm_phase<EpiQ, pg8::StaticOrder, true, true>(LDS3(lds), g, S, E);
}

#define INS16(KEY)                                            \
  do {                                                        \
    unsigned _k = (KEY);                                      \
    _Pragma("unroll") for (int _q = 0; _q < 16; ++_q) {       \
      const unsigned _hi = max(tv[_q], _k);                   \
      _k = min(tv[_q], _k);                                   \
      tv[_q] = _hi;                                           \
    }                                                         \
  } while (0)

__device__ __forceinline__ void select_item(const Params& p, int item, char* lds) {
  const int tid = tid_() & 255, lane = tid & 63, wave = tid >> 6, l15 = lane & 15, g = lane >> 4;
  const int h = item & 7, t0 = (item >> 3) * 64;
  const u16* PQ = (const u16*)(p.ws + OFF_PQ);
  const u16* KEYS = (const u16*)(p.ws + OFF_KEYS);
  int* EIDX = (int*)(p.ws + OFF_EIDX);
  float* BEST = (float*)(p.ws + OFF_BEST);
  float* sc = (float*)lds;
  __syncthreads();
  {
    const u16* qp = PQ + (size_t)(t0 + wave * 16 + l15) * 2048 + h * 256 + g * 8;
#pragma unroll
    for (int pp = 0; pp < 2; ++pp) {
      bf16x8 qf[4];
#pragma unroll
      for (int ks = 0; ks < 4; ++ks) qf[ks] = *(const bf16x8*)(qp + pp * 128 + ks * 32);
#pragma unroll
      for (int nt = 0; nt < 8; ++nt) {
        const u16* kp = KEYS + ((size_t)((h * 2 + pp) * 128 + nt * 16 + l15)) * 128 + g * 8;
        f32x4 a = f32x4{0.f, 0.f, 0.f, 0.f};
#pragma unroll
        for (int ks = 0; ks < 4; ++ks) a = mfma16(qf[ks], *(const bf16x8*)(kp + ks * 32), a);
#pragma unroll
        for (int j = 0; j < 4; ++j) sc[(wave * 16 + g * 4 + j) * 257 + pp * 128 + nt * 16 + l15] = a[j];
      }
    }
  }
  __syncthreads();
  if (tid < 128) {
    const int row = tid & 63, pp = tid >> 6;
    float* srow = sc + row * 257 + pp * 128;
    unsigned tv[16];
#pragma unroll
    for (int q = 0; q < 16; ++q) tv[q] = 0u;
#pragma unroll 4
    for (int k = 0; k < 128; ++k) {
      const unsigned key = (okey(srow[k]) & ~127u) | (unsigned)(127 - k);
      INS16(key);
    }
    float vals[16];
    int idxs[16];
#pragma unroll
    for (int q = 0; q < 16; ++q) { idxs[q] = 127 - (int)(tv[q] & 127u); vals[q] = srow[idxs[q]]; }
#pragma unroll
    for (int q = 0; q < 16; ++q) { srow[q] = vals[q]; ((int*)srow)[16 + q] = idxs[q]; }
  }
  __syncthreads();
  if (tid < 64) {
    const int row = tid;
    const float* r0 = sc + row * 257;
    const float* r1 = r0 + 128;
    float s0[16], s1[16];
#pragma unroll
    for (int q = 0; q < 16; ++q) { s0[q] = r0[q]; s1[q] = r1[q]; }
    unsigned tv[16];
#pragma unroll
    for (int q = 0; q < 16; ++q) tv[q] = 0u;
#pragma unroll
    for (int a = 0; a < 16; ++a) {
#pragma unroll
      for (int bb = 0; bb < 16; ++bb) {
        if ((a + 1) * (bb + 1) <= 16) {
          const unsigned key = (okey(s0[a] + s1[bb]) & ~255u) | (unsigned)(255 - (a * 16 + bb));
          INS16(key);
        }
      }
    }
    const size_t ob = ((size_t)(t0 + row) * 8 + h) * 16;
#pragma unroll
    for (int q = 0; q < 16; ++q) {
      const int code = 255 - (int)(tv[q] & 255u);
      const int a = code >> 4, bb = code & 15;
      const float best = r0[a] + r1[bb];
      const int e = ((const int*)r0)[16 + a] * 128 + ((const int*)r1)[16 + bb];
      EIDX[ob + q] = e;
      BEST[ob + q] = best;
    }
  }
}

__device__ __forceinline__ void phase5(const Params& p, char* lds) {
  const int sub = tid_() >> 8;
  for (int it = bid_(); it < 512 * 4; it += gridDim.x) select_item(p, it * 2 + sub, lds + sub * 65792);
}

#define CVT_LO(w) __builtin_amdgcn_cvt_pk_f32_fp8((int)(w), false)
#define CVT_HI(w) __builtin_amdgcn_cvt_pk_f32_fp8((int)(w), true)
__device__ __forceinline__ void phase6(const Params& p, char* lds) {
  const int tid = tid_(), lane = tid & 63, wave = tid >> 6, l15 = lane & 15, g = lane >> 4;
  const u16* HB = (const u16*)(p.ws + OFF_HB);
  const unsigned char* EU8 = (const unsigned char*)(p.ws + OFF_EU);
  const unsigned char* EV8 = (const unsigned char*)(p.ws + OFF_EV);
  const float* ESC = (const float*)(p.ws + OFF_ESC);
  const int* EIDX = (const int*)(p.ws + OFF_EIDX);
  const float* BEST = (const float*)(p.ws + OFF_BEST);
  float* wl = (float*)lds + wave * 128;
  for (int t = bid_() * NWAVE + wave; t < T; t += gridDim.x * NWAVE) {
    f32x2 hf[32];
    {
      const u16* hrow = HB + (size_t)t * 1024 + l15 * 16;
#pragma unroll
      for (int i = 0; i < 4; ++i) {
        const uint4 a = *(const uint4*)(hrow + i * 256), b = *(const uint4*)(hrow + i * 256 + 8);
        hf[i * 8 + 0] = f32x2{bf_lo(a.x), bf_hi(a.x)}; hf[i * 8 + 1] = f32x2{bf_lo(a.y), bf_hi(a.y)};
        hf[i * 8 + 2] = f32x2{bf_lo(a.z), bf_hi(a.z)}; hf[i * 8 + 3] = f32x2{bf_lo(a.w), bf_hi(a.w)};
        hf[i * 8 + 4] = f32x2{bf_lo(b.x), bf_hi(b.x)}; hf[i * 8 + 5] = f32x2{bf_lo(b.y), bf_hi(b.y)};
        hf[i * 8 + 6] = f32x2{bf_lo(b.z), bf_hi(b.z)}; hf[i * 8 + 7] = f32x2{bf_lo(b.w), bf_hi(b.w)};
      }
    }
    float ss;
    {
      f32x2 s2 = f32x2{0.f, 0.f};
#pragma unroll
      for (int i = 0; i < 32; ++i) s2 = __builtin_elementwise_fma(hf[i], hf[i], s2);
      ss = s2.x + s2.y;
    }
    ss += __shfl_xor(ss, 1); ss += __shfl_xor(ss, 2); ss += __shfl_xor(ss, 4); ss += __shfl_xor(ss, 8);
    const float rs2 = rsqrtf(ss * (1.f / 1024.f) + EPS);
    const int ea = EIDX[(size_t)t * 128 + lane], eb = EIDX[(size_t)t * 128 + 64 + lane];
    float ga, gb;
    {
      const float ba = BEST[(size_t)t * 128 + lane] * rs2, bb = BEST[(size_t)t * 128 + 64 + lane] * rs2;
      float ma = ba, mb = bb;
#pragma unroll
      for (int o = 1; o < 16; o <<= 1) { ma = fmaxf(ma, __shfl_xor(ma, o)); mb = fmaxf(mb, __shfl_xor(mb, o)); }
      const float xa = __expf(ba - ma), xb = __expf(bb - mb);
      float sa = xa, sb = xb;
#pragma unroll
      for (int o = 1; o < 16; o <<= 1) { sa += __shfl_xor(sa, o); sb += __shfl_xor(sb, o); }
      ga = xa / sa; gb = xb / sb;
    }
#pragma unroll 2
    for (int it = 0; it < 32; ++it) {
      const int k = it * 4 + g;
      const int e = __shfl((it < 16) ? ea : eb, k & 63);
      const float gk = __shfl((it < 16) ? ga : gb, k & 63);
      const unsigned char* urow = EU8 + (size_t)e * 1024 + l15 * 16;
      uint4 uv[4];
#pragma unroll
      for (int i = 0; i < 4; ++i) uv[i] = *(const uint4*)(urow + i * 256);
      const float usc = ESC[e], vsc = ESC[16384 + e];
      f32x2 d0 = f32x2{0.f, 0.f}, d1 = f32x2{0.f, 0.f};
#pragma unroll
      for (int i = 0; i < 4; ++i) {
        d0 = __builtin_elementwise_fma(CVT_LO(uv[i].x), hf[i * 8 + 0], d0); d1 = __builtin_elementwise_fma(CVT_HI(uv[i].x), hf[i * 8 + 1], d1);
        d0 = __builtin_elementwise_fma(CVT_LO(uv[i].y), hf[i * 8 + 2], d0); d1 = __builtin_elementwise_fma(CVT_HI(uv[i].y), hf[i * 8 + 3], d1);
        d0 = __builtin_elementwise_fma(CVT_LO(uv[i].z), hf[i * 8 + 4], d0); d1 = __builtin_elementwise_fma(CVT_HI(uv[i].z), hf[i * 8 + 5], d1);
        d0 = __builtin_elementwise_fma(CVT_LO(uv[i].w), hf[i * 8 + 6], d0); d1 = __builtin_elementwise_fma(CVT_HI(uv[i].w), hf[i * 8 + 7], d1);
      }
      float d = (d0.x + d0.y) + (d1.x + d1.y);
      d += __shfl_xor(d, 1); d += __shfl_xor(d, 2); d += __shfl_xor(d, 4); d += __shfl_xor(d, 8);
      const float hk = gelu_f(d * rs2 * usc);
      if (l15 == 0) wl[k] = gk * hk * vsc;
    }
    f32x2 acc[32];
#pragma unroll
    for (int i = 0; i < 32; ++i) acc[i] = f32x2{0.f, 0.f};
#pragma unroll 2
    for (int it = 0; it < 32; ++it) {
      const int k = it * 4 + g;
      const int e = __shfl((it < 16) ? ea : eb, k & 63);
      const float wk = wl[k];
      const f32x2 w2 = f32x2{wk, wk};
      const unsigned char* vrow = EV8 + (size_t)e * 1024 + l15 * 16;
      uint4 vv[4];
#pragma unroll
      for (int i = 0; i < 4; ++i) vv[i] = *(const uint4*)(vrow + i * 256);
#pragma unroll
      for (int i = 0; i < 4; ++i) {
        acc[i * 8 + 0] = __builtin_elementwise_fma(CVT_LO(vv[i].x), w2, acc[i * 8 + 0]); acc[i * 8 + 1] = __builtin_elementwise_fma(CVT_HI(vv[i].x), w2, acc[i * 8 + 1]);
        acc[i * 8 + 2] = __builtin_elementwise_fma(CVT_LO(vv[i].y), w2, acc[i * 8 + 2]); acc[i * 8 + 3] = __builtin_elementwise_fma(CVT_HI(vv[i].y), w2, acc[i * 8 + 3]);
        acc[i * 8 + 4] = __builtin_elementwise_fma(CVT_LO(vv[i].z), w2, acc[i * 8 + 4]); acc[i * 8 + 5] = __builtin_elementwise_fma(CVT_HI(vv[i].z), w2, acc[i * 8 + 5]);
        acc[i * 8 + 6] = __builtin_elementwise_fma(CVT_LO(vv[i].w), w2, acc[i * 8 + 6]); acc[i * 8 + 7] = __builtin_elementwise_fma(CVT_HI(vv[i].w), w2, acc[i * 8 + 7]);
      }
    }
    f32x2 r1[16];
    const bool hi2 = (g & 2) != 0;
#pragma unroll
    for (int i = 0; i < 16; ++i) {
      const f32x2 send = hi2 ? acc[i] : acc[i + 16];
      const f32x2 keep = hi2 ? acc[i + 16] : acc[i];
      r1[i] = f32x2{keep.x + __shfl_xor(send.x, 32), keep.y + __shfl_xor(send.y, 32)};
    }
    f32x2 r2[8];
    const bool hi1 = (g & 1) != 0;
#pragma unroll
    for (int i = 0; i < 8; ++i) {
      const f32x2 send = hi1 ? r1[i] : r1[i + 8];
      const f32x2 keep = hi1 ? r1[i + 8] : r1[i];
      r2[i] = f32x2{keep.x + __shfl_xor(send.x, 16), keep.y + __shfl_xor(send.y, 16)};
    }
    float4* op = (float4*)(p.out + (size_t)t * 1024 + g * 256 + l15 * 16);
#pragma unroll
    for (int q = 0; q < 4; ++q) {
      float4 a = op[q];
      a.x += r2[q * 2].x; a.y += r2[q * 2].y; a.z += r2[q * 2 + 1].x; a.w += r2[q * 2 + 1].y;
      op[q] = a;
    }
  }
}

#ifndef PMASK
#define PMASK 127
#endif
#define PROG 0x6543210ull
#define NPROG 7
__global__ void __launch_bounds__(NTHR, 2) mega(Params p, int ph_lo, int ph_hi) {
  extern __shared__ __attribute__((aligned(16))) char lds[];
  cg::grid_group grid = cg::this_grid();
#define IN(k) (ph_lo <= (k) && (k) < ph_hi)
#define SEAM(k) do { if (IN(k) && IN((k) + 1)) grid.sync(); } while (0)
  if (IN(0)) phase0(p, lds);
  SEAM(0);
  if (IN(1)) phase1(p, lds);
  SEAM(1);
  if (IN(2)) phase2(p, lds);
  SEAM(2);
  if (IN(3)) phase3(p, lds);
  SEAM(3);
  if (IN(4)) phase4(p, lds);
  SEAM(4);
  if (IN(5)) phase5(p, lds);
  SEAM(5);
  if (IN(6)) phase6(p, lds);
}

extern "C" void kernel_launch(void* const* d_in, const int* in_sizes, int n_in, void* d_out, int out_size, void* d_ws,
                              size_t ws_size, hipStream_t stream) {
  static int grid_blocks = 0;
  if (!grid_blocks) {
    int dev = 0, cus = 0, per_cu = 0;
    (void)hipGetDevice(&dev);
    (void)hipDeviceGetAttribute(&cus, hipDeviceAttributeMultiprocessorCount, dev);
    (void)hipFuncSetAttribute((const void*)mega, hipFuncAttributeMaxDynamicSharedMemorySize, LDS_BYTES);
    (void)hipOccupancyMaxActiveBlocksPerMultiprocessor(&per_cu, mega, NTHR, LDS_BYTES);
    if (per_cu > 1) per_cu = 1;
    grid_blocks = cus * per_cu;
  }
  Params p{};
  p.x = (const float*)d_in[0]; p.ln_mix_g = (const float*)d_in[1]; p.w_in = (const float*)d_in[2];
  p.gmlp_norm_g = (const float*)d_in[3]; p.gmlp_w_s = (const float*)d_in[4]; p.gmlp_b_s = (const float*)d_in[5];
  p.q_norm_g = (const float*)d_in[6]; p.k_norm_g = (const float*)d_in[7]; p.rel_bias = (const float*)d_in[8];
  p.w_out = (const float*)d_in[9]; p.ln_ffn_g = (const float*)d_in[10]; p.w_query = (const float*)d_in[11];
  p.sub_keys = (const float*)d_in[12]; p.peer_u = (const float*)d_in[13]; p.peer_v = (const float*)d_in[14];
  p.out = (float*)d_out; p.ws = (char*)d_ws;
#if FUSED
  int lo = 0, hi = NPROG;
  void* args[] = {&p, &lo, &hi};
  hipError_t e = hipLaunchCooperativeKernel((void*)mega, dim3(grid_blocks), dim3(NTHR), args, LDS_BYTES, stream);
  if (e != hipSuccess) fprintf(stderr, "cooperative launch failed: %s (grid %d)\n", hipGetErrorString(e), grid_blocks);
#else
  for (int ph = 0; ph < NPROG; ++ph) mega<<<dim3(grid_blocks), dim3(NTHR), LDS_BYTES, stream>>>(p, ph, ph + 1);
#endif
}
```

```cpp
#include <hip/hip_runtime.h>
#include <hip/hip_cooperative_groups.h>
#include <cstdio>
namespace cg = cooperative_groups;

#ifndef FUSED
#define FUSED 1
#endif

typedef unsigned short u16;
using bf16x8 = __attribute__((ext_vector_type(8))) short;
using s16x4 = __attribute__((ext_vector_type(4))) short;
using f32x4 = __attribute__((ext_vector_type(4))) float;
using bf16x2 = __attribute__((ext_vector_type(2))) __bf16;
using f32x2 = __attribute__((ext_vector_type(2))) float;

constexpr int T = 32768, DM = 1024, SEQ = 4096;
constexpr float EPS = 1e-6f;
constexpr size_t MiB = 1u << 20;
constexpr size_t OFF_XB = 0, OFF_WINT = 64 * MiB  , OFF_WB = 67 * MiB  , OFF_WOUTT = 69 * MiB, OFF_WQT = 71 * MiB, OFF_KEYS = 75 * MiB,
                 OFF_RS = 76 * MiB, OFF_VSS = 76 * MiB + 512 * 1024, OFF_EU = 77 * MiB, OFF_EV = 109 * MiB,
                 OFF_U = 141 * MiB, OFF_GVT = 173 * MiB, OFF_QK = 205 * MiB, OFF_VT = 269 * MiB, OFF_AB = 301 * MiB,
                 OFF_HB = 365 * MiB, OFF_PQ = 141 * MiB  , OFF_EIDX = 429 * MiB,
                 OFF_BEST = 445 * MiB, OFF_ESC = 461 * MiB  , OFF_WGT = 462 * MiB  , OFF_PART = 141 * MiB  ;

struct Params {
  const float *x, *ln_mix_g, *w_in, *gmlp_norm_g, *gmlp_w_s, *gmlp_b_s, *q_norm_g, *k_norm_g, *rel_bias, *w_out,
      *ln_ffn_g, *w_query, *sub_keys, *peer_u, *peer_v;
  float* out;
  char* ws;
};

constexpr int LDS_BYTES = 131584;
constexpr int NTHR = 512, NWAVE = 8;
constexpr int LSTR = 144;
constexpr int OPER_BYTES = 128 * LSTR;

__device__ __forceinline__ u16 f2bf(float f) {
  unsigned u = __float_as_uint(f);
  u += 0x7fffu + ((u >> 16) & 1u);
  return (u16)(u >> 16);
}
__device__ __forceinline__ unsigned pack2(float lo, float hi) { return (unsigned)f2bf(lo) | ((unsigned)f2bf(hi) << 16); }
__device__ __forceinline__ float bf_lo(unsigned u) { return __uint_as_float(u << 16); }
__device__ __forceinline__ float bf_hi(unsigned u) { return __uint_as_float(u & 0xffff0000u); }
__device__ __forceinline__ float bf2f(u16 v) { return __uint_as_float(((unsigned)v) << 16); }
__device__ __forceinline__ float gelu_f(float x) {
  float z = 0.7978845608028654f * (x + 0.044715f * x * x * x);
  float e = __expf(2.f * z);
  float th = 1.f - 2.f / (1.f + e);
  return 0.5f * x * (1.f + th);
}
__device__ __forceinline__ float dot2(unsigned a, unsigned b, float acc) {
  return __builtin_amdgcn_fdot2_f32_bf16(__builtin_bit_cast(bf16x2, a), __builtin_bit_cast(bf16x2, b), acc, false);
}
__device__ __forceinline__ f32x4 mfma16(bf16x8 a, bf16x8 b, f32x4 c) {
  return __builtin_amdgcn_mfma_f32_16x16x32_bf16(a, b, c, 0, 0, 0);
}
__device__ __forceinline__ bf16x8 mk8(unsigned a, unsigned b, unsigned c, unsigned d) {
  uint4 u = make_uint4(a, b, c, d);
  return __builtin_bit_cast(bf16x8, u);
}
__device__ __forceinline__ unsigned pack4_fp8(float a, float b, float c, float d) {
  int r = 0;
  r = __builtin_amdgcn_cvt_pk_fp8_f32(a, b, r, false);
  r = __builtin_amdgcn_cvt_pk_fp8_f32(c, d, r, true);
  return (unsigned)r;
}
__device__ __forceinline__ unsigned okey(float x) {
  unsigned u = __float_as_uint(x);
  return (u & 0x80000000u) ? ~u : (u | 0x80000000u);
}


__device__ __forceinline__ int tid_() { int t = threadIdx.x; asm volatile("" : "+v"(t)); return t; }
__device__ __forceinline__ int bid_() { int b = blockIdx.x; asm volatile("" : "+s"(b)); return b; }
namespace pg8 {
#define PG8_LAS __attribute__((address_space(3)))
typedef unsigned short bf16_t;
typedef short bf16x8 __attribute__((ext_vector_type(8)));
typedef float f32x4 __attribute__((ext_vector_type(4)));
typedef unsigned u32x4 __attribute__((ext_vector_type(4)));
constexpr int BM = 256, BK = 64, HALF = 128, HTB = HALF * BK * 2  , STAGE_BYTES = 8 * HTB, NXCD = 8, WGM = 8;

__host__ __device__ __forceinline__ int lds_byte(int r, int c) { const int st = (r >> 4) * 2 + (c >> 5), rr = r & 15, cc = c & 31, ob = rr * 64 + cc * 2; return st * 1024 + (ob ^ (((ob >> 9) & 1) << 5)); }
__host__ __device__ __forceinline__ void stage_rc(int b, int& R, int& C) { const int st = b / 1024, sb = b % 1024, swz = sb ^ (((sb >> 9) & 1) << 5); R = (st >> 1) * 16 + swz / 64; C = (st & 1) * 32 + (swz % 64) / 2; }
__host__ __device__ __forceinline__ int perm32(int rho) { const int n = rho >> 4, i = rho & 15; return 8 * (i >> 2) + 4 * n + (i & 3); }

struct Unit { int pm, pn; };
struct Gemm { const bf16_t* A; const bf16_t* Bt; int M, N, K; };

struct StaticOrder {
    int nM, nN, nwg, G, c;
    __host__ __device__ void init(int M, int N, int G_, int c_) { nM = M / BM; nN = N / BM; nwg = nM * nN; G = G_; c = c_; }
    __host__ __device__ bool next(int i, Unit& u) const {
        const long L = (long)i * G + c; if (L >= nwg) return false;
        int wgid = (int)L; { const int q = nwg / NXCD, r = nwg % NXCD, xcd = wgid % NXCD, off = wgid / NXCD; wgid = (xcd < r ? xcd * (q + 1) : r * (q + 1) + (xcd - r) * q) + off; }
        const int nig = WGM * nN, gid = wgid / nig, fm = gid * WGM, gsz = (nM - fm) < WGM ? (nM - fm) : WGM;
        u.pm = fm + ((wgid % nig) % gsz); u.pn = (wgid % nig) / gsz; return true;
    }
    __device__ __forceinline__ void a_ready(const Unit&) const {}
    __device__ __forceinline__ void done(const Unit&) const {}
};

__device__ __forceinline__ unsigned cvt_pk_bf16(float lo, float hi) { unsigned r; asm volatile("v_cvt_pk_bf16_f32 %0, %1, %2" : "=v"(r) : "v"(lo), "v"(hi)); return r; }
template <class Epi, class Sched, bool ALIGN_EPI = false, bool SP2 = false>
__device__ __forceinline__ void gemm_phase(PG8_LAS unsigned char* lds, const Gemm g, const Sched& S, const Epi& E) {
    const int tid = threadIdx.x, wid = __builtin_amdgcn_readfirstlane(tid >> 6), lane = tid & 63, wr = wid >> 2, wc = wid & 3, fr = lane & 15, fq = lane >> 4;
    const int K = g.K, nt = K / BK;
    unsigned voffA[2], voffB[2];
#pragma unroll
    for (int i = 0; i < 2; ++i) { int R, C; stage_rc(tid * 16 + i * 8192, R, C); const int Rb = Epi::PERM ? ((R & ~31) + perm32(R & 31)) : R;
        voffA[i] = (unsigned)(R * K + C) * 2u; voffB[i] = (unsigned)(Rb * K + C) * 2u; }
    const size_t kstep = (size_t)(BK * 2);
    const size_t hstep = (size_t)HALF * K * 2;
    const size_t tstep = 2 * hstep;
    const unsigned ldsw = (unsigned)wid * 1024u;
    const int aoff = lds_byte(wr * 64 + fr, fq * 8), boff = lds_byte(wc * 32 + fr, fq * 8);
#define PG8_SA(b, h) (((b) * 2 + (h)) * HTB)
#define PG8_SB(b, h) ((4 + (b) * 2 + (h)) * HTB)
#define PG8_STAGE(bufoff, gbase, voff) do { _Pragma("unroll") for (int _i = 0; _i < 2; ++_i) \
        __builtin_amdgcn_global_load_lds((const unsigned*)((const char*)(gbase) + (voff)[_i]), (PG8_LAS unsigned*)(lds + (bufoff) + ldsw + _i * 8192), 16, 0, 0); } while (0)
#define PG8_LDA(dst, b, h) do { _Pragma("unroll") for (int m = 0; m < 4; ++m) _Pragma("unroll") for (int k = 0; k < 2; ++k) dst[m][k] = *(const PG8_LAS bf16x8*)(lds + PG8_SA(b, h) + aoff + m * 2048 + k * 1024); } while (0)
#define PG8_LDB(dst, b, h) do { _Pragma("unroll") for (int n = 0; n < 2; ++n) _Pragma("unroll") for (int k = 0; k < 2; ++k) dst[n][k] = *(const PG8_LAS bf16x8*)(lds + PG8_SB(b, h) + boff + n * 2048 + k * 1024); } while (0)
#define PG8_MMA(ai, bj, At, Bt) do { __builtin_amdgcn_s_setprio(1); _Pragma("unroll") for (int m = 0; m < 4; ++m) _Pragma("unroll") for (int n = 0; n < 2; ++n) _Pragma("unroll") for (int k = 0; k < 2; ++k) \
        acc[ai][bj][m][n] = __builtin_amdgcn_mfma_f32_16x16x32_bf16(Bt[n][k], At[m][k], acc[ai][bj][m][n], 0, 0, 0); __builtin_amdgcn_s_setprio(0); } while (0)
#define PG8_WAIT_V(n) asm volatile("s_waitcnt vmcnt(" #n ")" ::: "memory")
#define PG8_WAIT_L(n) asm volatile("s_waitcnt lgkmcnt(" #n ")" ::: "memory")
#define PG8_BAR __builtin_amdgcn_s_barrier()
#define PG8_SCHED __builtin_amdgcn_sched_barrier(0)
    Unit cur, nxt; int ui = 0;
    if (!S.next(0, cur)) return;
    f32x4 acc[2][2][4][2];
#pragma unroll
    for (int a = 0; a < 2; ++a)
#pragma unroll
        for (int b = 0; b < 2; ++b)
#pragma unroll
            for (int m = 0; m < 4; ++m)
#pragma unroll
                for (int n = 0; n < 2; ++n) acc[a][b][m][n] = (f32x4){0.f, 0.f, 0.f, 0.f};
    bf16x8 At[4][2], B0[2][2], B1[2][2];
    const char* cA = (const char*)g.A + (size_t)cur.pm * tstep; const char* cB = (const char*)g.Bt + (size_t)cur.pn * tstep;
    S.a_ready(cur);
    if constexpr (SP2) {
        PG8_STAGE(PG8_SB(0, 0), cB, voffB); PG8_STAGE(PG8_SB(0, 1), cB + hstep, voffB); PG8_STAGE(PG8_SA(0, 0), cA, voffA); PG8_STAGE(PG8_SA(0, 1), cA + hstep, voffA);
        if (wr == 1) PG8_BAR;
        PG8_WAIT_V(2); PG8_BAR;
        PG8_STAGE(PG8_SB(1, 0), cB + kstep, voffB); PG8_STAGE(PG8_SA(1, 0), cA + kstep, voffA); PG8_STAGE(PG8_SB(1, 1), cB + hstep + kstep, voffB);
        PG8_WAIT_V(6); PG8_BAR;
    } else {
        PG8_STAGE(PG8_SB(0, 0), cB, voffB); PG8_STAGE(PG8_SA(0, 0), cA, voffA); PG8_STAGE(PG8_SB(0, 1), cB + hstep, voffB); PG8_STAGE(PG8_SA(0, 1), cA + hstep, voffA);
        if (wr == 1) PG8_BAR;
        PG8_WAIT_V(4); PG8_BAR;
        PG8_STAGE(PG8_SB(1, 0), cB + kstep, voffB); PG8_STAGE(PG8_SA(1, 0), cA + kstep, voffA); PG8_STAGE(PG8_SB(1, 1), cB + hstep + kstep, voffB);
        PG8_WAIT_V(6); PG8_BAR;
    }
    for (;;) {
        const bool has_next = S.next(ui + 1, nxt);
        const char* nA = has_next ? (const char*)g.A + (size_t)nxt.pm * tstep : cA; const char* nB = has_next ? (const char*)g.Bt + (size_t)nxt.pn * tstep : cB;
        for (int t = 0; t < nt; t += 2) {
            const bool last = (t == nt - 2);
            const char* a1 = cA + (size_t)(t + 1) * kstep;
            const char* a2 = last ? nA : cA + (size_t)(t + 2) * kstep; const char* b2 = last ? nB : cB + (size_t)(t + 2) * kstep;
            const char* a3 = a2 + kstep; const char* b3 = b2 + kstep;
            if (last && has_next) S.a_ready(nxt);
            if constexpr (SP2) {
            PG8_LDB(B0, 0, 0); PG8_LDB(B1, 0, 1); PG8_SCHED; PG8_LDA(At, 0, 0); PG8_STAGE(PG8_SA(1, 1), a1 + hstep, voffA);
            PG8_WAIT_V(8); PG8_WAIT_L(0); PG8_BAR; PG8_MMA(0, 0, At, B0); PG8_MMA(0, 1, At, B1); PG8_BAR; PG8_SCHED;
            PG8_LDA(At, 0, 1); PG8_STAGE(PG8_SB(0, 0), b2, voffB); PG8_STAGE(PG8_SB(0, 1), b2 + hstep, voffB); PG8_STAGE(PG8_SA(0, 0), a2, voffA);
            PG8_WAIT_V(8); PG8_WAIT_L(0); PG8_BAR; PG8_MMA(1, 0, At, B0); PG8_MMA(1, 1, At, B1); PG8_BAR; PG8_SCHED;
            PG8_LDB(B0, 1, 0); PG8_LDB(B1, 1, 1); PG8_SCHED; PG8_LDA(At, 1, 0); PG8_STAGE(PG8_SA(0, 1), a2 + hstep, voffA);
            PG8_WAIT_V(8); PG8_WAIT_L(0); PG8_BAR; PG8_MMA(0, 0, At, B0); PG8_MMA(0, 1, At, B1); PG8_BAR; PG8_SCHED;
            PG8_LDA(At, 1, 1); PG8_STAGE(PG8_SB(1, 0), b3, voffB); PG8_STAGE(PG8_SB(1, 1), b3 + hstep, voffB); PG8_STAGE(PG8_SA(1, 0), a3, voffA);
            PG8_WAIT_V(8); PG8_WAIT_L(0); PG8_BAR; PG8_MMA(1, 0, At, B0); PG8_MMA(1, 1, At, B1); PG8_BAR; PG8_SCHED;
            } else {
            PG8_LDB(B0, 0, 0); PG8_SCHED; PG8_LDA(At, 0, 0); PG8_STAGE(PG8_SA(1, 1), a1 + hstep, voffA);
            PG8_WAIT_L(8); PG8_BAR; PG8_WAIT_L(0); PG8_MMA(0, 0, At, B0); PG8_BAR; PG8_SCHED;
            PG8_LDB(B1, 0, 1); PG8_STAGE(PG8_SB(0, 0), b2, voffB);
            PG8_BAR; PG8_WAIT_L(0); PG8_MMA(0, 1, At, B1); PG8_BAR;
            PG8_LDA(At, 0, 1); PG8_STAGE(PG8_SA(0, 0), a2, voffA);
            PG8_BAR; PG8_WAIT_L(0); PG8_MMA(1, 0, At, B0); PG8_BAR; PG8_SCHED;
            PG8_STAGE(PG8_SB(0, 1), b2 + hstep, voffB);
            PG8_WAIT_V(6); PG8_BAR; PG8_MMA(1, 1, At, B1); PG8_BAR;
            PG8_LDB(B0, 1, 0); PG8_SCHED; PG8_LDA(At, 1, 0); PG8_STAGE(PG8_SA(0, 1), a2 + hstep, voffA);
            PG8_WAIT_L(8); PG8_BAR; PG8_WAIT_L(0); PG8_MMA(0, 0, At, B0); PG8_BAR; PG8_SCHED;
            PG8_LDB(B1, 1, 1); PG8_STAGE(PG8_SB(1, 0), b3, voffB);
            PG8_BAR; PG8_WAIT_L(0); PG8_MMA(0, 1, At, B1); PG8_BAR;
            PG8_LDA(At, 1, 1); PG8_STAGE(PG8_SA(1, 0), a3, voffA);
            PG8_BAR; PG8_WAIT_L(0); PG8_MMA(1, 0, At, B0); PG8_BAR; PG8_SCHED;
            PG8_STAGE(PG8_SB(1, 1), b3 + hstep, voffB);
            PG8_WAIT_V(6); PG8_BAR; PG8_MMA(1, 1, At, B1); PG8_BAR;
            }
        }
        if constexpr (ALIGN_EPI) { if (wr == 0) PG8_BAR; }
        if constexpr (!Epi::AFTER_DRAIN) { E(acc, cur, wr, wc, fr, fq); S.done(cur); }
        if (!has_next) break;
#pragma unroll
        for (int a = 0; a < 2; ++a)
#pragma unroll
            for (int b = 0; b < 2; ++b)
#pragma unroll
                for (int m = 0; m < 4; ++m)
#pragma unroll
                    for (int n = 0; n < 2; ++n) acc[a][b][m][n] = (f32x4){0.f, 0.f, 0.f, 0.f};
        cur = nxt; cA = nA; cB = nB; ++ui;
        if constexpr (ALIGN_EPI) { if (wr == 1) PG8_BAR; }
    }
    PG8_WAIT_V(0);
    if constexpr (!ALIGN_EPI) { if (wr == 0) PG8_BAR; }
    PG8_BAR;
    if constexpr (Epi::AFTER_DRAIN) { E.fused(acc, cur, wr, wc, fr, fq, lds, wid, lane); S.done(cur); }
#undef PG8_SA
#undef PG8_SB
#undef PG8_STAGE
#undef PG8_LDA
#undef PG8_LDB
#undef PG8_MMA
#undef PG8_WAIT_V
#undef PG8_WAIT_L
#undef PG8_BAR
#undef PG8_SCHED
}
}

#define EPI_V8(v, A, s) float v[8] = {A[0][0] * (s), A[0][1] * (s), A[0][2] * (s), A[0][3] * (s), A[1][0] * (s), A[1][1] * (s), A[1][2] * (s), A[1][3] * (s)}
__device__ __forceinline__ uint4 pk8(const float (&v)[8]) {
  return make_uint4(pg8::cvt_pk_bf16(v[0], v[1]), pg8::cvt_pk_bf16(v[2], v[3]), pg8::cvt_pk_bf16(v[4], v[5]), pg8::cvt_pk_bf16(v[6], v[7]));
}
struct EpiIn {
  static constexpr bool PERM = true, AFTER_DRAIN = false;
  u16* U; u16* QK; const float* RS;
  __device__ __forceinline__ void operator()(const pg8::f32x4 (&acc)[2][2][4][2], const pg8::Unit& u, int wr, int wc, int fr, int fq) const {
    const int row0 = u.pm * 256 + wr * 64 + fr, colt = u.pn * 256, c0 = colt + wc * 32 + 8 * fq;
    const bool isu = colt < 512;
#pragma unroll
    for (int ai = 0; ai < 2; ++ai)
#pragma unroll
      for (int m = 0; m < 4; ++m) {
        const int row = row0 + ai * 128 + m * 16;
        const float r = RS[row];
#pragma unroll
        for (int bj = 0; bj < 2; ++bj) {
          const int col = c0 + bj * 128;
          EPI_V8(v, acc[ai][bj][m], r);
          if (isu) {
#pragma unroll
            for (int j = 0; j < 8; ++j) v[j] = gelu_f(v[j]);
            *(uint4*)(U + (size_t)row * 512 + col) = pk8(v);
          } else {
            *(uint4*)(QK + (size_t)row * 1024 + (col - 512)) = pk8(v);
          }
        }
      }
  }
};
struct EpiInT {
  static constexpr bool PERM = true, AFTER_DRAIN = false;
  u16* GVT; u16* VT; const float* RS; float* VSS;
  __device__ __forceinline__ void operator()(const pg8::f32x4 (&acc)[2][2][4][2], const pg8::Unit& u, int wr, int wc, int fr, int fq) const {
    const int ch0 = u.pm * 256 + wr * 64 + fr, t0 = u.pn * 256 + wc * 32 + 8 * fq;
    const bool isg = u.pm < 2;
#pragma unroll
    for (int bj = 0; bj < 2; ++bj) {
      const int t = t0 + bj * 128, b = t >> 12, s = t & 4095;
      const float4 ra = *(const float4*)(RS + t), rb = *(const float4*)(RS + t + 4);
      const float rr[8] = {ra.x, ra.y, ra.z, ra.w, rb.x, rb.y, rb.z, rb.w};
      float ss[8] = {0.f, 0.f, 0.f, 0.f, 0.f, 0.f, 0.f, 0.f};
#pragma unroll
      for (int ai = 0; ai < 2; ++ai)
#pragma unroll
        for (int m = 0; m < 4; ++m) {
          const int ch = ch0 + ai * 128 + m * 16;
          float v[8];
#pragma unroll
          for (int j = 0; j < 8; ++j) v[j] = acc[ai][bj][m][j >> 2][j & 3] * rr[j];
          if (isg) {
#pragma unroll
            for (int j = 0; j < 8; ++j) { v[j] = gelu_f(v[j]); ss[j] += v[j] * v[j]; }
            *(uint4*)(GVT + ((size_t)b * 512 + ch) * SEQ + s) = pk8(v);
          } else {
            *(uint4*)(VT + ((size_t)b * 512 + (ch - 512)) * SEQ + s) = pk8(v);
          }
        }
      if (isg) {
#pragma unroll
        for (int j = 0; j < 8; ++j) {
          float sv = ss[j];
          sv += __shfl_xor(sv, 1); sv += __shfl_xor(sv, 2); sv += __shfl_xor(sv, 4); sv += __shfl_xor(sv, 8);
          if (fr == 0) atomicAdd(VSS + t + j, sv);
        }
      }
    }
  }
};
struct EpiOut {
  static constexpr bool PERM = true, AFTER_DRAIN = false;
  const float* X; float* OUT; u16* HB;
  __device__ __forceinline__ void operator()(const pg8::f32x4 (&acc)[2][2][4][2], const pg8::Unit& u, int wr, int wc, int fr, int fq) const {
    const int row0 = u.pm * 256 + wr * 64 + fr, c0 = u.pn * 256 + wc * 32 + 8 * fq;
#pragma unroll
    for (int ai = 0; ai < 2; ++ai)
#pragma unroll
      for (int m = 0; m < 4; ++m) {
        const int row = row0 + ai * 128 + m * 16;
#pragma unroll
        for (int bj = 0; bj < 2; ++bj) {
          const size_t idx = (size_t)row * 1024 + c0 + bj * 128;
          const float4 xa = *(const float4*)(X + idx), xb = *(const float4*)(X + idx + 4);
          float v[8] = {xa.x + acc[ai][bj][m][0][0], xa.y + acc[ai][bj][m][0][1], xa.z + acc[ai][bj][m][0][2], xa.w + acc[ai][bj][m][0][3],
                        xb.x + acc[ai][bj][m][1][0], xb.y + acc[ai][bj][m][1][1], xb.z + acc[ai][bj][m][1][2], xb.w + acc[ai][bj][m][1][3]};
          *(float4*)(OUT + idx) = make_float4(v[0], v[1], v[2], v[3]);
          *(float4*)(OUT + idx + 4) = make_float4(v[4], v[5], v[6], v[7]);
          *(uint4*)(HB + idx) = pk8(v);
        }
      }
  }
};
struct EpiQ {
  static constexpr bool PERM = true, AFTER_DRAIN = false;
  u16* PQ;
  __device__ __forceinline__ void operator()(const pg8::f32x4 (&acc)[2][2][4][2], const pg8::Unit& u, int wr, int wc, int fr, int fq) const {
    const int row0 = u.pm * 256 + wr * 64 + fr, c0 = u.pn * 256 + wc * 32 + 8 * fq;
#pragma unroll
    for (int ai = 0; ai < 2; ++ai)
#pragma unroll
      for (int m = 0; m < 4; ++m) {
        const int row = row0 + ai * 128 + m * 16;
#pragma unroll
        for (int bj = 0; bj < 2; ++bj) {
          EPI_V8(v, acc[ai][bj][m], 1.f);
          *(uint4*)(PQ + (size_t)row * 2048 + c0 + bj * 128) = pk8(v);
        }
      }
  }
};
#define LDS3(p) ((__attribute__((address_space(3))) unsigned char*)(p))

__device__ __forceinline__ void phase0(const Params& p, char* lds) {
  const int tid = tid_(), lane = tid & 63, wave = tid >> 6;
  const int nblk = gridDim.x, blk = bid_();
  u16* XB = (u16*)(p.ws + OFF_XB);
  float* RS = (float*)(p.ws + OFF_RS);
  float* VSS = (float*)(p.ws + OFF_VSS);
  for (int row = blk * NWAVE + wave; row < T; row += nblk * NWAVE) {
    const float4* xr = (const float4*)(p.x + (size_t)row * DM);
    float4 v[4];
    float ss = 0.f;
#pragma unroll
    for (int i = 0; i < 4; ++i) {
      v[i] = xr[lane + 64 * i];
      ss += v[i].x * v[i].x + v[i].y * v[i].y + v[i].z * v[i].z + v[i].w * v[i].w;
    }
#pragma unroll
    for (int o = 1; o < 64; o <<= 1) ss += __shfl_xor(ss, o);
    if (lane == 0) RS[row] = rsqrtf(ss * (1.f / 1024.f) + EPS);
#pragma unroll
    for (int i = 0; i < 4; ++i) {
      uint2 o2 = make_uint2(pack2(v[i].x, v[i].y), pack2(v[i].z, v[i].w));
      *(uint2*)(XB + (size_t)row * DM + (lane + 64 * i) * 4) = o2;
    }
  }
  {
    unsigned char* EU8 = (unsigned char*)(p.ws + OFF_EU);
    unsigned char* EV8 = (unsigned char*)(p.ws + OFF_EV);
    float* ESC = (float*)(p.ws + OFF_ESC);
    for (int row = blk * NWAVE + wave; row < 32768; row += nblk * NWAVE) {
      const bool isv = row >= 16384;
      const int e = row & 16383;
      const float4* src = (const float4*)((isv ? p.peer_v : p.peer_u) + (size_t)e * 1024);
      float4 v[4];
      float am = 0.f;
#pragma unroll
      for (int i = 0; i < 4; ++i) {
        v[i] = src[i * 64 + lane];
        if (!isv) {
          const float4 g4 = ((const float4*)p.ln_ffn_g)[i * 64 + lane];
          v[i].x *= g4.x; v[i].y *= g4.y; v[i].z *= g4.z; v[i].w *= g4.w;
        }
        am = fmaxf(am, fmaxf(fmaxf(fabsf(v[i].x), fabsf(v[i].y)), fmaxf(fabsf(v[i].z), fabsf(v[i].w))));
      }
#pragma unroll
      for (int o = 1; o < 64; o <<= 1) am = fmaxf(am, __shfl_xor(am, o));
      const int ex = (int)((__float_as_uint(am) >> 23) & 255u) - 127;
      const bool ok = (am > 1e-30f);
      const float scale = ok ? __uint_as_float((unsigned)(127 + 7 - ex) << 23) : 1.f;
      const float inv = ok ? __uint_as_float((unsigned)(127 - 7 + ex) << 23) : 1.f;
      unsigned char* dst = (isv ? EV8 : EU8) + (size_t)e * 128;
#pragma unroll
      for (int i = 0; i < 4; ++i) {
        const int d = i * 256 + lane * 4;
        *(unsigned*)(dst + (size_t)(d >> 7) * (2 * MiB) + (d & 127)) = pack4_fp8(v[i].x * scale, v[i].y * scale, v[i].z * scale, v[i].w * scale);
      }
      if (lane == 0) ESC[row] = inv;
    }
  }
  {
    const int half = wave >> 2, w4 = wave & 3;
    float* tile = (float*)lds + half * (64 * 65);
    for (int tp = blk; tp < 704; tp += nblk) {
      const int tl = tp * 2 + half;
      const float* W; const float* gain; u16* dst; int N, kt, nt, drow;
      if (tl < 640) {
        W = p.w_in; gain = p.ln_mix_g; N = 2560; kt = tl / 40; nt = tl % 40;
        const int n0 = nt * 64;
        if (n0 < 512) { dst = (u16*)(p.ws + OFF_WINT); drow = n0; }
        else if (n0 < 1024) { dst = (u16*)(p.ws + OFF_WB); drow = n0 - 512; }
        else if (n0 < 2048) { dst = (u16*)(p.ws + OFF_WINT); drow = n0 - 512; }
        else { dst = (u16*)(p.ws + OFF_WB); drow = n0 - 2048 + 512; }
      } else if (tl < 896) { int t2 = tl - 640; W = p.w_out; gain = nullptr; dst = (u16*)(p.ws + OFF_WOUTT); N = 1024; kt = t2 / 16; nt = t2 % 16; drow = nt * 64; }
      else { int t2 = tl - 896; W = p.w_query; gain = p.ln_ffn_g; dst = (u16*)(p.ws + OFF_WQT); N = 2048; kt = t2 / 32; nt = t2 % 32; drow = nt * 64; }
      __syncthreads();
#pragma unroll 4
      for (int i = 0; i < 16; ++i) {
        const int kk = i * 4 + w4;
        const float gk = gain ? gain[kt * 64 + kk] : 1.f;
        tile[kk * 65 + lane] = W[(size_t)(kt * 64 + kk) * N + nt * 64 + lane] * gk;
      }
      __syncthreads();
#pragma unroll 4
      for (int i = 0; i < 16; ++i) {
        const int nn = i * 4 + w4;
        dst[(size_t)(drow + nn) * 1024 + kt * 64 + lane] = f2bf(tile[lane * 65 + nn]);
      }
    }
    __syncthreads();
  }
  {
    u16* KEYS = (u16*)(p.ws + OFF_KEYS);
    for (int i = blk * NTHR + tid; i < 262144 / 4; i += nblk * NTHR) {
      float4 a = ((const float4*)p.sub_keys)[i];
      *(uint2*)(KEYS + (size_t)i * 4) = make_uint2(pack2(a.x, a.y), pack2(a.z, a.w));
    }
  }
  for (int i = blk * NTHR + tid; i < T; i += nblk * NTHR) VSS[i] = 0.f;
}

__device__ __forceinline__ void phase1(const Params& p, char* lds) {
  const u16* XB = (const u16*)(p.ws + OFF_XB);
  const float* RS = (const float*)(p.ws + OFF_RS);
  {
    pg8::Gemm g{XB, (const u16*)(p.ws + OFF_WINT), T, 1536, 1024};
    pg8::StaticOrder S; S.init(T, 1536, (int)gridDim.x, (int)blockIdx.x);
    EpiIn E{(u16*)(p.ws + OFF_U), (u16*)(p.ws + OFF_QK), RS};
    pg8::gemm_phase<EpiIn, pg8::StaticOrder, true, true>(LDS3(lds), g, S, E);
  }
  {
    pg8::Gemm g{(const u16*)(p.ws + OFF_WB), XB, 1024, T, 1024};
    pg8::StaticOrder S; S.init(1024, T, (int)gridDim.x, (int)blockIdx.x);
    EpiInT E{(u16*)(p.ws + OFF_GVT), (u16*)(p.ws + OFF_VT), RS, (float*)(p.ws + OFF_VSS)};
    pg8::gemm_phase<EpiInT, pg8::StaticOrder, true, true>(LDS3(lds), g, S, E);
  }
}

__device__ __forceinline__ void gmlp_item(const Params& p, int item) {
  const int tid = tid_() & 255, lane = tid & 63, wave = tid >> 6, l15 = lane & 15, g = lane >> 4;
  const int gr = item & 7, n = (item >> 3) & 31, b = item >> 8;
  const int t0 = b * SEQ + n * 128;
  const float* VSS = (const float*)(p.ws + OFF_VSS);
  const u16* GVT = (const u16*)(p.ws + OFF_GVT);
  const u16* U = (const u16*)(p.ws + OFF_U);
  u16* AB = (u16*)(p.ws + OFF_AB);
  f32x4 acc[2][4];
#pragma unroll
  for (int i = 0; i < 2; ++i)
#pragma unroll
    for (int j = 0; j < 4; ++j) acc[i][j] = f32x4{0.f, 0.f, 0.f, 0.f};
  const int i_base = wave * 32;
  const int nks = (wave < 2) ? 2 : 4;
  for (int ks = 0; ks < nks; ++ks) {
    const int j0 = ks * 32 + g * 8;
    const float4 s0 = *(const float4*)(VSS + t0 + j0), s1 = *(const float4*)(VSS + t0 + j0 + 4);
    float r[8] = {s0.x, s0.y, s0.z, s0.w, s1.x, s1.y, s1.z, s1.w};
#pragma unroll
    for (int q = 0; q < 8; ++q) r[q] = rsqrtf(r[q] * (1.f / 512.f) + EPS);
    bf16x8 af[2];
#pragma unroll
    for (int mi = 0; mi < 2; ++mi) {
      const int i = i_base + mi * 16 + l15;
      const float* wp = p.gmlp_w_s + ((size_t)(gr * 128 + i)) * 128 + j0;
      const float4 w0 = *(const float4*)wp, w1 = *(const float4*)(wp + 4);
      af[mi] = mk8(pack2(w0.x * r[0], w0.y * r[1]), pack2(w0.z * r[2], w0.w * r[3]), pack2(w1.x * r[4], w1.y * r[5]),
                   pack2(w1.z * r[6], w1.w * r[7]));
    }
#pragma unroll
    for (int ni = 0; ni < 4; ++ni) {
      const int c = ni * 16 + l15;
      const bf16x8 bfr = *(const bf16x8*)(GVT + ((size_t)b * 512 + gr * 64 + c) * SEQ + n * 128 + j0);
#pragma unroll
      for (int mi = 0; mi < 2; ++mi) acc[mi][ni] = mfma16(af[mi], bfr, acc[mi][ni]);
    }
  }
#pragma unroll
  for (int mi = 0; mi < 2; ++mi) {
#pragma unroll
    for (int ni = 0; ni < 4; ++ni) {
      const int c = ni * 16 + l15, ch = gr * 64 + c;
      const float ng = p.gmlp_norm_g[ch];
#pragma unroll
      for (int j = 0; j < 4; ++j) {
        const int i = i_base + mi * 16 + g * 4 + j;
        const size_t t = (size_t)t0 + i;
        const float sp = acc[mi][ni][j] * ng + p.gmlp_b_s[gr * 128 + i];
        AB[t * 1024 + ch] = f2bf(bf2f(U[t * 512 + ch]) * sp);
      }
    }
  }
}

__device__ __forceinline__ void attn_item(const Params& p, int item, char* lds) {
  const int tid = tid_() & 255, lane = tid & 63, wave = tid >> 6, l15 = lane & 15, g = lane >> 4;
  const int c = item & 63, h = (item >> 6) & 7, b = item >> 9;
  const u16* QK = (const u16*)(p.ws + OFF_QK);
  const u16* VT = (const u16*)(p.ws + OFF_VT);
  u16* AB = (u16*)(p.ws + OFF_AB);
  char* Ks = lds;
  char* Vs = lds + 64 * LSTR;
  float* bias_s = (float*)(lds + 2 * 64 * LSTR);
  __syncthreads();
  for (int i = tid; i < 257; i += 256) bias_s[i] = p.rel_bias[h * 257 + i];
  const size_t tq = (size_t)b * SEQ + c * 64 + wave * 16 + l15;
  bf16x8 qb0, qb1;
  {
    const u16* qp = QK + tq * 1024 + h * 64 + g * 8;
    const uint4 q0 = *(const uint4*)qp, q1 = *(const uint4*)(qp + 32);
    float f[16] = {bf_lo(q0.x), bf_hi(q0.x), bf_lo(q0.y), bf_hi(q0.y), bf_lo(q0.z), bf_hi(q0.z), bf_lo(q0.w), bf_hi(q0.w),
                   bf_lo(q1.x), bf_hi(q1.x), bf_lo(q1.y), bf_hi(q1.y), bf_lo(q1.z), bf_hi(q1.z), bf_lo(q1.w), bf_hi(q1.w)};
    float ss = 0.f;
#pragma unroll
    for (int i = 0; i < 16; ++i) ss += f[i] * f[i];
    ss += __shfl_xor(ss, 16); ss += __shfl_xor(ss, 32);
    const float rq = rsqrtf(ss * (1.f / 64.f) + EPS) * 0.125f;
    const float4 ga = *(const float4*)(p.q_norm_g + g * 8), gb = *(const float4*)(p.q_norm_g + g * 8 + 4);
    const float4 gc = *(const float4*)(p.q_norm_g + 32 + g * 8), gd = *(const float4*)(p.q_norm_g + 32 + g * 8 + 4);
    const float gg[16] = {ga.x, ga.y, ga.z, ga.w, gb.x, gb.y, gb.z, gb.w, gc.x, gc.y, gc.z, gc.w, gd.x, gd.y, gd.z, gd.w};
#pragma unroll
    for (int i = 0; i < 16; ++i) f[i] *= rq * gg[i];
    qb0 = mk8(pack2(f[0], f[1]), pack2(f[2], f[3]), pack2(f[4], f[5]), pack2(f[6], f[7]));
    qb1 = mk8(pack2(f[8], f[9]), pack2(f[10], f[11]), pack2(f[12], f[13]), pack2(f[14], f[15]));
  }
  f32x4 o[4];
#pragma unroll
  for (int i = 0; i < 4; ++i) o[i] = f32x4{0.f, 0.f, 0.f, 0.f};
  float m_run = -1e30f, l_run = 0.f;
  const int srow = tid >> 2, spart = tid & 3;
  float kg[16];
  {
    const float4* kgp = (const float4*)(p.k_norm_g + spart * 16);
    const float4 a = kgp[0], bq = kgp[1], cq = kgp[2], d = kgp[3];
    kg[0] = a.x; kg[1] = a.y; kg[2] = a.z; kg[3] = a.w; kg[4] = bq.x; kg[5] = bq.y; kg[6] = bq.z; kg[7] = bq.w;
    kg[8] = cq.x; kg[9] = cq.y; kg[10] = cq.z; kg[11] = cq.w; kg[12] = d.x; kg[13] = d.y; kg[14] = d.z; kg[15] = d.w;
  }
  const int kc_lo = (c >= 8) ? 0 : (8 - c);
  for (int kc = kc_lo; kc <= 8; ++kc) {
    const int kchunk = c - 8 + kc;
    __syncthreads();
    {
      const size_t tk = (size_t)b * SEQ + kchunk * 64 + srow;
      const u16* kp = QK + tk * 1024 + 512 + h * 64 + spart * 16;
      const uint4 k0 = *(const uint4*)kp, k1 = *(const uint4*)(kp + 8);
      const u16* vp = VT + ((size_t)b * 512 + h * 64 + srow) * SEQ + kchunk * 64 + spart * 16;
      const uint4 v0 = *(const uint4*)vp, v1 = *(const uint4*)(vp + 8);
      float f[16] = {bf_lo(k0.x), bf_hi(k0.x), bf_lo(k0.y), bf_hi(k0.y), bf_lo(k0.z), bf_hi(k0.z), bf_lo(k0.w), bf_hi(k0.w),
                     bf_lo(k1.x), bf_hi(k1.x), bf_lo(k1.y), bf_hi(k1.y), bf_lo(k1.z), bf_hi(k1.z), bf_lo(k1.w), bf_hi(k1.w)};
      float ss = 0.f;
#pragma unroll
      for (int i = 0; i < 16; ++i) ss += f[i] * f[i];
      ss += __shfl_xor(ss, 1); ss += __shfl_xor(ss, 2);
      const float rk = rsqrtf(ss * (1.f / 64.f) + EPS);
#pragma unroll
      for (int i = 0; i < 16; ++i) f[i] *= rk * kg[i];
      char* kd = Ks + srow * LSTR + spart * 32;
      *(uint4*)kd = make_uint4(pack2(f[0], f[1]), pack2(f[2], f[3]), pack2(f[4], f[5]), pack2(f[6], f[7]));
      *(uint4*)(kd + 16) = make_uint4(pack2(f[8], f[9]), pack2(f[10], f[11]), pack2(f[12], f[13]), pack2(f[14], f[15]));
      char* vd = Vs + srow * LSTR + spart * 32;
      *(uint4*)vd = v0;
      *(uint4*)(vd + 16) = v1;
    }
    __syncthreads();
    f32x4 s[4];
#pragma unroll
    for (int mt = 0; mt < 4; ++mt) {
      const char* kr = Ks + (mt * 16 + l15) * LSTR + g * 16;
      const bf16x8 a0 = *(const bf16x8*)kr, a1 = *(const bf16x8*)(kr + 64);
      s[mt] = mfma16(a0, qb0, f32x4{0.f, 0.f, 0.f, 0.f});
      s[mt] = mfma16(a1, qb1, s[mt]);
    }
    if (kc <= 5) {
      const float bc = bias_s[256];
#pragma unroll
      for (int mt = 0; mt < 4; ++mt)
#pragma unroll
        for (int j = 0; j < 4; ++j) s[mt][j] += bc;
    } else {
      const int qi = wave * 16 + l15 + 64 * (8 - kc);
#pragma unroll
      for (int mt = 0; mt < 4; ++mt)
#pragma unroll
        for (int j = 0; j < 4; ++j) {
          int rel = qi - (mt * 16 + g * 4 + j);
          rel = rel > 128 ? 128 : rel;
          s[mt][j] += bias_s[rel + 128];
        }
    }
    float mx = s[0][0];
#pragma unroll
    for (int mt = 0; mt < 4; ++mt)
#pragma unroll
      for (int j = 0; j < 4; ++j) mx = fmaxf(mx, s[mt][j]);
    mx = fmaxf(mx, __shfl_xor(mx, 16));
    mx = fmaxf(mx, __shfl_xor(mx, 32));
    const float m_new = fmaxf(m_run, mx);
    const float alpha = __expf(m_run - m_new);
    m_run = m_new;
    float ls = 0.f;
#pragma unroll
    for (int mt = 0; mt < 4; ++mt)
#pragma unroll
      for (int j = 0; j < 4; ++j) { s[mt][j] = __expf(s[mt][j] - m_new); ls += s[mt][j]; }
    l_run = l_run * alpha + ls;
#pragma unroll
    for (int mt = 0; mt < 4; ++mt)
#pragma unroll
      for (int j = 0; j < 4; ++j) o[mt][j] *= alpha;
#pragma unroll
    for (int k2 = 0; k2 < 2; ++k2) {
      const bf16x8 pb = mk8(pack2(s[2 * k2][0], s[2 * k2][1]), pack2(s[2 * k2][2], s[2 * k2][3]),
                            pack2(s[2 * k2 + 1][0], s[2 * k2 + 1][1]), pack2(s[2 * k2 + 1][2], s[2 * k2 + 1][3]));
#pragma unroll
      for (int mt = 0; mt < 4; ++mt) {
        const char* vr = Vs + (mt * 16 + l15) * LSTR + (32 * k2 + 4 * g) * 2;
        const uint2 va = *(const uint2*)vr, vb = *(const uint2*)(vr + 32);
        o[mt] = mfma16(mk8(va.x, va.y, vb.x, vb.y), pb, o[mt]);
      }
    }
  }
  float l = l_run;
  l += __shfl_xor(l, 16); l += __shfl_xor(l, 32);
  const float inv = 1.f / l;
#pragma unroll
  for (int mt = 0; mt < 4; ++mt) {
    *(uint2*)(AB + tq * 1024 + 512 + h * 64 + mt * 16 + g * 4) =
        make_uint2(pack2(o[mt][0] * inv, o[mt][1] * inv), pack2(o[mt][2] * inv, o[mt][3] * inv));
  }
}

__device__ __forceinline__ void phase2(const Params& p, char* lds) {
  const int sub = tid_() >> 8;
  for (int it = bid_(); it < 2048 + 1024; it += gridDim.x) {
    if (it < 2048) {
      const int b = it >> 8, hp = (it >> 6) & 3, c = ((it & 63) + 8 * b) & 63;
      attn_item(p, (b << 9) | ((hp * 2 + sub) << 6) | c, lds + sub * 20480);
    } else {
      gmlp_item(p, (it - 2048) * 2 + sub);
    }
  }
}

__device__ __forceinline__ void phase3(const Params& p, char* lds) {
  pg8::Gemm g{(const u16*)(p.ws + OFF_AB), (const u16*)(p.ws + OFF_WOUTT), T, 1024, 1024};
  pg8::StaticOrder S; S.init(T, 1024, (int)gridDim.x, (int)blockIdx.x);
  EpiOut E{p.x, p.out, (u16*)(p.ws + OFF_HB)};
  pg8::gemm_phase<EpiOut, pg8::StaticOrder, true, true>(LDS3(lds), g, S, E);
}
__device__ __forceinline__ void phase4(const Params& p, char* lds) {
  pg8::Gemm g{(const u16*)(p.ws + OFF_HB), (const u16*)(p.ws + OFF_WQT), T, 2048, 1024};
  pg8::StaticOrder S; S.init(T, 2048, (int)gridDim.x, (int)blockIdx.x);
  EpiQ E{(u16*)(p.ws + OFF_PQ)};
  pg8::gemm_phase<EpiQ, pg8::StaticOrder, true, true>(LDS3(lds), g, S, E);
}

#define INS16(KEY)                                            \
  do {                                                        \
    unsigned _k = (KEY);                                      \
    _Pragma("unroll") for (int _q = 0; _q < 16; ++_q) {       \
      const unsigned _hi = max(tv[_q], _k);                   \
      _k = min(tv[_q], _k);                                   \
      tv[_q] = _hi;                                           \
    }                                                         \
  } while (0)

__device__ __forceinline__ void select_item(const Params& p, int item, char* lds) {
  const int tid = tid_() & 255, lane = tid & 63, wave = tid >> 6, l15 = lane & 15, g = lane >> 4;
  const int h = item & 7, t0 = (item >> 3) * 64;
  const u16* PQ = (const u16*)(p.ws + OFF_PQ);
  const u16* KEYS = (const u16*)(p.ws + OFF_KEYS);
  int* EIDX = (int*)(p.ws + OFF_EIDX);
  float* BEST = (float*)(p.ws + OFF_BEST);
  float* sc = (float*)lds;
  __syncthreads();
  {
    const u16* qp = PQ + (size_t)(t0 + wave * 16 + l15) * 2048 + h * 256 + g * 8;
#pragma unroll
    for (int pp = 0; pp < 2; ++pp) {
      bf16x8 qf[4];
#pragma unroll
      for (int ks = 0; ks < 4; ++ks) qf[ks] = *(const bf16x8*)(qp + pp * 128 + ks * 32);
#pragma unroll
      for (int nt = 0; nt < 8; ++nt) {
        const u16* kp = KEYS + ((size_t)((h * 2 + pp) * 128 + nt * 16 + l15)) * 128 + g * 8;
        f32x4 a = f32x4{0.f, 0.f, 0.f, 0.f};
#pragma unroll
        for (int ks = 0; ks < 4; ++ks) a = mfma16(qf[ks], *(const bf16x8*)(kp + ks * 32), a);
#pragma unroll
        for (int j = 0; j < 4; ++j) sc[(wave * 16 + g * 4 + j) * 257 + pp * 128 + nt * 16 + l15] = a[j];
      }
    }
  }
  __syncthreads();
  if (tid < 128) {
    const int row = tid & 63, pp = tid >> 6;
    float* srow = sc + row * 257 + pp * 128;
    unsigned tv[16];
#pragma unroll
    for (int q = 0; q < 16; ++q) tv[q] = 0u;
#pragma unroll 4
    for (int k = 0; k < 128; ++k) {
      const unsigned key = (okey(srow[k]) & ~127u) | (unsigned)(127 - k);
      INS16(key);
    }
    float vals[16];
    int idxs[16];
#pragma unroll
    for (int q = 0; q < 16; ++q) { idxs[q] = 127 - (int)(tv[q] & 127u); vals[q] = srow[idxs[q]]; }
#pragma unroll
    for (int q = 0; q < 16; ++q) { srow[q] = vals[q]; ((int*)srow)[16 + q] = idxs[q]; }
  }
  __syncthreads();
  if (tid < 64) {
    const int row = tid;
    const float* r0 = sc + row * 257;
    const float* r1 = r0 + 128;
    float s0[16], s1[16];
#pragma unroll
    for (int q = 0; q < 16; ++q) { s0[q] = r0[q]; s1[q] = r1[q]; }
    unsigned tv[16];
#pragma unroll
    for (int q = 0; q < 16; ++q) tv[q] = 0u;
#pragma unroll
    for (int a = 0; a < 16; ++a) {
#pragma unroll
      for (int bb = 0; bb < 16; ++bb) {
        if ((a + 1) * (bb + 1) <= 16) {
          const unsigned key = (okey(s0[a] + s1[bb]) & ~255u) | (unsigned)(255 - (a * 16 + bb));
          INS16(key);
        }
      }
    }
    const size_t ob = ((size_t)(t0 + row) * 8 + h) * 16;
#pragma unroll
    for (int q = 0; q < 16; ++q) {
      const int code = 255 - (int)(tv[q] & 255u);
      const int a = code >> 4, bb = code & 15;
      const float best = r0[a] + r1[bb];
      const int e = ((const int*)r0)[16 + a] * 128 + ((const int*)r1)[16 + bb];
      EIDX[ob + q] = e;
      BEST[ob + q] = best;
    }
  }
}

__device__ __forceinline__ void phase5(const Params& p, char* lds) {
  const int sub = tid_() >> 8;
  for (int it = bid_(); it < 512 * 4; it += gridDim.x) select_item(p, it * 2 + sub, lds + sub * 65792);
}

#define CVT_LO(w) __builtin_amdgcn_cvt_pk_f32_fp8((int)(w), false)
#define CVT_HI(w) __builtin_amdgcn_cvt_pk_f32_fp8((int)(w), true)
__device__ __forceinline__ void phase6(const Params& p, char* lds) {
  const int tid = tid_(), lane = tid & 63, wave = tid >> 6, l15 = lane & 15, g = lane >> 4;
  const u16* HB = (const u16*)(p.ws + OFF_HB);
  const unsigned char* EU8 = (const unsigned char*)(p.ws + OFF_EU);
  const unsigned char* EV8 = (const unsigned char*)(p.ws + OFF_EV);
  const float* ESC = (const float*)(p.ws + OFF_ESC);
  const int* EIDX = (const int*)(p.ws + OFF_EIDX);
  const float* BEST = (const float*)(p.ws + OFF_BEST);
  float* wl = (float*)lds + wave * 128;
  for (int t = bid_() * NWAVE + wave; t < T; t += gridDim.x * NWAVE) {
    f32x2 hf[32];
    {
      const u16* hrow = HB + (size_t)t * 1024 + l15 * 16;
#pragma unroll
      for (int i = 0; i < 4; ++i) {
        const uint4 a = *(const uint4*)(hrow + i * 256), b = *(const uint4*)(hrow + i * 256 + 8);
        hf[i * 8 + 0] = f32x2{bf_lo(a.x), bf_hi(a.x)}; hf[i * 8 + 1] = f32x2{bf_lo(a.y), bf_hi(a.y)};
        hf[i * 8 + 2] = f32x2{bf_lo(a.z), bf_hi(a.z)}; hf[i * 8 + 3] = f32x2{bf_lo(a.w), bf_hi(a.w)};
        hf[i * 8 + 4] = f32x2{bf_lo(b.x), bf_hi(b.x)}; hf[i * 8 + 5] = f32x2{bf_lo(b.y), bf_hi(b.y)};
        hf[i * 8 + 6] = f32x2{bf_lo(b.z), bf_hi(b.z)}; hf[i * 8 + 7] = f32x2{bf_lo(b.w), bf_hi(b.w)};
      }
    }
    float ss;
    {
      f32x2 s2 = f32x2{0.f, 0.f};
#pragma unroll
      for (int i = 0; i < 32; ++i) s2 = __builtin_elementwise_fma(hf[i], hf[i], s2);
      ss = s2.x + s2.y;
    }
    ss += __shfl_xor(ss, 1); ss += __shfl_xor(ss, 2); ss += __shfl_xor(ss, 4); ss += __shfl_xor(ss, 8);
    const float rs2 = rsqrtf(ss * (1.f / 1024.f) + EPS);
    const int ea = EIDX[(size_t)t * 128 + lane], eb = EIDX[(size_t)t * 128 + 64 + lane];
    float ga, gb;
    {
      const float ba = BEST[(size_t)t * 128 + lane] * rs2, bb = BEST[(size_t)t * 128 + 64 + lane] * rs2;
      float ma = ba, mb = bb;
#pragma unroll
      for (int o = 1; o < 16; o <<= 1) { ma = fmaxf(ma, __shfl_xor(ma, o)); mb = fmaxf(mb, __shfl_xor(mb, o)); }
      const float xa = __expf(ba - ma), xb = __expf(bb - mb);
      float sa = xa, sb = xb;
#pragma unroll
      for (int o = 1; o < 16; o <<= 1) { sa += __shfl_xor(sa, o); sb += __shfl_xor(sb, o); }
      ga = xa / sa; gb = xb / sb;
    }
#pragma unroll 2
    for (int it = 0; it < 32; ++it) {
      const int k = it * 4 + g;
      const int e = __shfl((it < 16) ? ea : eb, k & 63);
      const float gk = __shfl((it < 16) ? ga : gb, k & 63);
      const unsigned char* urow = EU8 + (size_t)e * 1024 + l15 * 16;
      uint4 uv[4];
#pragma unroll
      for (int i = 0; i < 4; ++i) uv[i] = *(const uint4*)(urow + i * 256);
      const float usc = ESC[e], vsc = ESC[16384 + e];
      f32x2 d0 = f32x2{0.f, 0.f}, d1 = f32x2{0.f, 0.f};
#pragma unroll
      for (int i = 0; i < 4; ++i) {
        d0 = __builtin_elementwise_fma(CVT_LO(uv[i].x), hf[i * 8 + 0], d0); d1 = __builtin_elementwise_fma(CVT_HI(uv[i].x), hf[i * 8 + 1], d1);
        d0 = __builtin_elementwise_fma(CVT_LO(uv[i].y), hf[i * 8 + 2], d0); d1 = __builtin_elementwise_fma(CVT_HI(uv[i].y), hf[i * 8 + 3], d1);
        d0 = __builtin_elementwise_fma(CVT_LO(uv[i].z), hf[i * 8 + 4], d0); d1 = __builtin_elementwise_fma(CVT_HI(uv[i].z), hf[i * 8 + 5], d1);
        d0 = __builtin_elementwise_fma(CVT_LO(uv[i].w), hf[i * 8 + 6], d0); d1 = __builtin_elementwise_fma(CVT_HI(uv[i].w), hf[i * 8 + 7], d1);
      }
      float d = (d0.x + d0.y) + (d1.x + d1.y);
      d += __shfl_xor(d, 1); d += __shfl_xor(d, 2); d += __shfl_xor(d, 4); d += __shfl_xor(d, 8);
      const float hk = gelu_f(d * rs2 * usc);
      if (l15 == 0) wl[k] = gk * hk * vsc;
    }
    f32x2 acc[32];
#pragma unroll
    for (int i = 0; i < 32; ++i) acc[i] = f32x2{0.f, 0.f};
#pragma unroll 2
    for (int it = 0; it < 32; ++it) {
      const int k = it * 4 + g;
      const int e = __shfl((it < 16) ? ea : eb, k & 63);
      const float wk = wl[k];
      const f32x2 w2 = f32x2{wk, wk};
      const unsigned char* vrow = EV8 + (size_t)e * 1024 + l15 * 16;
      uint4 vv[4];
#pragma unroll
      for (int i = 0; i < 4; ++i) vv[i] = *(const uint4*)(vrow + i * 256);
#pragma unroll
      for (int i = 0; i < 4; ++i) {
        acc[i * 8 + 0] = __builtin_elementwise_fma(CVT_LO(vv[i].x), w2, acc[i * 8 + 0]); acc[i * 8 + 1] = __builtin_elementwise_fma(CVT_HI(vv[i].x), w2, acc[i * 8 + 1]);
        acc[i * 8 + 2] = __builtin_elementwise_fma(CVT_LO(vv[i].y), w2, acc[i * 8 + 2]); acc[i * 8 + 3] = __builtin_elementwise_fma(CVT_HI(vv[i].y), w2, acc[i * 8 + 3]);
        acc[i * 8 + 4] = __builtin_elementwise_fma(CVT_LO(vv[i].z), w2, acc[i * 8 + 4]); acc[i * 8 + 5] = __builtin_elementwise_fma(CVT_HI(vv[i].z), w2, acc[i * 8 + 5]);
        acc[i * 8 + 6] = __builtin_elementwise_fma(CVT_LO(vv[i].w), w2, acc[i * 8 + 6]); acc[i * 8 + 7] = __builtin_elementwise_fma(CVT_HI(vv[i].w), w2, acc[i * 8 + 7]);
      }
    }
    f32x2 r1[16];
    const bool hi2 = (g & 2) != 0;
#pragma unroll
    for (int i = 0; i < 16; ++i) {
      const f32x2 send = hi2 ? acc[i] : acc[i + 16];
      const f32x2 keep = hi2 ? acc[i + 16] : acc[i];
      r1[i] = f32x2{keep.x + __shfl_xor(send.x, 32), keep.y + __shfl_xor(send.y, 32)};
    }
    f32x2 r2[8];
    const bool hi1 = (g & 1) != 0;
#pragma unroll
    for (int i = 0; i < 8; ++i) {
      const f32x2 send = hi1 ? r1[i] : r1[i + 8];
      const f32x2 keep = hi1 ? r1[i + 8] : r1[i];
      r2[i] = f32x2{keep.x + __shfl_xor(send.x, 16), keep.y + __shfl_xor(send.y, 16)};
    }
    float4* op = (float4*)(p.out + (size_t)t * 1024 + g * 256 + l15 * 16);
#pragma unroll
    for (int q = 0; q < 4; ++q) {
      float4 a = op[q];
      a.x += r2[q * 2].x; a.y += r2[q * 2].y; a.z += r2[q * 2 + 1].x; a.w += r2[q * 2 + 1].y;
      op[q] = a;
    }
  }
}

__device__ __forceinline__ void phase6a(const Params& p, char* lds) {
  const int tid = tid_(), lane = tid & 63, wave = tid >> 6, eg = lane >> 3, part = lane & 7;
  const int bid = bid_();
  const int x = bid & 7, xb = bid >> 3, ncb = ((int)gridDim.x + 7 - x) >> 3;
  const unsigned char* EUX = (const unsigned char*)(p.ws + OFF_EU) + (size_t)x * (2 * MiB) + part * 16;
  const u16* HBX = (const u16*)(p.ws + OFF_HB) + x * 128 + part * 16;
  const int* EIDX = (const int*)(p.ws + OFF_EIDX);
  float* PART = (float*)(p.ws + OFF_PART) + (size_t)x * T * 128;
  const int tstep = ncb * NWAVE;
  for (int t = xb * NWAVE + wave; t < T; t += 2 * tstep) {
    const int t1 = t + tstep;
    const bool two = t1 < T;
    const int tb = two ? t1 : t;
    const int ea0 = EIDX[(size_t)t * 128 + lane], eb0 = EIDX[(size_t)t * 128 + 64 + lane];
    const int ea1 = EIDX[(size_t)tb * 128 + lane], eb1 = EIDX[(size_t)tb * 128 + 64 + lane];
    uint4 uv0[16], uv1[16];
#pragma unroll
    for (int it = 0; it < 16; ++it) {
      const int src = (it * 8 + eg) & 63;
      const int e0 = __shfl((it < 8) ? ea0 : eb0, src);
      const int e1 = __shfl((it < 8) ? ea1 : eb1, src);
      uv0[it] = *(const uint4*)(EUX + (size_t)e0 * 128);
      uv1[it] = *(const uint4*)(EUX + (size_t)e1 * 128);
    }
    f32x2 h0[8], h1[8];
    {
      const uint4 a = *(const uint4*)(HBX + (size_t)t * 1024), b = *(const uint4*)(HBX + (size_t)t * 1024 + 8);
      h0[0] = f32x2{bf_lo(a.x), bf_hi(a.x)}; h0[1] = f32x2{bf_lo(a.y), bf_hi(a.y)}; h0[2] = f32x2{bf_lo(a.z), bf_hi(a.z)}; h0[3] = f32x2{bf_lo(a.w), bf_hi(a.w)};
      h0[4] = f32x2{bf_lo(b.x), bf_hi(b.x)}; h0[5] = f32x2{bf_lo(b.y), bf_hi(b.y)}; h0[6] = f32x2{bf_lo(b.z), bf_hi(b.z)}; h0[7] = f32x2{bf_lo(b.w), bf_hi(b.w)};
      const uint4 c = *(const uint4*)(HBX + (size_t)tb * 1024), d = *(const uint4*)(HBX + (size_t)tb * 1024 + 8);
      h1[0] = f32x2{bf_lo(c.x), bf_hi(c.x)}; h1[1] = f32x2{bf_lo(c.y), bf_hi(c.y)}; h1[2] = f32x2{bf_lo(c.z), bf_hi(c.z)}; h1[3] = f32x2{bf_lo(c.w), bf_hi(c.w)};
      h1[4] = f32x2{bf_lo(d.x), bf_hi(d.x)}; h1[5] = f32x2{bf_lo(d.y), bf_hi(d.y)}; h1[6] = f32x2{bf_lo(d.z), bf_hi(d.z)}; h1[7] = f32x2{bf_lo(d.w), bf_hi(d.w)};
    }
    float d0[16], d1[16];
#pragma unroll
    for (int it = 0; it < 16; ++it) {
      f32x2 s = __builtin_elementwise_fma(CVT_LO(uv0[it].x), h0[0], f32x2{0.f, 0.f});
      s = __builtin_elementwise_fma(CVT_HI(uv0[it].x), h0[1], s); s = __builtin_elementwise_fma(CVT_LO(uv0[it].y), h0[2], s);
      s = __builtin_elementwise_fma(CVT_HI(uv0[it].y), h0[3], s); s = __builtin_elementwise_fma(CVT_LO(uv0[it].z), h0[4], s);
      s = __builtin_elementwise_fma(CVT_HI(uv0[it].z), h0[5], s); s = __builtin_elementwise_fma(CVT_LO(uv0[it].w), h0[6], s);
      s = __builtin_elementwise_fma(CVT_HI(uv0[it].w), h0[7], s);
      d0[it] = s.x + s.y;
      f32x2 q = __builtin_elementwise_fma(CVT_LO(uv1[it].x), h1[0], f32x2{0.f, 0.f});
      q = __builtin_elementwise_fma(CVT_HI(uv1[it].x), h1[1], q); q = __builtin_elementwise_fma(CVT_LO(uv1[it].y), h1[2], q);
      q = __builtin_elementwise_fma(CVT_HI(uv1[it].y), h1[3], q); q = __builtin_elementwise_fma(CVT_LO(uv1[it].z), h1[4], q);
      q = __builtin_elementwise_fma(CVT_HI(uv1[it].z), h1[5], q); q = __builtin_elementwise_fma(CVT_LO(uv1[it].w), h1[6], q);
      q = __builtin_elementwise_fma(CVT_HI(uv1[it].w), h1[7], q);
      d1[it] = q.x + q.y;
    }
    const bool b2 = (lane & 4) != 0, b1 = (lane & 2) != 0, b0 = (lane & 1) != 0;
    float r0[8], r1[8];
#pragma unroll
    for (int i = 0; i < 8; ++i) {
      r0[i] = (b2 ? d0[i + 8] : d0[i]) + __shfl_xor(b2 ? d0[i] : d0[i + 8], 4);
      r1[i] = (b2 ? d1[i + 8] : d1[i]) + __shfl_xor(b2 ? d1[i] : d1[i + 8], 4);
    }
    float s0[4], s1[4];
#pragma unroll
    for (int i = 0; i < 4; ++i) {
      s0[i] = (b1 ? r0[i + 4] : r0[i]) + __shfl_xor(b1 ? r0[i] : r0[i + 4], 2);
      s1[i] = (b1 ? r1[i + 4] : r1[i]) + __shfl_xor(b1 ? r1[i] : r1[i + 4], 2);
    }
    float u0[2], u1[2];
#pragma unroll
    for (int i = 0; i < 2; ++i) {
      u0[i] = (b0 ? s0[i + 2] : s0[i]) + __shfl_xor(b0 ? s0[i] : s0[i + 2], 1);
      u1[i] = (b0 ? s1[i + 2] : s1[i]) + __shfl_xor(b0 ? s1[i] : s1[i + 2], 1);
    }
#pragma unroll
    for (int i = 0; i < 2; ++i) {
      const int k = (2 * part + i) * 8 + eg;
      PART[(size_t)t * 128 + k] = u0[i];
      if (two) PART[(size_t)t1 * 128 + k] = u1[i];
    }
  }
}

__device__ __forceinline__ void phase6m(const Params& p, char* lds) {
  const int tid = tid_(), lane = tid & 63, wave = tid >> 6;
  const u16* HB = (const u16*)(p.ws + OFF_HB);
  const float* ESC = (const float*)(p.ws + OFF_ESC);
  const int* EIDX = (const int*)(p.ws + OFF_EIDX);
  const float* BEST = (const float*)(p.ws + OFF_BEST);
  const float* PART = (const float*)(p.ws + OFF_PART);
  float* WGT = (float*)(p.ws + OFF_WGT);
  for (int t = bid_() * NWAVE + wave; t < T; t += gridDim.x * NWAVE) {
    const uint4 a = *(const uint4*)(HB + (size_t)t * 1024 + lane * 16), b = *(const uint4*)(HB + (size_t)t * 1024 + lane * 16 + 8);
    float ss = 0.f;
    ss = dot2(a.x, a.x, ss); ss = dot2(a.y, a.y, ss); ss = dot2(a.z, a.z, ss); ss = dot2(a.w, a.w, ss);
    ss = dot2(b.x, b.x, ss); ss = dot2(b.y, b.y, ss); ss = dot2(b.z, b.z, ss); ss = dot2(b.w, b.w, ss);
#pragma unroll
    for (int o = 1; o < 64; o <<= 1) ss += __shfl_xor(ss, o);
    const float rs2 = rsqrtf(ss * (1.f / 1024.f) + EPS);
#pragma unroll
    for (int hf = 0; hf < 2; ++hf) {
      const size_t idx = (size_t)t * 128 + hf * 64 + lane;
      float d = 0.f;
#pragma unroll
      for (int x = 0; x < 8; ++x) d += PART[(size_t)x * T * 128 + idx];
      const int e = EIDX[idx];
      const float v = BEST[idx] * rs2;
      float m = v;
#pragma unroll
      for (int o = 1; o < 16; o <<= 1) m = fmaxf(m, __shfl_xor(m, o));
      const float ex = __expf(v - m);
      float s = ex;
#pragma unroll
      for (int o = 1; o < 16; o <<= 1) s += __shfl_xor(s, o);
      WGT[idx] = (ex / s) * gelu_f(d * rs2 * ESC[e]) * ESC[16384 + e];
    }
  }
}

__device__ __forceinline__ void phase6b(const Params& p, char* lds) {
  const int tid = tid_(), lane = tid & 63, wave = tid >> 6, eg = lane >> 3, part = lane & 7;
  const int bid = bid_();
  const int x = bid & 7, xb = bid >> 3, ncb = ((int)gridDim.x + 7 - x) >> 3;
  const unsigned char* EVX = (const unsigned char*)(p.ws + OFF_EV) + (size_t)x * (2 * MiB) + part * 16;
  const int* EIDX = (const int*)(p.ws + OFF_EIDX);
  const float* WGT = (const float*)(p.ws + OFF_WGT);
  const int tstep = ncb * NWAVE;
  const int pi = ((lane >> 5) & 1) * 4 + ((lane >> 4) & 1) * 2 + ((lane >> 3) & 1);
  const bool h5 = (lane & 32) != 0, h4 = (lane & 16) != 0, h3 = (lane & 8) != 0;
  for (int t = xb * NWAVE + wave; t < T; t += 2 * tstep) {
    const int t1 = t + tstep;
    const bool two = t1 < T;
    const int tb = two ? t1 : t;
    const int ea0 = EIDX[(size_t)t * 128 + lane], eb0 = EIDX[(size_t)t * 128 + 64 + lane];
    const int ea1 = EIDX[(size_t)tb * 128 + lane], eb1 = EIDX[(size_t)tb * 128 + 64 + lane];
    const float wa0 = WGT[(size_t)t * 128 + lane], wb0 = WGT[(size_t)t * 128 + 64 + lane];
    const float wa1 = WGT[(size_t)tb * 128 + lane], wb1 = WGT[(size_t)tb * 128 + 64 + lane];
    uint4 vv0[16], vv1[16];
#pragma unroll
    for (int it = 0; it < 16; ++it) {
      const int src = (it * 8 + eg) & 63;
      const int e0 = __shfl((it < 8) ? ea0 : eb0, src);
      const int e1 = __shfl((it < 8) ? ea1 : eb1, src);
      vv0[it] = *(const uint4*)(EVX + (size_t)e0 * 128);
      vv1[it] = *(const uint4*)(EVX + (size_t)e1 * 128);
    }
    float2* op0 = (float2*)(p.out + (size_t)t * 1024 + x * 128 + part * 16 + pi * 2);
    float2* op1 = (float2*)(p.out + (size_t)tb * 1024 + x * 128 + part * 16 + pi * 2);
    const float2 o0 = *op0, o1 = *op1;
    f32x2 a0[8], a1[8];
#pragma unroll
    for (int i = 0; i < 8; ++i) { a0[i] = f32x2{0.f, 0.f}; a1[i] = f32x2{0.f, 0.f}; }
#pragma unroll
    for (int it = 0; it < 16; ++it) {
      const int src = (it * 8 + eg) & 63;
      const float w0 = __shfl((it < 8) ? wa0 : wb0, src), w1 = __shfl((it < 8) ? wa1 : wb1, src);
      const f32x2 w20 = f32x2{w0, w0}, w21 = f32x2{w1, w1};
      a0[0] = __builtin_elementwise_fma(CVT_LO(vv0[it].x), w20, a0[0]); a0[1] = __builtin_elementwise_fma(CVT_HI(vv0[it].x), w20, a0[1]);
      a0[2] = __builtin_elementwise_fma(CVT_LO(vv0[it].y), w20, a0[2]); a0[3] = __builtin_elementwise_fma(CVT_HI(vv0[it].y), w20, a0[3]);
      a0[4] = __builtin_elementwise_fma(CVT_LO(vv0[it].z), w20, a0[4]); a0[5] = __builtin_elementwise_fma(CVT_HI(vv0[it].z), w20, a0[5]);
      a0[6] = __builtin_elementwise_fma(CVT_LO(vv0[it].w), w20, a0[6]); a0[7] = __builtin_elementwise_fma(CVT_HI(vv0[it].w), w20, a0[7]);
      a1[0] = __builtin_elementwise_fma(CVT_LO(vv1[it].x), w21, a1[0]); a1[1] = __builtin_elementwise_fma(CVT_HI(vv1[it].x), w21, a1[1]);
      a1[2] = __builtin_elementwise_fma(CVT_LO(vv1[it].y), w21, a1[2]); a1[3] = __builtin_elementwise_fma(CVT_HI(vv1[it].y), w21, a1[3]);
      a1[4] = __builtin_elementwise_fma(CVT_LO(vv1[it].z), w21, a1[4]); a1[5] = __builtin_elementwise_fma(CVT_HI(vv1[it].z), w21, a1[5]);
      a1[6] = __builtin_elementwise_fma(CVT_LO(vv1[it].w), w21, a1[6]); a1[7] = __builtin_elementwise_fma(CVT_HI(vv1[it].w), w21, a1[7]);
    }
#define RS8(acc, res)                                                                                            \
    {                                                                                                            \
      f32x2 q1[4];                                                                                               \
      _Pragma("unroll") for (int i = 0; i < 4; ++i) {                                                            \
        const f32x2 sd = h5 ? acc[i] : acc[i + 4], kp = h5 ? acc[i + 4] : acc[i];                                \
        q1[i] = f32x2{kp.x + __shfl_xor(sd.x, 32), kp.y + __shfl_xor(sd.y, 32)};                                 \
      }                                                                                                          \
      f32x2 q2[2];                                                                                               \
      _Pragma("unroll") for (int i = 0; i < 2; ++i) {                                                            \
        const f32x2 sd = h4 ? q1[i] : q1[i + 2], kp = h4 ? q1[i + 2] : q1[i];                                    \
        q2[i] = f32x2{kp.x + __shfl_xor(sd.x, 16), kp.y + __shfl_xor(sd.y, 16)};                                 \
      }                                                                                                          \
      const f32x2 sd = h3 ? q2[0] : q2[1], kp = h3 ? q2[1] : q2[0];                                              \
      res = f32x2{kp.x + __shfl_xor(sd.x, 8), kp.y + __shfl_xor(sd.y, 8)};                                       \
    }
    f32x2 z0, z1;
    RS8(a0, z0);
    RS8(a1, z1);
    *op0 = make_float2(o0.x + z0.x, o0.y + z0.y);
    if (two) *op1 = make_float2(o1.x + z1.x, o1.y + z1.y);
  }
}

#ifndef PMASK
#define PMASK 127
#endif
#define PROG 0x6543210ull
#define NPROG 9
__global__ void __launch_bounds__(NTHR, 2) mega(Params p, int ph_lo, int ph_hi) {
  extern __shared__ __attribute__((aligned(16))) char lds[];
  cg::grid_group grid = cg::this_grid();
#ifndef REP_PHASE
#define REP_PHASE -1
#endif
#define IN(k) (ph_lo <= (k) && (k) < ph_hi)
#define SEAM(k) do { if (IN(k) && IN((k) + 1)) grid.sync(); } while (0)
  if (IN(0)) { phase0(p, lds); if (REP_PHASE == 0) { grid.sync(); phase0(p, lds); } }
  SEAM(0);
  if (IN(1)) { phase1(p, lds); if (REP_PHASE == 1) { grid.sync(); phase1(p, lds); } }
  SEAM(1);
  if (IN(2)) { phase2(p, lds); if (REP_PHASE == 2) { grid.sync(); phase2(p, lds); } }
  SEAM(2);
  if (IN(3)) { phase3(p, lds); if (REP_PHASE == 3) { grid.sync(); phase3(p, lds); } }
  SEAM(3);
  if (IN(4)) { phase4(p, lds); if (REP_PHASE == 4) { grid.sync(); phase4(p, lds); } }
  SEAM(4);
  if (IN(5)) { phase5(p, lds); if (REP_PHASE == 5) { grid.sync(); phase5(p, lds); } }
  SEAM(5);
  if (IN(6)) { phase6a(p, lds); if (REP_PHASE == 6) { grid.sync(); phase6a(p, lds); } }
  SEAM(6);
  if (IN(7)) { phase6m(p, lds); if (REP_PHASE == 7) { grid.sync(); phase6m(p, lds); } }
  SEAM(7);
  if (IN(8)) phase6b(p, lds);
}

extern "C" void kernel_launch(void* const* d_in, const int* in_sizes, int n_in, void* d_out, int out_size, void* d_ws,
                              size_t ws_size, hipStream_t stream) {
  static int grid_blocks = 0;
  if (!grid_blocks) {
    int dev = 0, cus = 0, per_cu = 0;
    (void)hipGetDevice(&dev);
    (void)hipDeviceGetAttribute(&cus, hipDeviceAttributeMultiprocessorCount, dev);
    (void)hipFuncSetAttribute((const void*)mega, hipFuncAttributeMaxDynamicSharedMemorySize, LDS_BYTES);
    (void)hipOccupancyMaxActiveBlocksPerMultiprocessor(&per_cu, mega, NTHR, LDS_BYTES);
    if (per_cu > 1) per_cu = 1;
    grid_blocks = cus * per_cu;
  }
  Params p{};
  p.x = (const float*)d_in[0]; p.ln_mix_g = (const float*)d_in[1]; p.w_in = (const float*)d_in[2];
  p.gmlp_norm_g = (const float*)d_in[3]; p.gmlp_w_s = (const float*)d_in[4]; p.gmlp_b_s = (const float*)d_in[5];
  p.q_norm_g = (const float*)d_in[6]; p.k_norm_g = (const float*)d_in[7]; p.rel_bias = (const float*)d_in[8];
  p.w_out = (const float*)d_in[9]; p.ln_ffn_g = (const float*)d_in[10]; p.w_query = (const float*)d_in[11];
  p.sub_keys = (const float*)d_in[12]; p.peer_u = (const float*)d_in[13]; p.peer_v = (const float*)d_in[14];
  p.out = (float*)d_out; p.ws = (char*)d_ws;
#if FUSED
  int lo = 0, hi = NPROG;
  void* args[] = {&p, &lo, &hi};
  hipError_t e = hipLaunchCooperativeKernel((void*)mega, dim3(grid_blocks), dim3(NTHR), args, LDS_BYTES, stream);
  if (e != hipSuccess) fprintf(stderr, "cooperative launch failed: %s (grid %d)\n", hipGetErrorString(e), grid_blocks);
#else
  for (int ph = 0; ph < NPROG; ++ph) mega<<<dim3(grid_blocks), dim3(NTHR), LDS_BYTES, stream>>>(p, ph, ph + 1);
#endif
}
```

```cpp
#include <hip/hip_runtime.h>
#include <hip/hip_cooperative_groups.h>
#include <cstdio>
namespace cg = cooperative_groups;

#ifndef FUSED
#define FUSED 1
#endif

typedef unsigned short u16;
using bf16x8 = __attribute__((ext_vector_type(8))) short;
using s16x4 = __attribute__((ext_vector_type(4))) short;
using f32x4 = __attribute__((ext_vector_type(4))) float;
using bf16x2 = __attribute__((ext_vector_type(2))) __bf16;
using f32x2 = __attribute__((ext_vector_type(2))) float;

constexpr int T = 32768, DM = 1024, SEQ = 4096;
constexpr float EPS = 1e-6f;
constexpr size_t MiB = 1u << 20;
constexpr size_t OFF_XB = 0, OFF_WINT = 64 * MiB  , OFF_WB = 67 * MiB  , OFF_WOUTT = 69 * MiB, OFF_WQT = 71 * MiB, OFF_KEYS = 75 * MiB,
                 OFF_RS = 76 * MiB, OFF_VSS = 76 * MiB + 512 * 1024, OFF_EU = 77 * MiB, OFF_EV = 109 * MiB,
                 OFF_U = 141 * MiB, OFF_GVT = 173 * MiB, OFF_QK = 205 * MiB, OFF_VT = 269 * MiB, OFF_AB = 301 * MiB,
                 OFF_HB = 365 * MiB, OFF_PQ = 141 * MiB  , OFF_EIDX = 429 * MiB,
                 OFF_BEST = 445 * MiB, OFF_ESC = 461 * MiB  , OFF_WGT = 462 * MiB  , OFF_BAR = 480 * MiB  , OFF_PART = 141 * MiB  ;

struct Params {
  const float *x, *ln_mix_g, *w_in, *gmlp_norm_g, *gmlp_w_s, *gmlp_b_s, *q_norm_g, *k_norm_g, *rel_bias, *w_out,
      *ln_ffn_g, *w_query, *sub_keys, *peer_u, *peer_v;
  float* out;
  char* ws;
};

constexpr int LDS_BYTES = 131584;
constexpr int NTHR = 512, NWAVE = 8;
constexpr int LSTR = 144;
constexpr int OPER_BYTES = 128 * LSTR;

__device__ __forceinline__ u16 f2bf(float f) {
  unsigned u = __float_as_uint(f);
  u += 0x7fffu + ((u >> 16) & 1u);
  return (u16)(u >> 16);
}
__device__ __forceinline__ unsigned pack2(float lo, float hi) { return (unsigned)f2bf(lo) | ((unsigned)f2bf(hi) << 16); }
__device__ __forceinline__ float bf_lo(unsigned u) { return __uint_as_float(u << 16); }
__device__ __forceinline__ float bf_hi(unsigned u) { return __uint_as_float(u & 0xffff0000u); }
__device__ __forceinline__ float bf2f(u16 v) { return __uint_as_float(((unsigned)v) << 16); }
__device__ __forceinline__ float gelu_f(float x) {
  float z = 0.7978845608028654f * (x + 0.044715f * x * x * x);
  float e = __expf(2.f * z);
  float th = 1.f - 2.f / (1.f + e);
  return 0.5f * x * (1.f + th);
}
__device__ __forceinline__ float dot2(unsigned a, unsigned b, float acc) {
  return __builtin_amdgcn_fdot2_f32_bf16(__builtin_bit_cast(bf16x2, a), __builtin_bit_cast(bf16x2, b), acc, false);
}
__device__ __forceinline__ f32x4 mfma16(bf16x8 a, bf16x8 b, f32x4 c) {
  return __builtin_amdgcn_mfma_f32_16x16x32_bf16(a, b, c, 0, 0, 0);
}
__device__ __forceinline__ bf16x8 mk8(unsigned a, unsigned b, unsigned c, unsigned d) {
  uint4 u = make_uint4(a, b, c, d);
  return __builtin_bit_cast(bf16x8, u);
}
__device__ __forceinline__ unsigned pack4_fp8(float a, float b, float c, float d) {
  int r = 0;
  r = __builtin_amdgcn_cvt_pk_fp8_f32(a, b, r, false);
  r = __builtin_amdgcn_cvt_pk_fp8_f32(c, d, r, true);
  return (unsigned)r;
}
__device__ __forceinline__ unsigned okey(float x) {
  unsigned u = __float_as_uint(x);
  return (u & 0x80000000u) ? ~u : (u | 0x80000000u);
}


__device__ __forceinline__ int tid_() { int t = threadIdx.x; asm volatile("" : "+v"(t)); return t; }
__device__ __forceinline__ int bid_() { int b = blockIdx.x; asm volatile("" : "+s"(b)); return b; }
namespace pg8 {
#define PG8_LAS __attribute__((address_space(3)))
typedef unsigned short bf16_t;
typedef short bf16x8 __attribute__((ext_vector_type(8)));
typedef float f32x4 __attribute__((ext_vector_type(4)));
typedef unsigned u32x4 __attribute__((ext_vector_type(4)));
constexpr int BM = 256, BK = 64, HALF = 128, HTB = HALF * BK * 2  , STAGE_BYTES = 8 * HTB, NXCD = 8, WGM = 8;

__host__ __device__ __forceinline__ int lds_byte(int r, int c) { const int st = (r >> 4) * 2 + (c >> 5), rr = r & 15, cc = c & 31, ob = rr * 64 + cc * 2; return st * 1024 + (ob ^ (((ob >> 9) & 1) << 5)); }
__host__ __device__ __forceinline__ void stage_rc(int b, int& R, int& C) { const int st = b / 1024, sb = b % 1024, swz = sb ^ (((sb >> 9) & 1) << 5); R = (st >> 1) * 16 + swz / 64; C = (st & 1) * 32 + (swz % 64) / 2; }
__host__ __device__ __forceinline__ int perm32(int rho) { const int n = rho >> 4, i = rho & 15; return 8 * (i >> 2) + 4 * n + (i & 3); }

struct Unit { int pm, pn; };
struct Gemm { const bf16_t* A; const bf16_t* Bt; int M, N, K; };

struct StaticOrder {
    int nM, nN, nwg, G, c;
    __host__ __device__ void init(int M, int N, int G_, int c_) { nM = M / BM; nN = N / BM; nwg = nM * nN; G = G_; c = c_; }
    __host__ __device__ bool next(int i, Unit& u) const {
        const long L = (long)i * G + c; if (L >= nwg) return false;
        int wgid = (int)L; { const int q = nwg / NXCD, r = nwg % NXCD, xcd = wgid % NXCD, off = wgid / NXCD; wgid = (xcd < r ? xcd * (q + 1) : r * (q + 1) + (xcd - r) * q) + off; }
        const int nig = WGM * nN, gid = wgid / nig, fm = gid * WGM, gsz = (nM - fm) < WGM ? (nM - fm) : WGM;
        u.pm = fm + ((wgid % nig) % gsz); u.pn = (wgid % nig) / gsz; return true;
    }
    __device__ __forceinline__ void a_ready(const Unit&) const {}
    __device__ __forceinline__ void done(const Unit&) const {}
};

__device__ __forceinline__ unsigned cvt_pk_bf16(float lo, float hi) { unsigned r; asm volatile("v_cvt_pk_bf16_f32 %0, %1, %2" : "=v"(r) : "v"(lo), "v"(hi)); return r; }
template <class Epi, class Sched, bool ALIGN_EPI = false, bool SP2 = false>
__device__ __forceinline__ void gemm_phase(PG8_LAS unsigned char* lds, const Gemm g, const Sched& S, const Epi& E) {
    const int tid = threadIdx.x, wid = __builtin_amdgcn_readfirstlane(tid >> 6), lane = tid & 63, wr = wid >> 2, wc = wid & 3, fr = lane & 15, fq = lane >> 4;
    const int K = g.K, nt = K / BK;
    unsigned voffA[2], voffB[2];
#pragma unroll
    for (int i = 0; i < 2; ++i) { int R, C; stage_rc(tid * 16 + i * 8192, R, C); const int Rb = Epi::PERM ? ((R & ~31) + perm32(R & 31)) : R;
        voffA[i] = (unsigned)(R * K + C) * 2u; voffB[i] = (unsigned)(Rb * K + C) * 2u; }
    const size_t kstep = (size_t)(BK * 2);
    const size_t hstep = (size_t)HALF * K * 2;
    const size_t tstep = 2 * hstep;
    const unsigned ldsw = (unsigned)wid * 1024u;
    const int aoff = lds_byte(wr * 64 + fr, fq * 8), boff = lds_byte(wc * 32 + fr, fq * 8);
#define PG8_SA(b, h) (((b) * 2 + (h)) * HTB)
#define PG8_SB(b, h) ((4 + (b) * 2 + (h)) * HTB)
#define PG8_STAGE(bufoff, gbase, voff) do { _Pragma("unroll") for (int _i = 0; _i < 2; ++_i) \
        __builtin_amdgcn_global_load_lds((const unsigned*)((const char*)(gbase) + (voff)[_i]), (PG8_LAS unsigned*)(lds + (bufoff) + ldsw + _i * 8192), 16, 0, 0); } while (0)
#define PG8_LDA(dst, b, h) do { _Pragma("unroll") for (int m = 0; m < 4; ++m) _Pragma("unroll") for (int k = 0; k < 2; ++k) dst[m][k] = *(const PG8_LAS bf16x8*)(lds + PG8_SA(b, h) + aoff + m * 2048 + k * 1024); } while (0)
#define PG8_LDB(dst, b, h) do { _Pragma("unroll") for (int n = 0; n < 2; ++n) _Pragma("unroll") for (int k = 0; k < 2; ++k) dst[n][k] = *(const PG8_LAS bf16x8*)(lds + PG8_SB(b, h) + boff + n * 2048 + k * 1024); } while (0)
#define PG8_MMA(ai, bj, At, Bt) do { __builtin_amdgcn_s_setprio(1); _Pragma("unroll") for (int m = 0; m < 4; ++m) _Pragma("unroll") for (int n = 0; n < 2; ++n) _Pragma("unroll") for (int k = 0; k < 2; ++k) \
        acc[ai][bj][m][n] = __builtin_amdgcn_mfma_f32_16x16x32_bf16(Bt[n][k], At[m][k], acc[ai][bj][m][n], 0, 0, 0); __builtin_amdgcn_s_setprio(0); } while (0)
#define PG8_WAIT_V(n) asm volatile("s_waitcnt vmcnt(" #n ")" ::: "memory")
#define PG8_WAIT_L(n) asm volatile("s_waitcnt lgkmcnt(" #n ")" ::: "memory")
#define PG8_BAR __builtin_amdgcn_s_barrier()
#define PG8_SCHED __builtin_amdgcn_sched_barrier(0)
    Unit cur, nxt; int ui = 0;
    if (!S.next(0, cur)) return;
    f32x4 acc[2][2][4][2];
#pragma unroll
    for (int a = 0; a < 2; ++a)
#pragma unroll
        for (int b = 0; b < 2; ++b)
#pragma unroll
            for (int m = 0; m < 4; ++m)
#pragma unroll
                for (int n = 0; n < 2; ++n) acc[a][b][m][n] = (f32x4){0.f, 0.f, 0.f, 0.f};
    bf16x8 At[4][2], B0[2][2], B1[2][2];
    const char* cA = (const char*)g.A + (size_t)cur.pm * tstep; const char* cB = (const char*)g.Bt + (size_t)cur.pn * tstep;
    S.a_ready(cur);
    if constexpr (SP2) {
        PG8_STAGE(PG8_SB(0, 0), cB, voffB); PG8_STAGE(PG8_SB(0, 1), cB + hstep, voffB); PG8_STAGE(PG8_SA(0, 0), cA, voffA); PG8_STAGE(PG8_SA(0, 1), cA + hstep, voffA);
        if (wr == 1) PG8_BAR;
        PG8_WAIT_V(2); PG8_BAR;
        PG8_STAGE(PG8_SB(1, 0), cB + kstep, voffB); PG8_STAGE(PG8_SA(1, 0), cA + kstep, voffA); PG8_STAGE(PG8_SB(1, 1), cB + hstep + kstep, voffB);
        PG8_WAIT_V(6); PG8_BAR;
    } else {
        PG8_STAGE(PG8_SB(0, 0), cB, voffB); PG8_STAGE(PG8_SA(0, 0), cA, voffA); PG8_STAGE(PG8_SB(0, 1), cB + hstep, voffB); PG8_STAGE(PG8_SA(0, 1), cA + hstep, voffA);
        if (wr == 1) PG8_BAR;
        PG8_WAIT_V(4); PG8_BAR;
        PG8_STAGE(PG8_SB(1, 0), cB + kstep, voffB); PG8_STAGE(PG8_SA(1, 0), cA + kstep, voffA); PG8_STAGE(PG8_SB(1, 1), cB + hstep + kstep, voffB);
        PG8_WAIT_V(6); PG8_BAR;
    }
    for (;;) {
        const bool has_next = S.next(ui + 1, nxt);
        const char* nA = has_next ? (const char*)g.A + (size_t)nxt.pm * tstep : cA; const char* nB = has_next ? (const char*)g.Bt + (size_t)nxt.pn * tstep : cB;
        for (int t = 0; t < nt; t += 2) {
            const bool last = (t == nt - 2);
            const char* a1 = cA + (size_t)(t + 1) * kstep;
            const char* a2 = last ? nA : cA + (size_t)(t + 2) * kstep; const char* b2 = last ? nB : cB + (size_t)(t + 2) * kstep;
            const char* a3 = a2 + kstep; const char* b3 = b2 + kstep;
            if (last && has_next) S.a_ready(nxt);
            if constexpr (SP2) {
            PG8_LDB(B0, 0, 0); PG8_LDB(B1, 0, 1); PG8_SCHED; PG8_LDA(At, 0, 0); PG8_STAGE(PG8_SA(1, 1), a1 + hstep, voffA);
            PG8_WAIT_V(8); PG8_WAIT_L(0); PG8_BAR; PG8_MMA(0, 0, At, B0); PG8_MMA(0, 1, At, B1); PG8_BAR; PG8_SCHED;
            PG8_LDA(At, 0, 1); PG8_STAGE(PG8_SB(0, 0), b2, voffB); PG8_STAGE(PG8_SB(0, 1), b2 + hstep, voffB); PG8_STAGE(PG8_SA(0, 0), a2, voffA);
            PG8_WAIT_V(8); PG8_WAIT_L(0); PG8_BAR; PG8_MMA(1, 0, At, B0); PG8_MMA(1, 1, At, B1); PG8_BAR; PG8_SCHED;
            PG8_LDB(B0, 1, 0); PG8_LDB(B1, 1, 1); PG8_SCHED; PG8_LDA(At, 1, 0); PG8_STAGE(PG8_SA(0, 1), a2 + hstep, voffA);
            PG8_WAIT_V(8); PG8_WAIT_L(0); PG8_BAR; PG8_MMA(0, 0, At, B0); PG8_MMA(0, 1, At, B1); PG8_BAR; PG8_SCHED;
            PG8_LDA(At, 1, 1); PG8_STAGE(PG8_SB(1, 0), b3, voffB); PG8_STAGE(PG8_SB(1, 1), b3 + hstep, voffB); PG8_STAGE(PG8_SA(1, 0), a3, voffA);
            PG8_WAIT_V(8); PG8_WAIT_L(0); PG8_BAR; PG8_MMA(1, 0, At, B0); PG8_MMA(1, 1, At, B1); PG8_BAR; PG8_SCHED;
            } else {
            PG8_LDB(B0, 0, 0); PG8_SCHED; PG8_LDA(At, 0, 0); PG8_STAGE(PG8_SA(1, 1), a1 + hstep, voffA);
            PG8_WAIT_L(8); PG8_BAR; PG8_WAIT_L(0); PG8_MMA(0, 0, At, B0); PG8_BAR; PG8_SCHED;
            PG8_LDB(B1, 0, 1); PG8_STAGE(PG8_SB(0, 0), b2, voffB);
            PG8_BAR; PG8_WAIT_L(0); PG8_MMA(0, 1, At, B1); PG8_BAR;
            PG8_LDA(At, 0, 1); PG8_STAGE(PG8_SA(0, 0), a2, voffA);
            PG8_BAR; PG8_WAIT_L(0); PG8_MMA(1, 0, At, B0); PG8_BAR; PG8_SCHED;
            PG8_STAGE(PG8_SB(0, 1), b2 + hstep, voffB);
            PG8_WAIT_V(6); PG8_BAR; PG8_MMA(1, 1, At, B1); PG8_BAR;
            PG8_LDB(B0, 1, 0); PG8_SCHED; PG8_LDA(At, 1, 0); PG8_STAGE(PG8_SA(0, 1), a2 + hstep, voffA);
            PG8_WAIT_L(8); PG8_BAR; PG8_WAIT_L(0); PG8_MMA(0, 0, At, B0); PG8_BAR; PG8_SCHED;
            PG8_LDB(B1, 1, 1); PG8_STAGE(PG8_SB(1, 0), b3, voffB);
            PG8_BAR; PG8_WAIT_L(0); PG8_MMA(0, 1, At, B1); PG8_BAR;
            PG8_LDA(At, 1, 1); PG8_STAGE(PG8_SA(1, 0), a3, voffA);
            PG8_BAR; PG8_WAIT_L(0); PG8_MMA(1, 0, At, B0); PG8_BAR; PG8_SCHED;
            PG8_STAGE(PG8_SB(1, 1), b3 + hstep, voffB);
            PG8_WAIT_V(6); PG8_BAR; PG8_MMA(1, 1, At, B1); PG8_BAR;
            }
        }
        if constexpr (ALIGN_EPI) { if (wr == 0) PG8_BAR; }
        if constexpr (!Epi::AFTER_DRAIN) { E(acc, cur, wr, wc, fr, fq); S.done(cur); }
        if (!has_next) break;
#pragma unroll
        for (int a = 0; a < 2; ++a)
#pragma unroll
            for (int b = 0; b < 2; ++b)
#pragma unroll
                for (int m = 0; m < 4; ++m)
#pragma unroll
                    for (int n = 0; n < 2; ++n) acc[a][b][m][n] = (f32x4){0.f, 0.f, 0.f, 0.f};
        cur = nxt; cA = nA; cB = nB; ++ui;
        if constexpr (ALIGN_EPI) { if (wr == 1) PG8_BAR; }
    }
    PG8_WAIT_V(0);
    if constexpr (!ALIGN_EPI) { if (wr == 0) PG8_BAR; }
    PG8_BAR;
    if constexpr (Epi::AFTER_DRAIN) { E.fused(acc, cur, wr, wc, fr, fq, lds, wid, lane); S.done(cur); }
#undef PG8_SA
#undef PG8_SB
#undef PG8_STAGE
#undef PG8_LDA
#undef PG8_LDB
#undef PG8_MMA
#undef PG8_WAIT_V
#undef PG8_WAIT_L
#undef PG8_BAR
#undef PG8_SCHED
}
}

#define EPI_V8(v, A, s) float v[8] = {A[0][0] * (s), A[0][1] * (s), A[0][2] * (s), A[0][3] * (s), A[1][0] * (s), A[1][1] * (s), A[1][2] * (s), A[1][3] * (s)}
__device__ __forceinline__ uint4 pk8(const float (&v)[8]) {
  return make_uint4(pg8::cvt_pk_bf16(v[0], v[1]), pg8::cvt_pk_bf16(v[2], v[3]), pg8::cvt_pk_bf16(v[4], v[5]), pg8::cvt_pk_bf16(v[6], v[7]));
}
struct EpiIn {
  static constexpr bool PERM = true, AFTER_DRAIN = false;
  u16* U; u16* QK; const float* RS;
  __device__ __forceinline__ void operator()(const pg8::f32x4 (&acc)[2][2][4][2], const pg8::Unit& u, int wr, int wc, int fr, int fq) const {
    const int row0 = u.pm * 256 + wr * 64 + fr, colt = u.pn * 256, c0 = colt + wc * 32 + 8 * fq;
    const bool isu = colt < 512;
#pragma unroll
    for (int ai = 0; ai < 2; ++ai)
#pragma unroll
      for (int m = 0; m < 4; ++m) {
        const int row = row0 + ai * 128 + m * 16;
        const float r = RS[row];
#pragma unroll
        for (int bj = 0; bj < 2; ++bj) {
          const int col = c0 + bj * 128;
          EPI_V8(v, acc[ai][bj][m], r);
          if (isu) {
#pragma unroll
            for (int j = 0; j < 8; ++j) v[j] = gelu_f(v[j]);
            *(uint4*)(U + (size_t)row * 512 + col) = pk8(v);
          } else {
            *(uint4*)(QK + (size_t)row * 1024 + (col - 512)) = pk8(v);
          }
        }
      }
  }
};
struct EpiInT {
  static constexpr bool PERM = true, AFTER_DRAIN = false;
  u16* GVT; u16* VT; const float* RS; float* VSS;
  __device__ __forceinline__ void operator()(const pg8::f32x4 (&acc)[2][2][4][2], const pg8::Unit& u, int wr, int wc, int fr, int fq) const {
    const int ch0 = u.pm * 256 + wr * 64 + fr, t0 = u.pn * 256 + wc * 32 + 8 * fq;
    const bool isg = u.pm < 2;
#pragma unroll
    for (int bj = 0; bj < 2; ++bj) {
      const int t = t0 + bj * 128, b = t >> 12, s = t & 4095;
      const float4 ra = *(const float4*)(RS + t), rb = *(const float4*)(RS + t + 4);
      const float rr[8] = {ra.x, ra.y, ra.z, ra.w, rb.x, rb.y, rb.z, rb.w};
      float ss[8] = {0.f, 0.f, 0.f, 0.f, 0.f, 0.f, 0.f, 0.f};
#pragma unroll
      for (int ai = 0; ai < 2; ++ai)
#pragma unroll
        for (int m = 0; m < 4; ++m) {
          const int ch = ch0 + ai * 128 + m * 16;
          float v[8];
#pragma unroll
          for (int j = 0; j < 8; ++j) v[j] = acc[ai][bj][m][j >> 2][j & 3] * rr[j];
          if (isg) {
#pragma unroll
            for (int j = 0; j < 8; ++j) { v[j] = gelu_f(v[j]); ss[j] += v[j] * v[j]; }
            *(uint4*)(GVT + ((size_t)b * 512 + ch) * SEQ + s) = pk8(v);
          } else {
            *(uint4*)(VT + ((size_t)b * 512 + (ch - 512)) * SEQ + s) = pk8(v);
          }
        }
      if (isg) {
#pragma unroll
        for (int j = 0; j < 8; ++j) {
          float sv = ss[j];
          sv += __shfl_xor(sv, 1); sv += __shfl_xor(sv, 2); sv += __shfl_xor(sv, 4); sv += __shfl_xor(sv, 8);
          if (fr == 0) atomicAdd(VSS + t + j, sv);
        }
      }
    }
  }
};
struct EpiOut {
  static constexpr bool PERM = true, AFTER_DRAIN = false;
  const float* X; float* OUT; u16* HB;
  __device__ __forceinline__ void operator()(const pg8::f32x4 (&acc)[2][2][4][2], const pg8::Unit& u, int wr, int wc, int fr, int fq) const {
    const int row0 = u.pm * 256 + wr * 64 + fr, c0 = u.pn * 256 + wc * 32 + 8 * fq;
#pragma unroll
    for (int ai = 0; ai < 2; ++ai)
#pragma unroll
      for (int m = 0; m < 4; ++m) {
        const int row = row0 + ai * 128 + m * 16;
#pragma unroll
        for (int bj = 0; bj < 2; ++bj) {
          const size_t idx = (size_t)row * 1024 + c0 + bj * 128;
          const float4 xa = *(const float4*)(X + idx), xb = *(const float4*)(X + idx + 4);
          float v[8] = {xa.x + acc[ai][bj][m][0][0], xa.y + acc[ai][bj][m][0][1], xa.z + acc[ai][bj][m][0][2], xa.w + acc[ai][bj][m][0][3],
                        xb.x + acc[ai][bj][m][1][0], xb.y + acc[ai][bj][m][1][1], xb.z + acc[ai][bj][m][1][2], xb.w + acc[ai][bj][m][1][3]};
          *(float4*)(OUT + idx) = make_float4(v[0], v[1], v[2], v[3]);
          *(float4*)(OUT + idx + 4) = make_float4(v[4], v[5], v[6], v[7]);
          *(uint4*)(HB + idx) = pk8(v);
        }
      }
  }
};
struct EpiQ {
  static constexpr bool PERM = true, AFTER_DRAIN = false;
  u16* PQ;
  __device__ __forceinline__ void operator()(const pg8::f32x4 (&acc)[2][2][4][2], const pg8::Unit& u, int wr, int wc, int fr, int fq) const {
    const int row0 = u.pm * 256 + wr * 64 + fr, c0 = u.pn * 256 + wc * 32 + 8 * fq;
#pragma unroll
    for (int ai = 0; ai < 2; ++ai)
#pragma unroll
      for (int m = 0; m < 4; ++m) {
        const int row = row0 + ai * 128 + m * 16;
#pragma unroll
        for (int bj = 0; bj < 2; ++bj) {
          EPI_V8(v, acc[ai][bj][m], 1.f);
          *(uint4*)(PQ + (size_t)row * 2048 + c0 + bj * 128) = pk8(v);
        }
      }
  }
};
#define LDS3(p) ((__attribute__((address_space(3))) unsigned char*)(p))

__device__ __forceinline__ void phase0(const Params& p, char* lds) {
  const int tid = tid_(), lane = tid & 63, wave = tid >> 6;
  const int nblk = gridDim.x, blk = bid_();
  u16* XB = (u16*)(p.ws + OFF_XB);
  float* RS = (float*)(p.ws + OFF_RS);
  float* VSS = (float*)(p.ws + OFF_VSS);
  for (int row = blk * NWAVE + wave; row < T; row += nblk * NWAVE) {
    const float4* xr = (const float4*)(p.x + (size_t)row * DM);
    float4 v[4];
    float ss = 0.f;
#pragma unroll
    for (int i = 0; i < 4; ++i) {
      v[i] = xr[lane + 64 * i];
      ss += v[i].x * v[i].x + v[i].y * v[i].y + v[i].z * v[i].z + v[i].w * v[i].w;
    }
#pragma unroll
    for (int o = 1; o < 64; o <<= 1) ss += __shfl_xor(ss, o);
    if (lane == 0) RS[row] = rsqrtf(ss * (1.f / 1024.f) + EPS);
#pragma unroll
    for (int i = 0; i < 4; ++i) {
      uint2 o2 = make_uint2(pack2(v[i].x, v[i].y), pack2(v[i].z, v[i].w));
      *(uint2*)(XB + (size_t)row * DM + (lane + 64 * i) * 4) = o2;
    }
  }
  {
    unsigned char* EU8 = (unsigned char*)(p.ws + OFF_EU);
    unsigned char* EV8 = (unsigned char*)(p.ws + OFF_EV);
    float* ESC = (float*)(p.ws + OFF_ESC);
    for (int row = blk * NWAVE + wave; row < 32768; row += nblk * NWAVE) {
      const bool isv = row >= 16384;
      const int e = row & 16383;
      const float4* src = (const float4*)((isv ? p.peer_v : p.peer_u) + (size_t)e * 1024);
      float4 v[4];
      float am = 0.f;
#pragma unroll
      for (int i = 0; i < 4; ++i) {
        v[i] = src[i * 64 + lane];
        if (!isv) {
          const float4 g4 = ((const float4*)p.ln_ffn_g)[i * 64 + lane];
          v[i].x *= g4.x; v[i].y *= g4.y; v[i].z *= g4.z; v[i].w *= g4.w;
        }
        am = fmaxf(am, fmaxf(fmaxf(fabsf(v[i].x), fabsf(v[i].y)), fmaxf(fabsf(v[i].z), fabsf(v[i].w))));
      }
#pragma unroll
      for (int o = 1; o < 64; o <<= 1) am = fmaxf(am, __shfl_xor(am, o));
      const int ex = (int)((__float_as_uint(am) >> 23) & 255u) - 127;
      const bool ok = (am > 1e-30f);
      const float scale = ok ? __uint_as_float((unsigned)(127 + 7 - ex) << 23) : 1.f;
      const float inv = ok ? __uint_as_float((unsigned)(127 - 7 + ex) << 23) : 1.f;
      unsigned char* dst = (isv ? EV8 : EU8) + (size_t)e * 128;
#pragma unroll
      for (int i = 0; i < 4; ++i) {
        const int d = i * 256 + lane * 4;
        *(unsigned*)(dst + (size_t)(d >> 7) * (2 * MiB) + (d & 127)) = pack4_fp8(v[i].x * scale, v[i].y * scale, v[i].z * scale, v[i].w * scale);
      }
      if (lane == 0) ESC[row] = inv;
    }
  }
  {
    const int half = wave >> 2, w4 = wave & 3;
    float* tile = (float*)lds + half * (64 * 65);
    for (int tp = blk; tp < 704; tp += nblk) {
      const int tl = tp * 2 + half;
      const float* W; const float* gain; u16* dst; int N, kt, nt, drow;
      if (tl < 640) {
        W = p.w_in; gain = p.ln_mix_g; N = 2560; kt = tl / 40; nt = tl % 40;
        const int n0 = nt * 64;
        if (n0 < 512) { dst = (u16*)(p.ws + OFF_WINT); drow = n0; }
        else if (n0 < 1024) { dst = (u16*)(p.ws + OFF_WB); drow = n0 - 512; }
        else if (n0 < 2048) { dst = (u16*)(p.ws + OFF_WINT); drow = n0 - 512; }
        else { dst = (u16*)(p.ws + OFF_WB); drow = n0 - 2048 + 512; }
      } else if (tl < 896) { int t2 = tl - 640; W = p.w_out; gain = nullptr; dst = (u16*)(p.ws + OFF_WOUTT); N = 1024; kt = t2 / 16; nt = t2 % 16; drow = nt * 64; }
      else { int t2 = tl - 896; W = p.w_query; gain = p.ln_ffn_g; dst = (u16*)(p.ws + OFF_WQT); N = 2048; kt = t2 / 32; nt = t2 % 32; drow = nt * 64; }
      __syncthreads();
#pragma unroll 4
      for (int i = 0; i < 16; ++i) {
        const int kk = i * 4 + w4;
        const float gk = gain ? gain[kt * 64 + kk] : 1.f;
        tile[kk * 65 + lane] = W[(size_t)(kt * 64 + kk) * N + nt * 64 + lane] * gk;
      }
      __syncthreads();
#pragma unroll 4
      for (int i = 0; i < 16; ++i) {
        const int nn = i * 4 + w4;
        dst[(size_t)(drow + nn) * 1024 + kt * 64 + lane] = f2bf(tile[lane * 65 + nn]);
      }
    }
    __syncthreads();
  }
  {
    u16* KEYS = (u16*)(p.ws + OFF_KEYS);
    for (int i = blk * NTHR + tid; i < 262144 / 4; i += nblk * NTHR) {
      float4 a = ((const float4*)p.sub_keys)[i];
      *(uint2*)(KEYS + (size_t)i * 4) = make_uint2(pack2(a.x, a.y), pack2(a.z, a.w));
    }
  }
  for (int i = blk * NTHR + tid; i < T; i += nblk * NTHR) VSS[i] = 0.f;
  if (blk == 0 && tid < 16) ((unsigned*)(p.ws + OFF_BAR))[tid * 64] = 0u;
}

__device__ __forceinline__ void phase1(const Params& p, char* lds) {
  const u16* XB = (const u16*)(p.ws + OFF_XB);
  const float* RS = (const float*)(p.ws + OFF_RS);
  {
    pg8::Gemm g{XB, (const u16*)(p.ws + OFF_WINT), T, 1536, 1024};
    pg8::StaticOrder S; S.init(T, 1536, (int)gridDim.x, (int)blockIdx.x);
    EpiIn E{(u16*)(p.ws + OFF_U), (u16*)(p.ws + OFF_QK), RS};
    pg8::gemm_phase<EpiIn, pg8::StaticOrder, true, true>(LDS3(lds), g, S, E);
  }
  {
    pg8::Gemm g{(const u16*)(p.ws + OFF_WB), XB, 1024, T, 1024};
    pg8::StaticOrder S; S.init(1024, T, (int)gridDim.x, (int)blockIdx.x);
    EpiInT E{(u16*)(p.ws + OFF_GVT), (u16*)(p.ws + OFF_VT), RS, (float*)(p.ws + OFF_VSS)};
    pg8::gemm_phase<EpiInT, pg8::StaticOrder, true, true>(LDS3(lds), g, S, E);
  }
}

__device__ __forceinline__ void gmlp_item(const Params& p, int item) {
  const int tid = tid_() & 255, lane = tid & 63, wave = tid >> 6, l15 = lane & 15, g = lane >> 4;
  const int gr = item & 7, n = (item >> 3) & 31, b = item >> 8;
  const int t0 = b * SEQ + n * 128;
  const float* VSS = (const float*)(p.ws + OFF_VSS);
  const u16* GVT = (const u16*)(p.ws + OFF_GVT);
  const u16* U = (const u16*)(p.ws + OFF_U);
  u16* AB = (u16*)(p.ws + OFF_AB);
  f32x4 acc[2][4];
#pragma unroll
  for (int i = 0; i < 2; ++i)
#pragma unroll
    for (int j = 0; j < 4; ++j) acc[i][j] = f32x4{0.f, 0.f, 0.f, 0.f};
  const int i_base = wave * 32;
  const int nks = (wave < 2) ? 2 : 4;
  for (int ks = 0; ks < nks; ++ks) {
    const int j0 = ks * 32 + g * 8;
    const float4 s0 = *(const float4*)(VSS + t0 + j0), s1 = *(const float4*)(VSS + t0 + j0 + 4);
    float r[8] = {s0.x, s0.y, s0.z, s0.w, s1.x, s1.y, s1.z, s1.w};
#pragma unroll
    for (int q = 0; q < 8; ++q) r[q] = rsqrtf(r[q] * (1.f / 512.f) + EPS);
    bf16x8 af[2];
#pragma unroll
    for (int mi = 0; mi < 2; ++mi) {
      const int i = i_base + mi * 16 + l15;
      const float* wp = p.gmlp_w_s + ((size_t)(gr * 128 + i)) * 128 + j0;
      const float4 w0 = *(const float4*)wp, w1 = *(const float4*)(wp + 4);
      af[mi] = mk8(pack2(w0.x * r[0], w0.y * r[1]), pack2(w0.z * r[2], w0.w * r[3]), pack2(w1.x * r[4], w1.y * r[5]),
                   pack2(w1.z * r[6], w1.w * r[7]));
    }
#pragma unroll
    for (int ni = 0; ni < 4; ++ni) {
      const int c = ni * 16 + l15;
      const bf16x8 bfr = *(const bf16x8*)(GVT + ((size_t)b * 512 + gr * 64 + c) * SEQ + n * 128 + j0);
#pragma unroll
      for (int mi = 0; mi < 2; ++mi) acc[mi][ni] = mfma16(af[mi], bfr, acc[mi][ni]);
    }
  }
#pragma unroll
  for (int mi = 0; mi < 2; ++mi) {
#pragma unroll
    for (int ni = 0; ni < 4; ++ni) {
      const int c = ni * 16 + l15, ch = gr * 64 + c;
      const float ng = p.gmlp_norm_g[ch];
#pragma unroll
      for (int j = 0; j < 4; ++j) {
        const int i = i_base + mi * 16 + g * 4 + j;
        const size_t t = (size_t)t0 + i;
        const float sp = acc[mi][ni][j] * ng + p.gmlp_b_s[gr * 128 + i];
        AB[t * 1024 + ch] = f2bf(bf2f(U[t * 512 + ch]) * sp);
      }
    }
  }
}

__device__ __forceinline__ void attn_item(const Params& p, int item, char* lds) {
  const int tid = tid_() & 255, lane = tid & 63, wave = tid >> 6, l15 = lane & 15, g = lane >> 4;
  const int c = item & 63, h = (item >> 6) & 7, b = item >> 9;
  const u16* QK = (const u16*)(p.ws + OFF_QK);
  const u16* VT = (const u16*)(p.ws + OFF_VT);
  u16* AB = (u16*)(p.ws + OFF_AB);
  char* Ks = lds;
  char* Vs = lds + 64 * LSTR;
  float* bias_s = (float*)(lds + 2 * 64 * LSTR);
  __syncthreads();
  for (int i = tid; i < 257; i += 256) bias_s[i] = p.rel_bias[h * 257 + i];
  const size_t tq = (size_t)b * SEQ + c * 64 + wave * 16 + l15;
  bf16x8 qb0, qb1;
  {
    const u16* qp = QK + tq * 1024 + h * 64 + g * 8;
    const uint4 q0 = *(const uint4*)qp, q1 = *(const uint4*)(qp + 32);
    float f[16] = {bf_lo(q0.x), bf_hi(q0.x), bf_lo(q0.y), bf_hi(q0.y), bf_lo(q0.z), bf_hi(q0.z), bf_lo(q0.w), bf_hi(q0.w),
                   bf_lo(q1.x), bf_hi(q1.x), bf_lo(q1.y), bf_hi(q1.y), bf_lo(q1.z), bf_hi(q1.z), bf_lo(q1.w), bf_hi(q1.w)};
    float ss = 0.f;
#pragma unroll
    for (int i = 0; i < 16; ++i) ss += f[i] * f[i];
    ss += __shfl_xor(ss, 16); ss += __shfl_xor(ss, 32);
    const float rq = rsqrtf(ss * (1.f / 64.f) + EPS) * 0.125f;
    const float4 ga = *(const float4*)(p.q_norm_g + g * 8), gb = *(const float4*)(p.q_norm_g + g * 8 + 4);
    const float4 gc = *(const float4*)(p.q_norm_g + 32 + g * 8), gd = *(const float4*)(p.q_norm_g + 32 + g * 8 + 4);
    const float gg[16] = {ga.x, ga.y, ga.z, ga.w, gb.x, gb.y, gb.z, gb.w, gc.x, gc.y, gc.z, gc.w, gd.x, gd.y, gd.z, gd.w};
#pragma unroll
    for (int i = 0; i < 16; ++i) f[i] *= rq * gg[i];
    qb0 = mk8(pack2(f[0], f[1]), pack2(f[2], f[3]), pack2(f[4], f[5]), pack2(f[6], f[7]));
    qb1 = mk8(pack2(f[8], f[9]), pack2(f[10], f[11]), pack2(f[12], f[13]), pack2(f[14], f[15]));
  }
  f32x4 o[4];
#pragma unroll
  for (int i = 0; i < 4; ++i) o[i] = f32x4{0.f, 0.f, 0.f, 0.f};
  float m_run = -1e30f, l_run = 0.f;
  const int srow = tid >> 2, spart = tid & 3;
  float kg[16];
  {
    const float4* kgp = (const float4*)(p.k_norm_g + spart * 16);
    const float4 a = kgp[0], bq = kgp[1], cq = kgp[2], d = kgp[3];
    kg[0] = a.x; kg[1] = a.y; kg[2] = a.z; kg[3] = a.w; kg[4] = bq.x; kg[5] = bq.y; kg[6] = bq.z; kg[7] = bq.w;
    kg[8] = cq.x; kg[9] = cq.y; kg[10] = cq.z; kg[11] = cq.w; kg[12] = d.x; kg[13] = d.y; kg[14] = d.z; kg[15] = d.w;
  }
  const int kc_lo = (c >= 8) ? 0 : (8 - c);
  for (int kc = kc_lo; kc <= 8; ++kc) {
    const int kchunk = c - 8 + kc;
    __syncthreads();
    {
      const size_t tk = (size_t)b * SEQ + kchunk * 64 + srow;
      const u16* kp = QK + tk * 1024 + 512 + h * 64 + spart * 16;
      const uint4 k0 = *(const uint4*)kp, k1 = *(const uint4*)(kp + 8);
      const u16* vp = VT + ((size_t)b * 512 + h * 64 + srow) * SEQ + kchunk * 64 + spart * 16;
      const uint4 v0 = *(const uint4*)vp, v1 = *(const uint4*)(vp + 8);
      float f[16] = {bf_lo(k0.x), bf_hi(k0.x), bf_lo(k0.y), bf_hi(k0.y), bf_lo(k0.z), bf_hi(k0.z), bf_lo(k0.w), bf_hi(k0.w),
                     bf_lo(k1.x), bf_hi(k1.x), bf_lo(k1.y), bf_hi(k1.y), bf_lo(k1.z), bf_hi(k1.z), bf_lo(k1.w), bf_hi(k1.w)};
      float ss = 0.f;
#pragma unroll
      for (int i = 0; i < 16; ++i) ss += f[i] * f[i];
      ss += __shfl_xor(ss, 1); ss += __shfl_xor(ss, 2);
      const float rk = rsqrtf(ss * (1.f / 64.f) + EPS);
#pragma unroll
      for (int i = 0; i < 16; ++i) f[i] *= rk * kg[i];
      char* kd = Ks + srow * LSTR + spart * 32;
      *(uint4*)kd = make_uint4(pack2(f[0], f[1]), pack2(f[2], f[3]), pack2(f[4], f[5]), pack2(f[6], f[7]));
      *(uint4*)(kd + 16) = make_uint4(pack2(f[8], f[9]), pack2(f[10], f[11]), pack2(f[12], f[13]), pack2(f[14], f[15]));
      char* vd = Vs + srow * LSTR + spart * 32;
      *(uint4*)vd = v0;
      *(uint4*)(vd + 16) = v1;
    }
    __syncthreads();
    f32x4 s[4];
#pragma unroll
    for (int mt = 0; mt < 4; ++mt) {
      const char* kr = Ks + (mt * 16 + l15) * LSTR + g * 16;
      const bf16x8 a0 = *(const bf16x8*)kr, a1 = *(const bf16x8*)(kr + 64);
      s[mt] = mfma16(a0, qb0, f32x4{0.f, 0.f, 0.f, 0.f});
      s[mt] = mfma16(a1, qb1, s[mt]);
    }
    if (kc <= 5) {
      const float bc = bias_s[256];
#pragma unroll
      for (int mt = 0; mt < 4; ++mt)
#pragma unroll
        for (int j = 0; j < 4; ++j) s[mt][j] += bc;
    } else {
      const int qi = wave * 16 + l15 + 64 * (8 - kc);
#pragma unroll
      for (int mt = 0; mt < 4; ++mt)
#pragma unroll
        for (int j = 0; j < 4; ++j) {
          int rel = qi - (mt * 16 + g * 4 + j);
          rel = rel > 128 ? 128 : rel;
          s[mt][j] += bias_s[rel + 128];
        }
    }
    float mx = s[0][0];
#pragma unroll
    for (int mt = 0; mt < 4; ++mt)
#pragma unroll
      for (int j = 0; j < 4; ++j) mx = fmaxf(mx, s[mt][j]);
    mx = fmaxf(mx, __shfl_xor(mx, 16));
    mx = fmaxf(mx, __shfl_xor(mx, 32));
    const float m_new = fmaxf(m_run, mx);
    const float alpha = __expf(m_run - m_new);
    m_run = m_new;
    float ls = 0.f;
#pragma unroll
    for (int mt = 0; mt < 4; ++mt)
#pragma unroll
      for (int j = 0; j < 4; ++j) { s[mt][j] = __expf(s[mt][j] - m_new); ls += s[mt][j]; }
    l_run = l_run * alpha + ls;
#pragma unroll
    for (int mt = 0; mt < 4; ++mt)
#pragma unroll
      for (int j = 0; j < 4; ++j) o[mt][j] *= alpha;
#pragma unroll
    for (int k2 = 0; k2 < 2; ++k2) {
      const bf16x8 pb = mk8(pack2(s[2 * k2][0], s[2 * k2][1]), pack2(s[2 * k2][2], s[2 * k2][3]),
                            pack2(s[2 * k2 + 1][0], s[2 * k2 + 1][1]), pack2(s[2 * k2 + 1][2], s[2 * k2 + 1][3]));
#pragma unroll
      for (int mt = 0; mt < 4; ++mt) {
        const char* vr = Vs + (mt * 16 + l15) * LSTR + (32 * k2 + 4 * g) * 2;
        const uint2 va = *(const uint2*)vr, vb = *(const uint2*)(vr + 32);
        o[mt] = mfma16(mk8(va.x, va.y, vb.x, vb.y), pb, o[mt]);
      }
    }
  }
  float l = l_run;
  l += __shfl_xor(l, 16); l += __shfl_xor(l, 32);
  const float inv = 1.f / l;
#pragma unroll
  for (int mt = 0; mt < 4; ++mt) {
    *(uint2*)(AB + tq * 1024 + 512 + h * 64 + mt * 16 + g * 4) =
        make_uint2(pack2(o[mt][0] * inv, o[mt][1] * inv), pack2(o[mt][2] * inv, o[mt][3] * inv));
  }
}

__device__ __forceinline__ void phase2(const Params& p, char* lds) {
  const int sub = tid_() >> 8;
  for (int it = bid_(); it < 2048 + 1024; it += gridDim.x) {
    if (it < 2048) {
      const int b = it >> 8, hp = (it >> 6) & 3, c = ((it & 63) + 8 * b) & 63;
      attn_item(p, (b << 9) | ((hp * 2 + sub) << 6) | c, lds + sub * 20480);
    } else {
      gmlp_item(p, (it - 2048) * 2 + sub);
    }
  }
}

__device__ __forceinline__ void phase3(const Params& p, char* lds) {
  pg8::Gemm g{(const u16*)(p.ws + OFF_AB), (const u16*)(p.ws + OFF_WOUTT), T, 1024, 1024};
  pg8::StaticOrder S; S.init(T, 1024, (int)gridDim.x, (int)blockIdx.x);
  EpiOut E{p.x, p.out, (u16*)(p.ws + OFF_HB)};
  pg8::gemm_phase<EpiOut, pg8::StaticOrder, true, true>(LDS3(lds), g, S, E);
}
__device__ __forceinline__ void phase4(const Params& p, char* lds) {
  pg8::Gemm g{(const u16*)(p.ws + OFF_HB), (const u16*)(p.ws + OFF_WQT), T, 2048, 1024};
  pg8::StaticOrder S; S.init(T, 2048, (int)gridDim.x, (int)blockIdx.x);
  EpiQ E{(u16*)(p.ws + OFF_PQ)};
  pg8::gemm_phase<EpiQ, pg8::StaticOrder, true, true>(LDS3(lds), g, S, E);
}

__device__ __forceinline__ void sort16_desc(unsigned (&v)[16]) {
#pragma unroll
  for (int k = 2; k <= 16; k <<= 1)
#pragma unroll
    for (int j = k >> 1; j > 0; j >>= 1)
#pragma unroll
      for (int i = 0; i < 16; ++i) {
        const int l = i ^ j;
        if (l > i) {
          const unsigned hi = max(v[i], v[l]), lo = min(v[i], v[l]);
          if ((i & k) == 0) { v[i] = hi; v[l] = lo; } else { v[i] = lo; v[l] = hi; }
        }
      }
}
__device__ __forceinline__ void merge16_desc(unsigned (&a)[16], const unsigned (&b)[16]) {
#pragma unroll
  for (int i = 0; i < 16; ++i) a[i] = max(a[i], b[15 - i]);
#pragma unroll
  for (int j = 8; j > 0; j >>= 1)
#pragma unroll
    for (int i = 0; i < 16; ++i) {
      const int l = i ^ j;
      if (l > i) { const unsigned hi = max(a[i], a[l]), lo = min(a[i], a[l]); a[i] = hi; a[l] = lo; }
    }
}
constexpr int SC_STR = 385, LSTR17 = 17;
constexpr int P5_LV = 64 * SC_STR, P5_LI = P5_LV + 128 * LSTR17, P5_TAB = P5_LI + 128 * LSTR17;

__device__ __forceinline__ void select_item(const Params& p, int item, int next_item, char* lds, const bf16x8 (&kf)[8][4], bf16x8 (&qf)[4]) {
  const int tid = tid_(), lane = tid & 63, wave = tid >> 6, l15 = lane & 15, g = lane >> 4;
  const int h = item & 7, t0 = (item >> 3) * 64;
  const u16* PQ = (const u16*)(p.ws + OFF_PQ);
  int* EIDX = (int*)(p.ws + OFF_EIDX);
  float* BEST = (float*)(p.ws + OFF_BEST);
  float* sc = (float*)lds;
  float* LV = sc + P5_LV;
  int* LI = (int*)lds + P5_LI;
  const int* tab = (const int*)lds + P5_TAB;
  __syncthreads();
  {
    const int pp = wave >> 2, wq = wave & 3;
#pragma unroll
    for (int nt = 0; nt < 8; ++nt) {
      f32x4 a = f32x4{0.f, 0.f, 0.f, 0.f};
#pragma unroll
      for (int ks = 0; ks < 4; ++ks) a = mfma16(qf[ks], kf[nt][ks], a);
#pragma unroll
      for (int j = 0; j < 4; ++j) sc[(wq * 16 + g * 4 + j) * SC_STR + pp * 192 + (nt >> 1) * 48 + (nt & 1) * 16 + l15] = a[j];
    }
    if (next_item < 512 * 8) {
      const u16* qp = PQ + (size_t)((next_item >> 3) * 64 + wq * 16 + l15) * 2048 + (next_item & 7) * 256 + pp * 128 + g * 8;
#pragma unroll
      for (int ks = 0; ks < 4; ++ks) qf[ks] = *(const bf16x8*)(qp + ks * 32);
    }
  }
  __syncthreads();
  {
    const int q = tid & 3, list = tid >> 2, row = list & 63, pp = list >> 6;
    const float* rowp = sc + row * SC_STR + pp * 192;
    const float* src = rowp + q * 48;
    unsigned A[16], B[16];
#pragma unroll
    for (int j = 0; j < 16; ++j) {
      A[j] = (okey(src[j]) & ~127u) | (unsigned)(127 - (q * 32 + j));
      B[j] = (okey(src[16 + j]) & ~127u) | (unsigned)(127 - (q * 32 + 16 + j));
    }
    sort16_desc(A);
    sort16_desc(B);
    merge16_desc(A, B);
#pragma unroll
    for (int i = 0; i < 16; ++i) B[i] = (unsigned)__shfl_xor((int)A[i], 1);
    merge16_desc(A, B);
#pragma unroll
    for (int i = 0; i < 16; ++i) B[i] = (unsigned)__shfl_xor((int)A[i], 2);
    merge16_desc(A, B);
#pragma unroll
    for (int r = 0; r < 16; ++r) {
      if ((r & 3) == q) {
        const int idx = 127 - (int)(A[r] & 127u);
        LV[list * LSTR17 + r] = rowp[(idx >> 5) * 48 + (idx & 31)];
        LI[list * LSTR17 + r] = idx;
      }
    }
  }
  __syncthreads();
  if (tid < 256) {
    const int grp = tid & 3, row = tid >> 2;
    const float* v0 = LV + row * LSTR17;
    const float* v1 = LV + (64 + row) * LSTR17;
    unsigned A[16], B[16];
#pragma unroll
    for (int j = 0; j < 16; ++j) {
      const int code = tab[grp * 16 + j];
      const int cc = code & 255;
      const float s = v0[cc >> 4] + v1[cc & 15];
      A[j] = (code < 0) ? 0u : ((okey(s) & ~255u) | (unsigned)(255 - cc));
    }
    sort16_desc(A);
#pragma unroll
    for (int i = 0; i < 16; ++i) B[i] = (unsigned)__shfl_xor((int)A[i], 1);
    merge16_desc(A, B);
#pragma unroll
    for (int i = 0; i < 16; ++i) B[i] = (unsigned)__shfl_xor((int)A[i], 2);
    merge16_desc(A, B);
    const size_t ob = ((size_t)(t0 + row) * 8 + h) * 16 + grp * 4;
    const int* i0 = LI + row * LSTR17;
    const int* i1 = LI + (64 + row) * LSTR17;
    int e4[4];
    float b4[4];
#pragma unroll
    for (int j = 0; j < 4; ++j) {
      const unsigned sel = (grp == 0) ? A[j] : (grp == 1) ? A[4 + j] : (grp == 2) ? A[8 + j] : A[12 + j];
      const int cc = 255 - (int)(sel & 255u);
      const int a = cc >> 4, bq = cc & 15;
      e4[j] = i0[a] * 128 + i1[bq];
      b4[j] = v0[a] + v1[bq];
    }
    *(int4*)(EIDX + ob) = make_int4(e4[0], e4[1], e4[2], e4[3]);
    *(float4*)(BEST + ob) = make_float4(b4[0], b4[1], b4[2], b4[3]);
  }
}

__device__ __forceinline__ void phase5(const Params& p, char* lds) {
  {
    const int i = tid_();
    if (i < 64) {
      const int grp = i >> 4, j = i & 15;
      int code = -1;
      if (grp == 0) code = j;
      else if (grp == 1) { if (j < 8) code = 16 + j; else if (j < 13) code = 32 + (j - 8); }
      else if (grp == 2) { if (j < 4) code = 48 + j; else if (j < 7) code = 64 + (j - 4); else if (j < 9) code = 80 + (j - 7); else if (j < 11) code = 96 + (j - 9); else if (j < 13) code = 112 + (j - 11); }
      else { if (j < 8) code = (8 + j) * 16; }
      ((int*)lds)[P5_TAB + i] = code;
    }
  }
  const int tid = tid_(), lane = tid & 63, wave = tid >> 6, l15 = lane & 15, g = lane >> 4;
  const int pp = wave >> 2, wq = wave & 3;
  int it = bid_();
  if (it >= 512 * 8) return;
  const bool fixed_head = (gridDim.x & 7) == 0;
  bf16x8 kf[8][4];
  bf16x8 qf[4];
  {
    const u16* KEYS = (const u16*)(p.ws + OFF_KEYS);
#pragma unroll
    for (int nt = 0; nt < 8; ++nt) {
      const u16* kp = KEYS + ((size_t)(((it & 7) * 2 + pp) * 128 + nt * 16 + l15)) * 128 + g * 8;
#pragma unroll
      for (int ks = 0; ks < 4; ++ks) kf[nt][ks] = *(const bf16x8*)(kp + ks * 32);
    }
    const u16* qp = (const u16*)(p.ws + OFF_PQ) + (size_t)((it >> 3) * 64 + wq * 16 + l15) * 2048 + (it & 7) * 256 + pp * 128 + g * 8;
#pragma unroll
    for (int ks = 0; ks < 4; ++ks) qf[ks] = *(const bf16x8*)(qp + ks * 32);
  }
  for (; it < 512 * 8; it += gridDim.x) {
    if (!fixed_head) {
      const u16* KEYS = (const u16*)(p.ws + OFF_KEYS);
#pragma unroll
      for (int nt = 0; nt < 8; ++nt) {
        const u16* kp = KEYS + ((size_t)(((it & 7) * 2 + pp) * 128 + nt * 16 + l15)) * 128 + g * 8;
#pragma unroll
        for (int ks = 0; ks < 4; ++ks) kf[nt][ks] = *(const bf16x8*)(kp + ks * 32);
      }
    }
    select_item(p, it, it + (int)gridDim.x, lds, kf, qf);
  }
}

#define CVT_LO(w) __builtin_amdgcn_cvt_pk_f32_fp8((int)(w), false)
#define CVT_HI(w) __builtin_amdgcn_cvt_pk_f32_fp8((int)(w), true)
__device__ __forceinline__ void phase6(const Params& p, char* lds) {
  const int tid = tid_(), lane = tid & 63, wave = tid >> 6, l15 = lane & 15, g = lane >> 4;
  const u16* HB = (const u16*)(p.ws + OFF_HB);
  const unsigned char* EU8 = (const unsigned char*)(p.ws + OFF_EU);
  const unsigned char* EV8 = (const unsigned char*)(p.ws + OFF_EV);
  const float* ESC = (const float*)(p.ws + OFF_ESC);
  const int* EIDX = (const int*)(p.ws + OFF_EIDX);
  const float* BEST = (const float*)(p.ws + OFF_BEST);
  float* wl = (float*)lds + wave * 128;
  for (int t = bid_() * NWAVE + wave; t < T; t += gridDim.x * NWAVE) {
    f32x2 hf[32];
    {
      const u16* hrow = HB + (size_t)t * 1024 + l15 * 16;
#pragma unroll
      for (int i = 0; i < 4; ++i) {
        const uint4 a = *(const uint4*)(hrow + i * 256), b = *(const uint4*)(hrow + i * 256 + 8);
        hf[i * 8 + 0] = f32x2{bf_lo(a.x), bf_hi(a.x)}; hf[i * 8 + 1] = f32x2{bf_lo(a.y), bf_hi(a.y)};
        hf[i * 8 + 2] = f32x2{bf_lo(a.z), bf_hi(a.z)}; hf[i * 8 + 3] = f32x2{bf_lo(a.w), bf_hi(a.w)};
        hf[i * 8 + 4] = f32x2{bf_lo(b.x), bf_hi(b.x)}; hf[i * 8 + 5] = f32x2{bf_lo(b.y), bf_hi(b.y)};
        hf[i * 8 + 6] = f32x2{bf_lo(b.z), bf_hi(b.z)}; hf[i * 8 + 7] = f32x2{bf_lo(b.w), bf_hi(b.w)};
      }
    }
    float ss;
    {
      f32x2 s2 = f32x2{0.f, 0.f};
#pragma unroll
      for (int i = 0; i < 32; ++i) s2 = __builtin_elementwise_fma(hf[i], hf[i], s2);
      ss = s2.x + s2.y;
    }
    ss += __shfl_xor(ss, 1); ss += __shfl_xor(ss, 2); ss += __shfl_xor(ss, 4); ss += __shfl_xor(ss, 8);
    const float rs2 = rsqrtf(ss * (1.f / 1024.f) + EPS);
    const int ea = EIDX[(size_t)t * 128 + lane], eb = EIDX[(size_t)t * 128 + 64 + lane];
    float ga, gb;
    {
      const float ba = BEST[(size_t)t * 128 + lane] * rs2, bb = BEST[(size_t)t * 128 + 64 + lane] * rs2;
      float ma = ba, mb = bb;
#pragma unroll
      for (int o = 1; o < 16; o <<= 1) { ma = fmaxf(ma, __shfl_xor(ma, o)); mb = fmaxf(mb, __shfl_xor(mb, o)); }
      const float xa = __expf(ba - ma), xb = __expf(bb - mb);
      float sa = xa, sb = xb;
#pragma unroll
      for (int o = 1; o < 16; o <<= 1) { sa += __shfl_xor(sa, o); sb += __shfl_xor(sb, o); }
      ga = xa / sa; gb = xb / sb;
    }
#pragma unroll 2
    for (int it = 0; it < 32; ++it) {
      const int k = it * 4 + g;
      const int e = __shfl((it < 16) ? ea : eb, k & 63);
      const float gk = __shfl((it < 16) ? ga : gb, k & 63);
      const unsigned char* urow = EU8 + (size_t)e * 1024 + l15 * 16;
      uint4 uv[4];
#pragma unroll
      for (int i = 0; i < 4; ++i) uv[i] = *(const uint4*)(urow + i * 256);
      const float usc = ESC[e], vsc = ESC[16384 + e];
      f32x2 d0 = f32x2{0.f, 0.f}, d1 = f32x2{0.f, 0.f};
#pragma unroll
      for (int i = 0; i < 4; ++i) {
        d0 = __builtin_elementwise_fma(CVT_LO(uv[i].x), hf[i * 8 + 0], d0); d1 = __builtin_elementwise_fma(CVT_HI(uv[i].x), hf[i * 8 + 1], d1);
        d0 = __builtin_elementwise_fma(CVT_LO(uv[i].y), hf[i * 8 + 2], d0); d1 = __builtin_elementwise_fma(CVT_HI(uv[i].y), hf[i * 8 + 3], d1);
        d0 = __builtin_elementwise_fma(CVT_LO(uv[i].z), hf[i * 8 + 4], d0); d1 = __builtin_elementwise_fma(CVT_HI(uv[i].z), hf[i * 8 + 5], d1);
        d0 = __builtin_elementwise_fma(CVT_LO(uv[i].w), hf[i * 8 + 6], d0); d1 = __builtin_elementwise_fma(CVT_HI(uv[i].w), hf[i * 8 + 7], d1);
      }
      float d = (d0.x + d0.y) + (d1.x + d1.y);
      d += __shfl_xor(d, 1); d += __shfl_xor(d, 2); d += __shfl_xor(d, 4); d += __shfl_xor(d, 8);
      const float hk = gelu_f(d * rs2 * usc);
      if (l15 == 0) wl[k] = gk * hk * vsc;
    }
    f32x2 acc[32];
#pragma unroll
    for (int i = 0; i < 32; ++i) acc[i] = f32x2{0.f, 0.f};
#pragma unroll 2
    for (int it = 0; it < 32; ++it) {
      const int k = it * 4 + g;
      const int e = __shfl((it < 16) ? ea : eb, k & 63);
      const float wk = wl[k];
      const f32x2 w2 = f32x2{wk, wk};
      const unsigned char* vrow = EV8 + (size_t)e * 1024 + l15 * 16;
      uint4 vv[4];
#pragma unroll
      for (int i = 0; i < 4; ++i) vv[i] = *(const uint4*)(vrow + i * 256);
#pragma unroll
      for (int i = 0; i < 4; ++i) {
        acc[i * 8 + 0] = __builtin_elementwise_fma(CVT_LO(vv[i].x), w2, acc[i * 8 + 0]); acc[i * 8 + 1] = __builtin_elementwise_fma(CVT_HI(vv[i].x), w2, acc[i * 8 + 1]);
        acc[i * 8 + 2] = __builtin_elementwise_fma(CVT_LO(vv[i].y), w2, acc[i * 8 + 2]); acc[i * 8 + 3] = __builtin_elementwise_fma(CVT_HI(vv[i].y), w2, acc[i * 8 + 3]);
        acc[i * 8 + 4] = __builtin_elementwise_fma(CVT_LO(vv[i].z), w2, acc[i * 8 + 4]); acc[i * 8 + 5] = __builtin_elementwise_fma(CVT_HI(vv[i].z), w2, acc[i * 8 + 5]);
        acc[i * 8 + 6] = __builtin_elementwise_fma(CVT_LO(vv[i].w), w2, acc[i * 8 + 6]); acc[i * 8 + 7] = __builtin_elementwise_fma(CVT_HI(vv[i].w), w2, acc[i * 8 + 7]);
      }
    }
    f32x2 r1[16];
    const bool hi2 = (g & 2) != 0;
#pragma unroll
    for (int i = 0; i < 16; ++i) {
      const f32x2 send = hi2 ? acc[i] : acc[i + 16];
      const f32x2 keep = hi2 ? acc[i + 16] : acc[i];
      r1[i] = f32x2{keep.x + __shfl_xor(send.x, 32), keep.y + __shfl_xor(send.y, 32)};
    }
    f32x2 r2[8];
    const bool hi1 = (g & 1) != 0;
#pragma unroll
    for (int i = 0; i < 8; ++i) {
      const f32x2 send = hi1 ? r1[i] : r1[i + 8];
      const f32x2 keep = hi1 ? r1[i + 8] : r1[i];
      r2[i] = f32x2{keep.x + __shfl_xor(send.x, 16), keep.y + __shfl_xor(send.y, 16)};
    }
    float4* op = (float4*)(p.out + (size_t)t * 1024 + g * 256 + l15 * 16);
#pragma unroll
    for (int q = 0; q < 4; ++q) {
      float4 a = op[q];
      a.x += r2[q * 2].x; a.y += r2[q * 2].y; a.z += r2[q * 2 + 1].x; a.w += r2[q * 2 + 1].y;
      op[q] = a;
    }
  }
}

__device__ __forceinline__ void phase6a(const Params& p, char* lds) {
  const int tid = tid_(), lane = tid & 63, wave = tid >> 6, eg = lane >> 3, part = lane & 7;
  const int bid = bid_();
  const int x = bid & 7, xb = bid >> 3, ncb = ((int)gridDim.x + 7 - x) >> 3;
  const unsigned char* EUX = (const unsigned char*)(p.ws + OFF_EU) + (size_t)x * (2 * MiB) + part * 16;
  const u16* HBX = (const u16*)(p.ws + OFF_HB) + x * 128 + part * 16;
  const int* EIDX = (const int*)(p.ws + OFF_EIDX);
  float* PART = (float*)(p.ws + OFF_PART) + (size_t)x * T * 128;
  const int tstep = ncb * NWAVE;
  for (int t = xb * NWAVE + wave; t < T; t += 2 * tstep) {
    const int t1 = t + tstep;
    const bool two = t1 < T;
    const int tb = two ? t1 : t;
    const int ea0 = EIDX[(size_t)t * 128 + lane], eb0 = EIDX[(size_t)t * 128 + 64 + lane];
    const int ea1 = EIDX[(size_t)tb * 128 + lane], eb1 = EIDX[(size_t)tb * 128 + 64 + lane];
    uint4 uv0[16], uv1[16];
#pragma unroll
    for (int it = 0; it < 16; ++it) {
      const int src = (it * 8 + eg) & 63;
      const int e0 = __shfl((it < 8) ? ea0 : eb0, src);
      const int e1 = __shfl((it < 8) ? ea1 : eb1, src);
      uv0[it] = *(const uint4*)(EUX + (size_t)e0 * 128);
      uv1[it] = *(const uint4*)(EUX + (size_t)e1 * 128);
    }
    f32x2 h0[8], h1[8];
    {
      const uint4 a = *(const uint4*)(HBX + (size_t)t * 1024), b = *(const uint4*)(HBX + (size_t)t * 1024 + 8);
      h0[0] = f32x2{bf_lo(a.x), bf_hi(a.x)}; h0[1] = f32x2{bf_lo(a.y), bf_hi(a.y)}; h0[2] = f32x2{bf_lo(a.z), bf_hi(a.z)}; h0[3] = f32x2{bf_lo(a.w), bf_hi(a.w)};
      h0[4] = f32x2{bf_lo(b.x), bf_hi(b.x)}; h0[5] = f32x2{bf_lo(b.y), bf_hi(b.y)}; h0[6] = f32x2{bf_lo(b.z), bf_hi(b.z)}; h0[7] = f32x2{bf_lo(b.w), bf_hi(b.w)};
      const uint4 c = *(const uint4*)(HBX + (size_t)tb * 1024), d = *(const uint4*)(HBX + (size_t)tb * 1024 + 8);
      h1[0] = f32x2{bf_lo(c.x), bf_hi(c.x)}; h1[1] = f32x2{bf_lo(c.y), bf_hi(c.y)}; h1[2] = f32x2{bf_lo(c.z), bf_hi(c.z)}; h1[3] = f32x2{bf_lo(c.w), bf_hi(c.w)};
      h1[4] = f32x2{bf_lo(d.x), bf_hi(d.x)}; h1[5] = f32x2{bf_lo(d.y), bf_hi(d.y)}; h1[6] = f32x2{bf_lo(d.z), bf_hi(d.z)}; h1[7] = f32x2{bf_lo(d.w), bf_hi(d.w)};
    }
    float d0[16], d1[16];
#pragma unroll
    for (int it = 0; it < 16; ++it) {
      f32x2 s = __builtin_elementwise_fma(CVT_LO(uv0[it].x), h0[0], f32x2{0.f, 0.f});
      s = __builtin_elementwise_fma(CVT_HI(uv0[it].x), h0[1], s); s = __builtin_elementwise_fma(CVT_LO(uv0[it].y), h0[2], s);
      s = __builtin_elementwise_fma(CVT_HI(uv0[it].y), h0[3], s); s = __builtin_elementwise_fma(CVT_LO(uv0[it].z), h0[4], s);
      s = __builtin_elementwise_fma(CVT_HI(uv0[it].z), h0[5], s); s = __builtin_elementwise_fma(CVT_LO(uv0[it].w), h0[6], s);
      s = __builtin_elementwise_fma(CVT_HI(uv0[it].w), h0[7], s);
      d0[it] = s.x + s.y;
      f32x2 q = __builtin_elementwise_fma(CVT_LO(uv1[it].x), h1[0], f32x2{0.f, 0.f});
      q = __builtin_elementwise_fma(CVT_HI(uv1[it].x), h1[1], q); q = __builtin_elementwise_fma(CVT_LO(uv1[it].y), h1[2], q);
      q = __builtin_elementwise_fma(CVT_HI(uv1[it].y), h1[3], q); q = __builtin_elementwise_fma(CVT_LO(uv1[it].z), h1[4], q);
      q = __builtin_elementwise_fma(CVT_HI(uv1[it].z), h1[5], q); q = __builtin_elementwise_fma(CVT_LO(uv1[it].w), h1[6], q);
      q = __builtin_elementwise_fma(CVT_HI(uv1[it].w), h1[7], q);
      d1[it] = q.x + q.y;
    }
    const bool b2 = (lane & 4) != 0, b1 = (lane & 2) != 0, b0 = (lane & 1) != 0;
    float r0[8], r1[8];
#pragma unroll
    for (int i = 0; i < 8; ++i) {
      r0[i] = (b2 ? d0[i + 8] : d0[i]) + __shfl_xor(b2 ? d0[i] : d0[i + 8], 4);
      r1[i] = (b2 ? d1[i + 8] : d1[i]) + __shfl_xor(b2 ? d1[i] : d1[i + 8], 4);
    }
    float s0[4], s1[4];
#pragma unroll
    for (int i = 0; i < 4; ++i) {
      s0[i] = (b1 ? r0[i + 4] : r0[i]) + __shfl_xor(b1 ? r0[i] : r0[i + 4], 2);
      s1[i] = (b1 ? r1[i + 4] : r1[i]) + __shfl_xor(b1 ? r1[i] : r1[i + 4], 2);
    }
    float u0[2], u1[2];
#pragma unroll
    for (int i = 0; i < 2; ++i) {
      u0[i] = (b0 ? s0[i + 2] : s0[i]) + __shfl_xor(b0 ? s0[i] : s0[i + 2], 1);
      u1[i] = (b0 ? s1[i + 2] : s1[i]) + __shfl_xor(b0 ? s1[i] : s1[i + 2], 1);
    }
#pragma unroll
    for (int i = 0; i < 2; ++i) {
      const int k = (2 * part + i) * 8 + eg;
      PART[(size_t)t * 128 + k] = u0[i];
      if (two) PART[(size_t)t1 * 128 + k] = u1[i];
    }
  }
}

__device__ __forceinline__ void phase6m(const Params& p, char* lds) {
  const int tid = tid_(), lane = tid & 63, wave = tid >> 6;
  const u16* HB = (const u16*)(p.ws + OFF_HB);
  const float* ESC = (const float*)(p.ws + OFF_ESC);
  const int* EIDX = (const int*)(p.ws + OFF_EIDX);
  const float* BEST = (const float*)(p.ws + OFF_BEST);
  const float* PART = (const float*)(p.ws + OFF_PART);
  float* WGT = (float*)(p.ws + OFF_WGT);
  for (int t = bid_() * NWAVE + wave; t < T; t += gridDim.x * NWAVE) {
    const uint4 a = *(const uint4*)(HB + (size_t)t * 1024 + lane * 16), b = *(const uint4*)(HB + (size_t)t * 1024 + lane * 16 + 8);
    float ss = 0.f;
    ss = dot2(a.x, a.x, ss); ss = dot2(a.y, a.y, ss); ss = dot2(a.z, a.z, ss); ss = dot2(a.w, a.w, ss);
    ss = dot2(b.x, b.x, ss); ss = dot2(b.y, b.y, ss); ss = dot2(b.z, b.z, ss); ss = dot2(b.w, b.w, ss);
#pragma unroll
    for (int o = 1; o < 64; o <<= 1) ss += __shfl_xor(ss, o);
    const float rs2 = rsqrtf(ss * (1.f / 1024.f) + EPS);
#pragma unroll
    for (int hf = 0; hf < 2; ++hf) {
      const size_t idx = (size_t)t * 128 + hf * 64 + lane;
      float d = 0.f;
#pragma unroll
      for (int x = 0; x < 8; ++x) d += PART[(size_t)x * T * 128 + idx];
      const int e = EIDX[idx];
      const float v = BEST[idx] * rs2;
      float m = v;
#pragma unroll
      for (int o = 1; o < 16; o <<= 1) m = fmaxf(m, __shfl_xor(m, o));
      const float ex = __expf(v - m);
      float s = ex;
#pragma unroll
      for (int o = 1; o < 16; o <<= 1) s += __shfl_xor(s, o);
      WGT[idx] = (ex / s) * gelu_f(d * rs2 * ESC[e]) * ESC[16384 + e];
    }
  }
}

__device__ __forceinline__ void phase6b(const Params& p, char* lds) {
  const int tid = tid_(), lane = tid & 63, wave = tid >> 6, eg = lane >> 3, part = lane & 7;
  const int bid = bid_();
  const int x = bid & 7, xb = bid >> 3, ncb = ((int)gridDim.x + 7 - x) >> 3;
  const unsigned char* EVX = (const unsigned char*)(p.ws + OFF_EV) + (size_t)x * (2 * MiB) + part * 16;
  const int* EIDX = (const int*)(p.ws + OFF_EIDX);
  const float* WGT = (const float*)(p.ws + OFF_WGT);
  const int tstep = ncb * NWAVE;
  const int pi = ((lane >> 5) & 1) * 4 + ((lane >> 4) & 1) * 2 + ((lane >> 3) & 1);
  const bool h5 = (lane & 32) != 0, h4 = (lane & 16) != 0, h3 = (lane & 8) != 0;
  for (int t = xb * NWAVE + wave; t < T; t += 2 * tstep) {
    const int t1 = t + tstep;
    const bool two = t1 < T;
    const int tb = two ? t1 : t;
    const int ea0 = EIDX[(size_t)t * 128 + lane], eb0 = EIDX[(size_t)t * 128 + 64 + lane];
    const int ea1 = EIDX[(size_t)tb * 128 + lane], eb1 = EIDX[(size_t)tb * 128 + 64 + lane];
    const float wa0 = WGT[(size_t)t * 128 + lane], wb0 = WGT[(size_t)t * 128 + 64 + lane];
    const float wa1 = WGT[(size_t)tb * 128 + lane], wb1 = WGT[(size_t)tb * 128 + 64 + lane];
    uint4 vv0[16], vv1[16];
#pragma unroll
    for (int it = 0; it < 16; ++it) {
      const int src = (it * 8 + eg) & 63;
      const int e0 = __shfl((it < 8) ? ea0 : eb0, src);
      const int e1 = __shfl((it < 8) ? ea1 : eb1, src);
      vv0[it] = *(const uint4*)(EVX + (size_t)e0 * 128);
      vv1[it] = *(const uint4*)(EVX + (size_t)e1 * 128);
    }
    float2* op0 = (float2*)(p.out + (size_t)t * 1024 + x * 128 + part * 16 + pi * 2);
    float2* op1 = (float2*)(p.out + (size_t)tb * 1024 + x * 128 + part * 16 + pi * 2);
    const float2 o0 = *op0, o1 = *op1;
    f32x2 a0[8], a1[8];
#pragma unroll
    for (int i = 0; i < 8; ++i) { a0[i] = f32x2{0.f, 0.f}; a1[i] = f32x2{0.f, 0.f}; }
#pragma unroll
    for (int it = 0; it < 16; ++it) {
      const int src = (it * 8 + eg) & 63;
      const float w0 = __shfl((it < 8) ? wa0 : wb0, src), w1 = __shfl((it < 8) ? wa1 : wb1, src);
      const f32x2 w20 = f32x2{w0, w0}, w21 = f32x2{w1, w1};
      a0[0] = __builtin_elementwise_fma(CVT_LO(vv0[it].x), w20, a0[0]); a0[1] = __builtin_elementwise_fma(CVT_HI(vv0[it].x), w20, a0[1]);
      a0[2] = __builtin_elementwise_fma(CVT_LO(vv0[it].y), w20, a0[2]); a0[3] = __builtin_elementwise_fma(CVT_HI(vv0[it].y), w20, a0[3]);
      a0[4] = __builtin_elementwise_fma(CVT_LO(vv0[it].z), w20, a0[4]); a0[5] = __builtin_elementwise_fma(CVT_HI(vv0[it].z), w20, a0[5]);
      a0[6] = __builtin_elementwise_fma(CVT_LO(vv0[it].w), w20, a0[6]); a0[7] = __builtin_elementwise_fma(CVT_HI(vv0[it].w), w20, a0[7]);
      a1[0] = __builtin_elementwise_fma(CVT_LO(vv1[it].x), w21, a1[0]); a1[1] = __builtin_elementwise_fma(CVT_HI(vv1[it].x), w21, a1[1]);
      a1[2] = __builtin_elementwise_fma(CVT_LO(vv1[it].y), w21, a1[2]); a1[3] = __builtin_elementwise_fma(CVT_HI(vv1[it].y), w21, a1[3]);
      a1[4] = __builtin_elementwise_fma(CVT_LO(vv1[it].z), w21, a1[4]); a1[5] = __builtin_elementwise_fma(CVT_HI(vv1[it].z), w21, a1[5]);
      a1[6] = __builtin_elementwise_fma(CVT_LO(vv1[it].w), w21, a1[6]); a1[7] = __builtin_elementwise_fma(CVT_HI(vv1[it].w), w21, a1[7]);
    }
#define RS8(acc, res)                                                                                            \
    {                                                                                                            \
      f32x2 q1[4];                                                                                               \
      _Pragma("unroll") for (int i = 0; i < 4; ++i) {                                                            \
        const f32x2 sd = h5 ? acc[i] : acc[i + 4], kp = h5 ? acc[i + 4] : acc[i];                                \
        q1[i] = f32x2{kp.x + __shfl_xor(sd.x, 32), kp.y + __shfl_xor(sd.y, 32)};                                 \
      }                                                                                                          \
      f32x2 q2[2];                                                                                               \
      _Pragma("unroll") for (int i = 0; i < 2; ++i) {                                                            \
        const f32x2 sd = h4 ? q1[i] : q1[i + 2], kp = h4 ? q1[i + 2] : q1[i];                                    \
        q2[i] = f32x2{kp.x + __shfl_xor(sd.x, 16), kp.y + __shfl_xor(sd.y, 16)};                                 \
      }                                                                                                          \
      const f32x2 sd = h3 ? q2[0] : q2[1], kp = h3 ? q2[1] : q2[0];                                              \
      res = f32x2{kp.x + __shfl_xor(sd.x, 8), kp.y + __shfl_xor(sd.y, 8)};                                       \
    }
    f32x2 z0, z1;
    RS8(a0, z0);
    RS8(a1, z1);
    *op0 = make_float2(o0.x + z0.x, o0.y + z0.y);
    if (two) *op1 = make_float2(o1.x + z1.x, o1.y + z1.y);
  }
}

__device__ __forceinline__ void seam_barrier(unsigned* ctr, unsigned nblk) {
  __syncthreads();
  if (threadIdx.x == 0) {
    __builtin_amdgcn_fence(__ATOMIC_RELEASE, "agent");
    asm volatile("s_waitcnt vmcnt(0)" ::: "memory");
    __hip_atomic_fetch_add(ctr, 1u, __ATOMIC_RELAXED, __HIP_MEMORY_SCOPE_AGENT);
    while (__hip_atomic_load(ctr, __ATOMIC_RELAXED, __HIP_MEMORY_SCOPE_AGENT) < nblk) __builtin_amdgcn_s_sleep(2);
    __builtin_amdgcn_fence(__ATOMIC_ACQUIRE, "agent");
    asm volatile("s_waitcnt vmcnt(0)" ::: "memory");
  }
  __syncthreads();
}
#ifndef PMASK
#define PMASK 127
#endif
#define PROG 0x6543210ull
#define NPROG 9
__global__ void __launch_bounds__(NTHR, 2) mega(Params p, int ph_lo, int ph_hi) {
  extern __shared__ __attribute__((aligned(16))) char lds[];
  cg::grid_group grid = cg::this_grid();
#ifndef REP_PHASE
#define REP_PHASE -1
#endif
#define IN(k) (ph_lo <= (k) && (k) < ph_hi)
#define SEAM(k) do { if (IN(k) && IN((k) + 1)) { if ((k) == 0) grid.sync(); else seam_barrier((unsigned*)(p.ws + OFF_BAR) + (k) * 64, gridDim.x); } } while (0)
  if (IN(0)) { phase0(p, lds); if (REP_PHASE == 0) { grid.sync(); phase0(p, lds); } }
  SEAM(0);
  if (IN(1)) { phase1(p, lds); if (REP_PHASE == 1) { grid.sync(); phase1(p, lds); } }
  SEAM(1);
  if (IN(2)) { phase2(p, lds); if (REP_PHASE == 2) { grid.sync(); phase2(p, lds); } }
  SEAM(2);
  if (IN(3)) { phase3(p, lds); if (REP_PHASE == 3) { grid.sync(); phase3(p, lds); } }
  SEAM(3);
  if (IN(4)) { phase4(p, lds); if (REP_PHASE == 4) { grid.sync(); phase4(p, lds); } }
  SEAM(4);
  if (IN(5)) { phase5(p, lds); if (REP_PHASE == 5) { grid.sync(); phase5(p, lds); } }
  SEAM(5);
  if (IN(6)) { phase6a(p, lds); if (REP_PHASE == 6) { grid.sync(); phase6a(p, lds); } }
  SEAM(6);
  if (IN(7)) { phase6m(p, lds); if (REP_PHASE == 7) { grid.sync(); phase6m(p, lds); } }
  SEAM(7);
  if (IN(8)) phase6b(p, lds);
}

extern "C" void kernel_launch(void* const* d_in, const int* in_sizes, int n_in, void* d_out, int out_size, void* d_ws,
                              size_t ws_size, hipStream_t stream) {
  static int grid_blocks = 0;
  if (!grid_blocks) {
    int dev = 0, cus = 0, per_cu = 0;
    (void)hipGetDevice(&dev);
    (void)hipDeviceGetAttribute(&cus, hipDeviceAttributeMultiprocessorCount, dev);
    (void)hipFuncSetAttribute((const void*)mega, hipFuncAttributeMaxDynamicSharedMemorySize, LDS_BYTES);
    (void)hipOccupancyMaxActiveBlocksPerMultiprocessor(&per_cu, mega, NTHR, LDS_BYTES);
    if (per_cu > 1) per_cu = 1;
    grid_blocks = cus * per_cu;
  }
  Params p{};
  p.x = (const float*)d_in[0]; p.ln_mix_g = (const float*)d_in[1]; p.w_in = (const float*)d_in[2];
  p.gmlp_norm_g = (const float*)d_in[3]; p.gmlp_w_s = (const float*)d_in[4]; p.gmlp_b_s = (const float*)d_in[5];
  p.q_norm_g = (const float*)d_in[6]; p.k_norm_g = (const float*)d_in[7]; p.rel_bias = (const float*)d_in[8];
  p.w_out = (const float*)d_in[9]; p.ln_ffn_g = (const float*)d_in[10]; p.w_query = (const float*)d_in[11];
  p.sub_keys = (const float*)d_in[12]; p.peer_u = (const float*)d_in[13]; p.peer_v = (const float*)d_in[14];
  p.out = (float*)d_out; p.ws = (char*)d_ws;
#if FUSED
  int lo = 0, hi = NPROG;
  void* args[] = {&p, &lo, &hi};
  hipError_t e = hipLaunchCooperativeKernel((void*)mega, dim3(grid_blocks), dim3(NTHR), args, LDS_BYTES, stream);
  if (e != hipSuccess) fprintf(stderr, "cooperative launch failed: %s (grid %d)\n", hipGetErrorString(e), grid_blocks);
#else
  for (int ph = 0; ph < NPROG; ++ph) mega<<<dim3(grid_blocks), dim3(NTHR), LDS_BYTES, stream>>>(p, ph, ph + 1);
#endif
}
```

```cpp
#include <hip/hip_runtime.h>
#include <hip/hip_cooperative_groups.h>
#include <cstdio>
namespace cg = cooperative_groups;

#ifndef FUSED
#define FUSED 1
#endif

typedef unsigned short u16;
using bf16x8 = __attribute__((ext_vector_type(8))) short;
using s16x4 = __attribute__((ext_vector_type(4))) short;
using f32x4 = __attribute__((ext_vector_type(4))) float;
using bf16x2 = __attribute__((ext_vector_type(2))) __bf16;
using f32x2 = __attribute__((ext_vector_type(2))) float;

constexpr int T = 32768, DM = 1024, SEQ = 4096;
constexpr float EPS = 1e-6f;
constexpr size_t MiB = 1u << 20;
constexpr size_t OFF_XB = 0, OFF_WINT = 64 * MiB  , OFF_WB = 67 * MiB  , OFF_WOUTT = 69 * MiB, OFF_WQT = 71 * MiB, OFF_KEYS = 75 * MiB,
                 OFF_RS = 76 * MiB, OFF_VSS = 76 * MiB + 512 * 1024, OFF_EU = 77 * MiB, OFF_EV = 109 * MiB,
                 OFF_U = 141 * MiB, OFF_GVT = 173 * MiB, OFF_QK = 205 * MiB, OFF_VT = 269 * MiB, OFF_AB = 301 * MiB,
                 OFF_HB = 365 * MiB, OFF_PQ = 141 * MiB  , OFF_EIDX = 429 * MiB,
                 OFF_BEST = 445 * MiB, OFF_ESC = 461 * MiB  , OFF_WGT = 462 * MiB  , OFF_BAR = 480 * MiB  , OFF_PART = 141 * MiB  ;

struct Params {
  const float *x, *ln_mix_g, *w_in, *gmlp_norm_g, *gmlp_w_s, *gmlp_b_s, *q_norm_g, *k_norm_g, *rel_bias, *w_out,
      *ln_ffn_g, *w_query, *sub_keys, *peer_u, *peer_v;
  float* out;
  char* ws;
};

constexpr int LDS_BYTES = 131584;
constexpr int NTHR = 512, NWAVE = 8;
constexpr int LSTR = 144;
constexpr int OPER_BYTES = 128 * LSTR;

__device__ __forceinline__ u16 f2bf(float f) {
  unsigned u = __float_as_uint(f);
  u += 0x7fffu + ((u >> 16) & 1u);
  return (u16)(u >> 16);
}
__device__ __forceinline__ unsigned pack2(float lo, float hi) { return (unsigned)f2bf(lo) | ((unsigned)f2bf(hi) << 16); }
__device__ __forceinline__ float bf_lo(unsigned u) { return __uint_as_float(u << 16); }
__device__ __forceinline__ float bf_hi(unsigned u) { return __uint_as_float(u & 0xffff0000u); }
__device__ __forceinline__ float bf2f(u16 v) { return __uint_as_float(((unsigned)v) << 16); }
__device__ __forceinline__ float gelu_f(float x) {
  float z = 0.7978845608028654f * (x + 0.044715f * x * x * x);
  float e = __expf(2.f * z);
  float th = 1.f - 2.f / (1.f + e);
  return 0.5f * x * (1.f + th);
}
__device__ __forceinline__ float dot2(unsigned a, unsigned b, float acc) {
  return __builtin_amdgcn_fdot2_f32_bf16(__builtin_bit_cast(bf16x2, a), __builtin_bit_cast(bf16x2, b), acc, false);
}
__device__ __forceinline__ f32x4 mfma16(bf16x8 a, bf16x8 b, f32x4 c) {
  return __builtin_amdgcn_mfma_f32_16x16x32_bf16(a, b, c, 0, 0, 0);
}
__device__ __forceinline__ bf16x8 mk8(unsigned a, unsigned b, unsigned c, unsigned d) {
  uint4 u = make_uint4(a, b, c, d);
  return __builtin_bit_cast(bf16x8, u);
}
__device__ __forceinline__ unsigned pack4_fp8(float a, float b, float c, float d) {
  int r = 0;
  r = __builtin_amdgcn_cvt_pk_fp8_f32(a, b, r, false);
  r = __builtin_amdgcn_cvt_pk_fp8_f32(c, d, r, true);
  return (unsigned)r;
}
__device__ __forceinline__ unsigned okey(float x) {
  unsigned u = __float_as_uint(x);
  return (u & 0x80000000u) ? ~u : (u | 0x80000000u);
}


__device__ __forceinline__ int tid_() { int t = threadIdx.x; asm volatile("" : "+v"(t)); return t; }
__device__ __forceinline__ int bid_() { int b = blockIdx.x; asm volatile("" : "+s"(b)); return b; }
namespace pg8 {
#define PG8_LAS __attribute__((address_space(3)))
typedef unsigned short bf16_t;
typedef short bf16x8 __attribute__((ext_vector_type(8)));
typedef float f32x4 __attribute__((ext_vector_type(4)));
typedef unsigned u32x4 __attribute__((ext_vector_type(4)));
constexpr int BM = 256, BK = 64, HALF = 128, HTB = HALF * BK * 2  , STAGE_BYTES = 8 * HTB, NXCD = 8, WGM = 8;

__host__ __device__ __forceinline__ int lds_byte(int r, int c) { const int st = (r >> 4) * 2 + (c >> 5), rr = r & 15, cc = c & 31, ob = rr * 64 + cc * 2; return st * 1024 + (ob ^ (((ob >> 9) & 1) << 5)); }
__host__ __device__ __forceinline__ void stage_rc(int b, int& R, int& C) { const int st = b / 1024, sb = b % 1024, swz = sb ^ (((sb >> 9) & 1) << 5); R = (st >> 1) * 16 + swz / 64; C = (st & 1) * 32 + (swz % 64) / 2; }
__host__ __device__ __forceinline__ int perm32(int rho) { const int n = rho >> 4, i = rho & 15; return 8 * (i >> 2) + 4 * n + (i & 3); }

struct Unit { int pm, pn; };
struct Gemm { const bf16_t* A; const bf16_t* Bt; int M, N, K; };

struct StaticOrder {
    int nM, nN, nwg, G, c;
    __host__ __device__ void init(int M, int N, int G_, int c_) { nM = M / BM; nN = N / BM; nwg = nM * nN; G = G_; c = c_; }
    __host__ __device__ bool next(int i, Unit& u) const {
        const long L = (long)i * G + c; if (L >= nwg) return false;
        int wgid = (int)L; { const int q = nwg / NXCD, r = nwg % NXCD, xcd = wgid % NXCD, off = wgid / NXCD; wgid = (xcd < r ? xcd * (q + 1) : r * (q + 1) + (xcd - r) * q) + off; }
        const int nig = WGM * nN, gid = wgid / nig, fm = gid * WGM, gsz = (nM - fm) < WGM ? (nM - fm) : WGM;
        u.pm = fm + ((wgid % nig) % gsz); u.pn = (wgid % nig) / gsz; return true;
    }
    __device__ __forceinline__ void a_ready(const Unit&) const {}
    __device__ __forceinline__ void done(const Unit&) const {}
};

__device__ __forceinline__ unsigned cvt_pk_bf16(float lo, float hi) { unsigned r; asm volatile("v_cvt_pk_bf16_f32 %0, %1, %2" : "=v"(r) : "v"(lo), "v"(hi)); return r; }
template <class Epi, class Sched, bool ALIGN_EPI = false, bool SP2 = false>
__device__ __forceinline__ void gemm_phase(PG8_LAS unsigned char* lds, const Gemm g, const Sched& S, const Epi& E) {
    const int tid = threadIdx.x, wid = __builtin_amdgcn_readfirstlane(tid >> 6), lane = tid & 63, wr = wid >> 2, wc = wid & 3, fr = lane & 15, fq = lane >> 4;
    const int K = g.K, nt = K / BK;
    unsigned voffA[2], voffB[2];
#pragma unroll
    for (int i = 0; i < 2; ++i) { int R, C; stage_rc(tid * 16 + i * 8192, R, C); const int Rb = Epi::PERM ? ((R & ~31) + perm32(R & 31)) : R;
        voffA[i] = (unsigned)(R * K + C) * 2u; voffB[i] = (unsigned)(Rb * K + C) * 2u; }
    const size_t kstep = (size_t)(BK * 2);
    const size_t hstep = (size_t)HALF * K * 2;
    const size_t tstep = 2 * hstep;
    const unsigned ldsw = (unsigned)wid * 1024u;
    const int aoff = lds_byte(wr * 64 + fr, fq * 8), boff = lds_byte(wc * 32 + fr, fq * 8);
#define PG8_SA(b, h) (((b) * 2 + (h)) * HTB)
#define PG8_SB(b, h) ((4 + (b) * 2 + (h)) * HTB)
#define PG8_STAGE(bufoff, gbase, voff) do { _Pragma("unroll") for (int _i = 0; _i < 2; ++_i) \
        __builtin_amdgcn_global_load_lds((const unsigned*)((const char*)(gbase) + (voff)[_i]), (PG8_LAS unsigned*)(lds + (bufoff) + ldsw + _i * 8192), 16, 0, 0); } while (0)
#define PG8_LDA(dst, b, h) do { _Pragma("unroll") for (int m = 0; m < 4; ++m) _Pragma("unroll") for (int k = 0; k < 2; ++k) dst[m][k] = *(const PG8_LAS bf16x8*)(lds + PG8_SA(b, h) + aoff + m * 2048 + k * 1024); } while (0)
#define PG8_LDB(dst, b, h) do { _Pragma("unroll") for (int n = 0; n < 2; ++n) _Pragma("unroll") for (int k = 0; k < 2; ++k) dst[n][k] = *(const PG8_LAS bf16x8*)(lds + PG8_SB(b, h) + boff + n * 2048 + k * 1024); } while (0)
#define PG8_MMA(ai, bj, At, Bt) do { __builtin_amdgcn_s_setprio(1); _Pragma("unroll") for (int m = 0; m < 4; ++m) _Pragma("unroll") for (int n = 0; n < 2; ++n) _Pragma("unroll") for (int k = 0; k < 2; ++k) \
        acc[ai][bj][m][n] = __builtin_amdgcn_mfma_f32_16x16x32_bf16(Bt[n][k], At[m][k], acc[ai][bj][m][n], 0, 0, 0); __builtin_amdgcn_s_setprio(0); } while (0)
#define PG8_WAIT_V(n) asm volatile("s_waitcnt vmcnt(" #n ")" ::: "memory")
#define PG8_WAIT_L(n) asm volatile("s_waitcnt lgkmcnt(" #n ")" ::: "memory")
#define PG8_BAR __builtin_amdgcn_s_barrier()
#define PG8_SCHED __builtin_amdgcn_sched_barrier(0)
    Unit cur, nxt; int ui = 0;
    if (!S.next(0, cur)) return;
    f32x4 acc[2][2][4][2];
#pragma unroll
    for (int a = 0; a < 2; ++a)
#pragma unroll
        for (int b = 0; b < 2; ++b)
#pragma unroll
            for (int m = 0; m < 4; ++m)
#pragma unroll
                for (int n = 0; n < 2; ++n) acc[a][b][m][n] = (f32x4){0.f, 0.f, 0.f, 0.f};
    bf16x8 At[4][2], B0[2][2], B1[2][2];
    const char* cA = (const char*)g.A + (size_t)cur.pm * tstep; const char* cB = (const char*)g.Bt + (size_t)cur.pn * tstep;
    S.a_ready(cur);
    if constexpr (SP2) {
        PG8_STAGE(PG8_SB(0, 0), cB, voffB); PG8_STAGE(PG8_SB(0, 1), cB + hstep, voffB); PG8_STAGE(PG8_SA(0, 0), cA, voffA); PG8_STAGE(PG8_SA(0, 1), cA + hstep, voffA);
        if (wr == 1) PG8_BAR;
        PG8_WAIT_V(2); PG8_BAR;
        PG8_STAGE(PG8_SB(1, 0), cB + kstep, voffB); PG8_STAGE(PG8_SA(1, 0), cA + kstep, voffA); PG8_STAGE(PG8_SB(1, 1), cB + hstep + kstep, voffB);
        PG8_WAIT_V(6); PG8_BAR;
    } else {
        PG8_STAGE(PG8_SB(0, 0), cB, voffB); PG8_STAGE(PG8_SA(0, 0), cA, voffA); PG8_STAGE(PG8_SB(0, 1), cB + hstep, voffB); PG8_STAGE(PG8_SA(0, 1), cA + hstep, voffA);
        if (wr == 1) PG8_BAR;
        PG8_WAIT_V(4); PG8_BAR;
        PG8_STAGE(PG8_SB(1, 0), cB + kstep, voffB); PG8_STAGE(PG8_SA(1, 0), cA + kstep, voffA); PG8_STAGE(PG8_SB(1, 1), cB + hstep + kstep, voffB);
        PG8_WAIT_V(6); PG8_BAR;
    }
    for (;;) {
        const bool has_next = S.next(ui + 1, nxt);
        const char* nA = has_next ? (const char*)g.A + (size_t)nxt.pm * tstep : cA; const char* nB = has_next ? (const char*)g.Bt + (size_t)nxt.pn * tstep : cB;
        for (int t = 0; t < nt; t += 2) {
            const bool last = (t == nt - 2);
            const char* a1 = cA + (size_t)(t + 1) * kstep;
            const char* a2 = last ? nA : cA + (size_t)(t + 2) * kstep; const char* b2 = last ? nB : cB + (size_t)(t + 2) * kstep;
            const char* a3 = a2 + kstep; const char* b3 = b2 + kstep;
            if (last && has_next) S.a_ready(nxt);
            if constexpr (SP2) {
            PG8_LDB(B0, 0, 0); PG8_LDB(B1, 0, 1); PG8_SCHED; PG8_LDA(At, 0, 0); PG8_STAGE(PG8_SA(1, 1), a1 + hstep, voffA);
            PG8_WAIT_V(8); PG8_WAIT_L(0); PG8_BAR; PG8_MMA(0, 0, At, B0); PG8_MMA(0, 1, At, B1); PG8_BAR; PG8_SCHED;
            PG8_LDA(At, 0, 1); PG8_STAGE(PG8_SB(0, 0), b2, voffB); PG8_STAGE(PG8_SB(0, 1), b2 + hstep, voffB); PG8_STAGE(PG8_SA(0, 0), a2, voffA);
            PG8_WAIT_V(8); PG8_WAIT_L(0); PG8_BAR; PG8_MMA(1, 0, At, B0); PG8_MMA(1, 1, At, B1); PG8_BAR; PG8_SCHED;
            PG8_LDB(B0, 1, 0); PG8_LDB(B1, 1, 1); PG8_SCHED; PG8_LDA(At, 1, 0); PG8_STAGE(PG8_SA(0, 1), a2 + hstep, voffA);
            PG8_WAIT_V(8); PG8_WAIT_L(0); PG8_BAR; PG8_MMA(0, 0, At, B0); PG8_MMA(0, 1, At, B1); PG8_BAR; PG8_SCHED;
            PG8_LDA(At, 1, 1); PG8_STAGE(PG8_SB(1, 0), b3, voffB); PG8_STAGE(PG8_SB(1, 1), b3 + hstep, voffB); PG8_STAGE(PG8_SA(1, 0), a3, voffA);
            PG8_WAIT_V(8); PG8_WAIT_L(0); PG8_BAR; PG8_MMA(1, 0, At, B0); PG8_MMA(1, 1, At, B1); PG8_BAR; PG8_SCHED;
            } else {
            PG8_LDB(B0, 0, 0); PG8_SCHED; PG8_LDA(At, 0, 0); PG8_STAGE(PG8_SA(1, 1), a1 + hstep, voffA);
            PG8_WAIT_L(8); PG8_BAR; PG8_WAIT_L(0); PG8_MMA(0, 0, At, B0); PG8_BAR; PG8_SCHED;
            PG8_LDB(B1, 0, 1); PG8_STAGE(PG8_SB(0, 0), b2, voffB);
            PG8_BAR; PG8_WAIT_L(0); PG8_MMA(0, 1, At, B1); PG8_BAR;
            PG8_LDA(At, 0, 1); PG8_STAGE(PG8_SA(0, 0), a2, voffA);
            PG8_BAR; PG8_WAIT_L(0); PG8_MMA(1, 0, At, B0); PG8_BAR; PG8_SCHED;
            PG8_STAGE(PG8_SB(0, 1), b2 + hstep, voffB);
            PG8_WAIT_V(6); PG8_BAR; PG8_MMA(1, 1, At, B1); PG8_BAR;
            PG8_LDB(B0, 1, 0); PG8_SCHED; PG8_LDA(At, 1, 0); PG8_STAGE(PG8_SA(0, 1), a2 + hstep, voffA);
            PG8_WAIT_L(8); PG8_BAR; PG8_WAIT_L(0); PG8_MMA(0, 0, At, B0); PG8_BAR; PG8_SCHED;
            PG8_LDB(B1, 1, 1); PG8_STAGE(PG8_SB(1, 0), b3, voffB);
            PG8_BAR; PG8_WAIT_L(0); PG8_MMA(0, 1, At, B1); PG8_BAR;
            PG8_LDA(At, 1, 1); PG8_STAGE(PG8_SA(1, 0), a3, voffA);
            PG8_BAR; PG8_WAIT_L(0); PG8_MMA(1, 0, At, B0); PG8_BAR; PG8_SCHED;
            PG8_STAGE(PG8_SB(1, 1), b3 + hstep, voffB);
            PG8_WAIT_V(6); PG8_BAR; PG8_MMA(1, 1, At, B1); PG8_BAR;
            }
        }
        if constexpr (ALIGN_EPI) { if (wr == 0) PG8_BAR; }
        if constexpr (!Epi::AFTER_DRAIN) { E(acc, cur, wr, wc, fr, fq); S.done(cur); }
        if (!has_next) break;
#pragma unroll
        for (int a = 0; a < 2; ++a)
#pragma unroll
            for (int b = 0; b < 2; ++b)
#pragma unroll
                for (int m = 0; m < 4; ++m)
#pragma unroll
                    for (int n = 0; n < 2; ++n) acc[a][b][m][n] = (f32x4){0.f, 0.f, 0.f, 0.f};
        cur = nxt; cA = nA; cB = nB; ++ui;
        if constexpr (ALIGN_EPI) { if (wr == 1) PG8_BAR; }
    }
    PG8_WAIT_V(0);
    if constexpr (!ALIGN_EPI) { if (wr == 0) PG8_BAR; }
    PG8_BAR;
    if constexpr (Epi::AFTER_DRAIN) { E.fused(acc, cur, wr, wc, fr, fq, lds, wid, lane); S.done(cur); }
#undef PG8_SA
#undef PG8_SB
#undef PG8_STAGE
#undef PG8_LDA
#undef PG8_LDB
#undef PG8_MMA
#undef PG8_WAIT_V
#undef PG8_WAIT_L
#undef PG8_BAR
#undef PG8_SCHED
}
}

#define EPI_V8(v, A, s) float v[8] = {A[0][0] * (s), A[0][1] * (s), A[0][2] * (s), A[0][3] * (s), A[1][0] * (s), A[1][1] * (s), A[1][2] * (s), A[1][3] * (s)}
__device__ __forceinline__ uint4 pk8(const float (&v)[8]) {
  return make_uint4(pg8::cvt_pk_bf16(v[0], v[1]), pg8::cvt_pk_bf16(v[2], v[3]), pg8::cvt_pk_bf16(v[4], v[5]), pg8::cvt_pk_bf16(v[6], v[7]));
}
struct EpiIn {
  static constexpr bool PERM = true, AFTER_DRAIN = false;
  u16* U; u16* QK; const float* RS;
  __device__ __forceinline__ void operator()(const pg8::f32x4 (&acc)[2][2][4][2], const pg8::Unit& u, int wr, int wc, int fr, int fq) const {
    const int row0 = u.pm * 256 + wr * 64 + fr, colt = u.pn * 256, c0 = colt + wc * 32 + 8 * fq;
    const bool isu = colt < 512;
#pragma unroll
    for (int ai = 0; ai < 2; ++ai)
#pragma unroll
      for (int m = 0; m < 4; ++m) {
        const int row = row0 + ai * 128 + m * 16;
        const float r = RS[row];
#pragma unroll
        for (int bj = 0; bj < 2; ++bj) {
          const int col = c0 + bj * 128;
          EPI_V8(v, acc[ai][bj][m], r);
          if (isu) {
#pragma unroll
            for (int j = 0; j < 8; ++j) v[j] = gelu_f(v[j]);
            *(uint4*)(U + (size_t)row * 512 + col) = pk8(v);
          } else {
            *(uint4*)(QK + (size_t)row * 1024 + (col - 512)) = pk8(v);
          }
        }
      }
  }
};
struct EpiInT {
  static constexpr bool PERM = true, AFTER_DRAIN = false;
  u16* GVT; u16* VT; const float* RS; float* VSS;
  __device__ __forceinline__ void operator()(const pg8::f32x4 (&acc)[2][2][4][2], const pg8::Unit& u, int wr, int wc, int fr, int fq) const {
    const int ch0 = u.pm * 256 + wr * 64 + fr, t0 = u.pn * 256 + wc * 32 + 8 * fq;
    const bool isg = u.pm < 2;
#pragma unroll
    for (int bj = 0; bj < 2; ++bj) {
      const int t = t0 + bj * 128, b = t >> 12, s = t & 4095;
      const float4 ra = *(const float4*)(RS + t), rb = *(const float4*)(RS + t + 4);
      const float rr[8] = {ra.x, ra.y, ra.z, ra.w, rb.x, rb.y, rb.z, rb.w};
      float ss[8] = {0.f, 0.f, 0.f, 0.f, 0.f, 0.f, 0.f, 0.f};
#pragma unroll
      for (int ai = 0; ai < 2; ++ai)
#pragma unroll
        for (int m = 0; m < 4; ++m) {
          const int ch = ch0 + ai * 128 + m * 16;
          float v[8];
#pragma unroll
          for (int j = 0; j < 8; ++j) v[j] = acc[ai][bj][m][j >> 2][j & 3] * rr[j];
          if (isg) {
#pragma unroll
            for (int j = 0; j < 8; ++j) { v[j] = gelu_f(v[j]); ss[j] += v[j] * v[j]; }
            *(uint4*)(GVT + ((size_t)b * 512 + ch) * SEQ + s) = pk8(v);
          } else {
            *(uint4*)(VT + ((size_t)b * 512 + (ch - 512)) * SEQ + s) = pk8(v);
          }
        }
      if (isg) {
#pragma unroll
        for (int j = 0; j < 8; ++j) {
          float sv = ss[j];
          sv += __shfl_xor(sv, 1); sv += __shfl_xor(sv, 2); sv += __shfl_xor(sv, 4); sv += __shfl_xor(sv, 8);
          if (fr == 0) atomicAdd(VSS + t + j, sv);
        }
      }
    }
  }
};
struct EpiOut {
  static constexpr bool PERM = true, AFTER_DRAIN = false;
  const float* X; float* OUT; u16* HB;
  __device__ __forceinline__ void operator()(const pg8::f32x4 (&acc)[2][2][4][2], const pg8::Unit& u, int wr, int wc, int fr, int fq) const {
    const int row0 = u.pm * 256 + wr * 64 + fr, c0 = u.pn * 256 + wc * 32 + 8 * fq;
#pragma unroll
    for (int ai = 0; ai < 2; ++ai)
#pragma unroll
      for (int m = 0; m < 4; ++m) {
        const int row = row0 + ai * 128 + m * 16;
#pragma unroll
        for (int bj = 0; bj < 2; ++bj) {
          const size_t idx = (size_t)row * 1024 + c0 + bj * 128;
          const float4 xa = *(const float4*)(X + idx), xb = *(const float4*)(X + idx + 4);
          float v[8] = {xa.x + acc[ai][bj][m][0][0], xa.y + acc[ai][bj][m][0][1], xa.z + acc[ai][bj][m][0][2], xa.w + acc[ai][bj][m][0][3],
                        xb.x + acc[ai][bj][m][1][0], xb.y + acc[ai][bj][m][1][1], xb.z + acc[ai][bj][m][1][2], xb.w + acc[ai][bj][m][1][3]};
          *(float4*)(OUT + idx) = make_float4(v[0], v[1], v[2], v[3]);
          *(float4*)(OUT + idx + 4) = make_float4(v[4], v[5], v[6], v[7]);
          *(uint4*)(HB + idx) = pk8(v);
        }
      }
  }
};
struct EpiQ {
  static constexpr bool PERM = true, AFTER_DRAIN = false;
  u16* PQ;
  __device__ __forceinline__ void operator()(const pg8::f32x4 (&acc)[2][2][4][2], const pg8::Unit& u, int wr, int wc, int fr, int fq) const {
    const int row0 = u.pm * 256 + wr * 64 + fr, c0 = u.pn * 256 + wc * 32 + 8 * fq;
#pragma unroll
    for (int ai = 0; ai < 2; ++ai)
#pragma unroll
      for (int m = 0; m < 4; ++m) {
        const int row = row0 + ai * 128 + m * 16;
#pragma unroll
        for (int bj = 0; bj < 2; ++bj) {
          EPI_V8(v, acc[ai][bj][m], 1.f);
          *(uint4*)(PQ + (size_t)row * 2048 + c0 + bj * 128) = pk8(v);
        }
      }
  }
};
#define LDS3(p) ((__attribute__((address_space(3))) unsigned char*)(p))

__device__ __forceinline__ void phase0(const Params& p, char* lds) {
  const int tid = tid_(), lane = tid & 63, wave = tid >> 6;
  const int nblk = gridDim.x, blk = bid_();
  u16* XB = (u16*)(p.ws + OFF_XB);
  float* RS = (float*)(p.ws + OFF_RS);
  float* VSS = (float*)(p.ws + OFF_VSS);
  for (int row = blk * NWAVE + wave; row < T; row += nblk * NWAVE) {
    const float4* xr = (const float4*)(p.x + (size_t)row * DM);
    float4 v[4];
    float ss = 0.f;
#pragma unroll
    for (int i = 0; i < 4; ++i) {
      v[i] = xr[lane + 64 * i];
      ss += v[i].x * v[i].x + v[i].y * v[i].y + v[i].z * v[i].z + v[i].w * v[i].w;
    }
#pragma unroll
    for (int o = 1; o < 64; o <<= 1) ss += __shfl_xor(ss, o);
    if (lane == 0) RS[row] = rsqrtf(ss * (1.f / 1024.f) + EPS);
#pragma unroll
    for (int i = 0; i < 4; ++i) {
      uint2 o2 = make_uint2(pack2(v[i].x, v[i].y), pack2(v[i].z, v[i].w));
      *(uint2*)(XB + (size_t)row * DM + (lane + 64 * i) * 4) = o2;
    }
  }
  {
    unsigned char* EU8 = (unsigned char*)(p.ws + OFF_EU);
    unsigned char* EV8 = (unsigned char*)(p.ws + OFF_EV);
    float* ESC = (float*)(p.ws + OFF_ESC);
    for (int row = blk * NWAVE + wave; row < 32768; row += nblk * NWAVE) {
      const bool isv = row >= 16384;
      const int e = row & 16383;
      const float4* src = (const float4*)((isv ? p.peer_v : p.peer_u) + (size_t)e * 1024);
      float4 v[4];
      float am = 0.f;
#pragma unroll
      for (int i = 0; i < 4; ++i) {
        v[i] = src[i * 64 + lane];
        if (!isv) {
          const float4 g4 = ((const float4*)p.ln_ffn_g)[i * 64 + lane];
          v[i].x *= g4.x; v[i].y *= g4.y; v[i].z *= g4.z; v[i].w *= g4.w;
        }
        am = fmaxf(am, fmaxf(fmaxf(fabsf(v[i].x), fabsf(v[i].y)), fmaxf(fabsf(v[i].z), fabsf(v[i].w))));
      }
#pragma unroll
      for (int o = 1; o < 64; o <<= 1) am = fmaxf(am, __shfl_xor(am, o));
      const int ex = (int)((__float_as_uint(am) >> 23) & 255u) - 127;
      const bool ok = (am > 1e-30f);
      const float scale = ok ? __uint_as_float((unsigned)(127 + 7 - ex) << 23) : 1.f;
      const float inv = ok ? __uint_as_float((unsigned)(127 - 7 + ex) << 23) : 1.f;
      unsigned char* dst = (isv ? EV8 : EU8) + (size_t)e * 128;
#pragma unroll
      for (int i = 0; i < 4; ++i) {
        const int d = i * 256 + lane * 4;
        *(unsigned*)(dst + (size_t)(d >> 7) * (2 * MiB) + (d & 127)) = pack4_fp8(v[i].x * scale, v[i].y * scale, v[i].z * scale, v[i].w * scale);
      }
      if (lane == 0) ESC[row] = inv;
    }
  }
  {
    const int half = wave >> 2, w4 = wave & 3;
    float* tile = (float*)lds + half * (64 * 65);
    for (int tp = blk; tp < 704; tp += nblk) {
      const int tl = tp * 2 + half;
      const float* W; const float* gain; u16* dst; int N, kt, nt, drow;
      if (tl < 640) {
        W = p.w_in; gain = p.ln_mix_g; N = 2560; kt = tl / 40; nt = tl % 40;
        const int n0 = nt * 64;
        if (n0 < 512) { dst = (u16*)(p.ws + OFF_WINT); drow = n0; }
        else if (n0 < 1024) { dst = (u16*)(p.ws + OFF_WB); drow = n0 - 512; }
        else if (n0 < 2048) { dst = (u16*)(p.ws + OFF_WINT); drow = n0 - 512; }
        else { dst = (u16*)(p.ws + OFF_WB); drow = n0 - 2048 + 512; }
      } else if (tl < 896) { int t2 = tl - 640; W = p.w_out; gain = nullptr; dst = (u16*)(p.ws + OFF_WOUTT); N = 1024; kt = t2 / 16; nt = t2 % 16; drow = nt * 64; }
      else { int t2 = tl - 896; W = p.w_query; gain = p.ln_ffn_g; dst = (u16*)(p.ws + OFF_WQT); N = 2048; kt = t2 / 32; nt = t2 % 32; drow = nt * 64; }
      __syncthreads();
#pragma unroll 4
      for (int i = 0; i < 16; ++i) {
        const int kk = i * 4 + w4;
        const float gk = gain ? gain[kt * 64 + kk] : 1.f;
        tile[kk * 65 + lane] = W[(size_t)(kt * 64 + kk) * N + nt * 64 + lane] * gk;
      }
      __syncthreads();
#pragma unroll 4
      for (int i = 0; i < 16; ++i) {
        const int nn = i * 4 + w4;
        dst[(size_t)(drow + nn) * 1024 + kt * 64 + lane] = f2bf(tile[lane * 65 + nn]);
      }
    }
    __syncthreads();
  }
  {
    u16* KEYS = (u16*)(p.ws + OFF_KEYS);
    for (int i = blk * NTHR + tid; i < 262144 / 4; i += nblk * NTHR) {
      float4 a = ((const float4*)p.sub_keys)[i];
      *(uint2*)(KEYS + (size_t)i * 4) = make_uint2(pack2(a.x, a.y), pack2(a.z, a.w));
    }
  }
  for (int i = blk * NTHR + tid; i < T; i += nblk * NTHR) VSS[i] = 0.f;
  if (blk == 0 && tid < 16) ((unsigned*)(p.ws + OFF_BAR))[tid * 64] = 0u;
}

__device__ __forceinline__ void phase1(const Params& p, char* lds) {
  const u16* XB = (const u16*)(p.ws + OFF_XB);
  const float* RS = (const float*)(p.ws + OFF_RS);
  {
    pg8::Gemm g{XB, (const u16*)(p.ws + OFF_WINT), T, 1536, 1024};
    pg8::StaticOrder S; S.init(T, 1536, (int)gridDim.x, (int)blockIdx.x);
    EpiIn E{(u16*)(p.ws + OFF_U), (u16*)(p.ws + OFF_QK), RS};
    pg8::gemm_phase<EpiIn, pg8::StaticOrder, true, true>(LDS3(lds), g, S, E);
  }
  {
    pg8::Gemm g{(const u16*)(p.ws + OFF_WB), XB, 1024, T, 1024};
    pg8::StaticOrder S; S.init(1024, T, (int)gridDim.x, (int)blockIdx.x);
    EpiInT E{(u16*)(p.ws + OFF_GVT), (u16*)(p.ws + OFF_VT), RS, (float*)(p.ws + OFF_VSS)};
    pg8::gemm_phase<EpiInT, pg8::StaticOrder, true, true>(LDS3(lds), g, S, E);
  }
}

__device__ __forceinline__ void gmlp_item(const Params& p, int item) {
  const int tid = tid_() & 255, lane = tid & 63, wave = tid >> 6, l15 = lane & 15, g = lane >> 4;
  const int gr = item & 7, n = (item >> 3) & 31, b = item >> 8;
  const int t0 = b * SEQ + n * 128;
  const float* VSS = (const float*)(p.ws + OFF_VSS);
  const u16* GVT = (const u16*)(p.ws + OFF_GVT);
  const u16* U = (const u16*)(p.ws + OFF_U);
  u16* AB = (u16*)(p.ws + OFF_AB);
  f32x4 acc[2][4];
#pragma unroll
  for (int i = 0; i < 2; ++i)
#pragma unroll
    for (int j = 0; j < 4; ++j) acc[i][j] = f32x4{0.f, 0.f, 0.f, 0.f};
  const int i_base = wave * 32;
  const bool low = wave < 2;
#pragma unroll
  for (int ks = 0; ks < 4; ++ks) {
    if (ks >= 2 && low) continue;
    const int j0 = ks * 32 + g * 8;
    const float4 s0 = *(const float4*)(VSS + t0 + j0), s1 = *(const float4*)(VSS + t0 + j0 + 4);
    float r[8] = {s0.x, s0.y, s0.z, s0.w, s1.x, s1.y, s1.z, s1.w};
#pragma unroll
    for (int q = 0; q < 8; ++q) r[q] = rsqrtf(r[q] * (1.f / 512.f) + EPS);
    bf16x8 wf[2];
#pragma unroll
    for (int mi = 0; mi < 2; ++mi) {
      const int i = i_base + mi * 16 + l15;
      const float* wp = p.gmlp_w_s + ((size_t)(gr * 128 + i)) * 128 + j0;
      const float4 w0 = *(const float4*)wp, w1 = *(const float4*)(wp + 4);
      wf[mi] = mk8(pack2(w0.x * r[0], w0.y * r[1]), pack2(w0.z * r[2], w0.w * r[3]), pack2(w1.x * r[4], w1.y * r[5]),
                   pack2(w1.z * r[6], w1.w * r[7]));
    }
#pragma unroll
    for (int ni = 0; ni < 4; ++ni) {
      const int c = ni * 16 + l15;
      const bf16x8 gf = *(const bf16x8*)(GVT + ((size_t)b * 512 + gr * 64 + c) * SEQ + n * 128 + j0);
#pragma unroll
      for (int mi = 0; mi < 2; ++mi) acc[mi][ni] = mfma16(gf, wf[mi], acc[mi][ni]);
    }
  }
#pragma unroll
  for (int mi = 0; mi < 2; ++mi) {
    const int i = i_base + mi * 16 + l15;
    const size_t t = (size_t)t0 + i;
    const float bs = p.gmlp_b_s[gr * 128 + i];
#pragma unroll
    for (int ni = 0; ni < 4; ++ni) {
      const int ch = gr * 64 + ni * 16 + g * 4;
      const float4 ng = *(const float4*)(p.gmlp_norm_g + ch);
      const uint2 uu = *(const uint2*)(U + t * 512 + ch);
      const float o0 = bf_lo(uu.x) * (acc[mi][ni][0] * ng.x + bs), o1 = bf_hi(uu.x) * (acc[mi][ni][1] * ng.y + bs);
      const float o2 = bf_lo(uu.y) * (acc[mi][ni][2] * ng.z + bs), o3 = bf_hi(uu.y) * (acc[mi][ni][3] * ng.w + bs);
      *(uint2*)(AB + t * 1024 + ch) = make_uint2(pack2(o0, o1), pack2(o2, o3));
    }
  }
}

constexpr int ATT_BUF = 2 * 64 * LSTR + 256;
constexpr float LOG2E = 1.4426950408889634f;
__device__ __forceinline__ void attn_item(const Params& p, int item, char* lds) {
  const int tid = tid_() & 255, lane = tid & 63, wave = tid >> 6, l15 = lane & 15, g = lane >> 4;
  const int c = item & 63, h = (item >> 6) & 7, b = item >> 9;
  const u16* QK = (const u16*)(p.ws + OFF_QK);
  const u16* VT = (const u16*)(p.ws + OFF_VT);
  u16* AB = (u16*)(p.ws + OFF_AB);
  float* bias_s = (float*)(lds + 2 * ATT_BUF);
  __syncthreads();
  for (int i = tid; i < 257; i += 256) bias_s[i] = p.rel_bias[h * 257 + i] * LOG2E;
  const size_t tq = (size_t)b * SEQ + c * 64 + wave * 16 + l15;
  bf16x8 qb0, qb1;
  {
    const u16* qp = QK + tq * 1024 + h * 64 + g * 8;
    const uint4 q0 = *(const uint4*)qp, q1 = *(const uint4*)(qp + 32);
    float f[16] = {bf_lo(q0.x), bf_hi(q0.x), bf_lo(q0.y), bf_hi(q0.y), bf_lo(q0.z), bf_hi(q0.z), bf_lo(q0.w), bf_hi(q0.w),
                   bf_lo(q1.x), bf_hi(q1.x), bf_lo(q1.y), bf_hi(q1.y), bf_lo(q1.z), bf_hi(q1.z), bf_lo(q1.w), bf_hi(q1.w)};
    float ss = 0.f;
#pragma unroll
    for (int i = 0; i < 16; ++i) ss += f[i] * f[i];
    ss += __shfl_xor(ss, 16); ss += __shfl_xor(ss, 32);
    const float rq = rsqrtf(ss * (1.f / 64.f) + EPS) * (0.125f * LOG2E);
    const float4 ga = *(const float4*)(p.q_norm_g + g * 8), gb = *(const float4*)(p.q_norm_g + g * 8 + 4);
    const float4 gc = *(const float4*)(p.q_norm_g + 32 + g * 8), gd = *(const float4*)(p.q_norm_g + 32 + g * 8 + 4);
    const float4 ka = *(const float4*)(p.k_norm_g + g * 8), kb = *(const float4*)(p.k_norm_g + g * 8 + 4);
    const float4 kc4 = *(const float4*)(p.k_norm_g + 32 + g * 8), kd = *(const float4*)(p.k_norm_g + 32 + g * 8 + 4);
    const float gg[16] = {ga.x * ka.x, ga.y * ka.y, ga.z * ka.z, ga.w * ka.w, gb.x * kb.x, gb.y * kb.y, gb.z * kb.z, gb.w * kb.w,
                          gc.x * kc4.x, gc.y * kc4.y, gc.z * kc4.z, gc.w * kc4.w, gd.x * kd.x, gd.y * kd.y, gd.z * kd.z, gd.w * kd.w};
#pragma unroll
    for (int i = 0; i < 16; ++i) f[i] *= rq * gg[i];
    qb0 = mk8(pg8::cvt_pk_bf16(f[0], f[1]), pg8::cvt_pk_bf16(f[2], f[3]), pg8::cvt_pk_bf16(f[4], f[5]), pg8::cvt_pk_bf16(f[6], f[7]));
    qb1 = mk8(pg8::cvt_pk_bf16(f[8], f[9]), pg8::cvt_pk_bf16(f[10], f[11]), pg8::cvt_pk_bf16(f[12], f[13]), pg8::cvt_pk_bf16(f[14], f[15]));
  }
  f32x4 o[4];
#pragma unroll
  for (int i = 0; i < 4; ++i) o[i] = f32x4{0.f, 0.f, 0.f, 0.f};
  float m_run = -1e30f, l_run = 0.f;
  const int srow = tid >> 2, spart = tid & 3;
  const int kc_lo = (c >= 8) ? 0 : (8 - c);
  const u16* kbase = QK + ((size_t)b * SEQ + srow) * 1024 + 512 + h * 64 + spart * 16;
  const u16* vbase = VT + ((size_t)b * 512 + h * 64 + srow) * SEQ + spart * 16;
  uint4 k0, k1, v0, v1;
  {
    const int kchunk = c - 8 + kc_lo;
    const u16* kp = kbase + (size_t)kchunk * 64 * 1024;
    k0 = *(const uint4*)kp; k1 = *(const uint4*)(kp + 8);
    const u16* vp = vbase + kchunk * 64;
    v0 = *(const uint4*)vp; v1 = *(const uint4*)(vp + 8);
  }
  for (int kc = kc_lo; kc <= 8; ++kc) {
    char* Ks = lds + ((kc - kc_lo) & 1) * ATT_BUF;
    char* Vs = Ks + 64 * LSTR;
    float* rks = (float*)(Ks + 2 * 64 * LSTR);
    {
      float ss = 0.f;
      ss = dot2(k0.x, k0.x, ss); ss = dot2(k0.y, k0.y, ss); ss = dot2(k0.z, k0.z, ss); ss = dot2(k0.w, k0.w, ss);
      ss = dot2(k1.x, k1.x, ss); ss = dot2(k1.y, k1.y, ss); ss = dot2(k1.z, k1.z, ss); ss = dot2(k1.w, k1.w, ss);
      ss += __shfl_xor(ss, 1); ss += __shfl_xor(ss, 2);
      if (spart == 0) rks[srow] = rsqrtf(ss * (1.f / 64.f) + EPS);
      char* kd = Ks + srow * LSTR + spart * 32;
      *(uint4*)kd = k0;
      *(uint4*)(kd + 16) = k1;
      char* vd = Vs + srow * LSTR + spart * 32;
      *(uint4*)vd = v0;
      *(uint4*)(vd + 16) = v1;
    }
    __syncthreads();
    if (kc < 8) {
      const int kchunk = c - 8 + kc + 1;
      const u16* kp = kbase + (size_t)kchunk * 64 * 1024;
      k0 = *(const uint4*)kp; k1 = *(const uint4*)(kp + 8);
      const u16* vp = vbase + kchunk * 64;
      v0 = *(const uint4*)vp; v1 = *(const uint4*)(vp + 8);
    }
    f32x4 s[4];
#pragma unroll
    for (int mt = 0; mt < 4; ++mt) {
      const char* kr = Ks + (mt * 16 + l15) * LSTR + g * 16;
      const bf16x8 a0 = *(const bf16x8*)kr, a1 = *(const bf16x8*)(kr + 64);
      s[mt] = mfma16(a0, qb0, f32x4{0.f, 0.f, 0.f, 0.f});
      s[mt] = mfma16(a1, qb1, s[mt]);
    }
    if (kc <= 5) {
      const float bc = bias_s[256];
#pragma unroll
      for (int mt = 0; mt < 4; ++mt) {
        const float4 rk4 = *(const float4*)(rks + mt * 16 + g * 4);
        s[mt][0] = s[mt][0] * rk4.x + bc; s[mt][1] = s[mt][1] * rk4.y + bc;
        s[mt][2] = s[mt][2] * rk4.z + bc; s[mt][3] = s[mt][3] * rk4.w + bc;
      }
    } else {
      const int qi = wave * 16 + l15 + 64 * (8 - kc);
#pragma unroll
      for (int mt = 0; mt < 4; ++mt) {
        const float4 rk4 = *(const float4*)(rks + mt * 16 + g * 4);
        const float rr[4] = {rk4.x, rk4.y, rk4.z, rk4.w};
#pragma unroll
        for (int j = 0; j < 4; ++j) {
          int rel = qi - (mt * 16 + g * 4 + j);
          rel = rel > 128 ? 128 : rel;
          s[mt][j] = s[mt][j] * rr[j] + bias_s[rel + 128];
        }
      }
    }
    float mx = s[0][0];
#pragma unroll
    for (int mt = 0; mt < 4; ++mt)
#pragma unroll
      for (int j = 0; j < 4; ++j) mx = fmaxf(mx, s[mt][j]);
    mx = fmaxf(mx, __shfl_xor(mx, 16));
    mx = fmaxf(mx, __shfl_xor(mx, 32));
    const float m_new = fmaxf(m_run, mx);
    const float alpha = __builtin_amdgcn_exp2f(m_run - m_new);
    m_run = m_new;
    float ls = 0.f;
#pragma unroll
    for (int mt = 0; mt < 4; ++mt)
#pragma unroll
      for (int j = 0; j < 4; ++j) { s[mt][j] = __builtin_amdgcn_exp2f(s[mt][j] - m_new); ls += s[mt][j]; }
    l_run = l_run * alpha + ls;
#pragma unroll
    for (int mt = 0; mt < 4; ++mt)
#pragma unroll
      for (int j = 0; j < 4; ++j) o[mt][j] *= alpha;
#pragma unroll
    for (int k2 = 0; k2 < 2; ++k2) {
      const bf16x8 pb = mk8(pg8::cvt_pk_bf16(s[2 * k2][0], s[2 * k2][1]), pg8::cvt_pk_bf16(s[2 * k2][2], s[2 * k2][3]),
                            pg8::cvt_pk_bf16(s[2 * k2 + 1][0], s[2 * k2 + 1][1]), pg8::cvt_pk_bf16(s[2 * k2 + 1][2], s[2 * k2 + 1][3]));
#pragma unroll
      for (int mt = 0; mt < 4; ++mt) {
        const char* vr = Vs + (mt * 16 + l15) * LSTR + (32 * k2 + 4 * g) * 2;
        const uint2 va = *(const uint2*)vr, vb = *(const uint2*)(vr + 32);
        o[mt] = mfma16(mk8(va.x, va.y, vb.x, vb.y), pb, o[mt]);
      }
    }
  }
  float l = l_run;
  l += __shfl_xor(l, 16); l += __shfl_xor(l, 32);
  const float inv = 1.f / l;
#pragma unroll
  for (int mt = 0; mt < 4; ++mt) {
    *(uint2*)(AB + tq * 1024 + 512 + h * 64 + mt * 16 + g * 4) =
        make_uint2(pg8::cvt_pk_bf16(o[mt][0] * inv, o[mt][1] * inv), pg8::cvt_pk_bf16(o[mt][2] * inv, o[mt][3] * inv));
  }
}

__device__ __forceinline__ void phase2(const Params& p, char* lds) {
  const int sub = tid_() >> 8;
  for (int it = bid_(); it < 2048 + 1024; it += gridDim.x) {
    if (it < 2048) {
      const int b = it >> 8, hp = (it >> 6) & 3, c = ((it & 63) + 8 * b) & 63;
      attn_item(p, (b << 9) | ((hp * 2 + sub) << 6) | c, lds + sub * 38912);
    } else {
      gmlp_item(p, (it - 2048) * 2 + sub);
    }
  }
}

__device__ __forceinline__ void phase3(const Params& p, char* lds) {
  pg8::Gemm g{(const u16*)(p.ws + OFF_AB), (const u16*)(p.ws + OFF_WOUTT), T, 1024, 1024};
  pg8::StaticOrder S; S.init(T, 1024, (int)gridDim.x, (int)blockIdx.x);
  EpiOut E{p.x, p.out, (u16*)(p.ws + OFF_HB)};
  pg8::gemm_phase<EpiOut, pg8::StaticOrder, true, true>(LDS3(lds), g, S, E);
}
__device__ __forceinline__ void phase4(const Params& p, char* lds) {
  pg8::Gemm g{(const u16*)(p.ws + OFF_HB), (const u16*)(p.ws + OFF_WQT), T, 2048, 1024};
  pg8::StaticOrder S; S.init(T, 2048, (int)gridDim.x, (int)blockIdx.x);
  EpiQ E{(u16*)(p.ws + OFF_PQ)};
  pg8::gemm_phase<EpiQ, pg8::StaticOrder, true, true>(LDS3(lds), g, S, E);
}

__device__ __forceinline__ void sort16_desc(unsigned (&v)[16]) {
#pragma unroll
  for (int k = 2; k <= 16; k <<= 1)
#pragma unroll
    for (int j = k >> 1; j > 0; j >>= 1)
#pragma unroll
      for (int i = 0; i < 16; ++i) {
        const int l = i ^ j;
        if (l > i) {
          const unsigned hi = max(v[i], v[l]), lo = min(v[i], v[l]);
          if ((i & k) == 0) { v[i] = hi; v[l] = lo; } else { v[i] = lo; v[l] = hi; }
        }
      }
}
__device__ __forceinline__ void merge16_desc(unsigned (&a)[16], const unsigned (&b)[16]) {
#pragma unroll
  for (int i = 0; i < 16; ++i) a[i] = max(a[i], b[15 - i]);
#pragma unroll
  for (int j = 8; j > 0; j >>= 1)
#pragma unroll
    for (int i = 0; i < 16; ++i) {
      const int l = i ^ j;
      if (l > i) { const unsigned hi = max(a[i], a[l]), lo = min(a[i], a[l]); a[i] = hi; a[l] = lo; }
    }
}
constexpr int SC_STR = 385, LSTR17 = 17;
constexpr int P5_LV = 64 * SC_STR, P5_LI = P5_LV + 128 * LSTR17, P5_TAB = P5_LI + 128 * LSTR17;

__device__ __forceinline__ void select_item(const Params& p, int item, int next_item, char* lds, const bf16x8 (&kf)[8][4], bf16x8 (&qf)[4]) {
  const int tid = tid_(), lane = tid & 63, wave = tid >> 6, l15 = lane & 15, g = lane >> 4;
  const int h = item & 7, t0 = (item >> 3) * 64;
  const u16* PQ = (const u16*)(p.ws + OFF_PQ);
  int* EIDX = (int*)(p.ws + OFF_EIDX);
  float* BEST = (float*)(p.ws + OFF_BEST);
  float* sc = (float*)lds;
  float* LV = sc + P5_LV;
  int* LI = (int*)lds + P5_LI;
  const int* tab = (const int*)lds + P5_TAB;
  __syncthreads();
  {
    const int pp = wave >> 2, wq = wave & 3;
#pragma unroll
    for (int nt = 0; nt < 8; ++nt) {
      f32x4 a = f32x4{0.f, 0.f, 0.f, 0.f};
#pragma unroll
      for (int ks = 0; ks < 4; ++ks) a = mfma16(qf[ks], kf[nt][ks], a);
#pragma unroll
      for (int j = 0; j < 4; ++j) sc[(wq * 16 + g * 4 + j) * SC_STR + pp * 192 + (nt >> 1) * 48 + (nt & 1) * 16 + l15] = a[j];
    }
    if (next_item < 512 * 8) {
      const u16* qp = PQ + (size_t)((next_item >> 3) * 64 + wq * 16 + l15) * 2048 + (next_item & 7) * 256 + pp * 128 + g * 8;
#pragma unroll
      for (int ks = 0; ks < 4; ++ks) qf[ks] = *(const bf16x8*)(qp + ks * 32);
    }
  }
  __syncthreads();
  {
    const int q = tid & 3, list = tid >> 2, row = list & 63, pp = list >> 6;
    const float* rowp = sc + row * SC_STR + pp * 192;
    const float* src = rowp + q * 48;
    unsigned A[16], B[16];
#pragma unroll
    for (int j = 0; j < 16; ++j) {
      A[j] = (okey(src[j]) & ~127u) | (unsigned)(127 - (q * 32 + j));
      B[j] = (okey(src[16 + j]) & ~127u) | (unsigned)(127 - (q * 32 + 16 + j));
    }
    sort16_desc(A);
    sort16_desc(B);
    merge16_desc(A, B);
#pragma unroll
    for (int i = 0; i < 16; ++i) B[i] = (unsigned)__shfl_xor((int)A[i], 1);
    merge16_desc(A, B);
#pragma unroll
    for (int i = 0; i < 16; ++i) B[i] = (unsigned)__shfl_xor((int)A[i], 2);
    merge16_desc(A, B);
#pragma unroll
    for (int r = 0; r < 16; ++r) {
      if ((r & 3) == q) {
        const int idx = 127 - (int)(A[r] & 127u);
        LV[list * LSTR17 + r] = rowp[(idx >> 5) * 48 + (idx & 31)];
        LI[list * LSTR17 + r] = idx;
      }
    }
  }
  __syncthreads();
  if (tid < 256) {
    const int grp = tid & 3, row = tid >> 2;
    const float* v0 = LV + row * LSTR17;
    const float* v1 = LV + (64 + row) * LSTR17;
    unsigned A[16], B[16];
#pragma unroll
    for (int j = 0; j < 16; ++j) {
      const int code = tab[grp * 16 + j];
      const int cc = code & 255;
      const float s = v0[cc >> 4] + v1[cc & 15];
      A[j] = (code < 0) ? 0u : ((okey(s) & ~255u) | (unsigned)(255 - cc));
    }
    sort16_desc(A);
#pragma unroll
    for (int i = 0; i < 16; ++i) B[i] = (unsigned)__shfl_xor((int)A[i], 1);
    merge16_desc(A, B);
#pragma unroll
    for (int i = 0; i < 16; ++i) B[i] = (unsigned)__shfl_xor((int)A[i], 2);
    merge16_desc(A, B);
    const size_t ob = ((size_t)(t0 + row) * 8 + h) * 16 + grp * 4;
    const int* i0 = LI + row * LSTR17;
    const int* i1 = LI + (64 + row) * LSTR17;
    int e4[4];
    float b4[4];
#pragma unroll
    for (int j = 0; j < 4; ++j) {
      const unsigned sel = (grp == 0) ? A[j] : (grp == 1) ? A[4 + j] : (grp == 2) ? A[8 + j] : A[12 + j];
      const int cc = 255 - (int)(sel & 255u);
      const int a = cc >> 4, bq = cc & 15;
      e4[j] = i0[a] * 128 + i1[bq];
      b4[j] = v0[a] + v1[bq];
    }
    *(int4*)(EIDX + ob) = make_int4(e4[0], e4[1], e4[2], e4[3]);
    *(float4*)(BEST + ob) = make_float4(b4[0], b4[1], b4[2], b4[3]);
  }
}

__device__ __forceinline__ void phase5(const Params& p, char* lds) {
  {
    const int i = tid_();
    if (i < 64) {
      const int grp = i >> 4, j = i & 15;
      int code = -1;
      if (grp == 0) code = j;
      else if (grp == 1) { if (j < 8) code = 16 + j; else if (j < 13) code = 32 + (j - 8); }
      else if (grp == 2) { if (j < 4) code = 48 + j; else if (j < 7) code = 64 + (j - 4); else if (j < 9) code = 80 + (j - 7); else if (j < 11) code = 96 + (j - 9); else if (j < 13) code = 112 + (j - 11); }
      else { if (j < 8) code = (8 + j) * 16; }
      ((int*)lds)[P5_TAB + i] = code;
    }
  }
  const int tid = tid_(), lane = tid & 63, wave = tid >> 6, l15 = lane & 15, g = lane >> 4;
  const int pp = wave >> 2, wq = wave & 3;
  int it = bid_();
  if (it >= 512 * 8) return;
  const bool fixed_head = (gridDim.x & 7) == 0;
  bf16x8 kf[8][4];
  bf16x8 qf[4];
  {
    const u16* KEYS = (const u16*)(p.ws + OFF_KEYS);
#pragma unroll
    for (int nt = 0; nt < 8; ++nt) {
      const u16* kp = KEYS + ((size_t)(((it & 7) * 2 + pp) * 128 + nt * 16 + l15)) * 128 + g * 8;
#pragma unroll
      for (int ks = 0; ks < 4; ++ks) kf[nt][ks] = *(const bf16x8*)(kp + ks * 32);
    }
    const u16* qp = (const u16*)(p.ws + OFF_PQ) + (size_t)((it >> 3) * 64 + wq * 16 + l15) * 2048 + (it & 7) * 256 + pp * 128 + g * 8;
#pragma unroll
    for (int ks = 0; ks < 4; ++ks) qf[ks] = *(const bf16x8*)(qp + ks * 32);
  }
  for (; it < 512 * 8; it += gridDim.x) {
    if (!fixed_head) {
      const u16* KEYS = (const u16*)(p.ws + OFF_KEYS);
#pragma unroll
      for (int nt = 0; nt < 8; ++nt) {
        const u16* kp = KEYS + ((size_t)(((it & 7) * 2 + pp) * 128 + nt * 16 + l15)) * 128 + g * 8;
#pragma unroll
        for (int ks = 0; ks < 4; ++ks) kf[nt][ks] = *(const bf16x8*)(kp + ks * 32);
      }
    }
    select_item(p, it, it + (int)gridDim.x, lds, kf, qf);
  }
}

#define CVT_LO(w) __builtin_amdgcn_cvt_pk_f32_fp8((int)(w), false)
#define CVT_HI(w) __builtin_amdgcn_cvt_pk_f32_fp8((int)(w), true)
__device__ __forceinline__ void phase6(const Params& p, char* lds) {
  const int tid = tid_(), lane = tid & 63, wave = tid >> 6, l15 = lane & 15, g = lane >> 4;
  const u16* HB = (const u16*)(p.ws + OFF_HB);
  const unsigned char* EU8 = (const unsigned char*)(p.ws + OFF_EU);
  const unsigned char* EV8 = (const unsigned char*)(p.ws + OFF_EV);
  const float* ESC = (const float*)(p.ws + OFF_ESC);
  const int* EIDX = (const int*)(p.ws + OFF_EIDX);
  const float* BEST = (const float*)(p.ws + OFF_BEST);
  float* wl = (float*)lds + wave * 128;
  for (int t = bid_() * NWAVE + wave; t < T; t += gridDim.x * NWAVE) {
    f32x2 hf[32];
    {
      const u16* hrow = HB + (size_t)t * 1024 + l15 * 16;
#pragma unroll
      for (int i = 0; i < 4; ++i) {
        const uint4 a = *(const uint4*)(hrow + i * 256), b = *(const uint4*)(hrow + i * 256 + 8);
        hf[i * 8 + 0] = f32x2{bf_lo(a.x), bf_hi(a.x)}; hf[i * 8 + 1] = f32x2{bf_lo(a.y), bf_hi(a.y)};
        hf[i * 8 + 2] = f32x2{bf_lo(a.z), bf_hi(a.z)}; hf[i * 8 + 3] = f32x2{bf_lo(a.w), bf_hi(a.w)};
        hf[i * 8 + 4] = f32x2{bf_lo(b.x), bf_hi(b.x)}; hf[i * 8 + 5] = f32x2{bf_lo(b.y), bf_hi(b.y)};
        hf[i * 8 + 6] = f32x2{bf_lo(b.z), bf_hi(b.z)}; hf[i * 8 + 7] = f32x2{bf_lo(b.w), bf_hi(b.w)};
      }
    }
    float ss;
    {
      f32x2 s2 = f32x2{0.f, 0.f};
#pragma unroll
      for (int i = 0; i < 32; ++i) s2 = __builtin_elementwise_fma(hf[i], hf[i], s2);
      ss = s2.x + s2.y;
    }
    ss += __shfl_xor(ss, 1); ss += __shfl_xor(ss, 2); ss += __shfl_xor(ss, 4); ss += __shfl_xor(ss, 8);
    const float rs2 = rsqrtf(ss * (1.f / 1024.f) + EPS);
    const int ea = EIDX[(size_t)t * 128 + lane], eb = EIDX[(size_t)t * 128 + 64 + lane];
    float ga, gb;
    {
      const float ba = BEST[(size_t)t * 128 + lane] * rs2, bb = BEST[(size_t)t * 128 + 64 + lane] * rs2;
      float ma = ba, mb = bb;
#pragma unroll
      for (int o = 1; o < 16; o <<= 1) { ma = fmaxf(ma, __shfl_xor(ma, o)); mb = fmaxf(mb, __shfl_xor(mb, o)); }
      const float xa = __expf(ba - ma), xb = __expf(bb - mb);
      float sa = xa, sb = xb;
#pragma unroll
      for (int o = 1; o < 16; o <<= 1) { sa += __shfl_xor(sa, o); sb += __shfl_xor(sb, o); }
      ga = xa / sa; gb = xb / sb;
    }
#pragma unroll 2
    for (int it = 0; it < 32; ++it) {
      const int k = it * 4 + g;
      const int e = __shfl((it < 16) ? ea : eb, k & 63);
      const float gk = __shfl((it < 16) ? ga : gb, k & 63);
      const unsigned char* urow = EU8 + (size_t)e * 1024 + l15 * 16;
      uint4 uv[4];
#pragma unroll
      for (int i = 0; i < 4; ++i) uv[i] = *(const uint4*)(urow + i * 256);
      const float usc = ESC[e], vsc = ESC[16384 + e];
      f32x2 d0 = f32x2{0.f, 0.f}, d1 = f32x2{0.f, 0.f};
#pragma unroll
      for (int i = 0; i < 4; ++i) {
        d0 = __builtin_elementwise_fma(CVT_LO(uv[i].x), hf[i * 8 + 0], d0); d1 = __builtin_elementwise_fma(CVT_HI(uv[i].x), hf[i * 8 + 1], d1);
        d0 = __builtin_elementwise_fma(CVT_LO(uv[i].y), hf[i * 8 + 2], d0); d1 = __builtin_elementwise_fma(CVT_HI(uv[i].y), hf[i * 8 + 3], d1);
        d0 = __builtin_elementwise_fma(CVT_LO(uv[i].z), hf[i * 8 + 4], d0); d1 = __builtin_elementwise_fma(CVT_HI(uv[i].z), hf[i * 8 + 5], d1);
        d0 = __builtin_elementwise_fma(CVT_LO(uv[i].w), hf[i * 8 + 6], d0); d1 = __builtin_elementwise_fma(CVT_HI(uv[i].w), hf[i * 8 + 7], d1);
      }
      float d = (d0.x + d0.y) + (d1.x + d1.y);
      d += __shfl_xor(d, 1); d += __shfl_xor(d, 2); d += __shfl_xor(d, 4); d += __shfl_xor(d, 8);
      const float hk = gelu_f(d * rs2 * usc);
      if (l15 == 0) wl[k] = gk * hk * vsc;
    }
    f32x2 acc[32];
#pragma unroll
    for (int i = 0; i < 32; ++i) acc[i] = f32x2{0.f, 0.f};
#pragma unroll 2
    for (int it = 0; it < 32; ++it) {
      const int k = it * 4 + g;
      const int e = __shfl((it < 16) ? ea : eb, k & 63);
      const float wk = wl[k];
      const f32x2 w2 = f32x2{wk, wk};
      const unsigned char* vrow = EV8 + (size_t)e * 1024 + l15 * 16;
      uint4 vv[4];
#pragma unroll
      for (int i = 0; i < 4; ++i) vv[i] = *(const uint4*)(vrow + i * 256);
#pragma unroll
      for (int i = 0; i < 4; ++i) {
        acc[i * 8 + 0] = __builtin_elementwise_fma(CVT_LO(vv[i].x), w2, acc[i * 8 + 0]); acc[i * 8 + 1] = __builtin_elementwise_fma(CVT_HI(vv[i].x), w2, acc[i * 8 + 1]);
        acc[i * 8 + 2] = __builtin_elementwise_fma(CVT_LO(vv[i].y), w2, acc[i * 8 + 2]); acc[i * 8 + 3] = __builtin_elementwise_fma(CVT_HI(vv[i].y), w2, acc[i * 8 + 3]);
        acc[i * 8 + 4] = __builtin_elementwise_fma(CVT_LO(vv[i].z), w2, acc[i * 8 + 4]); acc[i * 8 + 5] = __builtin_elementwise_fma(CVT_HI(vv[i].z), w2, acc[i * 8 + 5]);
        acc[i * 8 + 6] = __builtin_elementwise_fma(CVT_LO(vv[i].w), w2, acc[i * 8 + 6]); acc[i * 8 + 7] = __builtin_elementwise_fma(CVT_HI(vv[i].w), w2, acc[i * 8 + 7]);
      }
    }
    f32x2 r1[16];
    const bool hi2 = (g & 2) != 0;
#pragma unroll
    for (int i = 0; i < 16; ++i) {
      const f32x2 send = hi2 ? acc[i] : acc[i + 16];
      const f32x2 keep = hi2 ? acc[i + 16] : acc[i];
      r1[i] = f32x2{keep.x + __shfl_xor(send.x, 32), keep.y + __shfl_xor(send.y, 32)};
    }
    f32x2 r2[8];
    const bool hi1 = (g & 1) != 0;
#pragma unroll
    for (int i = 0; i < 8; ++i) {
      const f32x2 send = hi1 ? r1[i] : r1[i + 8];
      const f32x2 keep = hi1 ? r1[i + 8] : r1[i];
      r2[i] = f32x2{keep.x + __shfl_xor(send.x, 16), keep.y + __shfl_xor(send.y, 16)};
    }
    float4* op = (float4*)(p.out + (size_t)t * 1024 + g * 256 + l15 * 16);
#pragma unroll
    for (int q = 0; q < 4; ++q) {
      float4 a = op[q];
      a.x += r2[q * 2].x; a.y += r2[q * 2].y; a.z += r2[q * 2 + 1].x; a.w += r2[q * 2 + 1].y;
      op[q] = a;
    }
  }
}

__device__ __forceinline__ void phase6a(const Params& p, char* lds) {
  const int tid = tid_(), lane = tid & 63, wave = tid >> 6, eg = lane >> 3, part = lane & 7;
  const int bid = bid_();
  const int x = bid & 7, xb = bid >> 3, ncb = ((int)gridDim.x + 7 - x) >> 3;
  const unsigned char* EUX = (const unsigned char*)(p.ws + OFF_EU) + (size_t)x * (2 * MiB) + part * 16;
  const u16* HBX = (const u16*)(p.ws + OFF_HB) + x * 128 + part * 16;
  const int* EIDX = (const int*)(p.ws + OFF_EIDX);
  float* PART = (float*)(p.ws + OFF_PART) + (size_t)x * T * 128;
  const int tstep = ncb * NWAVE;
  for (int t = xb * NWAVE + wave; t < T; t += 2 * tstep) {
    const int t1 = t + tstep;
    const bool two = t1 < T;
    const int tb = two ? t1 : t;
    const int ea0 = EIDX[(size_t)t * 128 + lane], eb0 = EIDX[(size_t)t * 128 + 64 + lane];
    const int ea1 = EIDX[(size_t)tb * 128 + lane], eb1 = EIDX[(size_t)tb * 128 + 64 + lane];
    uint4 uv0[16], uv1[16];
#pragma unroll
    for (int it = 0; it < 16; ++it) {
      const int src = (it * 8 + eg) & 63;
      const int e0 = __shfl((it < 8) ? ea0 : eb0, src);
      const int e1 = __shfl((it < 8) ? ea1 : eb1, src);
      uv0[it] = *(const uint4*)(EUX + (size_t)e0 * 128);
      uv1[it] = *(const uint4*)(EUX + (size_t)e1 * 128);
    }
    f32x2 h0[8], h1[8];
    {
      const uint4 a = *(const uint4*)(HBX + (size_t)t * 1024), b = *(const uint4*)(HBX + (size_t)t * 1024 + 8);
      h0[0] = f32x2{bf_lo(a.x), bf_hi(a.x)}; h0[1] = f32x2{bf_lo(a.y), bf_hi(a.y)}; h0[2] = f32x2{bf_lo(a.z), bf_hi(a.z)}; h0[3] = f32x2{bf_lo(a.w), bf_hi(a.w)};
      h0[4] = f32x2{bf_lo(b.x), bf_hi(b.x)}; h0[5] = f32x2{bf_lo(b.y), bf_hi(b.y)}; h0[6] = f32x2{bf_lo(b.z), bf_hi(b.z)}; h0[7] = f32x2{bf_lo(b.w), bf_hi(b.w)};
      const uint4 c = *(const uint4*)(HBX + (size_t)tb * 1024), d = *(const uint4*)(HBX + (size_t)tb * 1024 + 8);
      h1[0] = f32x2{bf_lo(c.x), bf_hi(c.x)}; h1[1] = f32x2{bf_lo(c.y), bf_hi(c.y)}; h1[2] = f32x2{bf_lo(c.z), bf_hi(c.z)}; h1[3] = f32x2{bf_lo(c.w), bf_hi(c.w)};
      h1[4] = f32x2{bf_lo(d.x), bf_hi(d.x)}; h1[5] = f32x2{bf_lo(d.y), bf_hi(d.y)}; h1[6] = f32x2{bf_lo(d.z), bf_hi(d.z)}; h1[7] = f32x2{bf_lo(d.w), bf_hi(d.w)};
    }
    float d0[16], d1[16];
#pragma unroll
    for (int it = 0; it < 16; ++it) {
      f32x2 s = __builtin_elementwise_fma(CVT_LO(uv0[it].x), h0[0], f32x2{0.f, 0.f});
      s = __builtin_elementwise_fma(CVT_HI(uv0[it].x), h0[1], s); s = __builtin_elementwise_fma(CVT_LO(uv0[it].y), h0[2], s);
      s = __builtin_elementwise_fma(CVT_HI(uv0[it].y), h0[3], s); s = __builtin_elementwise_fma(CVT_LO(uv0[it].z), h0[4], s);
      s = __builtin_elementwise_fma(CVT_HI(uv0[it].z), h0[5], s); s = __builtin_elementwise_fma(CVT_LO(uv0[it].w), h0[6], s);
      s = __builtin_elementwise_fma(CVT_HI(uv0[it].w), h0[7], s);
      d0[it] = s.x + s.y;
      f32x2 q = __builtin_elementwise_fma(CVT_LO(uv1[it].x), h1[0], f32x2{0.f, 0.f});
      q = __builtin_elementwise_fma(CVT_HI(uv1[it].x), h1[1], q); q = __builtin_elementwise_fma(CVT_LO(uv1[it].y), h1[2], q);
      q = __builtin_elementwise_fma(CVT_HI(uv1[it].y), h1[3], q); q = __builtin_elementwise_fma(CVT_LO(uv1[it].z), h1[4], q);
      q = __builtin_elementwise_fma(CVT_HI(uv1[it].z), h1[5], q); q = __builtin_elementwise_fma(CVT_LO(uv1[it].w), h1[6], q);
      q = __builtin_elementwise_fma(CVT_HI(uv1[it].w), h1[7], q);
      d1[it] = q.x + q.y;
    }
    const bool b2 = (lane & 4) != 0, b1 = (lane & 2) != 0, b0 = (lane & 1) != 0;
    float r0[8], r1[8];
#pragma unroll
    for (int i = 0; i < 8; ++i) {
      r0[i] = (b2 ? d0[i + 8] : d0[i]) + __shfl_xor(b2 ? d0[i] : d0[i + 8], 4);
      r1[i] = (b2 ? d1[i + 8] : d1[i]) + __shfl_xor(b2 ? d1[i] : d1[i + 8], 4);
    }
    float s0[4], s1[4];
#pragma unroll
    for (int i = 0; i < 4; ++i) {
      s0[i] = (b1 ? r0[i + 4] : r0[i]) + __shfl_xor(b1 ? r0[i] : r0[i + 4], 2);
      s1[i] = (b1 ? r1[i + 4] : r1[i]) + __shfl_xor(b1 ? r1[i] : r1[i + 4], 2);
    }
    float u0[2], u1[2];
#pragma unroll
    for (int i = 0; i < 2; ++i) {
      u0[i] = (b0 ? s0[i + 2] : s0[i]) + __shfl_xor(b0 ? s0[i] : s0[i + 2], 1);
      u1[i] = (b0 ? s1[i + 2] : s1[i]) + __shfl_xor(b0 ? s1[i] : s1[i + 2], 1);
    }
#pragma unroll
    for (int i = 0; i < 2; ++i) {
      const int k = (2 * part + i) * 8 + eg;
      PART[(size_t)t * 128 + k] = u0[i];
      if (two) PART[(size_t)t1 * 128 + k] = u1[i];
    }
  }
}

__device__ __forceinline__ void phase6m(const Params& p, char* lds) {
  const int tid = tid_(), lane = tid & 63, wave = tid >> 6;
  const u16* HB = (const u16*)(p.ws + OFF_HB);
  const float* ESC = (const float*)(p.ws + OFF_ESC);
  const int* EIDX = (const int*)(p.ws + OFF_EIDX);
  const float* BEST = (const float*)(p.ws + OFF_BEST);
  const float* PART = (const float*)(p.ws + OFF_PART);
  float* WGT = (float*)(p.ws + OFF_WGT);
  for (int t = bid_() * NWAVE + wave; t < T; t += gridDim.x * NWAVE) {
    const uint4 a = *(const uint4*)(HB + (size_t)t * 1024 + lane * 16), b = *(const uint4*)(HB + (size_t)t * 1024 + lane * 16 + 8);
    float ss = 0.f;
    ss = dot2(a.x, a.x, ss); ss = dot2(a.y, a.y, ss); ss = dot2(a.z, a.z, ss); ss = dot2(a.w, a.w, ss);
    ss = dot2(b.x, b.x, ss); ss = dot2(b.y, b.y, ss); ss = dot2(b.z, b.z, ss); ss = dot2(b.w, b.w, ss);
#pragma unroll
    for (int o = 1; o < 64; o <<= 1) ss += __shfl_xor(ss, o);
    const float rs2 = rsqrtf(ss * (1.f / 1024.f) + EPS);
#pragma unroll
    for (int hf = 0; hf < 2; ++hf) {
      const size_t idx = (size_t)t * 128 + hf * 64 + lane;
      float d = 0.f;
#pragma unroll
      for (int x = 0; x < 8; ++x) d += PART[(size_t)x * T * 128 + idx];
      const int e = EIDX[idx];
      const float v = BEST[idx] * rs2;
      float m = v;
#pragma unroll
      for (int o = 1; o < 16; o <<= 1) m = fmaxf(m, __shfl_xor(m, o));
      const float ex = __expf(v - m);
      float s = ex;
#pragma unroll
      for (int o = 1; o < 16; o <<= 1) s += __shfl_xor(s, o);
      WGT[idx] = (ex / s) * gelu_f(d * rs2 * ESC[e]) * ESC[16384 + e];
    }
  }
}

__device__ __forceinline__ void phase6b(const Params& p, char* lds) {
  const int tid = tid_(), lane = tid & 63, wave = tid >> 6, eg = lane >> 3, part = lane & 7;
  const int bid = bid_();
  const int x = bid & 7, xb = bid >> 3, ncb = ((int)gridDim.x + 7 - x) >> 3;
  const unsigned char* EVX = (const unsigned char*)(p.ws + OFF_EV) + (size_t)x * (2 * MiB) + part * 16;
  const int* EIDX = (const int*)(p.ws + OFF_EIDX);
  const float* WGT = (const float*)(p.ws + OFF_WGT);
  const int tstep = ncb * NWAVE;
  const int pi = ((lane >> 5) & 1) * 4 + ((lane >> 4) & 1) * 2 + ((lane >> 3) & 1);
  const bool h5 = (lane & 32) != 0, h4 = (lane & 16) != 0, h3 = (lane & 8) != 0;
  for (int t = xb * NWAVE + wave; t < T; t += 2 * tstep) {
    const int t1 = t + tstep;
    const bool two = t1 < T;
    const int tb = two ? t1 : t;
    const int ea0 = EIDX[(size_t)t * 128 + lane], eb0 = EIDX[(size_t)t * 128 + 64 + lane];
    const int ea1 = EIDX[(size_t)tb * 128 + lane], eb1 = EIDX[(size_t)tb * 128 + 64 + lane];
    const float wa0 = WGT[(size_t)t * 128 + lane], wb0 = WGT[(size_t)t * 128 + 64 + lane];
    const float wa1 = WGT[(size_t)tb * 128 + lane], wb1 = WGT[(size_t)tb * 128 + 64 + lane];
    uint4 vv0[16], vv1[16];
#pragma unroll
    for (int it = 0; it < 16; ++it) {
      const int src = (it * 8 + eg) & 63;
      const int e0 = __shfl((it < 8) ? ea0 : eb0, src);
      const int e1 = __shfl((it < 8) ? ea1 : eb1, src);
      vv0[it] = *(const uint4*)(EVX + (size_t)e0 * 128);
      vv1[it] = *(const uint4*)(EVX + (size_t)e1 * 128);
    }
    float2* op0 = (float2*)(p.out + (size_t)t * 1024 + x * 128 + part * 16 + pi * 2);
    float2* op1 = (float2*)(p.out + (size_t)tb * 1024 + x * 128 + part * 16 + pi * 2);
    const float2 o0 = *op0, o1 = *op1;
    f32x2 a0[8], a1[8];
#pragma unroll
    for (int i = 0; i < 8; ++i) { a0[i] = f32x2{0.f, 0.f}; a1[i] = f32x2{0.f, 0.f}; }
#pragma unroll
    for (int it = 0; it < 16; ++it) {
      const int src = (it * 8 + eg) & 63;
      const float w0 = __shfl((it < 8) ? wa0 : wb0, src), w1 = __shfl((it < 8) ? wa1 : wb1, src);
      const f32x2 w20 = f32x2{w0, w0}, w21 = f32x2{w1, w1};
      a0[0] = __builtin_elementwise_fma(CVT_LO(vv0[it].x), w20, a0[0]); a0[1] = __builtin_elementwise_fma(CVT_HI(vv0[it].x), w20, a0[1]);
      a0[2] = __builtin_elementwise_fma(CVT_LO(vv0[it].y), w20, a0[2]); a0[3] = __builtin_elementwise_fma(CVT_HI(vv0[it].y), w20, a0[3]);
      a0[4] = __builtin_elementwise_fma(CVT_LO(vv0[it].z), w20, a0[4]); a0[5] = __builtin_elementwise_fma(CVT_HI(vv0[it].z), w20, a0[5]);
      a0[6] = __builtin_elementwise_fma(CVT_LO(vv0[it].w), w20, a0[6]); a0[7] = __builtin_elementwise_fma(CVT_HI(vv0[it].w), w20, a0[7]);
      a1[0] = __builtin_elementwise_fma(CVT_LO(vv1[it].x), w21, a1[0]); a1[1] = __builtin_elementwise_fma(CVT_HI(vv1[it].x), w21, a1[1]);
      a1[2] = __builtin_elementwise_fma(CVT_LO(vv1[it].y), w21, a1[2]); a1[3] = __builtin_elementwise_fma(CVT_HI(vv1[it].y), w21, a1[3]);
      a1[4] = __builtin_elementwise_fma(CVT_LO(vv1[it].z), w21, a1[4]); a1[5] = __builtin_elementwise_fma(CVT_HI(vv1[it].z), w21, a1[5]);
      a1[6] = __builtin_elementwise_fma(CVT_LO(vv1[it].w), w21, a1[6]); a1[7] = __builtin_elementwise_fma(CVT_HI(vv1[it].w), w21, a1[7]);
    }
#define RS8(acc, res)                                                                                            \
    {                                                                                                            \
      f32x2 q1[4];                                                                                               \
      _Pragma("unroll") for (int i = 0; i < 4; ++i) {                                                            \
        const f32x2 sd = h5 ? acc[i] : acc[i + 4], kp = h5 ? acc[i + 4] : acc[i];                                \
        q1[i] = f32x2{kp.x + __shfl_xor(sd.x, 32), kp.y + __shfl_xor(sd.y, 32)};                                 \
      }                                                                                                          \
      f32x2 q2[2];                                                                                               \
      _Pragma("unroll") for (int i = 0; i < 2; ++i) {                                                            \
        const f32x2 sd = h4 ? q1[i] : q1[i + 2], kp = h4 ? q1[i + 2] : q1[i];                                    \
        q2[i] = f32x2{kp.x + __shfl_xor(sd.x, 16), kp.y + __shfl_xor(sd.y, 16)};                                 \
      }                                                                                                          \
      const f32x2 sd = h3 ? q2[0] : q2[1], kp = h3 ? q2[1] : q2[0];                                              \
      res = f32x2{kp.x + __shfl_xor(sd.x, 8), kp.y + __shfl_xor(sd.y, 8)};                                       \
    }
    f32x2 z0, z1;
    RS8(a0, z0);
    RS8(a1, z1);
    *op0 = make_float2(o0.x + z0.x, o0.y + z0.y);
    if (two) *op1 = make_float2(o1.x + z1.x, o1.y + z1.y);
  }
}

__device__ __forceinline__ void seam_barrier(unsigned* ctr, unsigned nblk) {
  __syncthreads();
  if (threadIdx.x == 0) {
    __builtin_amdgcn_fence(__ATOMIC_RELEASE, "agent");
    asm volatile("s_waitcnt vmcnt(0)" ::: "memory");
    __hip_atomic_fetch_add(ctr, 1u, __ATOMIC_RELAXED, __HIP_MEMORY_SCOPE_AGENT);
    while (__hip_atomic_load(ctr, __ATOMIC_RELAXED, __HIP_MEMORY_SCOPE_AGENT) < nblk) __builtin_amdgcn_s_sleep(2);
    __builtin_amdgcn_fence(__ATOMIC_ACQUIRE, "agent");
    asm volatile("s_waitcnt vmcnt(0)" ::: "memory");
  }
  __syncthreads();
}
#ifndef PMASK
#define PMASK 127
#endif
#define PROG 0x6543210ull
#define NPROG 9
__global__ void __launch_bounds__(NTHR, 2) mega(Params p, int ph_lo, int ph_hi) {
  extern __shared__ __attribute__((aligned(16))) char lds[];
  cg::grid_group grid = cg::this_grid();
#ifndef REP_PHASE
#define REP_PHASE -1
#endif
#define IN(k) (ph_lo <= (k) && (k) < ph_hi)
#define SEAM(k) do { if (IN(k) && IN((k) + 1)) { if ((k) == 0) grid.sync(); else seam_barrier((unsigned*)(p.ws + OFF_BAR) + (k) * 64, gridDim.x); } } while (0)
  if (IN(0)) { phase0(p, lds); if (REP_PHASE == 0) { grid.sync(); phase0(p, lds); } }
  SEAM(0);
  if (IN(1)) { phase1(p, lds); if (REP_PHASE == 1) { grid.sync(); phase1(p, lds); } }
  SEAM(1);
  if (IN(2)) { phase2(p, lds); if (REP_PHASE == 2) { grid.sync(); phase2(p, lds); } }
  SEAM(2);
  if (IN(3)) { phase3(p, lds); if (REP_PHASE == 3) { grid.sync(); phase3(p, lds); } }
  SEAM(3);
  if (IN(4)) { phase4(p, lds); if (REP_PHASE == 4) { grid.sync(); phase4(p, lds); } }
  SEAM(4);
  if (IN(5)) { phase5(p, lds); if (REP_PHASE == 5) { grid.sync(); phase5(p, lds); } }
  SEAM(5);
  if (IN(6)) { phase6a(p, lds); if (REP_PHASE == 6) { grid.sync(); phase6a(p, lds); } }
  SEAM(6);
  if (IN(7)) { phase6m(p, lds); if (REP_PHASE == 7) { grid.sync(); phase6m(p, lds); } }
  SEAM(7);
  if (IN(8)) phase6b(p, lds);
}

extern "C" void kernel_launch(void* const* d_in, const int* in_sizes, int n_in, void* d_out, int out_size, void* d_ws,
                              size_t ws_size, hipStream_t stream) {
  static int grid_blocks = 0;
  if (!grid_blocks) {
    int dev = 0, cus = 0, per_cu = 0;
    (void)hipGetDevice(&dev);
    (void)hipDeviceGetAttribute(&cus, hipDeviceAttributeMultiprocessorCount, dev);
    (void)hipFuncSetAttribute((const void*)mega, hipFuncAttributeMaxDynamicSharedMemorySize, LDS_BYTES);
    (void)hipOccupancyMaxActiveBlocksPerMultiprocessor(&per_cu, mega, NTHR, LDS_BYTES);
    if (per_cu > 1) per_cu = 1;
    grid_blocks = cus * per_cu;
  }
  Params p{};
  p.x = (const float*)d_in[0]; p.ln_mix_g = (const float*)d_in[1]; p.w_in = (const float*)d_in[2];
  p.gmlp_norm_g = (const float*)d_in[3]; p.gmlp_w_s = (const float*)d_in[4]; p.gmlp_b_s = (const float*)d_in[5];
  p.q_norm_g = (const float*)d_in[6]; p.k_norm_g = (const float*)d_in[7]; p.rel_bias = (const float*)d_in[8];
  p.w_out = (const float*)d_in[9]; p.ln_ffn_g = (const float*)d_in[10]; p.w_query = (const float*)d_in[11];
  p.sub_keys = (const float*)d_in[12]; p.peer_u = (const float*)d_in[13]; p.peer_v = (const float*)d_in[14];
  p.out = (float*)d_out; p.ws = (char*)d_ws;
#if FUSED
  int lo = 0, hi = NPROG;
  void* args[] = {&p, &lo, &hi};
  hipError_t e = hipLaunchCooperativeKernel((void*)mega, dim3(grid_blocks), dim3(NTHR), args, LDS_BYTES, stream);
  if (e != hipSuccess) fprintf(stderr, "cooperative launch failed: %s (grid %d)\n", hipGetErrorString(e), grid_blocks);
#else
  for (int ph = 0; ph < NPROG; ++ph) mega<<<dim3(grid_blocks), dim3(NTHR), LDS_BYTES, stream>>>(p, ph, ph + 1);
#endif
}
```

```cpp
#include <hip/hip_runtime.h>
#include <hip/hip_cooperative_groups.h>
#include <cstdio>
namespace cg = cooperative_groups;

#ifndef FUSED
#define FUSED 1
#endif

typedef unsigned short u16;
using bf16x8 = __attribute__((ext_vector_type(8))) short;
using s16x4 = __attribute__((ext_vector_type(4))) short;
using f32x4 = __attribute__((ext_vector_type(4))) float;
using bf16x2 = __attribute__((ext_vector_type(2))) __bf16;
using f32x2 = __attribute__((ext_vector_type(2))) float;
using u32x4 = __attribute__((ext_vector_type(4))) unsigned;
using u32x2 = __attribute__((ext_vector_type(2))) unsigned;

constexpr int T = 32768, DM = 1024, SEQ = 4096;
constexpr float EPS = 1e-6f;
constexpr size_t MiB = 1u << 20;
constexpr size_t OFF_XB = 0, OFF_WINT = 64 * MiB  , OFF_WB = 67 * MiB  , OFF_WOUTT = 69 * MiB, OFF_WQT = 71 * MiB, OFF_KEYS = 75 * MiB,
                 OFF_RS = 76 * MiB, OFF_VSS = 76 * MiB + 512 * 1024, OFF_EU = 77 * MiB, OFF_EV = 109 * MiB,
                 OFF_U = 141 * MiB, OFF_GVT = 173 * MiB, OFF_QK = 205 * MiB, OFF_VT = 269 * MiB, OFF_AB = 301 * MiB,
                 OFF_HB = 365 * MiB, OFF_PQ = 141 * MiB  , OFF_EIDX = 429 * MiB,
                 OFF_BEST = 445 * MiB, OFF_ESC = 461 * MiB  , OFF_WGT = 462 * MiB  , OFF_BAR = 480 * MiB  , OFF_PART = 141 * MiB  ;

struct Params {
  const float *x, *ln_mix_g, *w_in, *gmlp_norm_g, *gmlp_w_s, *gmlp_b_s, *q_norm_g, *k_norm_g, *rel_bias, *w_out,
      *ln_ffn_g, *w_query, *sub_keys, *peer_u, *peer_v;
  float* out;
  char* ws;
};

constexpr int LDS_BYTES = 131584;
constexpr int NTHR = 512, NWAVE = 8;
constexpr int LSTR = 144;
constexpr int OPER_BYTES = 128 * LSTR;

__device__ __forceinline__ u16 f2bf(float f) {
  unsigned u = __float_as_uint(f);
  u += 0x7fffu + ((u >> 16) & 1u);
  return (u16)(u >> 16);
}
__device__ __forceinline__ unsigned pack2(float lo, float hi) { return (unsigned)f2bf(lo) | ((unsigned)f2bf(hi) << 16); }
__device__ __forceinline__ float bf_lo(unsigned u) { return __uint_as_float(u << 16); }
__device__ __forceinline__ float bf_hi(unsigned u) { return __uint_as_float(u & 0xffff0000u); }
__device__ __forceinline__ float bf2f(u16 v) { return __uint_as_float(((unsigned)v) << 16); }
__device__ __forceinline__ float gelu_f(float x) {
  float z = 0.7978845608028654f * (x + 0.044715f * x * x * x);
  float e = __expf(2.f * z);
  float th = 1.f - 2.f / (1.f + e);
  return 0.5f * x * (1.f + th);
}
__device__ __forceinline__ float dot2(unsigned a, unsigned b, float acc) {
  return __builtin_amdgcn_fdot2_f32_bf16(__builtin_bit_cast(bf16x2, a), __builtin_bit_cast(bf16x2, b), acc, false);
}
__device__ __forceinline__ f32x4 mfma16(bf16x8 a, bf16x8 b, f32x4 c) {
  return __builtin_amdgcn_mfma_f32_16x16x32_bf16(a, b, c, 0, 0, 0);
}
__device__ __forceinline__ bf16x8 mk8(unsigned a, unsigned b, unsigned c, unsigned d) {
  uint4 u = make_uint4(a, b, c, d);
  return __builtin_bit_cast(bf16x8, u);
}
__device__ __forceinline__ unsigned pack4_fp8(float a, float b, float c, float d) {
  int r = 0;
  r = __builtin_amdgcn_cvt_pk_fp8_f32(a, b, r, false);
  r = __builtin_amdgcn_cvt_pk_fp8_f32(c, d, r, true);
  return (unsigned)r;
}
__device__ __forceinline__ unsigned okey(float x) {
  unsigned u = __float_as_uint(x);
  return (u & 0x80000000u) ? ~u : (u | 0x80000000u);
}


__device__ __forceinline__ int tid_() { int t = threadIdx.x; asm volatile("" : "+v"(t)); return t; }
__device__ __forceinline__ int bid_() { int b = blockIdx.x; asm volatile("" : "+s"(b)); return b; }
namespace pg8 {
#define PG8_LAS __attribute__((address_space(3)))
typedef unsigned short bf16_t;
typedef short bf16x8 __attribute__((ext_vector_type(8)));
typedef float f32x4 __attribute__((ext_vector_type(4)));
typedef unsigned u32x4 __attribute__((ext_vector_type(4)));
constexpr int BM = 256, BK = 64, HALF = 128, HTB = HALF * BK * 2  , STAGE_BYTES = 8 * HTB, NXCD = 8, WGM = 8;

__host__ __device__ __forceinline__ int lds_byte(int r, int c) { const int st = (r >> 4) * 2 + (c >> 5), rr = r & 15, cc = c & 31, ob = rr * 64 + cc * 2; return st * 1024 + (ob ^ (((ob >> 9) & 1) << 5)); }
__host__ __device__ __forceinline__ void stage_rc(int b, int& R, int& C) { const int st = b / 1024, sb = b % 1024, swz = sb ^ (((sb >> 9) & 1) << 5); R = (st >> 1) * 16 + swz / 64; C = (st & 1) * 32 + (swz % 64) / 2; }
__host__ __device__ __forceinline__ int perm32(int rho) { const int n = rho >> 4, i = rho & 15; return 8 * (i >> 2) + 4 * n + (i & 3); }

struct Unit { int pm, pn; };
struct Gemm { const bf16_t* A; const bf16_t* Bt; int M, N, K; };

struct StaticOrder {
    int nM, nN, nwg, G, c;
    __host__ __device__ void init(int M, int N, int G_, int c_) { nM = M / BM; nN = N / BM; nwg = nM * nN; G = G_; c = c_; }
    __host__ __device__ bool next(int i, Unit& u) const {
        const long L = (long)i * G + c; if (L >= nwg) return false;
        int wgid = (int)L; { const int q = nwg / NXCD, r = nwg % NXCD, xcd = wgid % NXCD, off = wgid / NXCD; wgid = (xcd < r ? xcd * (q + 1) : r * (q + 1) + (xcd - r) * q) + off; }
        const int nig = WGM * nN, gid = wgid / nig, fm = gid * WGM, gsz = (nM - fm) < WGM ? (nM - fm) : WGM;
        u.pm = fm + ((wgid % nig) % gsz); u.pn = (wgid % nig) / gsz; return true;
    }
    __device__ __forceinline__ void a_ready(const Unit&) const {}
    __device__ __forceinline__ void done(const Unit&) const {}
};

__device__ __forceinline__ unsigned cvt_pk_bf16(float lo, float hi) { unsigned r; asm volatile("v_cvt_pk_bf16_f32 %0, %1, %2" : "=v"(r) : "v"(lo), "v"(hi)); return r; }
template <class Epi, class Sched, bool ALIGN_EPI = false, bool SP2 = false>
__device__ __forceinline__ void gemm_phase(PG8_LAS unsigned char* lds, const Gemm g, const Sched& S, const Epi& E) {
    const int tid = threadIdx.x, wid = __builtin_amdgcn_readfirstlane(tid >> 6), lane = tid & 63, wr = wid >> 2, wc = wid & 3, fr = lane & 15, fq = lane >> 4;
    const int K = g.K, nt = K / BK;
    unsigned voffA[2], voffB[2];
#pragma unroll
    for (int i = 0; i < 2; ++i) { int R, C; stage_rc(tid * 16 + i * 8192, R, C); const int Rb = Epi::PERM ? ((R & ~31) + perm32(R & 31)) : R;
        voffA[i] = (unsigned)(R * K + C) * 2u; voffB[i] = (unsigned)(Rb * K + C) * 2u; }
    const size_t kstep = (size_t)(BK * 2);
    const size_t hstep = (size_t)HALF * K * 2;
    const size_t tstep = 2 * hstep;
    const unsigned ldsw = (unsigned)wid * 1024u;
    const int aoff = lds_byte(wr * 64 + fr, fq * 8), boff = lds_byte(wc * 32 + fr, fq * 8);
#define PG8_SA(b, h) (((b) * 2 + (h)) * HTB)
#define PG8_SB(b, h) ((4 + (b) * 2 + (h)) * HTB)
#define PG8_STAGE(bufoff, gbase, voff) do { _Pragma("unroll") for (int _i = 0; _i < 2; ++_i) \
        __builtin_amdgcn_global_load_lds((const unsigned*)((const char*)(gbase) + (voff)[_i]), (PG8_LAS unsigned*)(lds + (bufoff) + ldsw + _i * 8192), 16, 0, 0); } while (0)
#define PG8_LDA(dst, b, h) do { _Pragma("unroll") for (int m = 0; m < 4; ++m) _Pragma("unroll") for (int k = 0; k < 2; ++k) dst[m][k] = *(const PG8_LAS bf16x8*)(lds + PG8_SA(b, h) + aoff + m * 2048 + k * 1024); } while (0)
#define PG8_LDB(dst, b, h) do { _Pragma("unroll") for (int n = 0; n < 2; ++n) _Pragma("unroll") for (int k = 0; k < 2; ++k) dst[n][k] = *(const PG8_LAS bf16x8*)(lds + PG8_SB(b, h) + boff + n * 2048 + k * 1024); } while (0)
#define PG8_MMA(ai, bj, At, Bt) do { __builtin_amdgcn_s_setprio(1); _Pragma("unroll") for (int m = 0; m < 4; ++m) _Pragma("unroll") for (int n = 0; n < 2; ++n) _Pragma("unroll") for (int k = 0; k < 2; ++k) \
        acc[ai][bj][m][n] = __builtin_amdgcn_mfma_f32_16x16x32_bf16(Bt[n][k], At[m][k], acc[ai][bj][m][n], 0, 0, 0); __builtin_amdgcn_s_setprio(0); } while (0)
#define PG8_WAIT_V(n) asm volatile("s_waitcnt vmcnt(" #n ")" ::: "memory")
#define PG8_WAIT_L(n) asm volatile("s_waitcnt lgkmcnt(" #n ")" ::: "memory")
#define PG8_BAR __builtin_amdgcn_s_barrier()
#define PG8_SCHED __builtin_amdgcn_sched_barrier(0)
    Unit cur, nxt; int ui = 0;
    if (!S.next(0, cur)) return;
    f32x4 acc[2][2][4][2];
#pragma unroll
    for (int a = 0; a < 2; ++a)
#pragma unroll
        for (int b = 0; b < 2; ++b)
#pragma unroll
            for (int m = 0; m < 4; ++m)
#pragma unroll
                for (int n = 0; n < 2; ++n) acc[a][b][m][n] = (f32x4){0.f, 0.f, 0.f, 0.f};
    bf16x8 At[4][2], B0[2][2], B1[2][2];
    const char* cA = (const char*)g.A + (size_t)cur.pm * tstep; const char* cB = (const char*)g.Bt + (size_t)cur.pn * tstep;
    S.a_ready(cur);
    if constexpr (SP2) {
        PG8_STAGE(PG8_SB(0, 0), cB, voffB); PG8_STAGE(PG8_SB(0, 1), cB + hstep, voffB); PG8_STAGE(PG8_SA(0, 0), cA, voffA); PG8_STAGE(PG8_SA(0, 1), cA + hstep, voffA);
        if (wr == 1) PG8_BAR;
        PG8_WAIT_V(2); PG8_BAR;
        PG8_STAGE(PG8_SB(1, 0), cB + kstep, voffB); PG8_STAGE(PG8_SA(1, 0), cA + kstep, voffA); PG8_STAGE(PG8_SB(1, 1), cB + hstep + kstep, voffB);
        PG8_WAIT_V(6); PG8_BAR;
    } else {
        PG8_STAGE(PG8_SB(0, 0), cB, voffB); PG8_STAGE(PG8_SA(0, 0), cA, voffA); PG8_STAGE(PG8_SB(0, 1), cB + hstep, voffB); PG8_STAGE(PG8_SA(0, 1), cA + hstep, voffA);
        if (wr == 1) PG8_BAR;
        PG8_WAIT_V(4); PG8_BAR;
        PG8_STAGE(PG8_SB(1, 0), cB + kstep, voffB); PG8_STAGE(PG8_SA(1, 0), cA + kstep, voffA); PG8_STAGE(PG8_SB(1, 1), cB + hstep + kstep, voffB);
        PG8_WAIT_V(6); PG8_BAR;
    }
    for (;;) {
        const bool has_next = S.next(ui + 1, nxt);
        const char* nA = has_next ? (const char*)g.A + (size_t)nxt.pm * tstep : cA; const char* nB = has_next ? (const char*)g.Bt + (size_t)nxt.pn * tstep : cB;
        for (int t = 0; t < nt; t += 2) {
            const bool last = (t == nt - 2);
            const char* a1 = cA + (size_t)(t + 1) * kstep;
            const char* a2 = last ? nA : cA + (size_t)(t + 2) * kstep; const char* b2 = last ? nB : cB + (size_t)(t + 2) * kstep;
            const char* a3 = a2 + kstep; const char* b3 = b2 + kstep;
            if (last && has_next) S.a_ready(nxt);
            if constexpr (SP2) {
            PG8_LDB(B0, 0, 0); PG8_LDB(B1, 0, 1); PG8_SCHED; PG8_LDA(At, 0, 0); PG8_STAGE(PG8_SA(1, 1), a1 + hstep, voffA);
            PG8_WAIT_V(8); PG8_WAIT_L(0); PG8_BAR; PG8_MMA(0, 0, At, B0); PG8_MMA(0, 1, At, B1); PG8_BAR; PG8_SCHED;
            PG8_LDA(At, 0, 1); PG8_STAGE(PG8_SB(0, 0), b2, voffB); PG8_STAGE(PG8_SB(0, 1), b2 + hstep, voffB); PG8_STAGE(PG8_SA(0, 0), a2, voffA);
            PG8_WAIT_V(8); PG8_WAIT_L(0); PG8_BAR; PG8_MMA(1, 0, At, B0); PG8_MMA(1, 1, At, B1); PG8_BAR; PG8_SCHED;
            PG8_LDB(B0, 1, 0); PG8_LDB(B1, 1, 1); PG8_SCHED; PG8_LDA(At, 1, 0); PG8_STAGE(PG8_SA(0, 1), a2 + hstep, voffA);
            PG8_WAIT_V(8); PG8_WAIT_L(0); PG8_BAR; PG8_MMA(0, 0, At, B0); PG8_MMA(0, 1, At, B1); PG8_BAR; PG8_SCHED;
            PG8_LDA(At, 1, 1); PG8_STAGE(PG8_SB(1, 0), b3, voffB); PG8_STAGE(PG8_SB(1, 1), b3 + hstep, voffB); PG8_STAGE(PG8_SA(1, 0), a3, voffA);
            PG8_WAIT_V(8); PG8_WAIT_L(0); PG8_BAR; PG8_MMA(1, 0, At, B0); PG8_MMA(1, 1, At, B1); PG8_BAR; PG8_SCHED;
            } else {
            PG8_LDB(B0, 0, 0); PG8_SCHED; PG8_LDA(At, 0, 0); PG8_STAGE(PG8_SA(1, 1), a1 + hstep, voffA);
            PG8_WAIT_L(8); PG8_BAR; PG8_WAIT_L(0); PG8_MMA(0, 0, At, B0); PG8_BAR; PG8_SCHED;
            PG8_LDB(B1, 0, 1); PG8_STAGE(PG8_SB(0, 0), b2, voffB);
            PG8_BAR; PG8_WAIT_L(0); PG8_MMA(0, 1, At, B1); PG8_BAR;
            PG8_LDA(At, 0, 1); PG8_STAGE(PG8_SA(0, 0), a2, voffA);
            PG8_BAR; PG8_WAIT_L(0); PG8_MMA(1, 0, At, B0); PG8_BAR; PG8_SCHED;
            PG8_STAGE(PG8_SB(0, 1), b2 + hstep, voffB);
            PG8_WAIT_V(6); PG8_BAR; PG8_MMA(1, 1, At, B1); PG8_BAR;
            PG8_LDB(B0, 1, 0); PG8_SCHED; PG8_LDA(At, 1, 0); PG8_STAGE(PG8_SA(0, 1), a2 + hstep, voffA);
            PG8_WAIT_L(8); PG8_BAR; PG8_WAIT_L(0); PG8_MMA(0, 0, At, B0); PG8_BAR; PG8_SCHED;
            PG8_LDB(B1, 1, 1); PG8_STAGE(PG8_SB(1, 0), b3, voffB);
            PG8_BAR; PG8_WAIT_L(0); PG8_MMA(0, 1, At, B1); PG8_BAR;
            PG8_LDA(At, 1, 1); PG8_STAGE(PG8_SA(1, 0), a3, voffA);
            PG8_BAR; PG8_WAIT_L(0); PG8_MMA(1, 0, At, B0); PG8_BAR; PG8_SCHED;
            PG8_STAGE(PG8_SB(1, 1), b3 + hstep, voffB);
            PG8_WAIT_V(6); PG8_BAR; PG8_MMA(1, 1, At, B1); PG8_BAR;
            }
        }
        if constexpr (ALIGN_EPI) { if (wr == 0) PG8_BAR; }
        if constexpr (!Epi::AFTER_DRAIN) { E(acc, cur, wr, wc, fr, fq); S.done(cur); }
        if (!has_next) break;
#pragma unroll
        for (int a = 0; a < 2; ++a)
#pragma unroll
            for (int b = 0; b < 2; ++b)
#pragma unroll
                for (int m = 0; m < 4; ++m)
#pragma unroll
                    for (int n = 0; n < 2; ++n) acc[a][b][m][n] = (f32x4){0.f, 0.f, 0.f, 0.f};
        cur = nxt; cA = nA; cB = nB; ++ui;
        if constexpr (ALIGN_EPI) { if (wr == 1) PG8_BAR; }
    }
    PG8_WAIT_V(0);
    if constexpr (!ALIGN_EPI) { if (wr == 0) PG8_BAR; }
    PG8_BAR;
    if constexpr (Epi::AFTER_DRAIN) { E.fused(acc, cur, wr, wc, fr, fq, lds, wid, lane); S.done(cur); }
#undef PG8_SA
#undef PG8_SB
#undef PG8_STAGE
#undef PG8_LDA
#undef PG8_LDB
#undef PG8_MMA
#undef PG8_WAIT_V
#undef PG8_WAIT_L
#undef PG8_BAR
#undef PG8_SCHED
}
}

#define EPI_V8(v, A, s) float v[8] = {A[0][0] * (s), A[0][1] * (s), A[0][2] * (s), A[0][3] * (s), A[1][0] * (s), A[1][1] * (s), A[1][2] * (s), A[1][3] * (s)}
__device__ __forceinline__ uint4 pk8(const float (&v)[8]) {
  return make_uint4(pg8::cvt_pk_bf16(v[0], v[1]), pg8::cvt_pk_bf16(v[2], v[3]), pg8::cvt_pk_bf16(v[4], v[5]), pg8::cvt_pk_bf16(v[6], v[7]));
}
struct EpiIn {
  static constexpr bool PERM = true, AFTER_DRAIN = false;
  u16* U; u16* QK; const float* RS;
  __device__ __forceinline__ void operator()(const pg8::f32x4 (&acc)[2][2][4][2], const pg8::Unit& u, int wr, int wc, int fr, int fq) const {
    const int row0 = u.pm * 256 + wr * 64 + fr, colt = u.pn * 256, c0 = colt + wc * 32 + 8 * fq;
    const bool isu = colt < 512;
#pragma unroll
    for (int ai = 0; ai < 2; ++ai)
#pragma unroll
      for (int m = 0; m < 4; ++m) {
        const int row = row0 + ai * 128 + m * 16;
        const float r = RS[row];
#pragma unroll
        for (int bj = 0; bj < 2; ++bj) {
          const int col = c0 + bj * 128;
          EPI_V8(v, acc[ai][bj][m], r);
          if (isu) {
#pragma unroll
            for (int j = 0; j < 8; ++j) v[j] = gelu_f(v[j]);
            *(uint4*)(U + (size_t)row * 512 + col) = pk8(v);
          } else {
            *(uint4*)(QK + (size_t)row * 1024 + (col - 512)) = pk8(v);
          }
        }
      }
  }
};
struct EpiInT {
  static constexpr bool PERM = true, AFTER_DRAIN = false;
  u16* GVT; u16* VT; const float* RS; float* VSS;
  __device__ __forceinline__ void operator()(const pg8::f32x4 (&acc)[2][2][4][2], const pg8::Unit& u, int wr, int wc, int fr, int fq) const {
    const int ch0 = u.pm * 256 + wr * 64 + fr, t0 = u.pn * 256 + wc * 32 + 8 * fq;
    const bool isg = u.pm < 2;
#pragma unroll
    for (int bj = 0; bj < 2; ++bj) {
      const int t = t0 + bj * 128, b = t >> 12, s = t & 4095;
      const float4 ra = *(const float4*)(RS + t), rb = *(const float4*)(RS + t + 4);
      const float rr[8] = {ra.x, ra.y, ra.z, ra.w, rb.x, rb.y, rb.z, rb.w};
      float ss[8] = {0.f, 0.f, 0.f, 0.f, 0.f, 0.f, 0.f, 0.f};
#pragma unroll
      for (int ai = 0; ai < 2; ++ai)
#pragma unroll
        for (int m = 0; m < 4; ++m) {
          const int ch = ch0 + ai * 128 + m * 16;
          float v[8];
#pragma unroll
          for (int j = 0; j < 8; ++j) v[j] = acc[ai][bj][m][j >> 2][j & 3] * rr[j];
          if (isg) {
#pragma unroll
            for (int j = 0; j < 8; ++j) { v[j] = gelu_f(v[j]); ss[j] += v[j] * v[j]; }
            *(uint4*)(GVT + ((size_t)b * 512 + ch) * SEQ + s) = pk8(v);
          } else {
            *(uint4*)(VT + ((size_t)b * 512 + (ch - 512)) * SEQ + s) = pk8(v);
          }
        }
      if (isg) {
#pragma unroll
        for (int j = 0; j < 8; ++j) {
          float sv = ss[j];
          sv += __shfl_xor(sv, 1); sv += __shfl_xor(sv, 2); sv += __shfl_xor(sv, 4); sv += __shfl_xor(sv, 8);
          if (fr == 0) atomicAdd(VSS + t + j, sv);
        }
      }
    }
  }
};
struct EpiOut {
  static constexpr bool PERM = true, AFTER_DRAIN = false;
  const float* X; float* OUT; u16* HB;
  __device__ __forceinline__ void operator()(const pg8::f32x4 (&acc)[2][2][4][2], const pg8::Unit& u, int wr, int wc, int fr, int fq) const {
    const int row0 = u.pm * 256 + wr * 64 + fr, c0 = u.pn * 256 + wc * 32 + 8 * fq;
#pragma unroll
    for (int ai = 0; ai < 2; ++ai)
#pragma unroll
      for (int m = 0; m < 4; ++m) {
        const int row = row0 + ai * 128 + m * 16;
#pragma unroll
        for (int bj = 0; bj < 2; ++bj) {
          const size_t idx = (size_t)row * 1024 + c0 + bj * 128;
          const float4 xa = *(const float4*)(X + idx), xb = *(const float4*)(X + idx + 4);
          float v[8] = {xa.x + acc[ai][bj][m][0][0], xa.y + acc[ai][bj][m][0][1], xa.z + acc[ai][bj][m][0][2], xa.w + acc[ai][bj][m][0][3],
                        xb.x + acc[ai][bj][m][1][0], xb.y + acc[ai][bj][m][1][1], xb.z + acc[ai][bj][m][1][2], xb.w + acc[ai][bj][m][1][3]};
          *(float4*)(OUT + idx) = make_float4(v[0], v[1], v[2], v[3]);
          *(float4*)(OUT + idx + 4) = make_float4(v[4], v[5], v[6], v[7]);
          *(uint4*)(HB + idx) = pk8(v);
        }
      }
  }
};
struct EpiQ {
  static constexpr bool PERM = true, AFTER_DRAIN = false;
  u16* PQ;
  __device__ __forceinline__ void operator()(const pg8::f32x4 (&acc)[2][2][4][2], const pg8::Unit& u, int wr, int wc, int fr, int fq) const {
    const int row0 = u.pm * 256 + wr * 64 + fr, c0 = u.pn * 256 + wc * 32 + 8 * fq;
#pragma unroll
    for (int ai = 0; ai < 2; ++ai)
#pragma unroll
      for (int m = 0; m < 4; ++m) {
        const int row = row0 + ai * 128 + m * 16;
#pragma unroll
        for (int bj = 0; bj < 2; ++bj) {
          EPI_V8(v, acc[ai][bj][m], 1.f);
          *(uint4*)(PQ + (size_t)row * 2048 + c0 + bj * 128) = pk8(v);
        }
      }
  }
};
#define LDS3(p) ((__attribute__((address_space(3))) unsigned char*)(p))

__device__ __forceinline__ void phase0(const Params& p, char* lds) {
  const int tid = tid_(), lane = tid & 63, wave = tid >> 6;
  const int nblk = gridDim.x, blk = bid_();
  u16* XB = (u16*)(p.ws + OFF_XB);
  float* RS = (float*)(p.ws + OFF_RS);
  float* VSS = (float*)(p.ws + OFF_VSS);
  for (int row = blk * NWAVE + wave; row < T; row += nblk * NWAVE) {
    const float4* xr = (const float4*)(p.x + (size_t)row * DM);
    float4 v[4];
    float ss = 0.f;
#pragma unroll
    for (int i = 0; i < 4; ++i) {
      v[i] = xr[lane + 64 * i];
      ss += v[i].x * v[i].x + v[i].y * v[i].y + v[i].z * v[i].z + v[i].w * v[i].w;
    }
#pragma unroll
    for (int o = 1; o < 64; o <<= 1) ss += __shfl_xor(ss, o);
    if (lane == 0) RS[row] = rsqrtf(ss * (1.f / 1024.f) + EPS);
#pragma unroll
    for (int i = 0; i < 4; ++i) {
      uint2 o2 = make_uint2(pack2(v[i].x, v[i].y), pack2(v[i].z, v[i].w));
      *(uint2*)(XB + (size_t)row * DM + (lane + 64 * i) * 4) = o2;
    }
  }
  {
    unsigned char* EU4 = (unsigned char*)(p.ws + OFF_EU);
    unsigned char* EV4 = (unsigned char*)(p.ws + OFF_EV);
    float* ESC = (float*)(p.ws + OFF_ESC);
    for (int row = blk * NWAVE + wave; row < 32768; row += nblk * NWAVE) {
      const bool isv = row >= 16384;
      const int e = row & 16383;
      const float4* src = (const float4*)((isv ? p.peer_v : p.peer_u) + (size_t)e * 1024);
      float4 v[2][2];
      float am = 0.f;
#pragma unroll
      for (int j = 0; j < 2; ++j)
#pragma unroll
        for (int q = 0; q < 2; ++q) {
          float4 t4 = src[j * 128 + lane * 2 + q];
          if (!isv) {
            const float4 g4 = ((const float4*)p.ln_ffn_g)[j * 128 + lane * 2 + q];
            t4.x *= g4.x; t4.y *= g4.y; t4.z *= g4.z; t4.w *= g4.w;
          }
          am = fmaxf(am, fmaxf(fmaxf(fabsf(t4.x), fabsf(t4.y)), fmaxf(fabsf(t4.z), fabsf(t4.w))));
          v[j][q] = t4;
        }
#pragma unroll
      for (int o = 1; o < 64; o <<= 1) am = fmaxf(am, __shfl_xor(am, o));
      const bool ok = (am > 1e-30f);
      const float scale = ok ? 6.0f / am : 1.f;
      const float inv = ok ? am * (1.f / 6.0f) : 1.f;
      unsigned char* dst = (isv ? EV4 : EU4) + (size_t)e * 128 + (lane & 31) * 4;
#pragma unroll
      for (int j = 0; j < 2; ++j) {
        unsigned w = 0;
        w = __builtin_amdgcn_cvt_scalef32_pk_fp4_f32(w, v[j][0].x * scale, v[j][0].y * scale, 1.0f, 0);
        w = __builtin_amdgcn_cvt_scalef32_pk_fp4_f32(w, v[j][0].z * scale, v[j][0].w * scale, 1.0f, 1);
        w = __builtin_amdgcn_cvt_scalef32_pk_fp4_f32(w, v[j][1].x * scale, v[j][1].y * scale, 1.0f, 2);
        w = __builtin_amdgcn_cvt_scalef32_pk_fp4_f32(w, v[j][1].z * scale, v[j][1].w * scale, 1.0f, 3);
        *(unsigned*)(dst + (size_t)(j * 2 + (lane >> 5)) * (2 * MiB)) = w;
      }
      if (lane == 0) ESC[row] = inv;
    }
  }
  {
    const int half = wave >> 2, w4 = wave & 3;
    float* tile = (float*)lds + half * (64 * 65);
    for (int tp = blk; tp < 704; tp += nblk) {
      const int tl = tp * 2 + half;
      const float* W; const float* gain; u16* dst; int N, kt, nt, drow;
      if (tl < 640) {
        W = p.w_in; gain = p.ln_mix_g; N = 2560; kt = tl / 40; nt = tl % 40;
        const int n0 = nt * 64;
        if (n0 < 512) { dst = (u16*)(p.ws + OFF_WINT); drow = n0; }
        else if (n0 < 1024) { dst = (u16*)(p.ws + OFF_WB); drow = n0 - 512; }
        else if (n0 < 2048) { dst = (u16*)(p.ws + OFF_WINT); drow = n0 - 512; }
        else { dst = (u16*)(p.ws + OFF_WB); drow = n0 - 2048 + 512; }
      } else if (tl < 896) { int t2 = tl - 640; W = p.w_out; gain = nullptr; dst = (u16*)(p.ws + OFF_WOUTT); N = 1024; kt = t2 / 16; nt = t2 % 16; drow = nt * 64; }
      else { int t2 = tl - 896; W = p.w_query; gain = p.ln_ffn_g; dst = (u16*)(p.ws + OFF_WQT); N = 2048; kt = t2 / 32; nt = t2 % 32; drow = nt * 64; }
      __syncthreads();
#pragma unroll 4
      for (int i = 0; i < 16; ++i) {
        const int kk = i * 4 + w4;
        const float gk = gain ? gain[kt * 64 + kk] : 1.f;
        tile[kk * 65 + lane] = W[(size_t)(kt * 64 + kk) * N + nt * 64 + lane] * gk;
      }
      __syncthreads();
#pragma unroll 4
      for (int i = 0; i < 16; ++i) {
        const int nn = i * 4 + w4;
        dst[(size_t)(drow + nn) * 1024 + kt * 64 + lane] = f2bf(tile[lane * 65 + nn]);
      }
    }
    __syncthreads();
  }
  {
    u16* KEYS = (u16*)(p.ws + OFF_KEYS);
    for (int i = blk * NTHR + tid; i < 262144 / 4; i += nblk * NTHR) {
      float4 a = ((const float4*)p.sub_keys)[i];
      *(uint2*)(KEYS + (size_t)i * 4) = make_uint2(pack2(a.x, a.y), pack2(a.z, a.w));
    }
  }
  for (int i = blk * NTHR + tid; i < T; i += nblk * NTHR) VSS[i] = 0.f;
  if (blk == 0 && tid < 16) ((unsigned*)(p.ws + OFF_BAR))[tid * 64] = 0u;
}

__device__ __forceinline__ void phase1(const Params& p, char* lds) {
  const u16* XB = (const u16*)(p.ws + OFF_XB);
  const float* RS = (const float*)(p.ws + OFF_RS);
  {
    pg8::Gemm g{XB, (const u16*)(p.ws + OFF_WINT), T, 1536, 1024};
    pg8::StaticOrder S; S.init(T, 1536, (int)gridDim.x, (int)blockIdx.x);
    EpiIn E{(u16*)(p.ws + OFF_U), (u16*)(p.ws + OFF_QK), RS};
    pg8::gemm_phase<EpiIn, pg8::StaticOrder, true, true>(LDS3(lds), g, S, E);
  }
  {
    pg8::Gemm g{(const u16*)(p.ws + OFF_WB), XB, 1024, T, 1024};
    pg8::StaticOrder S; S.init(1024, T, (int)gridDim.x, (int)blockIdx.x);
    EpiInT E{(u16*)(p.ws + OFF_GVT), (u16*)(p.ws + OFF_VT), RS, (float*)(p.ws + OFF_VSS)};
    pg8::gemm_phase<EpiInT, pg8::StaticOrder, true, true>(LDS3(lds), g, S, E);
  }
}

__device__ __forceinline__ void gmlp_item(const Params& p, int item) {
  const int tid = tid_() & 255, lane = tid & 63, wave = tid >> 6, l15 = lane & 15, g = lane >> 4;
  const int gr = item & 7, n = (item >> 3) & 31, b = item >> 8;
  const int t0 = b * SEQ + n * 128;
  const float* VSS = (const float*)(p.ws + OFF_VSS);
  const u16* GVT = (const u16*)(p.ws + OFF_GVT);
  const u16* U = (const u16*)(p.ws + OFF_U);
  u16* AB = (u16*)(p.ws + OFF_AB);
  f32x4 acc[2][4];
#pragma unroll
  for (int i = 0; i < 2; ++i)
#pragma unroll
    for (int j = 0; j < 4; ++j) acc[i][j] = f32x4{0.f, 0.f, 0.f, 0.f};
  const int i_base = wave * 32;
  const bool low = wave < 2;
#pragma unroll
  for (int ks = 0; ks < 4; ++ks) {
    if (ks >= 2 && low) continue;
    const int j0 = ks * 32 + g * 8;
    const float4 s0 = *(const float4*)(VSS + t0 + j0), s1 = *(const float4*)(VSS + t0 + j0 + 4);
    float r[8] = {s0.x, s0.y, s0.z, s0.w, s1.x, s1.y, s1.z, s1.w};
#pragma unroll
    for (int q = 0; q < 8; ++q) r[q] = rsqrtf(r[q] * (1.f / 512.f) + EPS);
    bf16x8 wf[2];
#pragma unroll
    for (int mi = 0; mi < 2; ++mi) {
      const int i = i_base + mi * 16 + l15;
      const float* wp = p.gmlp_w_s + ((size_t)(gr * 128 + i)) * 128 + j0;
      const float4 w0 = *(const float4*)wp, w1 = *(const float4*)(wp + 4);
      wf[mi] = mk8(pack2(w0.x * r[0], w0.y * r[1]), pack2(w0.z * r[2], w0.w * r[3]), pack2(w1.x * r[4], w1.y * r[5]),
                   pack2(w1.z * r[6], w1.w * r[7]));
    }
#pragma unroll
    for (int ni = 0; ni < 4; ++ni) {
      const int c = ni * 16 + l15;
      const bf16x8 gf = *(const bf16x8*)(GVT + ((size_t)b * 512 + gr * 64 + c) * SEQ + n * 128 + j0);
#pragma unroll
      for (int mi = 0; mi < 2; ++mi) acc[mi][ni] = mfma16(gf, wf[mi], acc[mi][ni]);
    }
  }
#pragma unroll
  for (int mi = 0; mi < 2; ++mi) {
    const int i = i_base + mi * 16 + l15;
    const size_t t = (size_t)t0 + i;
    const float bs = p.gmlp_b_s[gr * 128 + i];
#pragma unroll
    for (int ni = 0; ni < 4; ++ni) {
      const int ch = gr * 64 + ni * 16 + g * 4;
      const float4 ng = *(const float4*)(p.gmlp_norm_g + ch);
      const uint2 uu = *(const uint2*)(U + t * 512 + ch);
      const float o0 = bf_lo(uu.x) * (acc[mi][ni][0] * ng.x + bs), o1 = bf_hi(uu.x) * (acc[mi][ni][1] * ng.y + bs);
      const float o2 = bf_lo(uu.y) * (acc[mi][ni][2] * ng.z + bs), o3 = bf_hi(uu.y) * (acc[mi][ni][3] * ng.w + bs);
      *(uint2*)(AB + t * 1024 + ch) = make_uint2(pack2(o0, o1), pack2(o2, o3));
    }
  }
}

constexpr int ATT_BUF = 2 * 64 * LSTR + 256;
constexpr float LOG2E = 1.4426950408889634f;
__device__ __forceinline__ void attn_item(const Params& p, int item, char* lds) {
  const int tid = tid_() & 255, lane = tid & 63, wave = tid >> 6, l15 = lane & 15, g = lane >> 4;
  const int c = item & 63, h = (item >> 6) & 7, b = item >> 9;
  const u16* QK = (const u16*)(p.ws + OFF_QK);
  const u16* VT = (const u16*)(p.ws + OFF_VT);
  u16* AB = (u16*)(p.ws + OFF_AB);
  float* bias_s = (float*)(lds + 2 * ATT_BUF);
  __syncthreads();
  for (int i = tid; i < 257; i += 256) bias_s[i] = p.rel_bias[h * 257 + i] * LOG2E;
  const size_t tq = (size_t)b * SEQ + c * 64 + wave * 16 + l15;
  bf16x8 qb0, qb1;
  {
    const u16* qp = QK + tq * 1024 + h * 64 + g * 8;
    const uint4 q0 = *(const uint4*)qp, q1 = *(const uint4*)(qp + 32);
    float f[16] = {bf_lo(q0.x), bf_hi(q0.x), bf_lo(q0.y), bf_hi(q0.y), bf_lo(q0.z), bf_hi(q0.z), bf_lo(q0.w), bf_hi(q0.w),
                   bf_lo(q1.x), bf_hi(q1.x), bf_lo(q1.y), bf_hi(q1.y), bf_lo(q1.z), bf_hi(q1.z), bf_lo(q1.w), bf_hi(q1.w)};
    float ss = 0.f;
#pragma unroll
    for (int i = 0; i < 16; ++i) ss += f[i] * f[i];
    ss += __shfl_xor(ss, 16); ss += __shfl_xor(ss, 32);
    const float rq = rsqrtf(ss * (1.f / 64.f) + EPS) * (0.125f * LOG2E);
    const float4 ga = *(const float4*)(p.q_norm_g + g * 8), gb = *(const float4*)(p.q_norm_g + g * 8 + 4);
    const float4 gc = *(const float4*)(p.q_norm_g + 32 + g * 8), gd = *(const float4*)(p.q_norm_g + 32 + g * 8 + 4);
    const float4 ka = *(const float4*)(p.k_norm_g + g * 8), kb = *(const float4*)(p.k_norm_g + g * 8 + 4);
    const float4 kc4 = *(const float4*)(p.k_norm_g + 32 + g * 8), kd = *(const float4*)(p.k_norm_g + 32 + g * 8 + 4);
    const float gg[16] = {ga.x * ka.x, ga.y * ka.y, ga.z * ka.z, ga.w * ka.w, gb.x * kb.x, gb.y * kb.y, gb.z * kb.z, gb.w * kb.w,
                          gc.x * kc4.x, gc.y * kc4.y, gc.z * kc4.z, gc.w * kc4.w, gd.x * kd.x, gd.y * kd.y, gd.z * kd.z, gd.w * kd.w};
#pragma unroll
    for (int i = 0; i < 16; ++i) f[i] *= rq * gg[i];
    qb0 = mk8(pg8::cvt_pk_bf16(f[0], f[1]), pg8::cvt_pk_bf16(f[2], f[3]), pg8::cvt_pk_bf16(f[4], f[5]), pg8::cvt_pk_bf16(f[6], f[7]));
    qb1 = mk8(pg8::cvt_pk_bf16(f[8], f[9]), pg8::cvt_pk_bf16(f[10], f[11]), pg8::cvt_pk_bf16(f[12], f[13]), pg8::cvt_pk_bf16(f[14], f[15]));
  }
  f32x4 o[4];
#pragma unroll
  for (int i = 0; i < 4; ++i) o[i] = f32x4{0.f, 0.f, 0.f, 0.f};
  float m_run = -1e30f, l_run = 0.f;
  const int srow = tid >> 2, spart = tid & 3;
  const int kc_lo = (c >= 8) ? 0 : (8 - c);
  const u16* kbase = QK + ((size_t)b * SEQ + srow) * 1024 + 512 + h * 64 + spart * 16;
  const u16* vbase = VT + ((size_t)b * 512 + h * 64 + srow) * SEQ + spart * 16;
  uint4 k0, k1, v0, v1;
  {
    const int kchunk = c - 8 + kc_lo;
    const u16* kp = kbase + (size_t)kchunk * 64 * 1024;
    k0 = *(const uint4*)kp; k1 = *(const uint4*)(kp + 8);
    const u16* vp = vbase + kchunk * 64;
    v0 = *(const uint4*)vp; v1 = *(const uint4*)(vp + 8);
  }
  for (int kc = kc_lo; kc <= 8; ++kc) {
    char* Ks = lds + ((kc - kc_lo) & 1) * ATT_BUF;
    char* Vs = Ks + 64 * LSTR;
    float* rks = (float*)(Ks + 2 * 64 * LSTR);
    {
      float ss = 0.f;
      ss = dot2(k0.x, k0.x, ss); ss = dot2(k0.y, k0.y, ss); ss = dot2(k0.z, k0.z, ss); ss = dot2(k0.w, k0.w, ss);
      ss = dot2(k1.x, k1.x, ss); ss = dot2(k1.y, k1.y, ss); ss = dot2(k1.z, k1.z, ss); ss = dot2(k1.w, k1.w, ss);
      ss += __shfl_xor(ss, 1); ss += __shfl_xor(ss, 2);
      if (spart == 0) rks[srow] = rsqrtf(ss * (1.f / 64.f) + EPS);
      char* kd = Ks + srow * LSTR + spart * 32;
      *(uint4*)kd = k0;
      *(uint4*)(kd + 16) = k1;
      char* vd = Vs + srow * LSTR + spart * 32;
      *(uint4*)vd = v0;
      *(uint4*)(vd + 16) = v1;
    }
    __syncthreads();
    if (kc < 8) {
      const int kchunk = c - 8 + kc + 1;
      const u16* kp = kbase + (size_t)kchunk * 64 * 1024;
      k0 = *(const uint4*)kp; k1 = *(const uint4*)(kp + 8);
      const u16* vp = vbase + kchunk * 64;
      v0 = *(const uint4*)vp; v1 = *(const uint4*)(vp + 8);
    }
    f32x4 s[4];
#pragma unroll
    for (int mt = 0; mt < 4; ++mt) {
      const char* kr = Ks + (mt * 16 + l15) * LSTR + g * 16;
      const bf16x8 a0 = *(const bf16x8*)kr, a1 = *(const bf16x8*)(kr + 64);
      s[mt] = mfma16(a0, qb0, f32x4{0.f, 0.f, 0.f, 0.f});
      s[mt] = mfma16(a1, qb1, s[mt]);
    }
    if (kc <= 5) {
      const float bc = bias_s[256];
#pragma unroll
      for (int mt = 0; mt < 4; ++mt) {
        const float4 rk4 = *(const float4*)(rks + mt * 16 + g * 4);
        s[mt][0] = s[mt][0] * rk4.x + bc; s[mt][1] = s[mt][1] * rk4.y + bc;
        s[mt][2] = s[mt][2] * rk4.z + bc; s[mt][3] = s[mt][3] * rk4.w + bc;
      }
    } else {
      const int qi = wave * 16 + l15 + 64 * (8 - kc);
#pragma unroll
      for (int mt = 0; mt < 4; ++mt) {
        const float4 rk4 = *(const float4*)(rks + mt * 16 + g * 4);
        const float rr[4] = {rk4.x, rk4.y, rk4.z, rk4.w};
#pragma unroll
        for (int j = 0; j < 4; ++j) {
          int rel = qi - (mt * 16 + g * 4 + j);
          rel = rel > 128 ? 128 : rel;
          s[mt][j] = s[mt][j] * rr[j] + bias_s[rel + 128];
        }
      }
    }
    float mx = s[0][0];
#pragma unroll
    for (int mt = 0; mt < 4; ++mt)
#pragma unroll
      for (int j = 0; j < 4; ++j) mx = fmaxf(mx, s[mt][j]);
    mx = fmaxf(mx, __shfl_xor(mx, 16));
    mx = fmaxf(mx, __shfl_xor(mx, 32));
    const float m_new = fmaxf(m_run, mx);
    const float alpha = __builtin_amdgcn_exp2f(m_run - m_new);
    m_run = m_new;
    float ls = 0.f;
#pragma unroll
    for (int mt = 0; mt < 4; ++mt)
#pragma unroll
      for (int j = 0; j < 4; ++j) { s[mt][j] = __builtin_amdgcn_exp2f(s[mt][j] - m_new); ls += s[mt][j]; }
    l_run = l_run * alpha + ls;
#pragma unroll
    for (int mt = 0; mt < 4; ++mt)
#pragma unroll
      for (int j = 0; j < 4; ++j) o[mt][j] *= alpha;
#pragma unroll
    for (int k2 = 0; k2 < 2; ++k2) {
      const bf16x8 pb = mk8(pg8::cvt_pk_bf16(s[2 * k2][0], s[2 * k2][1]), pg8::cvt_pk_bf16(s[2 * k2][2], s[2 * k2][3]),
                            pg8::cvt_pk_bf16(s[2 * k2 + 1][0], s[2 * k2 + 1][1]), pg8::cvt_pk_bf16(s[2 * k2 + 1][2], s[2 * k2 + 1][3]));
#pragma unroll
      for (int mt = 0; mt < 4; ++mt) {
        const char* vr = Vs + (mt * 16 + l15) * LSTR + (32 * k2 + 4 * g) * 2;
        const uint2 va = *(const uint2*)vr, vb = *(const uint2*)(vr + 32);
        o[mt] = mfma16(mk8(va.x, va.y, vb.x, vb.y), pb, o[mt]);
      }
    }
  }
  float l = l_run;
  l += __shfl_xor(l, 16); l += __shfl_xor(l, 32);
  const float inv = 1.f / l;
#pragma unroll
  for (int mt = 0; mt < 4; ++mt) {
    *(uint2*)(AB + tq * 1024 + 512 + h * 64 + mt * 16 + g * 4) =
        make_uint2(pg8::cvt_pk_bf16(o[mt][0] * inv, o[mt][1] * inv), pg8::cvt_pk_bf16(o[mt][2] * inv, o[mt][3] * inv));
  }
}

__device__ __forceinline__ void phase2(const Params& p, char* lds) {
  const int sub = tid_() >> 8;
  for (int it = bid_(); it < 2048 + 1024; it += gridDim.x) {
    if (it < 2048) {
      const int b = it >> 8, hp = (it >> 6) & 3, c = ((it & 63) + 8 * b) & 63;
      attn_item(p, (b << 9) | ((hp * 2 + sub) << 6) | c, lds + sub * 38912);
    } else {
      gmlp_item(p, (it - 2048) * 2 + sub);
    }
  }
}

__device__ __forceinline__ void phase3(const Params& p, char* lds) {
  pg8::Gemm g{(const u16*)(p.ws + OFF_AB), (const u16*)(p.ws + OFF_WOUTT), T, 1024, 1024};
  pg8::StaticOrder S; S.init(T, 1024, (int)gridDim.x, (int)blockIdx.x);
  EpiOut E{p.x, p.out, (u16*)(p.ws + OFF_HB)};
  pg8::gemm_phase<EpiOut, pg8::StaticOrder, true, true>(LDS3(lds), g, S, E);
}
__device__ __forceinline__ void phase4(const Params& p, char* lds) {
  pg8::Gemm g{(const u16*)(p.ws + OFF_HB), (const u16*)(p.ws + OFF_WQT), T, 2048, 1024};
  pg8::StaticOrder S; S.init(T, 2048, (int)gridDim.x, (int)blockIdx.x);
  EpiQ E{(u16*)(p.ws + OFF_PQ)};
  pg8::gemm_phase<EpiQ, pg8::StaticOrder, true, true>(LDS3(lds), g, S, E);
}

__device__ __forceinline__ void sort16_desc(unsigned (&v)[16]) {
#pragma unroll
  for (int k = 2; k <= 16; k <<= 1)
#pragma unroll
    for (int j = k >> 1; j > 0; j >>= 1)
#pragma unroll
      for (int i = 0; i < 16; ++i) {
        const int l = i ^ j;
        if (l > i) {
          const unsigned hi = max(v[i], v[l]), lo = min(v[i], v[l]);
          if ((i & k) == 0) { v[i] = hi; v[l] = lo; } else { v[i] = lo; v[l] = hi; }
        }
      }
}
__device__ __forceinline__ void merge16_desc(unsigned (&a)[16], const unsigned (&b)[16]) {
#pragma unroll
  for (int i = 0; i < 16; ++i) a[i] = max(a[i], b[15 - i]);
#pragma unroll
  for (int j = 8; j > 0; j >>= 1)
#pragma unroll
    for (int i = 0; i < 16; ++i) {
      const int l = i ^ j;
      if (l > i) { const unsigned hi = max(a[i], a[l]), lo = min(a[i], a[l]); a[i] = hi; a[l] = lo; }
    }
}
constexpr int SC_STR = 385, LSTR17 = 17;
constexpr int P5_LV = 64 * SC_STR, P5_LI = P5_LV + 128 * LSTR17, P5_TAB = P5_LI + 128 * LSTR17;

__device__ __forceinline__ void select_item(const Params& p, int item, int next_item, char* lds, const bf16x8 (&kf)[8][4], bf16x8 (&qf)[4]) {
  const int tid = tid_(), lane = tid & 63, wave = tid >> 6, l15 = lane & 15, g = lane >> 4;
  const int h = item & 7, t0 = (item >> 3) * 64;
  const u16* PQ = (const u16*)(p.ws + OFF_PQ);
  int* EIDX = (int*)(p.ws + OFF_EIDX);
  float* BEST = (float*)(p.ws + OFF_BEST);
  float* sc = (float*)lds;
  float* LV = sc + P5_LV;
  int* LI = (int*)lds + P5_LI;
  const int* tab = (const int*)lds + P5_TAB;
  __syncthreads();
  {
    const int pp = wave >> 2, wq = wave & 3;
#pragma unroll
    for (int nt = 0; nt < 8; ++nt) {
      f32x4 a = f32x4{0.f, 0.f, 0.f, 0.f};
#pragma unroll
      for (int ks = 0; ks < 4; ++ks) a = mfma16(qf[ks], kf[nt][ks], a);
#pragma unroll
      for (int j = 0; j < 4; ++j) sc[(wq * 16 + g * 4 + j) * SC_STR + pp * 192 + (nt >> 1) * 48 + (nt & 1) * 16 + l15] = a[j];
    }
    if (next_item < 512 * 8) {
      const u16* qp = PQ + (size_t)((next_item >> 3) * 64 + wq * 16 + l15) * 2048 + (next_item & 7) * 256 + pp * 128 + g * 8;
#pragma unroll
      for (int ks = 0; ks < 4; ++ks) qf[ks] = *(const bf16x8*)(qp + ks * 32);
    }
  }
  __syncthreads();
  {
    const int q = tid & 3, list = tid >> 2, row = list & 63, pp = list >> 6;
    const float* rowp = sc + row * SC_STR + pp * 192;
    const float* src = rowp + q * 48;
    unsigned A[16], B[16];
#pragma unroll
    for (int j = 0; j < 16; ++j) {
      A[j] = (okey(src[j]) & ~127u) | (unsigned)(127 - (q * 32 + j));
      B[j] = (okey(src[16 + j]) & ~127u) | (unsigned)(127 - (q * 32 + 16 + j));
    }
    sort16_desc(A);
    sort16_desc(B);
    merge16_desc(A, B);
#pragma unroll
    for (int i = 0; i < 16; ++i) B[i] = (unsigned)__shfl_xor((int)A[i], 1);
    merge16_desc(A, B);
#pragma unroll
    for (int i = 0; i < 16; ++i) B[i] = (unsigned)__shfl_xor((int)A[i], 2);
    merge16_desc(A, B);
#pragma unroll
    for (int r = 0; r < 16; ++r) {
      if ((r & 3) == q) {
        const int idx = 127 - (int)(A[r] & 127u);
        LV[list * LSTR17 + r] = rowp[(idx >> 5) * 48 + (idx & 31)];
        LI[list * LSTR17 + r] = idx;
      }
    }
  }
  __syncthreads();
  if (tid < 256) {
    const int grp = tid & 3, row = tid >> 2;
    const float* v0 = LV + row * LSTR17;
    const float* v1 = LV + (64 + row) * LSTR17;
    unsigned A[16], B[16];
#pragma unroll
    for (int j = 0; j < 16; ++j) {
      const int code = tab[grp * 16 + j];
      const int cc = code & 255;
      const float s = v0[cc >> 4] + v1[cc & 15];
      A[j] = (code < 0) ? 0u : ((okey(s) & ~255u) | (unsigned)(255 - cc));
    }
    sort16_desc(A);
#pragma unroll
    for (int i = 0; i < 16; ++i) B[i] = (unsigned)__shfl_xor((int)A[i], 1);
    merge16_desc(A, B);
#pragma unroll
    for (int i = 0; i < 16; ++i) B[i] = (unsigned)__shfl_xor((int)A[i], 2);
    merge16_desc(A, B);
    const size_t ob = ((size_t)(t0 + row) * 8 + h) * 16 + grp * 4;
    const int* i0 = LI + row * LSTR17;
    const int* i1 = LI + (64 + row) * LSTR17;
    int e4[4];
    float b4[4];
#pragma unroll
    for (int j = 0; j < 4; ++j) {
      const unsigned sel = (grp == 0) ? A[j] : (grp == 1) ? A[4 + j] : (grp == 2) ? A[8 + j] : A[12 + j];
      const int cc = 255 - (int)(sel & 255u);
      const int a = cc >> 4, bq = cc & 15;
      e4[j] = i0[a] * 128 + i1[bq];
      b4[j] = v0[a] + v1[bq];
    }
    *(int4*)(EIDX + ob) = make_int4(e4[0], e4[1], e4[2], e4[3]);
    *(float4*)(BEST + ob) = make_float4(b4[0], b4[1], b4[2], b4[3]);
  }
}

__device__ __forceinline__ void phase5(const Params& p, char* lds) {
  {
    const int i = tid_();
    if (i < 64) {
      const int grp = i >> 4, j = i & 15;
      int code = -1;
      if (grp == 0) code = j;
      else if (grp == 1) { if (j < 8) code = 16 + j; else if (j < 13) code = 32 + (j - 8); }
      else if (grp == 2) { if (j < 4) code = 48 + j; else if (j < 7) code = 64 + (j - 4); else if (j < 9) code = 80 + (j - 7); else if (j < 11) code = 96 + (j - 9); else if (j < 13) code = 112 + (j - 11); }
      else { if (j < 8) code = (8 + j) * 16; }
      ((int*)lds)[P5_TAB + i] = code;
    }
  }
  const int tid = tid_(), lane = tid & 63, wave = tid >> 6, l15 = lane & 15, g = lane >> 4;
  const int pp = wave >> 2, wq = wave & 3;
  int it = bid_();
  if (it >= 512 * 8) return;
  const bool fixed_head = (gridDim.x & 7) == 0;
  bf16x8 kf[8][4];
  bf16x8 qf[4];
  {
    const u16* KEYS = (const u16*)(p.ws + OFF_KEYS);
#pragma unroll
    for (int nt = 0; nt < 8; ++nt) {
      const u16* kp = KEYS + ((size_t)(((it & 7) * 2 + pp) * 128 + nt * 16 + l15)) * 128 + g * 8;
#pragma unroll
      for (int ks = 0; ks < 4; ++ks) kf[nt][ks] = *(const bf16x8*)(kp + ks * 32);
    }
    const u16* qp = (const u16*)(p.ws + OFF_PQ) + (size_t)((it >> 3) * 64 + wq * 16 + l15) * 2048 + (it & 7) * 256 + pp * 128 + g * 8;
#pragma unroll
    for (int ks = 0; ks < 4; ++ks) qf[ks] = *(const bf16x8*)(qp + ks * 32);
  }
  for (; it < 512 * 8; it += gridDim.x) {
    if (!fixed_head) {
      const u16* KEYS = (const u16*)(p.ws + OFF_KEYS);
#pragma unroll
      for (int nt = 0; nt < 8; ++nt) {
        const u16* kp = KEYS + ((size_t)(((it & 7) * 2 + pp) * 128 + nt * 16 + l15)) * 128 + g * 8;
#pragma unroll
        for (int ks = 0; ks < 4; ++ks) kf[nt][ks] = *(const bf16x8*)(kp + ks * 32);
      }
    }
    select_item(p, it, it + (int)gridDim.x, lds, kf, qf);
  }
}

#define P4(w, i) __builtin_amdgcn_cvt_scalef32_pk_f32_fp4((w), 1.0f, (i))
#define B4(w, i) __builtin_amdgcn_cvt_scalef32_pk_bf16_fp4((w), 1.0f, (i))
__device__ __forceinline__ f32x2 hpair(unsigned w) { return f32x2{bf_lo(w), bf_hi(w)}; }
__device__ __forceinline__ float dot32_fp4(const u32x4 u, const u32x4 (&h)[4], float acc) {
  f32x2 s = f32x2{acc, 0.f};
  s = __builtin_elementwise_fma(P4(u.x, 0), hpair(h[0].x), s); s = __builtin_elementwise_fma(P4(u.x, 1), hpair(h[0].y), s);
  s = __builtin_elementwise_fma(P4(u.x, 2), hpair(h[0].z), s); s = __builtin_elementwise_fma(P4(u.x, 3), hpair(h[0].w), s);
  s = __builtin_elementwise_fma(P4(u.y, 0), hpair(h[1].x), s); s = __builtin_elementwise_fma(P4(u.y, 1), hpair(h[1].y), s);
  s = __builtin_elementwise_fma(P4(u.y, 2), hpair(h[1].z), s); s = __builtin_elementwise_fma(P4(u.y, 3), hpair(h[1].w), s);
  s = __builtin_elementwise_fma(P4(u.z, 0), hpair(h[2].x), s); s = __builtin_elementwise_fma(P4(u.z, 1), hpair(h[2].y), s);
  s = __builtin_elementwise_fma(P4(u.z, 2), hpair(h[2].z), s); s = __builtin_elementwise_fma(P4(u.z, 3), hpair(h[2].w), s);
  s = __builtin_elementwise_fma(P4(u.w, 0), hpair(h[3].x), s); s = __builtin_elementwise_fma(P4(u.w, 1), hpair(h[3].y), s);
  s = __builtin_elementwise_fma(P4(u.w, 2), hpair(h[3].z), s); s = __builtin_elementwise_fma(P4(u.w, 3), hpair(h[3].w), s);
  return s.x + s.y;
}
__device__ __forceinline__ void phase6a(const Params& p, char* lds) {
  const int tid = tid_(), lane = tid & 63, wave = tid >> 6, eg = lane >> 3, part = lane & 7;
  const int bid = bid_();
  const int x = bid & 7, xb = bid >> 3, ncb = ((int)gridDim.x + 7 - x) >> 3;
  const int sl = x >> 1, par = x & 1;
  const unsigned char* EUX = (const unsigned char*)(p.ws + OFF_EU) + (size_t)sl * (2 * MiB) + part * 16;
  const u16* HBX = (const u16*)(p.ws + OFF_HB) + sl * 256 + part * 32;
  const int* EIDX = (const int*)(p.ws + OFF_EIDX);
  float* PART = (float*)(p.ws + OFF_PART) + (size_t)sl * T * 128;
  const int tstep = ncb * NWAVE * 2;
  const int tfirst = (xb * NWAVE + wave) * 2 + par;
  int nea0 = 0, neb0 = 0, nea1 = 0, neb1 = 0;
  if (tfirst < T) {
    const int tb = (tfirst + tstep < T) ? tfirst + tstep : tfirst;
    nea0 = EIDX[(size_t)tfirst * 128 + lane]; neb0 = EIDX[(size_t)tfirst * 128 + 64 + lane];
    nea1 = EIDX[(size_t)tb * 128 + lane]; neb1 = EIDX[(size_t)tb * 128 + 64 + lane];
  }
  const bool b2 = (lane & 4) != 0, b1 = (lane & 2) != 0, b0 = (lane & 1) != 0;
  for (int t = tfirst; t < T; t += 2 * tstep) {
    const int t1 = t + tstep;
    const bool two = t1 < T;
    const int tb = two ? t1 : t;
    const int ea0 = nea0, eb0 = neb0, ea1 = nea1, eb1 = neb1;
    u32x4 uv0[16], uv1[16];
#pragma unroll
    for (int it = 0; it < 16; ++it) {
      const int src = (it * 8 + eg) & 63;
      const int e0 = __shfl((it < 8) ? ea0 : eb0, src);
      const int e1 = __shfl((it < 8) ? ea1 : eb1, src);
      uv0[it] = *(const u32x4*)(EUX + (size_t)e0 * 128);
      uv1[it] = *(const u32x4*)(EUX + (size_t)e1 * 128);
    }
    u32x4 h0[4], h1[4];
#pragma unroll
    for (int i = 0; i < 4; ++i) {
      h0[i] = *(const u32x4*)(HBX + (size_t)t * 1024 + i * 8);
      h1[i] = *(const u32x4*)(HBX + (size_t)tb * 1024 + i * 8);
    }
    {
      const int tn = t + 2 * tstep;
      if (tn < T) {
        const int tnb = (tn + tstep < T) ? tn + tstep : tn;
        nea0 = EIDX[(size_t)tn * 128 + lane]; neb0 = EIDX[(size_t)tn * 128 + 64 + lane];
        nea1 = EIDX[(size_t)tnb * 128 + lane]; neb1 = EIDX[(size_t)tnb * 128 + 64 + lane];
      }
    }
    float d0[16], d1[16];
#pragma unroll
    for (int it = 0; it < 16; ++it) {
      d0[it] = dot32_fp4(uv0[it], h0, 0.f);
      d1[it] = dot32_fp4(uv1[it], h1, 0.f);
    }
    float r0[8], r1[8];
#pragma unroll
    for (int i = 0; i < 8; ++i) {
      r0[i] = (b2 ? d0[i + 8] : d0[i]) + __shfl_xor(b2 ? d0[i] : d0[i + 8], 4);
      r1[i] = (b2 ? d1[i + 8] : d1[i]) + __shfl_xor(b2 ? d1[i] : d1[i + 8], 4);
    }
    float s0[4], s1[4];
#pragma unroll
    for (int i = 0; i < 4; ++i) {
      s0[i] = (b1 ? r0[i + 4] : r0[i]) + __shfl_xor(b1 ? r0[i] : r0[i + 4], 2);
      s1[i] = (b1 ? r1[i + 4] : r1[i]) + __shfl_xor(b1 ? r1[i] : r1[i + 4], 2);
    }
    float u0[2], u1[2];
#pragma unroll
    for (int i = 0; i < 2; ++i) {
      u0[i] = (b0 ? s0[i + 2] : s0[i]) + __shfl_xor(b0 ? s0[i] : s0[i + 2], 1);
      u1[i] = (b0 ? s1[i + 2] : s1[i]) + __shfl_xor(b0 ? s1[i] : s1[i + 2], 1);
    }
#pragma unroll
    for (int i = 0; i < 2; ++i) {
      const int k = (2 * part + i) * 8 + eg;
      PART[(size_t)t * 128 + k] = u0[i];
      if (two) PART[(size_t)t1 * 128 + k] = u1[i];
    }
  }
}

__device__ __forceinline__ void phase6m(const Params& p, char* lds) {
  const int tid = tid_(), lane = tid & 63, wave = tid >> 6;
  const u16* HB = (const u16*)(p.ws + OFF_HB);
  const float* ESC = (const float*)(p.ws + OFF_ESC);
  const int* EIDX = (const int*)(p.ws + OFF_EIDX);
  const float* BEST = (const float*)(p.ws + OFF_BEST);
  const float* PART = (const float*)(p.ws + OFF_PART);
  float* WGT = (float*)(p.ws + OFF_WGT);
  for (int t = bid_() * NWAVE + wave; t < T; t += gridDim.x * NWAVE) {
    const uint4 a = *(const uint4*)(HB + (size_t)t * 1024 + lane * 16), b = *(const uint4*)(HB + (size_t)t * 1024 + lane * 16 + 8);
    const size_t i0 = (size_t)t * 128 + lane, i1 = i0 + 64;
    float da = 0.f, db = 0.f;
#pragma unroll
    for (int x = 0; x < 4; ++x) { da += PART[(size_t)x * T * 128 + i0]; db += PART[(size_t)x * T * 128 + i1]; }
    const int ea = EIDX[i0], eb = EIDX[i1];
    const float ba = BEST[i0], bb = BEST[i1];
    const float ua = ESC[ea], ub = ESC[eb], va = ESC[16384 + ea], vb = ESC[16384 + eb];
    float ss = 0.f;
    ss = dot2(a.x, a.x, ss); ss = dot2(a.y, a.y, ss); ss = dot2(a.z, a.z, ss); ss = dot2(a.w, a.w, ss);
    ss = dot2(b.x, b.x, ss); ss = dot2(b.y, b.y, ss); ss = dot2(b.z, b.z, ss); ss = dot2(b.w, b.w, ss);
#pragma unroll
    for (int o = 1; o < 64; o <<= 1) ss += __shfl_xor(ss, o);
    const float rs2 = rsqrtf(ss * (1.f / 1024.f) + EPS);
    const float xa = ba * rs2, xb = bb * rs2;
    float ma = xa, mb = xb;
#pragma unroll
    for (int o = 1; o < 16; o <<= 1) { ma = fmaxf(ma, __shfl_xor(ma, o)); mb = fmaxf(mb, __shfl_xor(mb, o)); }
    const float pa = __expf(xa - ma), pb = __expf(xb - mb);
    float sa = pa, sb = pb;
#pragma unroll
    for (int o = 1; o < 16; o <<= 1) { sa += __shfl_xor(sa, o); sb += __shfl_xor(sb, o); }
    WGT[i0] = (pa / sa) * gelu_f(da * rs2 * ua) * va;
    WGT[i1] = (pb / sb) * gelu_f(db * rs2 * ub) * vb;
  }
}

__device__ __forceinline__ void phase6b(const Params& p, char* lds) {
  const int tid = tid_(), lane = tid & 63, wave = tid >> 6, eg = lane >> 3, part = lane & 7;
  const int bid = bid_();
  const int x = bid & 7, xb = bid >> 3, ncb = ((int)gridDim.x + 7 - x) >> 3;
  const int sl = x >> 1, par = x & 1;
  const unsigned char* EVX = (const unsigned char*)(p.ws + OFF_EV) + (size_t)sl * (2 * MiB) + part * 16;
  const int* EIDX = (const int*)(p.ws + OFF_EIDX);
  const float* WGT = (const float*)(p.ws + OFF_WGT);
  const int tstep = ncb * NWAVE * 2;
  const int tfirst = (xb * NWAVE + wave) * 2 + par;
  const int pi = ((lane >> 5) & 1) * 4 + ((lane >> 4) & 1) * 2 + ((lane >> 3) & 1);
  const bool h5 = (lane & 32) != 0, h4 = (lane & 16) != 0, h3 = (lane & 8) != 0;
  int nea = 0, neb = 0;
  float nwa = 0.f, nwb = 0.f;
  if (tfirst < T) {
    nea = EIDX[(size_t)tfirst * 128 + lane]; neb = EIDX[(size_t)tfirst * 128 + 64 + lane];
    nwa = WGT[(size_t)tfirst * 128 + lane]; nwb = WGT[(size_t)tfirst * 128 + 64 + lane];
  }
  for (int t = tfirst; t < T; t += tstep) {
    const int ea = nea, eb = neb;
    const float wa = nwa, wb = nwb;
    u32x4 vv[16];
#pragma unroll
    for (int it = 0; it < 16; ++it) {
      const int src = (it * 8 + eg) & 63;
      const int e = __shfl((it < 8) ? ea : eb, src);
      vv[it] = *(const u32x4*)(EVX + (size_t)e * 128);
    }
    float4* op = (float4*)(p.out + (size_t)t * 1024 + sl * 256 + part * 32 + pi * 4);
    const float4 o = *op;
    {
      const int tn = t + tstep;
      if (tn < T) {
        nea = EIDX[(size_t)tn * 128 + lane]; neb = EIDX[(size_t)tn * 128 + 64 + lane];
        nwa = WGT[(size_t)tn * 128 + lane]; nwb = WGT[(size_t)tn * 128 + 64 + lane];
      }
    }
    f32x2 acc[16];
#pragma unroll
    for (int i = 0; i < 16; ++i) acc[i] = f32x2{0.f, 0.f};
#pragma unroll
    for (int it = 0; it < 16; ++it) {
      const int src = (it * 8 + eg) & 63;
      const float w = __shfl((it < 8) ? wa : wb, src);
      const f32x2 w2 = f32x2{w, w};
      acc[0] = __builtin_elementwise_fma(P4(vv[it].x, 0), w2, acc[0]);   acc[1] = __builtin_elementwise_fma(P4(vv[it].x, 1), w2, acc[1]);
      acc[2] = __builtin_elementwise_fma(P4(vv[it].x, 2), w2, acc[2]);   acc[3] = __builtin_elementwise_fma(P4(vv[it].x, 3), w2, acc[3]);
      acc[4] = __builtin_elementwise_fma(P4(vv[it].y, 0), w2, acc[4]);   acc[5] = __builtin_elementwise_fma(P4(vv[it].y, 1), w2, acc[5]);
      acc[6] = __builtin_elementwise_fma(P4(vv[it].y, 2), w2, acc[6]);   acc[7] = __builtin_elementwise_fma(P4(vv[it].y, 3), w2, acc[7]);
      acc[8] = __builtin_elementwise_fma(P4(vv[it].z, 0), w2, acc[8]);   acc[9] = __builtin_elementwise_fma(P4(vv[it].z, 1), w2, acc[9]);
      acc[10] = __builtin_elementwise_fma(P4(vv[it].z, 2), w2, acc[10]); acc[11] = __builtin_elementwise_fma(P4(vv[it].z, 3), w2, acc[11]);
      acc[12] = __builtin_elementwise_fma(P4(vv[it].w, 0), w2, acc[12]); acc[13] = __builtin_elementwise_fma(P4(vv[it].w, 1), w2, acc[13]);
      acc[14] = __builtin_elementwise_fma(P4(vv[it].w, 2), w2, acc[14]); acc[15] = __builtin_elementwise_fma(P4(vv[it].w, 3), w2, acc[15]);
    }
    f32x2 q1[8];
#pragma unroll
    for (int i = 0; i < 8; ++i) {
      const f32x2 sd = h5 ? acc[i] : acc[i + 8], kp = h5 ? acc[i + 8] : acc[i];
      q1[i] = f32x2{kp.x + __shfl_xor(sd.x, 32), kp.y + __shfl_xor(sd.y, 32)};
    }
    f32x2 q2[4];
#pragma unroll
    for (int i = 0; i < 4; ++i) {
      const f32x2 sd = h4 ? q1[i] : q1[i + 4], kp = h4 ? q1[i + 4] : q1[i];
      q2[i] = f32x2{kp.x + __shfl_xor(sd.x, 16), kp.y + __shfl_xor(sd.y, 16)};
    }
    f32x2 q3[2];
#pragma unroll
    for (int i = 0; i < 2; ++i) {
      const f32x2 sd = h3 ? q2[i] : q2[i + 2], kp = h3 ? q2[i + 2] : q2[i];
      q3[i] = f32x2{kp.x + __shfl_xor(sd.x, 8), kp.y + __shfl_xor(sd.y, 8)};
    }
    *op = make_float4(o.x + q3[0].x, o.y + q3[0].y, o.z + q3[1].x, o.w + q3[1].y);
  }
}

__device__ __forceinline__ void seam_barrier(unsigned* ctr, unsigned nblk) {
  __syncthreads();
  if (threadIdx.x == 0) {
    __builtin_amdgcn_fence(__ATOMIC_RELEASE, "agent");
    asm volatile("s_waitcnt vmcnt(0)" ::: "memory");
    __hip_atomic_fetch_add(ctr, 1u, __ATOMIC_RELAXED, __HIP_MEMORY_SCOPE_AGENT);
    while (__hip_atomic_load(ctr, __ATOMIC_RELAXED, __HIP_MEMORY_SCOPE_AGENT) < nblk) __builtin_amdgcn_s_sleep(2);
    __builtin_amdgcn_fence(__ATOMIC_ACQUIRE, "agent");
    asm volatile("s_waitcnt vmcnt(0)" ::: "memory");
  }
  __syncthreads();
}
#ifndef PMASK
#define PMASK 127
#endif
#define PROG 0x6543210ull
#define NPROG 9
__global__ void __launch_bounds__(NTHR, 2) mega(Params p, int ph_lo, int ph_hi) {
  extern __shared__ __attribute__((aligned(16))) char lds[];
  cg::grid_group grid = cg::this_grid();
#ifndef REP_PHASE
#define REP_PHASE -1
#endif
#define IN(k) (ph_lo <= (k) && (k) < ph_hi)
#define SEAM(k) do { if (IN(k) && IN((k) + 1)) { if ((k) == 0) grid.sync(); else seam_barrier((unsigned*)(p.ws + OFF_BAR) + (k) * 64, gridDim.x); } } while (0)
  if (IN(0)) { phase0(p, lds); if (REP_PHASE == 0) { grid.sync(); phase0(p, lds); } }
  SEAM(0);
  if (IN(1)) { phase1(p, lds); if (REP_PHASE == 1) { grid.sync(); phase1(p, lds); } }
  SEAM(1);
  if (IN(2)) { phase2(p, lds); if (REP_PHASE == 2) { grid.sync(); phase2(p, lds); } }
  SEAM(2);
  if (IN(3)) { phase3(p, lds); if (REP_PHASE == 3) { grid.sync(); phase3(p, lds); } }
  SEAM(3);
  if (IN(4)) { phase4(p, lds); if (REP_PHASE == 4) { grid.sync(); phase4(p, lds); } }
  SEAM(4);
  if (IN(5)) { phase5(p, lds); if (REP_PHASE == 5) { grid.sync(); phase5(p, lds); } }
  SEAM(5);
  if (IN(6)) { phase6a(p, lds); if (REP_PHASE == 6) { grid.sync(); phase6a(p, lds); } }
  SEAM(6);
  if (IN(7)) { phase6m(p, lds); if (REP_PHASE == 7) { grid.sync(); phase6m(p, lds); } }
  SEAM(7);
  if (IN(8)) phase6b(p, lds);
}

extern "C" void kernel_launch(void* const* d_in, const int* in_sizes, int n_in, void* d_out, int out_size, void* d_ws,
                              size_t ws_size, hipStream_t stream) {
  static int grid_blocks = 0;
  if (!grid_blocks) {
    int dev = 0, cus = 0, per_cu = 0;
    (void)hipGetDevice(&dev);
    (void)hipDeviceGetAttribute(&cus, hipDeviceAttributeMultiprocessorCount, dev);
    (void)hipFuncSetAttribute((const void*)mega, hipFuncAttributeMaxDynamicSharedMemorySize, LDS_BYTES);
    (void)hipOccupancyMaxActiveBlocksPerMultiprocessor(&per_cu, mega, NTHR, LDS_BYTES);
    if (per_cu > 1) per_cu = 1;
    grid_blocks = cus * per_cu;
  }
  Params p{};
  p.x = (const float*)d_in[0]; p.ln_mix_g = (const float*)d_in[1]; p.w_in = (const float*)d_in[2];
  p.gmlp_norm_g = (const float*)d_in[3]; p.gmlp_w_s = (const float*)d_in[4]; p.gmlp_b_s = (const float*)d_in[5];
  p.q_norm_g = (const float*)d_in[6]; p.k_norm_g = (const float*)d_in[7]; p.rel_bias = (const float*)d_in[8];
  p.w_out = (const float*)d_in[9]; p.ln_ffn_g = (const float*)d_in[10]; p.w_query = (const float*)d_in[11];
  p.sub_keys = (const float*)d_in[12]; p.peer_u = (const float*)d_in[13]; p.peer_v = (const float*)d_in[14];
  p.out = (float*)d_out; p.ws = (char*)d_ws;
#if FUSED
  int lo = 0, hi = NPROG;
  void* args[] = {&p, &lo, &hi};
  hipError_t e = hipLaunchCooperativeKernel((void*)mega, dim3(grid_blocks), dim3(NTHR), args, LDS_BYTES, stream);
  if (e != hipSuccess) fprintf(stderr, "cooperative launch failed: %s (grid %d)\n", hipGetErrorString(e), grid_blocks);
#else
  for (int ph = 0; ph < NPROG; ++ph) mega<<<dim3(grid_blocks), dim3(NTHR), LDS_BYTES, stream>>>(p, ph, ph + 1);
#endif
}
```

```cpp
#include <hip/hip_runtime.h>
#include <hip/hip_cooperative_groups.h>
#include <cstdio>
namespace cg = cooperative_groups;

#ifndef FUSED
#define FUSED 1
#endif

typedef unsigned short u16;
using bf16x8 = __attribute__((ext_vector_type(8))) short;
using s16x4 = __attribute__((ext_vector_type(4))) short;
using f32x4 = __attribute__((ext_vector_type(4))) float;
using bf16x2 = __attribute__((ext_vector_type(2))) __bf16;
using f32x2 = __attribute__((ext_vector_type(2))) float;
using u32x4 = __attribute__((ext_vector_type(4))) unsigned;
using u32x2 = __attribute__((ext_vector_type(2))) unsigned;

constexpr int T = 32768, DM = 1024, SEQ = 4096;
constexpr float EPS = 1e-6f;
constexpr size_t MiB = 1u << 20;
constexpr size_t OFF_XB = 0, OFF_WINT = 64 * MiB  , OFF_WB = 67 * MiB  , OFF_WOUTT = 69 * MiB, OFF_WQT = 71 * MiB, OFF_KEYS = 75 * MiB,
                 OFF_RS = 76 * MiB, OFF_VSS = 76 * MiB + 512 * 1024, OFF_EU = 77 * MiB, OFF_EV = 109 * MiB,
                 OFF_U = 141 * MiB, OFF_GVT = 173 * MiB, OFF_QK = 205 * MiB, OFF_VT = 269 * MiB, OFF_AB = 301 * MiB,
                 OFF_HB = 365 * MiB, OFF_PQ = 141 * MiB  , OFF_EIDX = 429 * MiB,
                 OFF_BEST = 445 * MiB, OFF_ESC = 461 * MiB  , OFF_WGT = 462 * MiB  , OFF_BAR = 480 * MiB  , OFF_PART = 141 * MiB  ;

struct Params {
  const float *x, *ln_mix_g, *w_in, *gmlp_norm_g, *gmlp_w_s, *gmlp_b_s, *q_norm_g, *k_norm_g, *rel_bias, *w_out,
      *ln_ffn_g, *w_query, *sub_keys, *peer_u, *peer_v;
  float* out;
  char* ws;
};

constexpr int LDS_BYTES = 131584;
constexpr int NTHR = 512, NWAVE = 8;
constexpr int LSTR = 144;
constexpr int OPER_BYTES = 128 * LSTR;

__device__ __forceinline__ u16 f2bf(float f) {
  unsigned u = __float_as_uint(f);
  u += 0x7fffu + ((u >> 16) & 1u);
  return (u16)(u >> 16);
}
__device__ __forceinline__ unsigned pack2(float lo, float hi) { return (unsigned)f2bf(lo) | ((unsigned)f2bf(hi) << 16); }
__device__ __forceinline__ float bf_lo(unsigned u) { return __uint_as_float(u << 16); }
__device__ __forceinline__ float bf_hi(unsigned u) { return __uint_as_float(u & 0xffff0000u); }
__device__ __forceinline__ float bf2f(u16 v) { return __uint_as_float(((unsigned)v) << 16); }
__device__ __forceinline__ float gelu_f(float x) {
  float z = 0.7978845608028654f * (x + 0.044715f * x * x * x);
  float e = __expf(2.f * z);
  float th = 1.f - 2.f / (1.f + e);
  return 0.5f * x * (1.f + th);
}
__device__ __forceinline__ float dot2(unsigned a, unsigned b, float acc) {
  return __builtin_amdgcn_fdot2_f32_bf16(__builtin_bit_cast(bf16x2, a), __builtin_bit_cast(bf16x2, b), acc, false);
}
__device__ __forceinline__ f32x4 mfma16(bf16x8 a, bf16x8 b, f32x4 c) {
  return __builtin_amdgcn_mfma_f32_16x16x32_bf16(a, b, c, 0, 0, 0);
}
__device__ __forceinline__ bf16x8 mk8(unsigned a, unsigned b, unsigned c, unsigned d) {
  uint4 u = make_uint4(a, b, c, d);
  return __builtin_bit_cast(bf16x8, u);
}
__device__ __forceinline__ unsigned pack4_fp8(float a, float b, float c, float d) {
  int r = 0;
  r = __builtin_amdgcn_cvt_pk_fp8_f32(a, b, r, false);
  r = __builtin_amdgcn_cvt_pk_fp8_f32(c, d, r, true);
  return (unsigned)r;
}
__device__ __forceinline__ unsigned q4(float xs, int i) {
  return (__float_as_uint(xs + 12582912.f) & 15u) << (4 * i);
}
__device__ __forceinline__ unsigned okey(float x) {
  unsigned u = __float_as_uint(x);
  return (u & 0x80000000u) ? ~u : (u | 0x80000000u);
}


__device__ __forceinline__ int tid_() { int t = threadIdx.x; asm volatile("" : "+v"(t)); return t; }
__device__ __forceinline__ int bid_() { int b = blockIdx.x; asm volatile("" : "+s"(b)); return b; }
namespace pg8 {
#define PG8_LAS __attribute__((address_space(3)))
typedef unsigned short bf16_t;
typedef short bf16x8 __attribute__((ext_vector_type(8)));
typedef float f32x4 __attribute__((ext_vector_type(4)));
typedef unsigned u32x4 __attribute__((ext_vector_type(4)));
constexpr int BM = 256, BK = 64, HALF = 128, HTB = HALF * BK * 2  , STAGE_BYTES = 8 * HTB, NXCD = 8, WGM = 8;

__host__ __device__ __forceinline__ int lds_byte(int r, int c) { const int st = (r >> 4) * 2 + (c >> 5), rr = r & 15, cc = c & 31, ob = rr * 64 + cc * 2; return st * 1024 + (ob ^ (((ob >> 9) & 1) << 5)); }
__host__ __device__ __forceinline__ void stage_rc(int b, int& R, int& C) { const int st = b / 1024, sb = b % 1024, swz = sb ^ (((sb >> 9) & 1) << 5); R = (st >> 1) * 16 + swz / 64; C = (st & 1) * 32 + (swz % 64) / 2; }
__host__ __device__ __forceinline__ int perm32(int rho) { const int n = rho >> 4, i = rho & 15; return 8 * (i >> 2) + 4 * n + (i & 3); }

struct Unit { int pm, pn; };
struct Gemm { const bf16_t* A; const bf16_t* Bt; int M, N, K; };

struct StaticOrder {
    int nM, nN, nwg, G, c;
    __host__ __device__ void init(int M, int N, int G_, int c_) { nM = M / BM; nN = N / BM; nwg = nM * nN; G = G_; c = c_; }
    __host__ __device__ bool next(int i, Unit& u) const {
        const long L = (long)i * G + c; if (L >= nwg) return false;
        int wgid = (int)L; { const int q = nwg / NXCD, r = nwg % NXCD, xcd = wgid % NXCD, off = wgid / NXCD; wgid = (xcd < r ? xcd * (q + 1) : r * (q + 1) + (xcd - r) * q) + off; }
        const int nig = WGM * nN, gid = wgid / nig, fm = gid * WGM, gsz = (nM - fm) < WGM ? (nM - fm) : WGM;
        u.pm = fm + ((wgid % nig) % gsz); u.pn = (wgid % nig) / gsz; return true;
    }
    __device__ __forceinline__ void a_ready(const Unit&) const {}
    __device__ __forceinline__ void done(const Unit&) const {}
};

__device__ __forceinline__ unsigned cvt_pk_bf16(float lo, float hi) { unsigned r; asm volatile("v_cvt_pk_bf16_f32 %0, %1, %2" : "=v"(r) : "v"(lo), "v"(hi)); return r; }
template <class Epi, class Sched, bool ALIGN_EPI = false, bool SP2 = false>
__device__ __forceinline__ void gemm_phase(PG8_LAS unsigned char* lds, const Gemm g, const Sched& S, const Epi& E) {
    const int tid = threadIdx.x, wid = __builtin_amdgcn_readfirstlane(tid >> 6), lane = tid & 63, wr = wid >> 2, wc = wid & 3, fr = lane & 15, fq = lane >> 4;
    const int K = g.K, nt = K / BK;
    unsigned voffA[2], voffB[2];
#pragma unroll
    for (int i = 0; i < 2; ++i) { int R, C; stage_rc(tid * 16 + i * 8192, R, C); const int Rb = Epi::PERM ? ((R & ~31) + perm32(R & 31)) : R;
        voffA[i] = (unsigned)(R * K + C) * 2u; voffB[i] = (unsigned)(Rb * K + C) * 2u; }
    const size_t kstep = (size_t)(BK * 2);
    const size_t hstep = (size_t)HALF * K * 2;
    const size_t tstep = 2 * hstep;
    const unsigned ldsw = (unsigned)wid * 1024u;
    const int aoff = lds_byte(wr * 64 + fr, fq * 8), boff = lds_byte(wc * 32 + fr, fq * 8);
#define PG8_SA(b, h) (((b) * 2 + (h)) * HTB)
#define PG8_SB(b, h) ((4 + (b) * 2 + (h)) * HTB)
#define PG8_STAGE(bufoff, gbase, voff) do { _Pragma("unroll") for (int _i = 0; _i < 2; ++_i) \
        __builtin_amdgcn_global_load_lds((const unsigned*)((const char*)(gbase) + (voff)[_i]), (PG8_LAS unsigned*)(lds + (bufoff) + ldsw + _i * 8192), 16, 0, 0); } while (0)
#define PG8_LDA(dst, b, h) do { _Pragma("unroll") for (int m = 0; m < 4; ++m) _Pragma("unroll") for (int k = 0; k < 2; ++k) dst[m][k] = *(const PG8_LAS bf16x8*)(lds + PG8_SA(b, h) + aoff + m * 2048 + k * 1024); } while (0)
#define PG8_LDB(dst, b, h) do { _Pragma("unroll") for (int n = 0; n < 2; ++n) _Pragma("unroll") for (int k = 0; k < 2; ++k) dst[n][k] = *(const PG8_LAS bf16x8*)(lds + PG8_SB(b, h) + boff + n * 2048 + k * 1024); } while (0)
#define PG8_MMA(ai, bj, At, Bt) do { __builtin_amdgcn_s_setprio(1); _Pragma("unroll") for (int m = 0; m < 4; ++m) _Pragma("unroll") for (int n = 0; n < 2; ++n) _Pragma("unroll") for (int k = 0; k < 2; ++k) \
        acc[ai][bj][m][n] = __builtin_amdgcn_mfma_f32_16x16x32_bf16(Bt[n][k], At[m][k], acc[ai][bj][m][n], 0, 0, 0); __builtin_amdgcn_s_setprio(0); } while (0)
#define PG8_WAIT_V(n) asm volatile("s_waitcnt vmcnt(" #n ")" ::: "memory")
#define PG8_WAIT_L(n) asm volatile("s_waitcnt lgkmcnt(" #n ")" ::: "memory")
#define PG8_BAR __builtin_amdgcn_s_barrier()
#define PG8_SCHED __builtin_amdgcn_sched_barrier(0)
    Unit cur, nxt; int ui = 0;
    if (!S.next(0, cur)) return;
    f32x4 acc[2][2][4][2];
#pragma unroll
    for (int a = 0; a < 2; ++a)
#pragma unroll
        for (int b = 0; b < 2; ++b)
#pragma unroll
            for (int m = 0; m < 4; ++m)
#pragma unroll
                for (int n = 0; n < 2; ++n) acc[a][b][m][n] = (f32x4){0.f, 0.f, 0.f, 0.f};
    bf16x8 At[4][2], B0[2][2], B1[2][2];
    const char* cA = (const char*)g.A + (size_t)cur.pm * tstep; const char* cB = (const char*)g.Bt + (size_t)cur.pn * tstep;
    S.a_ready(cur);
    if constexpr (SP2) {
        PG8_STAGE(PG8_SB(0, 0), cB, voffB); PG8_STAGE(PG8_SB(0, 1), cB + hstep, voffB); PG8_STAGE(PG8_SA(0, 0), cA, voffA); PG8_STAGE(PG8_SA(0, 1), cA + hstep, voffA);
        if (wr == 1) PG8_BAR;
        PG8_WAIT_V(2); PG8_BAR;
        PG8_STAGE(PG8_SB(1, 0), cB + kstep, voffB); PG8_STAGE(PG8_SA(1, 0), cA + kstep, voffA); PG8_STAGE(PG8_SB(1, 1), cB + hstep + kstep, voffB);
        PG8_WAIT_V(6); PG8_BAR;
    } else {
        PG8_STAGE(PG8_SB(0, 0), cB, voffB); PG8_STAGE(PG8_SA(0, 0), cA, voffA); PG8_STAGE(PG8_SB(0, 1), cB + hstep, voffB); PG8_STAGE(PG8_SA(0, 1), cA + hstep, voffA);
        if (wr == 1) PG8_BAR;
        PG8_WAIT_V(4); PG8_BAR;
        PG8_STAGE(PG8_SB(1, 0), cB + kstep, voffB); PG8_STAGE(PG8_SA(1, 0), cA + kstep, voffA); PG8_STAGE(PG8_SB(1, 1), cB + hstep + kstep, voffB);
        PG8_WAIT_V(6); PG8_BAR;
    }
    for (;;) {
        const bool has_next = S.next(ui + 1, nxt);
        const char* nA = has_next ? (const char*)g.A + (size_t)nxt.pm * tstep : cA; const char* nB = has_next ? (const char*)g.Bt + (size_t)nxt.pn * tstep : cB;
        for (int t = 0; t < nt; t += 2) {
            const bool last = (t == nt - 2);
            const char* a1 = cA + (size_t)(t + 1) * kstep;
            const char* a2 = last ? nA : cA + (size_t)(t + 2) * kstep; const char* b2 = last ? nB : cB + (size_t)(t + 2) * kstep;
            const char* a3 = a2 + kstep; const char* b3 = b2 + kstep;
            if (last && has_next) S.a_ready(nxt);
            if constexpr (SP2) {
            PG8_LDB(B0, 0, 0); PG8_LDB(B1, 0, 1); PG8_SCHED; PG8_LDA(At, 0, 0); PG8_STAGE(PG8_SA(1, 1), a1 + hstep, voffA);
            PG8_WAIT_V(8); PG8_WAIT_L(0); PG8_BAR; PG8_MMA(0, 0, At, B0); PG8_MMA(0, 1, At, B1); PG8_BAR; PG8_SCHED;
            PG8_LDA(At, 0, 1); PG8_STAGE(PG8_SB(0, 0), b2, voffB); PG8_STAGE(PG8_SB(0, 1), b2 + hstep, voffB); PG8_STAGE(PG8_SA(0, 0), a2, voffA);
            PG8_WAIT_V(8); PG8_WAIT_L(0); PG8_BAR; PG8_MMA(1, 0, At, B0); PG8_MMA(1, 1, At, B1); PG8_BAR; PG8_SCHED;
            PG8_LDB(B0, 1, 0); PG8_LDB(B1, 1, 1); PG8_SCHED; PG8_LDA(At, 1, 0); PG8_STAGE(PG8_SA(0, 1), a2 + hstep, voffA);
            PG8_WAIT_V(8); PG8_WAIT_L(0); PG8_BAR; PG8_MMA(0, 0, At, B0); PG8_MMA(0, 1, At, B1); PG8_BAR; PG8_SCHED;
            PG8_LDA(At, 1, 1); PG8_STAGE(PG8_SB(1, 0), b3, voffB); PG8_STAGE(PG8_SB(1, 1), b3 + hstep, voffB); PG8_STAGE(PG8_SA(1, 0), a3, voffA);
            PG8_WAIT_V(8); PG8_WAIT_L(0); PG8_BAR; PG8_MMA(1, 0, At, B0); PG8_MMA(1, 1, At, B1); PG8_BAR; PG8_SCHED;
            } else {
            PG8_LDB(B0, 0, 0); PG8_SCHED; PG8_LDA(At, 0, 0); PG8_STAGE(PG8_SA(1, 1), a1 + hstep, voffA);
            PG8_WAIT_L(8); PG8_BAR; PG8_WAIT_L(0); PG8_MMA(0, 0, At, B0); PG8_BAR; PG8_SCHED;
            PG8_LDB(B1, 0, 1); PG8_STAGE(PG8_SB(0, 0), b2, voffB);
            PG8_BAR; PG8_WAIT_L(0); PG8_MMA(0, 1, At, B1); PG8_BAR;
            PG8_LDA(At, 0, 1); PG8_STAGE(PG8_SA(0, 0), a2, voffA);
            PG8_BAR; PG8_WAIT_L(0); PG8_MMA(1, 0, At, B0); PG8_BAR; PG8_SCHED;
            PG8_STAGE(PG8_SB(0, 1), b2 + hstep, voffB);
            PG8_WAIT_V(6); PG8_BAR; PG8_MMA(1, 1, At, B1); PG8_BAR;
            PG8_LDB(B0, 1, 0); PG8_SCHED; PG8_LDA(At, 1, 0); PG8_STAGE(PG8_SA(0, 1), a2 + hstep, voffA);
            PG8_WAIT_L(8); PG8_BAR; PG8_WAIT_L(0); PG8_MMA(0, 0, At, B0); PG8_BAR; PG8_SCHED;
            PG8_LDB(B1, 1, 1); PG8_STAGE(PG8_SB(1, 0), b3, voffB);
            PG8_BAR; PG8_WAIT_L(0); PG8_MMA(0, 1, At, B1); PG8_BAR;
            PG8_LDA(At, 1, 1); PG8_STAGE(PG8_SA(1, 0), a3, voffA);
            PG8_BAR; PG8_WAIT_L(0); PG8_MMA(1, 0, At, B0); PG8_BAR; PG8_SCHED;
            PG8_STAGE(PG8_SB(1, 1), b3 + hstep, voffB);
            PG8_WAIT_V(6); PG8_BAR; PG8_MMA(1, 1, At, B1); PG8_BAR;
            }
        }
        if constexpr (ALIGN_EPI) { if (wr == 0) PG8_BAR; }
        if constexpr (!Epi::AFTER_DRAIN) { E(acc, cur, wr, wc, fr, fq); S.done(cur); }
        if (!has_next) break;
#pragma unroll
        for (int a = 0; a < 2; ++a)
#pragma unroll
            for (int b = 0; b < 2; ++b)
#pragma unroll
                for (int m = 0; m < 4; ++m)
#pragma unroll
                    for (int n = 0; n < 2; ++n) acc[a][b][m][n] = (f32x4){0.f, 0.f, 0.f, 0.f};
        cur = nxt; cA = nA; cB = nB; ++ui;
        if constexpr (ALIGN_EPI) { if (wr == 1) PG8_BAR; }
    }
    PG8_WAIT_V(0);
    if constexpr (!ALIGN_EPI) { if (wr == 0) PG8_BAR; }
    PG8_BAR;
    if constexpr (Epi::AFTER_DRAIN) { E.fused(acc, cur, wr, wc, fr, fq, lds, wid, lane); S.done(cur); }
#undef PG8_SA
#undef PG8_SB
#undef PG8_STAGE
#undef PG8_LDA
#undef PG8_LDB
#undef PG8_MMA
#undef PG8_WAIT_V
#undef PG8_WAIT_L
#undef PG8_BAR
#undef PG8_SCHED
}
}

#define EPI_V8(v, A, s) float v[8] = {A[0][0] * (s), A[0][1] * (s), A[0][2] * (s), A[0][3] * (s), A[1][0] * (s), A[1][1] * (s), A[1][2] * (s), A[1][3] * (s)}
__device__ __forceinline__ uint4 pk8(const float (&v)[8]) {
  return make_uint4(pg8::cvt_pk_bf16(v[0], v[1]), pg8::cvt_pk_bf16(v[2], v[3]), pg8::cvt_pk_bf16(v[4], v[5]), pg8::cvt_pk_bf16(v[6], v[7]));
}
struct EpiIn {
  static constexpr bool PERM = true, AFTER_DRAIN = false;
  u16* U; u16* QK; const float* RS;
  __device__ __forceinline__ void operator()(const pg8::f32x4 (&acc)[2][2][4][2], const pg8::Unit& u, int wr, int wc, int fr, int fq) const {
    const int row0 = u.pm * 256 + wr * 64 + fr, colt = u.pn * 256, c0 = colt + wc * 32 + 8 * fq;
    const bool isu = colt < 512;
#pragma unroll
    for (int ai = 0; ai < 2; ++ai)
#pragma unroll
      for (int m = 0; m < 4; ++m) {
        const int row = row0 + ai * 128 + m * 16;
        const float r = RS[row];
#pragma unroll
        for (int bj = 0; bj < 2; ++bj) {
          const int col = c0 + bj * 128;
          EPI_V8(v, acc[ai][bj][m], r);
          if (isu) {
#pragma unroll
            for (int j = 0; j < 8; ++j) v[j] = gelu_f(v[j]);
            *(uint4*)(U + (size_t)row * 512 + col) = pk8(v);
          } else {
            *(uint4*)(QK + (size_t)row * 1024 + (col - 512)) = pk8(v);
          }
        }
      }
  }
};
struct EpiInT {
  static constexpr bool PERM = true, AFTER_DRAIN = false;
  u16* GVT; u16* VT; const float* RS; float* VSS;
  __device__ __forceinline__ void operator()(const pg8::f32x4 (&acc)[2][2][4][2], const pg8::Unit& u, int wr, int wc, int fr, int fq) const {
    const int ch0 = u.pm * 256 + wr * 64 + fr, t0 = u.pn * 256 + wc * 32 + 8 * fq;
    const bool isg = u.pm < 2;
#pragma unroll
    for (int bj = 0; bj < 2; ++bj) {
      const int t = t0 + bj * 128, b = t >> 12, s = t & 4095;
      const float4 ra = *(const float4*)(RS + t), rb = *(const float4*)(RS + t + 4);
      const float rr[8] = {ra.x, ra.y, ra.z, ra.w, rb.x, rb.y, rb.z, rb.w};
      float ss[8] = {0.f, 0.f, 0.f, 0.f, 0.f, 0.f, 0.f, 0.f};
#pragma unroll
      for (int ai = 0; ai < 2; ++ai)
#pragma unroll
        for (int m = 0; m < 4; ++m) {
          const int ch = ch0 + ai * 128 + m * 16;
          float v[8];
#pragma unroll
          for (int j = 0; j < 8; ++j) v[j] = acc[ai][bj][m][j >> 2][j & 3] * rr[j];
          if (isg) {
#pragma unroll
            for (int j = 0; j < 8; ++j) { v[j] = gelu_f(v[j]); ss[j] += v[j] * v[j]; }
            *(uint4*)(GVT + ((size_t)b * 512 + ch) * SEQ + s) = pk8(v);
          } else {
            *(uint4*)(VT + ((size_t)b * 512 + (ch - 512)) * SEQ + s) = pk8(v);
          }
        }
      if (isg) {
#pragma unroll
        for (int j = 0; j < 8; ++j) {
          float sv = ss[j];
          sv += __shfl_xor(sv, 1); sv += __shfl_xor(sv, 2); sv += __shfl_xor(sv, 4); sv += __shfl_xor(sv, 8);
          if (fr == 0) atomicAdd(VSS + t + j, sv);
        }
      }
    }
  }
};
struct EpiOut {
  static constexpr bool PERM = true, AFTER_DRAIN = false;
  const float* X; float* OUT; u16* HB;
  __device__ __forceinline__ void operator()(const pg8::f32x4 (&acc)[2][2][4][2], const pg8::Unit& u, int wr, int wc, int fr, int fq) const {
    const int row0 = u.pm * 256 + wr * 64 + fr, c0 = u.pn * 256 + wc * 32 + 8 * fq;
#pragma unroll
    for (int ai = 0; ai < 2; ++ai)
#pragma unroll
      for (int m = 0; m < 4; ++m) {
        const int row = row0 + ai * 128 + m * 16;
#pragma unroll
        for (int bj = 0; bj < 2; ++bj) {
          const size_t idx = (size_t)row * 1024 + c0 + bj * 128;
          const float4 xa = *(const float4*)(X + idx), xb = *(const float4*)(X + idx + 4);
          float v[8] = {xa.x + acc[ai][bj][m][0][0], xa.y + acc[ai][bj][m][0][1], xa.z + acc[ai][bj][m][0][2], xa.w + acc[ai][bj][m][0][3],
                        xb.x + acc[ai][bj][m][1][0], xb.y + acc[ai][bj][m][1][1], xb.z + acc[ai][bj][m][1][2], xb.w + acc[ai][bj][m][1][3]};
          *(uint4*)(HB + idx) = pk8(v);
        }
      }
  }
};
struct EpiQ {
  static constexpr bool PERM = true, AFTER_DRAIN = false;
  u16* PQ;
  __device__ __forceinline__ void operator()(const pg8::f32x4 (&acc)[2][2][4][2], const pg8::Unit& u, int wr, int wc, int fr, int fq) const {
    const int row0 = u.pm * 256 + wr * 64 + fr, c0 = u.pn * 256 + wc * 32 + 8 * fq;
#pragma unroll
    for (int ai = 0; ai < 2; ++ai)
#pragma unroll
      for (int m = 0; m < 4; ++m) {
        const int row = row0 + ai * 128 + m * 16;
#pragma unroll
        for (int bj = 0; bj < 2; ++bj) {
          EPI_V8(v, acc[ai][bj][m], 1.f);
          *(uint4*)(PQ + (size_t)row * 2048 + c0 + bj * 128) = pk8(v);
        }
      }
  }
};
#define LDS3(p) ((__attribute__((address_space(3))) unsigned char*)(p))

__device__ __forceinline__ void phase0(const Params& p, char* lds) {
  const int tid = tid_(), lane = tid & 63, wave = tid >> 6;
  const int nblk = gridDim.x, blk = bid_();
  u16* XB = (u16*)(p.ws + OFF_XB);
  float* RS = (float*)(p.ws + OFF_RS);
  float* VSS = (float*)(p.ws + OFF_VSS);
  for (int row0 = (blk * NWAVE + wave) * 2; row0 < T; row0 += nblk * NWAVE * 2) {
    float4 v[2][4];
#pragma unroll
    for (int r = 0; r < 2; ++r) {
      const float4* xr = (const float4*)(p.x + (size_t)(row0 + r) * DM);
#pragma unroll
      for (int j = 0; j < 2; ++j) { v[r][2 * j] = xr[j * 128 + lane * 2]; v[r][2 * j + 1] = xr[j * 128 + lane * 2 + 1]; }
    }
#pragma unroll
    for (int r = 0; r < 2; ++r) {
      float ss = 0.f;
#pragma unroll
      for (int i = 0; i < 4; ++i) ss += v[r][i].x * v[r][i].x + v[r][i].y * v[r][i].y + v[r][i].z * v[r][i].z + v[r][i].w * v[r][i].w;
#pragma unroll
      for (int o = 1; o < 64; o <<= 1) ss += __shfl_xor(ss, o);
      if (lane == 0) RS[row0 + r] = rsqrtf(ss * (1.f / 1024.f) + EPS);
#pragma unroll
      for (int j = 0; j < 2; ++j)
        *(uint4*)(XB + (size_t)(row0 + r) * DM + j * 512 + lane * 8) =
            make_uint4(pg8::cvt_pk_bf16(v[r][2 * j].x, v[r][2 * j].y), pg8::cvt_pk_bf16(v[r][2 * j].z, v[r][2 * j].w),
                       pg8::cvt_pk_bf16(v[r][2 * j + 1].x, v[r][2 * j + 1].y), pg8::cvt_pk_bf16(v[r][2 * j + 1].z, v[r][2 * j + 1].w));
    }
  }
  {
    unsigned char* EU4 = (unsigned char*)(p.ws + OFF_EU);
    unsigned char* EV4 = (unsigned char*)(p.ws + OFF_EV);
    float* ESC = (float*)(p.ws + OFF_ESC);
    float4 g4[2][2];
#pragma unroll
    for (int j = 0; j < 2; ++j)
#pragma unroll
      for (int q = 0; q < 2; ++q) g4[j][q] = ((const float4*)p.ln_ffn_g)[j * 128 + lane * 2 + q];
    for (int row0 = (blk * NWAVE + wave) * 2; row0 < 32768; row0 += nblk * NWAVE * 2) {
      const bool isv = row0 >= 16384;
      float4 v[2][2][2];
#pragma unroll
      for (int r = 0; r < 2; ++r) {
        const float4* src = (const float4*)((isv ? p.peer_v : p.peer_u) + (size_t)((row0 + r) & 16383) * 1024);
#pragma unroll
        for (int j = 0; j < 2; ++j)
#pragma unroll
          for (int q = 0; q < 2; ++q) v[r][j][q] = src[j * 128 + lane * 2 + q];
      }
#pragma unroll
      for (int r = 0; r < 2; ++r) {
        const int e = (row0 + r) & 16383;
        float am = 0.f;
#pragma unroll
        for (int j = 0; j < 2; ++j)
#pragma unroll
          for (int q = 0; q < 2; ++q) {
            float4 t4 = v[r][j][q];
            if (!isv) { t4.x *= g4[j][q].x; t4.y *= g4[j][q].y; t4.z *= g4[j][q].z; t4.w *= g4[j][q].w; }
            am = fmaxf(am, fmaxf(fmaxf(fabsf(t4.x), fabsf(t4.y)), fmaxf(fabsf(t4.z), fabsf(t4.w))));
            v[r][j][q] = t4;
          }
#pragma unroll
        for (int o = 1; o < 64; o <<= 1) am = fmaxf(am, __shfl_xor(am, o));
        const bool ok = (am > 1e-30f);
        const float qmax = isv ? 6.0f : 7.0f;
        const float scale = ok ? qmax / am : 1.f;
        const float inv = ok ? am / qmax : 1.f;
        unsigned char* dst = (isv ? EV4 : EU4) + (size_t)e * 128 + (lane & 31) * 4;
#pragma unroll
        for (int j = 0; j < 2; ++j) {
          unsigned w = 0;
          if (isv) {
            w = __builtin_amdgcn_cvt_scalef32_pk_fp4_f32(w, v[r][j][0].x * scale, v[r][j][0].y * scale, 1.0f, 0);
            w = __builtin_amdgcn_cvt_scalef32_pk_fp4_f32(w, v[r][j][0].z * scale, v[r][j][0].w * scale, 1.0f, 1);
            w = __builtin_amdgcn_cvt_scalef32_pk_fp4_f32(w, v[r][j][1].x * scale, v[r][j][1].y * scale, 1.0f, 2);
            w = __builtin_amdgcn_cvt_scalef32_pk_fp4_f32(w, v[r][j][1].z * scale, v[r][j][1].w * scale, 1.0f, 3);
          } else {
            w = q4(v[r][j][0].x * scale, 0) | q4(v[r][j][0].y * scale, 1) | q4(v[r][j][0].z * scale, 2) | q4(v[r][j][0].w * scale, 3) |
                q4(v[r][j][1].x * scale, 4) | q4(v[r][j][1].y * scale, 5) | q4(v[r][j][1].z * scale, 6) | q4(v[r][j][1].w * scale, 7);
          }
          *(unsigned*)(dst + (size_t)(j * 2 + (lane >> 5)) * (2 * MiB)) = w;
        }
        if (lane == 0) ESC[row0 + r] = inv;
      }
    }
  }
  {
    const int half = wave >> 2, w4 = wave & 3;
    float* tile = (float*)lds + half * (64 * 65);
    for (int tp = blk; tp < 704; tp += nblk) {
      const int tl = tp * 2 + half;
      const float* W; const float* gain; u16* dst; int N, kt, nt, drow;
      if (tl < 640) {
        W = p.w_in; gain = p.ln_mix_g; N = 2560; kt = tl / 40; nt = tl % 40;
        const int n0 = nt * 64;
        if (n0 < 512) { dst = (u16*)(p.ws + OFF_WINT); drow = n0; }
        else if (n0 < 1024) { dst = (u16*)(p.ws + OFF_WB); drow = n0 - 512; }
        else if (n0 < 2048) { dst = (u16*)(p.ws + OFF_WINT); drow = n0 - 512; }
        else { dst = (u16*)(p.ws + OFF_WB); drow = n0 - 2048 + 512; }
      } else if (tl < 896) { int t2 = tl - 640; W = p.w_out; gain = nullptr; dst = (u16*)(p.ws + OFF_WOUTT); N = 1024; kt = t2 / 16; nt = t2 % 16; drow = nt * 64; }
      else { int t2 = tl - 896; W = p.w_query; gain = p.ln_ffn_g; dst = (u16*)(p.ws + OFF_WQT); N = 2048; kt = t2 / 32; nt = t2 % 32; drow = nt * 64; }
      __syncthreads();
#pragma unroll 4
      for (int i = 0; i < 16; ++i) {
        const int kk = i * 4 + w4;
        const float gk = gain ? gain[kt * 64 + kk] : 1.f;
        tile[kk * 65 + lane] = W[(size_t)(kt * 64 + kk) * N + nt * 64 + lane] * gk;
      }
      __syncthreads();
#pragma unroll 4
      for (int i = 0; i < 16; ++i) {
        const int nn = i * 4 + w4;
        dst[(size_t)(drow + nn) * 1024 + kt * 64 + lane] = f2bf(tile[lane * 65 + nn]);
      }
    }
    __syncthreads();
  }
  {
    u16* KEYS = (u16*)(p.ws + OFF_KEYS);
    for (int i = blk * NTHR + tid; i < 262144 / 4; i += nblk * NTHR) {
      float4 a = ((const float4*)p.sub_keys)[i];
      *(uint2*)(KEYS + (size_t)i * 4) = make_uint2(pack2(a.x, a.y), pack2(a.z, a.w));
    }
  }
  for (int i = blk * NTHR + tid; i < T; i += nblk * NTHR) VSS[i] = 0.f;
  if (blk == 0 && tid < 16) ((unsigned*)(p.ws + OFF_BAR))[tid * 64] = 0u;
}

__device__ __forceinline__ void phase1(const Params& p, char* lds) {
  const u16* XB = (const u16*)(p.ws + OFF_XB);
  const float* RS = (const float*)(p.ws + OFF_RS);
  {
    pg8::Gemm g{XB, (const u16*)(p.ws + OFF_WINT), T, 1536, 1024};
    pg8::StaticOrder S; S.init(T, 1536, (int)gridDim.x, (int)blockIdx.x);
    EpiIn E{(u16*)(p.ws + OFF_U), (u16*)(p.ws + OFF_QK), RS};
    pg8::gemm_phase<EpiIn, pg8::StaticOrder, true, true>(LDS3(lds), g, S, E);
  }
  {
    pg8::Gemm g{(const u16*)(p.ws + OFF_WB), XB, 1024, T, 1024};
    pg8::StaticOrder S; S.init(1024, T, (int)gridDim.x, (int)blockIdx.x);
    EpiInT E{(u16*)(p.ws + OFF_GVT), (u16*)(p.ws + OFF_VT), RS, (float*)(p.ws + OFF_VSS)};
    pg8::gemm_phase<EpiInT, pg8::StaticOrder, true, true>(LDS3(lds), g, S, E);
  }
}

__device__ __forceinline__ void gmlp_item(const Params& p, int item) {
  const int tid = tid_() & 255, lane = tid & 63, wave = tid >> 6, l15 = lane & 15, g = lane >> 4;
  const int gr = item & 7, n = (item >> 3) & 31, b = item >> 8;
  const int t0 = b * SEQ + n * 128;
  const float* VSS = (const float*)(p.ws + OFF_VSS);
  const u16* GVT = (const u16*)(p.ws + OFF_GVT);
  const u16* U = (const u16*)(p.ws + OFF_U);
  u16* AB = (u16*)(p.ws + OFF_AB);
  f32x4 acc[2][4];
#pragma unroll
  for (int i = 0; i < 2; ++i)
#pragma unroll
    for (int j = 0; j < 4; ++j) acc[i][j] = f32x4{0.f, 0.f, 0.f, 0.f};
  const int i_base = wave * 32;
  const bool low = wave < 2;
#pragma unroll
  for (int ks = 0; ks < 4; ++ks) {
    if (ks >= 2 && low) continue;
    const int j0 = ks * 32 + g * 8;
    const float4 s0 = *(const float4*)(VSS + t0 + j0), s1 = *(const float4*)(VSS + t0 + j0 + 4);
    float r[8] = {s0.x, s0.y, s0.z, s0.w, s1.x, s1.y, s1.z, s1.w};
#pragma unroll
    for (int q = 0; q < 8; ++q) r[q] = rsqrtf(r[q] * (1.f / 512.f) + EPS);
    bf16x8 wf[2];
#pragma unroll
    for (int mi = 0; mi < 2; ++mi) {
      const int i = i_base + mi * 16 + l15;
      const float* wp = p.gmlp_w_s + ((size_t)(gr * 128 + i)) * 128 + j0;
      const float4 w0 = *(const float4*)wp, w1 = *(const float4*)(wp + 4);
      wf[mi] = mk8(pack2(w0.x * r[0], w0.y * r[1]), pack2(w0.z * r[2], w0.w * r[3]), pack2(w1.x * r[4], w1.y * r[5]),
                   pack2(w1.z * r[6], w1.w * r[7]));
    }
#pragma unroll
    for (int ni = 0; ni < 4; ++ni) {
      const int c = ni * 16 + l15;
      const bf16x8 gf = *(const bf16x8*)(GVT + ((size_t)b * 512 + gr * 64 + c) * SEQ + n * 128 + j0);
#pragma unroll
      for (int mi = 0; mi < 2; ++mi) acc[mi][ni] = mfma16(gf, wf[mi], acc[mi][ni]);
    }
  }
#pragma unroll
  for (int mi = 0; mi < 2; ++mi) {
    const int i = i_base + mi * 16 + l15;
    const size_t t = (size_t)t0 + i;
    const float bs = p.gmlp_b_s[gr * 128 + i];
#pragma unroll
    for (int ni = 0; ni < 4; ++ni) {
      const int ch = gr * 64 + ni * 16 + g * 4;
      const float4 ng = *(const float4*)(p.gmlp_norm_g + ch);
      const uint2 uu = *(const uint2*)(U + t * 512 + ch);
      const float o0 = bf_lo(uu.x) * (acc[mi][ni][0] * ng.x + bs), o1 = bf_hi(uu.x) * (acc[mi][ni][1] * ng.y + bs);
      const float o2 = bf_lo(uu.y) * (acc[mi][ni][2] * ng.z + bs), o3 = bf_hi(uu.y) * (acc[mi][ni][3] * ng.w + bs);
      *(uint2*)(AB + t * 1024 + ch) = make_uint2(pack2(o0, o1), pack2(o2, o3));
    }
  }
}

constexpr int ATT_BUF = 2 * 64 * LSTR + 256;
constexpr float LOG2E = 1.4426950408889634f;
__device__ __forceinline__ void attn_item(const Params& p, int item, char* lds) {
  const int tid = tid_() & 255, lane = tid & 63, wave = tid >> 6, l15 = lane & 15, g = lane >> 4;
  const int c = item & 63, h = (item >> 6) & 7, b = item >> 9;
  const u16* QK = (const u16*)(p.ws + OFF_QK);
  const u16* VT = (const u16*)(p.ws + OFF_VT);
  u16* AB = (u16*)(p.ws + OFF_AB);
  float* bias_s = (float*)(lds + 2 * ATT_BUF);
  __syncthreads();
  for (int i = tid; i < 257; i += 256) bias_s[i] = p.rel_bias[h * 257 + i] * LOG2E;
  const size_t tq = (size_t)b * SEQ + c * 64 + wave * 16 + l15;
  bf16x8 qb0, qb1;
  {
    const u16* qp = QK + tq * 1024 + h * 64 + g * 8;
    const uint4 q0 = *(const uint4*)qp, q1 = *(const uint4*)(qp + 32);
    float f[16] = {bf_lo(q0.x), bf_hi(q0.x), bf_lo(q0.y), bf_hi(q0.y), bf_lo(q0.z), bf_hi(q0.z), bf_lo(q0.w), bf_hi(q0.w),
                   bf_lo(q1.x), bf_hi(q1.x), bf_lo(q1.y), bf_hi(q1.y), bf_lo(q1.z), bf_hi(q1.z), bf_lo(q1.w), bf_hi(q1.w)};
    float ss = 0.f;
#pragma unroll
    for (int i = 0; i < 16; ++i) ss += f[i] * f[i];
    ss += __shfl_xor(ss, 16); ss += __shfl_xor(ss, 32);
    const float rq = rsqrtf(ss * (1.f / 64.f) + EPS) * (0.125f * LOG2E);
    const float4 ga = *(const float4*)(p.q_norm_g + g * 8), gb = *(const float4*)(p.q_norm_g + g * 8 + 4);
    const float4 gc = *(const float4*)(p.q_norm_g + 32 + g * 8), gd = *(const float4*)(p.q_norm_g + 32 + g * 8 + 4);
    const float4 ka = *(const float4*)(p.k_norm_g + g * 8), kb = *(const float4*)(p.k_norm_g + g * 8 + 4);
    const float4 kc4 = *(const float4*)(p.k_norm_g + 32 + g * 8), kd = *(const float4*)(p.k_norm_g + 32 + g * 8 + 4);
    const float gg[16] = {ga.x * ka.x, ga.y * ka.y, ga.z * ka.z, ga.w * ka.w, gb.x * kb.x, gb.y * kb.y, gb.z * kb.z, gb.w * kb.w,
                          gc.x * kc4.x, gc.y * kc4.y, gc.z * kc4.z, gc.w * kc4.w, gd.x * kd.x, gd.y * kd.y, gd.z * kd.z, gd.w * kd.w};
#pragma unroll
    for (int i = 0; i < 16; ++i) f[i] *= rq * gg[i];
    qb0 = mk8(pg8::cvt_pk_bf16(f[0], f[1]), pg8::cvt_pk_bf16(f[2], f[3]), pg8::cvt_pk_bf16(f[4], f[5]), pg8::cvt_pk_bf16(f[6], f[7]));
    qb1 = mk8(pg8::cvt_pk_bf16(f[8], f[9]), pg8::cvt_pk_bf16(f[10], f[11]), pg8::cvt_pk_bf16(f[12], f[13]), pg8::cvt_pk_bf16(f[14], f[15]));
  }
  f32x4 o[4];
#pragma unroll
  for (int i = 0; i < 4; ++i) o[i] = f32x4{0.f, 0.f, 0.f, 0.f};
  float m_run = -1e30f, l_run = 0.f;
  const int srow = tid >> 2, spart = tid & 3;
  const int kc_lo = (c >= 8) ? 0 : (8 - c);
  const u16* kbase = QK + ((size_t)b * SEQ + srow) * 1024 + 512 + h * 64 + spart * 16;
  const u16* vbase = VT + ((size_t)b * 512 + h * 64 + srow) * SEQ + spart * 16;
  uint4 k0, k1, v0, v1;
  {
    const int kchunk = c - 8 + kc_lo;
    const u16* kp = kbase + (size_t)kchunk * 64 * 1024;
    k0 = *(const uint4*)kp; k1 = *(const uint4*)(kp + 8);
    const u16* vp = vbase + kchunk * 64;
    v0 = *(const uint4*)vp; v1 = *(const uint4*)(vp + 8);
  }
  for (int kc = kc_lo; kc <= 8; ++kc) {
    char* Ks = lds + ((kc - kc_lo) & 1) * ATT_BUF;
    char* Vs = Ks + 64 * LSTR;
    float* rks = (float*)(Ks + 2 * 64 * LSTR);
    {
      float ss = 0.f;
      ss = dot2(k0.x, k0.x, ss); ss = dot2(k0.y, k0.y, ss); ss = dot2(k0.z, k0.z, ss); ss = dot2(k0.w, k0.w, ss);
      ss = dot2(k1.x, k1.x, ss); ss = dot2(k1.y, k1.y, ss); ss = dot2(k1.z, k1.z, ss); ss = dot2(k1.w, k1.w, ss);
      ss += __shfl_xor(ss, 1); ss += __shfl_xor(ss, 2);
      if (spart == 0) rks[srow] = rsqrtf(ss * (1.f / 64.f) + EPS);
      char* kd = Ks + srow * LSTR + spart * 32;
      *(uint4*)kd = k0;
      *(uint4*)(kd + 16) = k1;
      char* vd = Vs + srow * LSTR + spart * 32;
      *(uint4*)vd = v0;
      *(uint4*)(vd + 16) = v1;
    }
    __syncthreads();
    if (kc < 8) {
      const int kchunk = c - 8 + kc + 1;
      const u16* kp = kbase + (size_t)kchunk * 64 * 1024;
      k0 = *(const uint4*)kp; k1 = *(const uint4*)(kp + 8);
      const u16* vp = vbase + kchunk * 64;
      v0 = *(const uint4*)vp; v1 = *(const uint4*)(vp + 8);
    }
    f32x4 s[4];
#pragma unroll
    for (int mt = 0; mt < 4; ++mt) {
      const char* kr = Ks + (mt * 16 + l15) * LSTR + g * 16;
      const bf16x8 a0 = *(const bf16x8*)kr, a1 = *(const bf16x8*)(kr + 64);
      s[mt] = mfma16(a0, qb0, f32x4{0.f, 0.f, 0.f, 0.f});
      s[mt] = mfma16(a1, qb1, s[mt]);
    }
    if (kc <= 5) {
      const float bc = bias_s[256];
#pragma unroll
      for (int mt = 0; mt < 4; ++mt) {
        const float4 rk4 = *(const float4*)(rks + mt * 16 + g * 4);
        s[mt][0] = s[mt][0] * rk4.x + bc; s[mt][1] = s[mt][1] * rk4.y + bc;
        s[mt][2] = s[mt][2] * rk4.z + bc; s[mt][3] = s[mt][3] * rk4.w + bc;
      }
    } else {
      const int qi = wave * 16 + l15 + 64 * (8 - kc);
#pragma unroll
      for (int mt = 0; mt < 4; ++mt) {
        const float4 rk4 = *(const float4*)(rks + mt * 16 + g * 4);
        const float rr[4] = {rk4.x, rk4.y, rk4.z, rk4.w};
#pragma unroll
        for (int j = 0; j < 4; ++j) {
          int rel = qi - (mt * 16 + g * 4 + j);
          rel = rel > 128 ? 128 : rel;
          s[mt][j] = s[mt][j] * rr[j] + bias_s[rel + 128];
        }
      }
    }
    float mx = s[0][0];
#pragma unroll
    for (int mt = 0; mt < 4; ++mt)
#pragma unroll
      for (int j = 0; j < 4; ++j) mx = fmaxf(mx, s[mt][j]);
    mx = fmaxf(mx, __shfl_xor(mx, 16));
    mx = fmaxf(mx, __shfl_xor(mx, 32));
    const float m_new = fmaxf(m_run, mx);
    const float alpha = __builtin_amdgcn_exp2f(m_run - m_new);
    m_run = m_new;
    float ls = 0.f;
#pragma unroll
    for (int mt = 0; mt < 4; ++mt)
#pragma unroll
      for (int j = 0; j < 4; ++j) { s[mt][j] = __builtin_amdgcn_exp2f(s[mt][j] - m_new); ls += s[mt][j]; }
    l_run = l_run * alpha + ls;
#pragma unroll
    for (int mt = 0; mt < 4; ++mt)
#pragma unroll
      for (int j = 0; j < 4; ++j) o[mt][j] *= alpha;
#pragma unroll
    for (int k2 = 0; k2 < 2; ++k2) {
      const bf16x8 pb = mk8(pg8::cvt_pk_bf16(s[2 * k2][0], s[2 * k2][1]), pg8::cvt_pk_bf16(s[2 * k2][2], s[2 * k2][3]),
                            pg8::cvt_pk_bf16(s[2 * k2 + 1][0], s[2 * k2 + 1][1]), pg8::cvt_pk_bf16(s[2 * k2 + 1][2], s[2 * k2 + 1][3]));
#pragma unroll
      for (int mt = 0; mt < 4; ++mt) {
        const char* vr = Vs + (mt * 16 + l15) * LSTR + (32 * k2 + 4 * g) * 2;
        const uint2 va = *(const uint2*)vr, vb = *(const uint2*)(vr + 32);
        o[mt] = mfma16(mk8(va.x, va.y, vb.x, vb.y), pb, o[mt]);
      }
    }
  }
  float l = l_run;
  l += __shfl_xor(l, 16); l += __shfl_xor(l, 32);
  const float inv = 1.f / l;
#pragma unroll
  for (int mt = 0; mt < 4; ++mt) {
    *(uint2*)(AB + tq * 1024 + 512 + h * 64 + mt * 16 + g * 4) =
        make_uint2(pg8::cvt_pk_bf16(o[mt][0] * inv, o[mt][1] * inv), pg8::cvt_pk_bf16(o[mt][2] * inv, o[mt][3] * inv));
  }
}

__device__ __forceinline__ void phase2(const Params& p, char* lds) {
  const int sub = tid_() >> 8;
  for (int it = bid_(); it < 2048 + 1024; it += gridDim.x) {
    if (it < 2048) {
      const int b = it >> 8, hp = (it >> 6) & 3, c = ((it & 63) + 8 * b) & 63;
      attn_item(p, (b << 9) | ((hp * 2 + sub) << 6) | c, lds + sub * 38912);
    } else {
      gmlp_item(p, (it - 2048) * 2 + sub);
    }
  }
}

__device__ __forceinline__ void phase3(const Params& p, char* lds) {
  pg8::Gemm g{(const u16*)(p.ws + OFF_AB), (const u16*)(p.ws + OFF_WOUTT), T, 1024, 1024};
  pg8::StaticOrder S; S.init(T, 1024, (int)gridDim.x, (int)blockIdx.x);
  EpiOut E{p.x, p.out, (u16*)(p.ws + OFF_HB)};
  pg8::gemm_phase<EpiOut, pg8::StaticOrder, true, true>(LDS3(lds), g, S, E);
}
__device__ __forceinline__ void phase4(const Params& p, char* lds) {
  pg8::Gemm g{(const u16*)(p.ws + OFF_HB), (const u16*)(p.ws + OFF_WQT), T, 2048, 1024};
  pg8::StaticOrder S; S.init(T, 2048, (int)gridDim.x, (int)blockIdx.x);
  EpiQ E{(u16*)(p.ws + OFF_PQ)};
  pg8::gemm_phase<EpiQ, pg8::StaticOrder, true, true>(LDS3(lds), g, S, E);
}

__device__ __forceinline__ void sort16_desc(unsigned (&v)[16]) {
#pragma unroll
  for (int k = 2; k <= 16; k <<= 1)
#pragma unroll
    for (int j = k >> 1; j > 0; j >>= 1)
#pragma unroll
      for (int i = 0; i < 16; ++i) {
        const int l = i ^ j;
        if (l > i) {
          const unsigned hi = max(v[i], v[l]), lo = min(v[i], v[l]);
          if ((i & k) == 0) { v[i] = hi; v[l] = lo; } else { v[i] = lo; v[l] = hi; }
        }
      }
}
__device__ __forceinline__ void merge16_desc(unsigned (&a)[16], const unsigned (&b)[16]) {
#pragma unroll
  for (int i = 0; i < 16; ++i) a[i] = max(a[i], b[15 - i]);
#pragma unroll
  for (int j = 8; j > 0; j >>= 1)
#pragma unroll
    for (int i = 0; i < 16; ++i) {
      const int l = i ^ j;
      if (l > i) { const unsigned hi = max(a[i], a[l]), lo = min(a[i], a[l]); a[i] = hi; a[l] = lo; }
    }
}
constexpr int SC_STR = 385, LSTR17 = 17;
constexpr int P5_LV = 64 * SC_STR, P5_LI = P5_LV + 128 * LSTR17, P5_TAB = P5_LI + 128 * LSTR17;

__device__ __forceinline__ void select_item(const Params& p, int item, int next_item, char* lds, const bf16x8 (&kf)[8][4], bf16x8 (&qf)[4]) {
  const int tid = tid_(), lane = tid & 63, wave = tid >> 6, l15 = lane & 15, g = lane >> 4;
  const int h = item & 7, t0 = (item >> 3) * 64;
  const u16* PQ = (const u16*)(p.ws + OFF_PQ);
  int* EIDX = (int*)(p.ws + OFF_EIDX);
  float* BEST = (float*)(p.ws + OFF_BEST);
  float* sc = (float*)lds;
  float* LV = sc + P5_LV;
  int* LI = (int*)lds + P5_LI;
  const int* tab = (const int*)lds + P5_TAB;
  __syncthreads();
  {
    const int pp = wave >> 2, wq = wave & 3;
#pragma unroll
    for (int nt = 0; nt < 8; ++nt) {
      f32x4 a = f32x4{0.f, 0.f, 0.f, 0.f};
#pragma unroll
      for (int ks = 0; ks < 4; ++ks) a = mfma16(qf[ks], kf[nt][ks], a);
#pragma unroll
      for (int j = 0; j < 4; ++j) sc[(wq * 16 + g * 4 + j) * SC_STR + pp * 192 + (nt >> 1) * 48 + (nt & 1) * 16 + l15] = a[j];
    }
    if (next_item < 512 * 8) {
      const u16* qp = PQ + (size_t)((next_item >> 3) * 64 + wq * 16 + l15) * 2048 + (next_item & 7) * 256 + pp * 128 + g * 8;
#pragma unroll
      for (int ks = 0; ks < 4; ++ks) qf[ks] = *(const bf16x8*)(qp + ks * 32);
    }
  }
  __syncthreads();
  {
    const int q = tid & 3, list = tid >> 2, row = list & 63, pp = list >> 6;
    const float* rowp = sc + row * SC_STR + pp * 192;
    const float* src = rowp + q * 48;
    unsigned A[16], B[16];
#pragma unroll
    for (int j = 0; j < 16; ++j) {
      A[j] = (okey(src[j]) & ~127u) | (unsigned)(127 - (q * 32 + j));
      B[j] = (okey(src[16 + j]) & ~127u) | (unsigned)(127 - (q * 32 + 16 + j));
    }
    sort16_desc(A);
    sort16_desc(B);
    merge16_desc(A, B);
#pragma unroll
    for (int i = 0; i < 16; ++i) B[i] = (unsigned)__shfl_xor((int)A[i], 1);
    merge16_desc(A, B);
#pragma unroll
    for (int i = 0; i < 16; ++i) B[i] = (unsigned)__shfl_xor((int)A[i], 2);
    merge16_desc(A, B);
#pragma unroll
    for (int r = 0; r < 16; ++r) {
      if ((r & 3) == q) {
        const int idx = 127 - (int)(A[r] & 127u);
        LV[list * LSTR17 + r] = rowp[(idx >> 5) * 48 + (idx & 31)];
        LI[list * LSTR17 + r] = idx;
      }
    }
  }
  __syncthreads();
  if (tid < 256) {
    const int grp = tid & 3, row = tid >> 2;
    const float* v0 = LV + row * LSTR17;
    const float* v1 = LV + (64 + row) * LSTR17;
    unsigned A[16], B[16];
#pragma unroll
    for (int j = 0; j < 16; ++j) {
      const int code = tab[grp * 16 + j];
      const int cc = code & 255;
      const float s = v0[cc >> 4] + v1[cc & 15];
      A[j] = (code < 0) ? 0u : ((okey(s) & ~255u) | (unsigned)(255 - cc));
    }
    sort16_desc(A);
#pragma unroll
    for (int i = 0; i < 16; ++i) B[i] = (unsigned)__shfl_xor((int)A[i], 1);
    merge16_desc(A, B);
#pragma unroll
    for (int i = 0; i < 16; ++i) B[i] = (unsigned)__shfl_xor((int)A[i], 2);
    merge16_desc(A, B);
    const size_t ob = ((size_t)(t0 + row) * 8 + h) * 16 + grp * 4;
    const int* i0 = LI + row * LSTR17;
    const int* i1 = LI + (64 + row) * LSTR17;
    int e4[4];
    float b4[4];
#pragma unroll
    for (int j = 0; j < 4; ++j) {
      const unsigned sel = (grp == 0) ? A[j] : (grp == 1) ? A[4 + j] : (grp == 2) ? A[8 + j] : A[12 + j];
      const int cc = 255 - (int)(sel & 255u);
      const int a = cc >> 4, bq = cc & 15;
      e4[j] = i0[a] * 128 + i1[bq];
      b4[j] = v0[a] + v1[bq];
    }
    *(int4*)(EIDX + ob) = make_int4(e4[0], e4[1], e4[2], e4[3]);
    *(float4*)(BEST + ob) = make_float4(b4[0], b4[1], b4[2], b4[3]);
  }
}

__device__ __forceinline__ void phase5(const Params& p, char* lds) {
  {
    const int i = tid_();
    if (i < 64) {
      const int grp = i >> 4, j = i & 15;
      int code = -1;
      if (grp == 0) code = j;
      else if (grp == 1) { if (j < 8) code = 16 + j; else if (j < 13) code = 32 + (j - 8); }
      else if (grp == 2) { if (j < 4) code = 48 + j; else if (j < 7) code = 64 + (j - 4); else if (j < 9) code = 80 + (j - 7); else if (j < 11) code = 96 + (j - 9); else if (j < 13) code = 112 + (j - 11); }
      else { if (j < 8) code = (8 + j) * 16; }
      ((int*)lds)[P5_TAB + i] = code;
    }
  }
  const int tid = tid_(), lane = tid & 63, wave = tid >> 6, l15 = lane & 15, g = lane >> 4;
  const int pp = wave >> 2, wq = wave & 3;
  int it = bid_();
  if (it >= 512 * 8) return;
  const bool fixed_head = (gridDim.x & 7) == 0;
  bf16x8 kf[8][4];
  bf16x8 qf[4];
  {
    const u16* KEYS = (const u16*)(p.ws + OFF_KEYS);
#pragma unroll
    for (int nt = 0; nt < 8; ++nt) {
      const u16* kp = KEYS + ((size_t)(((it & 7) * 2 + pp) * 128 + nt * 16 + l15)) * 128 + g * 8;
#pragma unroll
      for (int ks = 0; ks < 4; ++ks) kf[nt][ks] = *(const bf16x8*)(kp + ks * 32);
    }
    const u16* qp = (const u16*)(p.ws + OFF_PQ) + (size_t)((it >> 3) * 64 + wq * 16 + l15) * 2048 + (it & 7) * 256 + pp * 128 + g * 8;
#pragma unroll
    for (int ks = 0; ks < 4; ++ks) qf[ks] = *(const bf16x8*)(qp + ks * 32);
  }
  for (; it < 512 * 8; it += gridDim.x) {
    if (!fixed_head) {
      const u16* KEYS = (const u16*)(p.ws + OFF_KEYS);
#pragma unroll
      for (int nt = 0; nt < 8; ++nt) {
        const u16* kp = KEYS + ((size_t)(((it & 7) * 2 + pp) * 128 + nt * 16 + l15)) * 128 + g * 8;
#pragma unroll
        for (int ks = 0; ks < 4; ++ks) kf[nt][ks] = *(const bf16x8*)(kp + ks * 32);
      }
    }
    select_item(p, it, it + (int)gridDim.x, lds, kf, qf);
  }
}

#define P4(w, i) __builtin_amdgcn_cvt_scalef32_pk_f32_fp4((w), 1.0f, (i))
#define B4(w, i) __builtin_amdgcn_cvt_scalef32_pk_bf16_fp4((w), 1.0f, (i))
__device__ __forceinline__ f32x2 hpair(unsigned w) { return f32x2{bf_lo(w), bf_hi(w)}; }
__device__ __forceinline__ float dot32_fp4(const u32x4 u, const u32x4 (&h)[4], float acc) {
  f32x2 s = f32x2{acc, 0.f};
  s = __builtin_elementwise_fma(P4(u.x, 0), hpair(h[0].x), s); s = __builtin_elementwise_fma(P4(u.x, 1), hpair(h[0].y), s);
  s = __builtin_elementwise_fma(P4(u.x, 2), hpair(h[0].z), s); s = __builtin_elementwise_fma(P4(u.x, 3), hpair(h[0].w), s);
  s = __builtin_elementwise_fma(P4(u.y, 0), hpair(h[1].x), s); s = __builtin_elementwise_fma(P4(u.y, 1), hpair(h[1].y), s);
  s = __builtin_elementwise_fma(P4(u.y, 2), hpair(h[1].z), s); s = __builtin_elementwise_fma(P4(u.y, 3), hpair(h[1].w), s);
  s = __builtin_elementwise_fma(P4(u.z, 0), hpair(h[2].x), s); s = __builtin_elementwise_fma(P4(u.z, 1), hpair(h[2].y), s);
  s = __builtin_elementwise_fma(P4(u.z, 2), hpair(h[2].z), s); s = __builtin_elementwise_fma(P4(u.z, 3), hpair(h[2].w), s);
  s = __builtin_elementwise_fma(P4(u.w, 0), hpair(h[3].x), s); s = __builtin_elementwise_fma(P4(u.w, 1), hpair(h[3].y), s);
  s = __builtin_elementwise_fma(P4(u.w, 2), hpair(h[3].z), s); s = __builtin_elementwise_fma(P4(u.w, 3), hpair(h[3].w), s);
  return s.x + s.y;
}
__device__ __forceinline__ void p6_gather(u32x4 (&buf)[16], const unsigned char* EX, int ea, int eb, int eg) {
#pragma unroll
  for (int it = 0; it < 16; ++it) {
    const int src = (it * 8 + eg) & 63;
    const int e = __shfl((it < 8) ? ea : eb, src);
    buf[it] = *(const u32x4*)(EX + (size_t)e * 128);
  }
}
__device__ __forceinline__ void p6a_compute(const u32x4 (&buf)[16], const u32x4 (&h)[4], float* PART, int t, int part, int eg, bool b2, bool b1, bool b0) {
  float f[32];
#pragma unroll
  for (int i = 0; i < 4; ++i) {
    f[i * 8 + 0] = bf_lo(h[i].x); f[i * 8 + 1] = bf_hi(h[i].x); f[i * 8 + 2] = bf_lo(h[i].y); f[i * 8 + 3] = bf_hi(h[i].y);
    f[i * 8 + 4] = bf_lo(h[i].z); f[i * 8 + 5] = bf_hi(h[i].z); f[i * 8 + 6] = bf_lo(h[i].w); f[i * 8 + 7] = bf_hi(h[i].w);
  }
  float am = 0.f;
#pragma unroll
  for (int i = 0; i < 32; ++i) am = fmaxf(am, fabsf(f[i]));
  const bool ok = am > 1e-30f;
  const float sc = ok ? 7.0f / am : 0.f, inv = ok ? am * (1.f / 7.0f) : 0.f;
  int hq[4];
#pragma unroll
  for (int i = 0; i < 4; ++i)
    hq[i] = (int)(q4(f[i * 8 + 0] * sc, 0) | q4(f[i * 8 + 1] * sc, 1) | q4(f[i * 8 + 2] * sc, 2) | q4(f[i * 8 + 3] * sc, 3) |
                  q4(f[i * 8 + 4] * sc, 4) | q4(f[i * 8 + 5] * sc, 5) | q4(f[i * 8 + 6] * sc, 6) | q4(f[i * 8 + 7] * sc, 7));
  float d[16];
#pragma unroll
  for (int it = 0; it < 16; ++it) {
    int a = __builtin_amdgcn_sdot8((int)buf[it].x, hq[0], 0, false);
    a = __builtin_amdgcn_sdot8((int)buf[it].y, hq[1], a, false);
    a = __builtin_amdgcn_sdot8((int)buf[it].z, hq[2], a, false);
    a = __builtin_amdgcn_sdot8((int)buf[it].w, hq[3], a, false);
    d[it] = (float)a * inv;
  }
  float r[8];
#pragma unroll
  for (int i = 0; i < 8; ++i) r[i] = (b2 ? d[i + 8] : d[i]) + __shfl_xor(b2 ? d[i] : d[i + 8], 4);
  float s4[4];
#pragma unroll
  for (int i = 0; i < 4; ++i) s4[i] = (b1 ? r[i + 4] : r[i]) + __shfl_xor(b1 ? r[i] : r[i + 4], 2);
#pragma unroll
  for (int i = 0; i < 2; ++i) {
    const float u = (b0 ? s4[i + 2] : s4[i]) + __shfl_xor(b0 ? s4[i] : s4[i + 2], 1);
    PART[(size_t)t * 128 + (2 * part + i) * 8 + eg] = u;
  }
}
__device__ __forceinline__ void phase6a(const Params& p, char* lds) {
  const int tid = tid_(), lane = tid & 63, wave = tid >> 6, eg = lane >> 3, part = lane & 7;
  const int bid = bid_();
  const int x = bid & 7, xb = bid >> 3, ncb = ((int)gridDim.x + 7 - x) >> 3;
  const int sl = x >> 1, par = x & 1;
  const unsigned char* EUX = (const unsigned char*)(p.ws + OFF_EU) + (size_t)sl * (2 * MiB) + part * 16;
  const u16* HBX = (const u16*)(p.ws + OFF_HB) + sl * 256 + part * 32;
  const int* EIDX = (const int*)(p.ws + OFF_EIDX);
  float* PART = (float*)(p.ws + OFF_PART) + (size_t)sl * T * 128;
  const int tstep = ncb * NWAVE * 2;
  const bool b2 = (lane & 4) != 0, b1 = (lane & 2) != 0, b0 = (lane & 1) != 0;
  int t = (xb * NWAVE + wave) * 2 + par;
  if (t < T) {
    u32x4 A[16], B[16], hA[4], hB[4];
    int e0 = EIDX[(size_t)t * 128 + lane], e1 = EIDX[(size_t)t * 128 + 64 + lane];
    p6_gather(A, EUX, e0, e1, eg);
#pragma unroll
    for (int i = 0; i < 4; ++i) hA[i] = *(const u32x4*)(HBX + (size_t)t * 1024 + i * 8);
    int tn = t + tstep;
    if (tn < T) { e0 = EIDX[(size_t)tn * 128 + lane]; e1 = EIDX[(size_t)tn * 128 + 64 + lane]; }
    for (;;) {
      int tnn = tn + tstep;
      if (tn < T) {
        p6_gather(B, EUX, e0, e1, eg);
#pragma unroll
        for (int i = 0; i < 4; ++i) hB[i] = *(const u32x4*)(HBX + (size_t)tn * 1024 + i * 8);
        if (tnn < T) { e0 = EIDX[(size_t)tnn * 128 + lane]; e1 = EIDX[(size_t)tnn * 128 + 64 + lane]; }
      }
      p6a_compute(A, hA, PART, t, part, eg, b2, b1, b0);
      if (tn >= T) break;
      const int t3 = tnn + tstep;
      if (tnn < T) {
        p6_gather(A, EUX, e0, e1, eg);
#pragma unroll
        for (int i = 0; i < 4; ++i) hA[i] = *(const u32x4*)(HBX + (size_t)tnn * 1024 + i * 8);
        if (t3 < T) { e0 = EIDX[(size_t)t3 * 128 + lane]; e1 = EIDX[(size_t)t3 * 128 + 64 + lane]; }
      }
      p6a_compute(B, hB, PART, tn, part, eg, b2, b1, b0);
      if (tnn >= T) break;
      t = tnn; tn = t3;
    }
  }
}

__device__ __forceinline__ void phase6m(const Params& p, char* lds) {
  const int tid = tid_(), lane = tid & 63, wave = tid >> 6;
  const u16* HB = (const u16*)(p.ws + OFF_HB);
  const float* ESC = (const float*)(p.ws + OFF_ESC);
  const int* EIDX = (const int*)(p.ws + OFF_EIDX);
  const float* BEST = (const float*)(p.ws + OFF_BEST);
  const float* PART = (const float*)(p.ws + OFF_PART);
  float* WGT = (float*)(p.ws + OFF_WGT);
  for (int t0 = (bid_() * NWAVE + wave) * 2; t0 < T; t0 += gridDim.x * NWAVE * 2) {
    uint4 ha[2], hb[2];
    float da[2], db[2], ba[2], bb[2];
    int ea[2], eb[2];
#pragma unroll
    for (int r = 0; r < 2; ++r) {
      const int t = t0 + r;
      ha[r] = *(const uint4*)(HB + (size_t)t * 1024 + lane * 16); hb[r] = *(const uint4*)(HB + (size_t)t * 1024 + lane * 16 + 8);
      const size_t i0 = (size_t)t * 128 + lane, i1 = i0 + 64;
      ea[r] = EIDX[i0]; eb[r] = EIDX[i1];
      ba[r] = BEST[i0]; bb[r] = BEST[i1];
      float sa = 0.f, sb = 0.f;
#pragma unroll
      for (int x = 0; x < 4; ++x) { sa += PART[(size_t)x * T * 128 + i0]; sb += PART[(size_t)x * T * 128 + i1]; }
      da[r] = sa; db[r] = sb;
    }
    float ua[2], ub[2], va[2], vb[2];
#pragma unroll
    for (int r = 0; r < 2; ++r) { ua[r] = ESC[ea[r]]; ub[r] = ESC[eb[r]]; va[r] = ESC[16384 + ea[r]]; vb[r] = ESC[16384 + eb[r]]; }
#pragma unroll
    for (int r = 0; r < 2; ++r) {
      const uint4 a = ha[r], b = hb[r];
      float ss = 0.f;
      ss = dot2(a.x, a.x, ss); ss = dot2(a.y, a.y, ss); ss = dot2(a.z, a.z, ss); ss = dot2(a.w, a.w, ss);
      ss = dot2(b.x, b.x, ss); ss = dot2(b.y, b.y, ss); ss = dot2(b.z, b.z, ss); ss = dot2(b.w, b.w, ss);
#pragma unroll
      for (int o = 1; o < 64; o <<= 1) ss += __shfl_xor(ss, o);
      const float rs2 = rsqrtf(ss * (1.f / 1024.f) + EPS);
      const float xa = ba[r] * rs2, xb = bb[r] * rs2;
      float ma = xa, mb = xb;
#pragma unroll
      for (int o = 1; o < 16; o <<= 1) { ma = fmaxf(ma, __shfl_xor(ma, o)); mb = fmaxf(mb, __shfl_xor(mb, o)); }
      const float pa = __expf(xa - ma), pb = __expf(xb - mb);
      float sa = pa, sb = pb;
#pragma unroll
      for (int o = 1; o < 16; o <<= 1) { sa += __shfl_xor(sa, o); sb += __shfl_xor(sb, o); }
      const size_t i0 = (size_t)(t0 + r) * 128 + lane;
      WGT[i0] = (pa / sa) * gelu_f(da[r] * rs2 * ua[r]) * va[r];
      WGT[i0 + 64] = (pb / sb) * gelu_f(db[r] * rs2 * ub[r]) * vb[r];
    }
  }
}

__device__ __forceinline__ void p6b_compute(const u32x4 (&buf)[16], float wa, float wb, uint2 hr, float* orow, int eg, bool h5, bool h4, bool h3) {
  f32x2 acc[16];
#pragma unroll
  for (int i = 0; i < 16; ++i) acc[i] = f32x2{0.f, 0.f};
#pragma unroll
  for (int it = 0; it < 16; ++it) {
    const int src = (it * 8 + eg) & 63;
    const float w = __shfl((it < 8) ? wa : wb, src);
    const f32x2 w2 = f32x2{w, w};
    const u32x4 v = buf[it];
    acc[0] = __builtin_elementwise_fma(P4(v.x, 0), w2, acc[0]);   acc[1] = __builtin_elementwise_fma(P4(v.x, 1), w2, acc[1]);
    acc[2] = __builtin_elementwise_fma(P4(v.x, 2), w2, acc[2]);   acc[3] = __builtin_elementwise_fma(P4(v.x, 3), w2, acc[3]);
    acc[4] = __builtin_elementwise_fma(P4(v.y, 0), w2, acc[4]);   acc[5] = __builtin_elementwise_fma(P4(v.y, 1), w2, acc[5]);
    acc[6] = __builtin_elementwise_fma(P4(v.y, 2), w2, acc[6]);   acc[7] = __builtin_elementwise_fma(P4(v.y, 3), w2, acc[7]);
    acc[8] = __builtin_elementwise_fma(P4(v.z, 0), w2, acc[8]);   acc[9] = __builtin_elementwise_fma(P4(v.z, 1), w2, acc[9]);
    acc[10] = __builtin_elementwise_fma(P4(v.z, 2), w2, acc[10]); acc[11] = __builtin_elementwise_fma(P4(v.z, 3), w2, acc[11]);
    acc[12] = __builtin_elementwise_fma(P4(v.w, 0), w2, acc[12]); acc[13] = __builtin_elementwise_fma(P4(v.w, 1), w2, acc[13]);
    acc[14] = __builtin_elementwise_fma(P4(v.w, 2), w2, acc[14]); acc[15] = __builtin_elementwise_fma(P4(v.w, 3), w2, acc[15]);
  }
  f32x2 q1[8];
#pragma unroll
  for (int i = 0; i < 8; ++i) {
    const f32x2 sd = h5 ? acc[i] : acc[i + 8], kp = h5 ? acc[i + 8] : acc[i];
    q1[i] = f32x2{kp.x + __shfl_xor(sd.x, 32), kp.y + __shfl_xor(sd.y, 32)};
  }
  f32x2 q2[4];
#pragma unroll
  for (int i = 0; i < 4; ++i) {
    const f32x2 sd = h4 ? q1[i] : q1[i + 4], kp = h4 ? q1[i + 4] : q1[i];
    q2[i] = f32x2{kp.x + __shfl_xor(sd.x, 16), kp.y + __shfl_xor(sd.y, 16)};
  }
  f32x2 q3[2];
#pragma unroll
  for (int i = 0; i < 2; ++i) {
    const f32x2 sd = h3 ? q2[i] : q2[i + 2], kp = h3 ? q2[i + 2] : q2[i];
    q3[i] = f32x2{kp.x + __shfl_xor(sd.x, 8), kp.y + __shfl_xor(sd.y, 8)};
  }
  *(float4*)orow = make_float4(bf_lo(hr.x) + q3[0].x, bf_hi(hr.x) + q3[0].y, bf_lo(hr.y) + q3[1].x, bf_hi(hr.y) + q3[1].y);
}
__device__ __forceinline__ void phase6b(const Params& p, char* lds) {
  const int tid = tid_(), lane = tid & 63, wave = tid >> 6, eg = lane >> 3, part = lane & 7;
  const int bid = bid_();
  const int x = bid & 7, xb = bid >> 3, ncb = ((int)gridDim.x + 7 - x) >> 3;
  const int sl = x >> 1, par = x & 1;
  const unsigned char* EVX = (const unsigned char*)(p.ws + OFF_EV) + (size_t)sl * (2 * MiB) + part * 16;
  const int* EIDX = (const int*)(p.ws + OFF_EIDX);
  const float* WGT = (const float*)(p.ws + OFF_WGT);
  const int tstep = ncb * NWAVE * 2;
  const int pi = ((lane >> 5) & 1) * 4 + ((lane >> 4) & 1) * 2 + ((lane >> 3) & 1);
  const int ocol = sl * 256 + part * 32 + pi * 4;
  const u16* HB = (const u16*)(p.ws + OFF_HB) + ocol;
  float* OUT = p.out + ocol;
  const bool h5 = (lane & 32) != 0, h4 = (lane & 16) != 0, h3 = (lane & 8) != 0;
  int t = (xb * NWAVE + wave) * 2 + par;
  if (t < T) {
    u32x4 A[16], B[16];
    int e0 = EIDX[(size_t)t * 128 + lane], e1 = EIDX[(size_t)t * 128 + 64 + lane];
    float wA0 = WGT[(size_t)t * 128 + lane], wA1 = WGT[(size_t)t * 128 + 64 + lane], wB0 = 0.f, wB1 = 0.f;
    uint2 hA = *(const uint2*)(HB + (size_t)t * 1024), hB = make_uint2(0u, 0u);
    p6_gather(A, EVX, e0, e1, eg);
    int tn = t + tstep;
    if (tn < T) { e0 = EIDX[(size_t)tn * 128 + lane]; e1 = EIDX[(size_t)tn * 128 + 64 + lane]; }
    for (;;) {
      int tnn = tn + tstep;
      if (tn < T) {
        p6_gather(B, EVX, e0, e1, eg);
        wB0 = WGT[(size_t)tn * 128 + lane]; wB1 = WGT[(size_t)tn * 128 + 64 + lane];
        hB = *(const uint2*)(HB + (size_t)tn * 1024);
        if (tnn < T) { e0 = EIDX[(size_t)tnn * 128 + lane]; e1 = EIDX[(size_t)tnn * 128 + 64 + lane]; }
      }
      p6b_compute(A, wA0, wA1, hA, OUT + (size_t)t * 1024, eg, h5, h4, h3);
      if (tn >= T) break;
      const int t3 = tnn + tstep;
      if (tnn < T) {
        p6_gather(A, EVX, e0, e1, eg);
        wA0 = WGT[(size_t)tnn * 128 + lane]; wA1 = WGT[(size_t)tnn * 128 + 64 + lane];
        hA = *(const uint2*)(HB + (size_t)tnn * 1024);
        if (t3 < T) { e0 = EIDX[(size_t)t3 * 128 + lane]; e1 = EIDX[(size_t)t3 * 128 + 64 + lane]; }
      }
      p6b_compute(B, wB0, wB1, hB, OUT + (size_t)tn * 1024, eg, h5, h4, h3);
      if (tnn >= T) break;
      t = tnn; tn = t3;
    }
  }
}

__device__ __forceinline__ void seam_barrier(unsigned* ctr, unsigned nblk) {
  __syncthreads();
  if (threadIdx.x == 0) {
    __builtin_amdgcn_fence(__ATOMIC_RELEASE, "agent");
    asm volatile("s_waitcnt vmcnt(0)" ::: "memory");
    __hip_atomic_fetch_add(ctr, 1u, __ATOMIC_RELAXED, __HIP_MEMORY_SCOPE_AGENT);
    while (__hip_atomic_load(ctr, __ATOMIC_RELAXED, __HIP_MEMORY_SCOPE_AGENT) < nblk) __builtin_amdgcn_s_sleep(2);
    __builtin_amdgcn_fence(__ATOMIC_ACQUIRE, "agent");
    asm volatile("s_waitcnt vmcnt(0)" ::: "memory");
  }
  __syncthreads();
}
#ifndef PMASK
#define PMASK 127
#endif
#define PROG 0x6543210ull
#define NPROG 9
__global__ void __launch_bounds__(NTHR, 2) mega(Params p, int ph_lo, int ph_hi) {
  extern __shared__ __attribute__((aligned(16))) char lds[];
  cg::grid_group grid = cg::this_grid();
#ifndef REP_PHASE
#define REP_PHASE -1
#endif
#define IN(k) (ph_lo <= (k) && (k) < ph_hi)
#define SEAM(k) do { if (IN(k) && IN((k) + 1)) { if ((k) == 0) grid.sync(); else seam_barrier((unsigned*)(p.ws + OFF_BAR) + (k) * 64, gridDim.x); } } while (0)
  if (IN(0)) { phase0(p, lds); if (REP_PHASE == 0) { grid.sync(); phase0(p, lds); } }
  SEAM(0);
  if (IN(1)) { phase1(p, lds); if (REP_PHASE == 1) { grid.sync(); phase1(p, lds); } }
  SEAM(1);
  if (IN(2)) { phase2(p, lds); if (REP_PHASE == 2) { grid.sync(); phase2(p, lds); } }
  SEAM(2);
  if (IN(3)) { phase3(p, lds); if (REP_PHASE == 3) { grid.sync(); phase3(p, lds); } }
  SEAM(3);
  if (IN(4)) { phase4(p, lds); if (REP_PHASE == 4) { grid.sync(); phase4(p, lds); } }
  SEAM(4);
  if (IN(5)) { phase5(p, lds); if (REP_PHASE == 5) { grid.sync(); phase5(p, lds); } }
  SEAM(5);
  if (IN(6)) { phase6a(p, lds); if (REP_PHASE == 6) { grid.sync(); phase6a(p, lds); } }
  SEAM(6);
  if (IN(7)) { phase6m(p, lds); if (REP_PHASE == 7) { grid.sync(); phase6m(p, lds); } }
  SEAM(7);
  if (IN(8)) phase6b(p, lds);
}

extern "C" void kernel_launch(void* const* d_in, const int* in_sizes, int n_in, void* d_out, int out_size, void* d_ws,
                              size_t ws_size, hipStream_t stream) {
  static int grid_blocks = 0;
  if (!grid_blocks) {
    int dev = 0, cus = 0, per_cu = 0;
    (void)hipGetDevice(&dev);
    (void)hipDeviceGetAttribute(&cus, hipDeviceAttributeMultiprocessorCount, dev);
    (void)hipFuncSetAttribute((const void*)mega, hipFuncAttributeMaxDynamicSharedMemorySize, LDS_BYTES);
    (void)hipOccupancyMaxActiveBlocksPerMultiprocessor(&per_cu, mega, NTHR, LDS_BYTES);
    if (per_cu > 1) per_cu = 1;
    grid_blocks = cus * per_cu;
  }
  Params p{};
  p.x = (const float*)d_in[0]; p.ln_mix_g = (const float*)d_in[1]; p.w_in = (const float*)d_in[2];
  p.gmlp_norm_g = (const float*)d_in[3]; p.gmlp_w_s = (const float*)d_in[4]; p.gmlp_b_s = (const float*)d_in[5];
  p.q_norm_g = (const float*)d_in[6]; p.k_norm_g = (const float*)d_in[7]; p.rel_bias = (const float*)d_in[8];
  p.w_out = (const float*)d_in[9]; p.ln_ffn_g = (const float*)d_in[10]; p.w_query = (const float*)d_in[11];
  p.sub_keys = (const float*)d_in[12]; p.peer_u = (const float*)d_in[13]; p.peer_v = (const float*)d_in[14];
  p.out = (float*)d_out; p.ws = (char*)d_ws;
#if FUSED
  int lo = 0, hi = NPROG;
  void* args[] = {&p, &lo, &hi};
  hipError_t e = hipLaunchCooperativeKernel((void*)mega, dim3(grid_blocks), dim3(NTHR), args, LDS_BYTES, stream);
  if (e != hipSuccess) fprintf(stderr, "cooperative launch failed: %s (grid %d)\n", hipGetErrorString(e), grid_blocks);
#else
  for (int ph = 0; ph < NPROG; ++ph) mega<<<dim3(grid_blocks), dim3(NTHR), LDS_BYTES, stream>>>(p, ph, ph + 1);
#endif
}
```

```cpp
#include <hip/hip_runtime.h>
#include <hip/hip_cooperative_groups.h>
#include <cstdio>
namespace cg = cooperative_groups;

#ifndef FUSED
#define FUSED 1
#endif

typedef unsigned short u16;
using bf16x8 = __attribute__((ext_vector_type(8))) short;
using s16x4 = __attribute__((ext_vector_type(4))) short;
using f32x4 = __attribute__((ext_vector_type(4))) float;
using bf16x2 = __attribute__((ext_vector_type(2))) __bf16;
using f32x2 = __attribute__((ext_vector_type(2))) float;
using u32x4 = __attribute__((ext_vector_type(4))) unsigned;
using u32x2 = __attribute__((ext_vector_type(2))) unsigned;

constexpr int T = 32768, DM = 1024, SEQ = 4096;
constexpr float EPS = 1e-6f;
constexpr size_t MiB = 1u << 20;
constexpr size_t OFF_XB = 0, OFF_WINT = 64 * MiB  , OFF_WB = 67 * MiB  , OFF_WOUTT = 69 * MiB, OFF_WQT = 71 * MiB, OFF_KEYS = 75 * MiB,
                 OFF_RS = 76 * MiB, OFF_VSS = 76 * MiB + 512 * 1024, OFF_EU = 77 * MiB, OFF_EV = 109 * MiB,
                 OFF_U = 141 * MiB, OFF_GVT = 173 * MiB, OFF_QK = 205 * MiB, OFF_VT = 269 * MiB, OFF_AB = 301 * MiB,
                 OFF_HB = 365 * MiB, OFF_PQ = 141 * MiB  , OFF_EIDX = 429 * MiB,
                 OFF_BEST = 445 * MiB, OFF_ESC = 461 * MiB  , OFF_WGT = 462 * MiB  , OFF_BAR = 480 * MiB  , OFF_PART = 141 * MiB  ;

struct Params {
  const float *x, *ln_mix_g, *w_in, *gmlp_norm_g, *gmlp_w_s, *gmlp_b_s, *q_norm_g, *k_norm_g, *rel_bias, *w_out,
      *ln_ffn_g, *w_query, *sub_keys, *peer_u, *peer_v;
  float* out;
  char* ws;
};

constexpr int LDS_BYTES = 131584;
constexpr int NTHR = 512, NWAVE = 8;
constexpr int LSTR = 144;
constexpr int OPER_BYTES = 128 * LSTR;

__device__ __forceinline__ u16 f2bf(float f) {
  unsigned u = __float_as_uint(f);
  u += 0x7fffu + ((u >> 16) & 1u);
  return (u16)(u >> 16);
}
__device__ __forceinline__ unsigned pack2(float lo, float hi) { return (unsigned)f2bf(lo) | ((unsigned)f2bf(hi) << 16); }
__device__ __forceinline__ float bf_lo(unsigned u) { return __uint_as_float(u << 16); }
__device__ __forceinline__ float bf_hi(unsigned u) { return __uint_as_float(u & 0xffff0000u); }
__device__ __forceinline__ float bf2f(u16 v) { return __uint_as_float(((unsigned)v) << 16); }
__device__ __forceinline__ float gelu_f(float x) {
  const float c1 = -2.f * 0.7978845608028654f * 1.4426950408889634f, c2 = c1 * 0.044715f;
  const float zp = x * __builtin_fmaf(x * x, c2, c1);
  return x * __builtin_amdgcn_rcpf(1.f + __builtin_amdgcn_exp2f(zp));
}
template <int CTRL> __device__ __forceinline__ float dpp_f(float v) { return __int_as_float(__builtin_amdgcn_mov_dpp(__float_as_int(v), CTRL, 0xF, 0xF, true)); }
constexpr int DPP_X1 = 0xB1  , DPP_X2 = 0x4E  , DPP_HM = 0x141  , DPP_R8 = 0x128  ;
__device__ __forceinline__ float row16_sum(float v) { v += dpp_f<DPP_X1>(v); v += dpp_f<DPP_X2>(v); v += dpp_f<DPP_HM>(v); v += dpp_f<DPP_R8>(v); return v; }
__device__ __forceinline__ float row16_max(float v) { v = fmaxf(v, dpp_f<DPP_X1>(v)); v = fmaxf(v, dpp_f<DPP_X2>(v)); v = fmaxf(v, dpp_f<DPP_HM>(v)); v = fmaxf(v, dpp_f<DPP_R8>(v)); return v; }
__device__ __forceinline__ float wave_sum(float v) {
  v = row16_sum(v);
  const auto r = __builtin_amdgcn_permlane16_swap(__float_as_uint(v), __float_as_uint(v), false, false);
  v = __uint_as_float(r[0]) + __uint_as_float(r[1]);
  const auto q = __builtin_amdgcn_permlane32_swap(__float_as_uint(v), __float_as_uint(v), false, false);
  return __uint_as_float(q[0]) + __uint_as_float(q[1]);
}
__device__ __forceinline__ float dot2(unsigned a, unsigned b, float acc) {
  return __builtin_amdgcn_fdot2_f32_bf16(__builtin_bit_cast(bf16x2, a), __builtin_bit_cast(bf16x2, b), acc, false);
}
__device__ __forceinline__ f32x4 mfma16(bf16x8 a, bf16x8 b, f32x4 c) {
  return __builtin_amdgcn_mfma_f32_16x16x32_bf16(a, b, c, 0, 0, 0);
}
__device__ __forceinline__ bf16x8 mk8(unsigned a, unsigned b, unsigned c, unsigned d) {
  uint4 u = make_uint4(a, b, c, d);
  return __builtin_bit_cast(bf16x8, u);
}
__device__ __forceinline__ unsigned pack4_fp8(float a, float b, float c, float d) {
  int r = 0;
  r = __builtin_amdgcn_cvt_pk_fp8_f32(a, b, r, false);
  r = __builtin_amdgcn_cvt_pk_fp8_f32(c, d, r, true);
  return (unsigned)r;
}
__device__ __forceinline__ unsigned q4(float xs, int i) {
  return (__float_as_uint(xs + 12582912.f) & 15u) << (4 * i);
}
__device__ __forceinline__ unsigned okey(float x) {
  unsigned u = __float_as_uint(x);
  return (u & 0x80000000u) ? ~u : (u | 0x80000000u);
}


__device__ __forceinline__ int tid_() { int t = threadIdx.x; asm volatile("" : "+v"(t)); return t; }
__device__ __forceinline__ int bid_() { int b = blockIdx.x; asm volatile("" : "+s"(b)); return b; }
namespace pg8 {
#define PG8_LAS __attribute__((address_space(3)))
typedef unsigned short bf16_t;
typedef short bf16x8 __attribute__((ext_vector_type(8)));
typedef float f32x4 __attribute__((ext_vector_type(4)));
typedef unsigned u32x4 __attribute__((ext_vector_type(4)));
constexpr int BM = 256, BK = 64, HALF = 128, HTB = HALF * BK * 2  , STAGE_BYTES = 8 * HTB, NXCD = 8, WGM = 8;

__host__ __device__ __forceinline__ int lds_byte(int r, int c) { const int st = (r >> 4) * 2 + (c >> 5), rr = r & 15, cc = c & 31, ob = rr * 64 + cc * 2; return st * 1024 + (ob ^ (((ob >> 9) & 1) << 5)); }
__host__ __device__ __forceinline__ void stage_rc(int b, int& R, int& C) { const int st = b / 1024, sb = b % 1024, swz = sb ^ (((sb >> 9) & 1) << 5); R = (st >> 1) * 16 + swz / 64; C = (st & 1) * 32 + (swz % 64) / 2; }
__host__ __device__ __forceinline__ int perm32(int rho) { const int n = rho >> 4, i = rho & 15; return 8 * (i >> 2) + 4 * n + (i & 3); }

struct Unit { int pm, pn; };
struct Gemm { const bf16_t* A; const bf16_t* Bt; int M, N, K; };

struct StaticOrder {
    int nM, nN, nwg, G, c;
    __host__ __device__ void init(int M, int N, int G_, int c_) { nM = M / BM; nN = N / BM; nwg = nM * nN; G = G_; c = c_; }
    __host__ __device__ bool next(int i, Unit& u) const {
        const long L = (long)i * G + c; if (L >= nwg) return false;
        int wgid = (int)L; { const int q = nwg / NXCD, r = nwg % NXCD, xcd = wgid % NXCD, off = wgid / NXCD; wgid = (xcd < r ? xcd * (q + 1) : r * (q + 1) + (xcd - r) * q) + off; }
        const int nig = WGM * nN, gid = wgid / nig, fm = gid * WGM, gsz = (nM - fm) < WGM ? (nM - fm) : WGM;
        u.pm = fm + ((wgid % nig) % gsz); u.pn = (wgid % nig) / gsz; return true;
    }
    __device__ __forceinline__ void a_ready(const Unit&) const {}
    __device__ __forceinline__ void done(const Unit&) const {}
};

__device__ __forceinline__ unsigned cvt_pk_bf16(float lo, float hi) { unsigned r; asm volatile("v_cvt_pk_bf16_f32 %0, %1, %2" : "=v"(r) : "v"(lo), "v"(hi)); return r; }
template <class Epi, class Sched, bool ALIGN_EPI = false, bool SP2 = false>
__device__ __forceinline__ void gemm_phase(PG8_LAS unsigned char* lds, const Gemm g, const Sched& S, const Epi& E) {
    const int tid = threadIdx.x, wid = __builtin_amdgcn_readfirstlane(tid >> 6), lane = tid & 63, wr = wid >> 2, wc = wid & 3, fr = lane & 15, fq = lane >> 4;
    const int K = g.K, nt = K / BK;
    unsigned voffA[2], voffB[2];
#pragma unroll
    for (int i = 0; i < 2; ++i) { int R, C; stage_rc(tid * 16 + i * 8192, R, C); const int Rb = Epi::PERM ? ((R & ~31) + perm32(R & 31)) : R;
        voffA[i] = (unsigned)(R * K + C) * 2u; voffB[i] = (unsigned)(Rb * K + C) * 2u; }
    const size_t kstep = (size_t)(BK * 2);
    const size_t hstep = (size_t)HALF * K * 2;
    const size_t tstep = 2 * hstep;
    const unsigned ldsw = (unsigned)wid * 1024u;
    const int aoff = lds_byte(wr * 64 + fr, fq * 8), boff = lds_byte(wc * 32 + fr, fq * 8);
#define PG8_SA(b, h) (((b) * 2 + (h)) * HTB)
#define PG8_SB(b, h) ((4 + (b) * 2 + (h)) * HTB)
#define PG8_STAGE(bufoff, gbase, voff) do { _Pragma("unroll") for (int _i = 0; _i < 2; ++_i) \
        __builtin_amdgcn_global_load_lds((const unsigned*)((const char*)(gbase) + (voff)[_i]), (PG8_LAS unsigned*)(lds + (bufoff) + ldsw + _i * 8192), 16, 0, 0); } while (0)
#define PG8_LDA(dst, b, h) do { _Pragma("unroll") for (int m = 0; m < 4; ++m) _Pragma("unroll") for (int k = 0; k < 2; ++k) dst[m][k] = *(const PG8_LAS bf16x8*)(lds + PG8_SA(b, h) + aoff + m * 2048 + k * 1024); } while (0)
#define PG8_LDB(dst, b, h) do { _Pragma("unroll") for (int n = 0; n < 2; ++n) _Pragma("unroll") for (int k = 0; k < 2; ++k) dst[n][k] = *(const PG8_LAS bf16x8*)(lds + PG8_SB(b, h) + boff + n * 2048 + k * 1024); } while (0)
#define PG8_MMA(ai, bj, At, Bt) do { __builtin_amdgcn_s_setprio(1); _Pragma("unroll") for (int m = 0; m < 4; ++m) _Pragma("unroll") for (int n = 0; n < 2; ++n) _Pragma("unroll") for (int k = 0; k < 2; ++k) \
        acc[ai][bj][m][n] = __builtin_amdgcn_mfma_f32_16x16x32_bf16(Bt[n][k], At[m][k], acc[ai][bj][m][n], 0, 0, 0); __builtin_amdgcn_s_setprio(0); } while (0)
#define PG8_WAIT_V(n) asm volatile("s_waitcnt vmcnt(" #n ")" ::: "memory")
#define PG8_WAIT_L(n) asm volatile("s_waitcnt lgkmcnt(" #n ")" ::: "memory")
#define PG8_BAR __builtin_amdgcn_s_barrier()
#define PG8_SCHED __builtin_amdgcn_sched_barrier(0)
    Unit cur, nxt; int ui = 0;
    if (!S.next(0, cur)) return;
    f32x4 acc[2][2][4][2];
#pragma unroll
    for (int a = 0; a < 2; ++a)
#pragma unroll
        for (int b = 0; b < 2; ++b)
#pragma unroll
            for (int m = 0; m < 4; ++m)
#pragma unroll
                for (int n = 0; n < 2; ++n) acc[a][b][m][n] = (f32x4){0.f, 0.f, 0.f, 0.f};
    bf16x8 At[4][2], B0[2][2], B1[2][2];
    const char* cA = (const char*)g.A + (size_t)cur.pm * tstep; const char* cB = (const char*)g.Bt + (size_t)cur.pn * tstep;
    S.a_ready(cur);
    if constexpr (SP2) {
        PG8_STAGE(PG8_SB(0, 0), cB, voffB); PG8_STAGE(PG8_SB(0, 1), cB + hstep, voffB); PG8_STAGE(PG8_SA(0, 0), cA, voffA); PG8_STAGE(PG8_SA(0, 1), cA + hstep, voffA);
        if (wr == 1) PG8_BAR;
        PG8_WAIT_V(2); PG8_BAR;
        PG8_STAGE(PG8_SB(1, 0), cB + kstep, voffB); PG8_STAGE(PG8_SA(1, 0), cA + kstep, voffA); PG8_STAGE(PG8_SB(1, 1), cB + hstep + kstep, voffB);
        PG8_WAIT_V(6); PG8_BAR;
    } else {
        PG8_STAGE(PG8_SB(0, 0), cB, voffB); PG8_STAGE(PG8_SA(0, 0), cA, voffA); PG8_STAGE(PG8_SB(0, 1), cB + hstep, voffB); PG8_STAGE(PG8_SA(0, 1), cA + hstep, voffA);
        if (wr == 1) PG8_BAR;
        PG8_WAIT_V(4); PG8_BAR;
        PG8_STAGE(PG8_SB(1, 0), cB + kstep, voffB); PG8_STAGE(PG8_SA(1, 0), cA + kstep, voffA); PG8_STAGE(PG8_SB(1, 1), cB + hstep + kstep, voffB);
        PG8_WAIT_V(6); PG8_BAR;
    }
    for (;;) {
        const bool has_next = S.next(ui + 1, nxt);
        const char* nA = has_next ? (const char*)g.A + (size_t)nxt.pm * tstep : cA; const char* nB = has_next ? (const char*)g.Bt + (size_t)nxt.pn * tstep : cB;
        for (int t = 0; t < nt; t += 2) {
            const bool last = (t == nt - 2);
            const char* a1 = cA + (size_t)(t + 1) * kstep;
            const char* a2 = last ? nA : cA + (size_t)(t + 2) * kstep; const char* b2 = last ? nB : cB + (size_t)(t + 2) * kstep;
            const char* a3 = a2 + kstep; const char* b3 = b2 + kstep;
            if (last && has_next) S.a_ready(nxt);
            if constexpr (SP2) {
            PG8_LDB(B0, 0, 0); PG8_LDB(B1, 0, 1); PG8_SCHED; PG8_LDA(At, 0, 0); PG8_STAGE(PG8_SA(1, 1), a1 + hstep, voffA);
            PG8_WAIT_V(8); PG8_WAIT_L(0); PG8_BAR; PG8_MMA(0, 0, At, B0); PG8_MMA(0, 1, At, B1); PG8_BAR; PG8_SCHED;
            PG8_LDA(At, 0, 1); PG8_STAGE(PG8_SB(0, 0), b2, voffB); PG8_STAGE(PG8_SB(0, 1), b2 + hstep, voffB); PG8_STAGE(PG8_SA(0, 0), a2, voffA);
            PG8_WAIT_V(8); PG8_WAIT_L(0); PG8_BAR; PG8_MMA(1, 0, At, B0); PG8_MMA(1, 1, At, B1); PG8_BAR; PG8_SCHED;
            PG8_LDB(B0, 1, 0); PG8_LDB(B1, 1, 1); PG8_SCHED; PG8_LDA(At, 1, 0); PG8_STAGE(PG8_SA(0, 1), a2 + hstep, voffA);
            PG8_WAIT_V(8); PG8_WAIT_L(0); PG8_BAR; PG8_MMA(0, 0, At, B0); PG8_MMA(0, 1, At, B1); PG8_BAR; PG8_SCHED;
            PG8_LDA(At, 1, 1); PG8_STAGE(PG8_SB(1, 0), b3, voffB); PG8_STAGE(PG8_SB(1, 1), b3 + hstep, voffB); PG8_STAGE(PG8_SA(1, 0), a3, voffA);
            PG8_WAIT_V(8); PG8_WAIT_L(0); PG8_BAR; PG8_MMA(1, 0, At, B0); PG8_MMA(1, 1, At, B1); PG8_BAR; PG8_SCHED;
            } else {
            PG8_LDB(B0, 0, 0); PG8_SCHED; PG8_LDA(At, 0, 0); PG8_STAGE(PG8_SA(1, 1), a1 + hstep, voffA);
            PG8_WAIT_L(8); PG8_BAR; PG8_WAIT_L(0); PG8_MMA(0, 0, At, B0); PG8_BAR; PG8_SCHED;
            PG8_LDB(B1, 0, 1); PG8_STAGE(PG8_SB(0, 0), b2, voffB);
            PG8_BAR; PG8_WAIT_L(0); PG8_MMA(0, 1, At, B1); PG8_BAR;
            PG8_LDA(At, 0, 1); PG8_STAGE(PG8_SA(0, 0), a2, voffA);
            PG8_BAR; PG8_WAIT_L(0); PG8_MMA(1, 0, At, B0); PG8_BAR; PG8_SCHED;
            PG8_STAGE(PG8_SB(0, 1), b2 + hstep, voffB);
            PG8_WAIT_V(6); PG8_BAR; PG8_MMA(1, 1, At, B1); PG8_BAR;
            PG8_LDB(B0, 1, 0); PG8_SCHED; PG8_LDA(At, 1, 0); PG8_STAGE(PG8_SA(0, 1), a2 + hstep, voffA);
            PG8_WAIT_L(8); PG8_BAR; PG8_WAIT_L(0); PG8_MMA(0, 0, At, B0); PG8_BAR; PG8_SCHED;
            PG8_LDB(B1, 1, 1); PG8_STAGE(PG8_SB(1, 0), b3, voffB);
            PG8_BAR; PG8_WAIT_L(0); PG8_MMA(0, 1, At, B1); PG8_BAR;
            PG8_LDA(At, 1, 1); PG8_STAGE(PG8_SA(1, 0), a3, voffA);
            PG8_BAR; PG8_WAIT_L(0); PG8_MMA(1, 0, At, B0); PG8_BAR; PG8_SCHED;
            PG8_STAGE(PG8_SB(1, 1), b3 + hstep, voffB);
            PG8_WAIT_V(6); PG8_BAR; PG8_MMA(1, 1, At, B1); PG8_BAR;
            }
        }
        if constexpr (ALIGN_EPI) { if (wr == 0) PG8_BAR; }
        if constexpr (!Epi::AFTER_DRAIN) { E(acc, cur, wr, wc, fr, fq); S.done(cur); }
        if (!has_next) break;
#pragma unroll
        for (int a = 0; a < 2; ++a)
#pragma unroll
            for (int b = 0; b < 2; ++b)
#pragma unroll
                for (int m = 0; m < 4; ++m)
#pragma unroll
                    for (int n = 0; n < 2; ++n) acc[a][b][m][n] = (f32x4){0.f, 0.f, 0.f, 0.f};
        cur = nxt; cA = nA; cB = nB; ++ui;
        if constexpr (ALIGN_EPI) { if (wr == 1) PG8_BAR; }
    }
    PG8_WAIT_V(0);
    if constexpr (!ALIGN_EPI) { if (wr == 0) PG8_BAR; }
    PG8_BAR;
    if constexpr (Epi::AFTER_DRAIN) { E.fused(acc, cur, wr, wc, fr, fq, lds, wid, lane); S.done(cur); }
#undef PG8_SA
#undef PG8_SB
#undef PG8_STAGE
#undef PG8_LDA
#undef PG8_LDB
#undef PG8_MMA
#undef PG8_WAIT_V
#undef PG8_WAIT_L
#undef PG8_BAR
#undef PG8_SCHED
}
}

#define EPI_V8(v, A, s) float v[8] = {A[0][0] * (s), A[0][1] * (s), A[0][2] * (s), A[0][3] * (s), A[1][0] * (s), A[1][1] * (s), A[1][2] * (s), A[1][3] * (s)}
__device__ __forceinline__ uint4 pk8(const float (&v)[8]) {
  return make_uint4(pg8::cvt_pk_bf16(v[0], v[1]), pg8::cvt_pk_bf16(v[2], v[3]), pg8::cvt_pk_bf16(v[4], v[5]), pg8::cvt_pk_bf16(v[6], v[7]));
}
struct EpiIn {
  static constexpr bool PERM = true, AFTER_DRAIN = false;
  u16* U; u16* QK; const float* RS;
  __device__ __forceinline__ void operator()(const pg8::f32x4 (&acc)[2][2][4][2], const pg8::Unit& u, int wr, int wc, int fr, int fq) const {
    const int row0 = u.pm * 256 + wr * 64 + fr, colt = u.pn * 256, c0 = colt + wc * 32 + 8 * fq;
    const bool isu = colt < 512;
#pragma unroll
    for (int ai = 0; ai < 2; ++ai)
#pragma unroll
      for (int m = 0; m < 4; ++m) {
        const int row = row0 + ai * 128 + m * 16;
        const float r = RS[row];
#pragma unroll
        for (int bj = 0; bj < 2; ++bj) {
          const int col = c0 + bj * 128;
          EPI_V8(v, acc[ai][bj][m], r);
          if (isu) {
#pragma unroll
            for (int j = 0; j < 8; ++j) v[j] = gelu_f(v[j]);
            *(uint4*)(U + (size_t)row * 512 + col) = pk8(v);
          } else {
            *(uint4*)(QK + (size_t)row * 1024 + (col - 512)) = pk8(v);
          }
        }
      }
  }
};
struct EpiInT {
  static constexpr bool PERM = true, AFTER_DRAIN = false;
  u16* GVT; u16* VT; const float* RS; float* VSS;
  __device__ __forceinline__ void operator()(const pg8::f32x4 (&acc)[2][2][4][2], const pg8::Unit& u, int wr, int wc, int fr, int fq) const {
    const int ch0 = u.pm * 256 + wr * 64 + fr, t0 = u.pn * 256 + wc * 32 + 8 * fq;
    const bool isg = u.pm < 2;
#pragma unroll
    for (int bj = 0; bj < 2; ++bj) {
      const int t = t0 + bj * 128, b = t >> 12, s = t & 4095;
      const float4 ra = *(const float4*)(RS + t), rb = *(const float4*)(RS + t + 4);
      const float rr[8] = {ra.x, ra.y, ra.z, ra.w, rb.x, rb.y, rb.z, rb.w};
      float ss[8] = {0.f, 0.f, 0.f, 0.f, 0.f, 0.f, 0.f, 0.f};
#pragma unroll
      for (int ai = 0; ai < 2; ++ai)
#pragma unroll
        for (int m = 0; m < 4; ++m) {
          const int ch = ch0 + ai * 128 + m * 16;
          float v[8];
#pragma unroll
          for (int j = 0; j < 8; ++j) v[j] = acc[ai][bj][m][j >> 2][j & 3] * rr[j];
          if (isg) {
#pragma unroll
            for (int j = 0; j < 8; ++j) { v[j] = gelu_f(v[j]); ss[j] += v[j] * v[j]; }
            *(uint4*)(GVT + ((size_t)b * 512 + ch) * SEQ + s) = pk8(v);
          } else {
            *(uint4*)(VT + ((size_t)b * 512 + (ch - 512)) * SEQ + s) = pk8(v);
          }
        }
      if (isg) {
#pragma unroll
        for (int j = 0; j < 8; ++j) {
          float sv = ss[j];
          sv += dpp_f<DPP_X1>(sv); sv += dpp_f<DPP_X2>(sv); sv += dpp_f<DPP_HM>(sv); sv += dpp_f<DPP_R8>(sv);
          if (fr == 0) atomicAdd(VSS + t + j, sv);
        }
      }
    }
  }
};
struct EpiOut {
  static constexpr bool PERM = true, AFTER_DRAIN = false;
  const float* X; float* OUT; u16* HB;
  __device__ __forceinline__ void operator()(const pg8::f32x4 (&acc)[2][2][4][2], const pg8::Unit& u, int wr, int wc, int fr, int fq) const {
    const int row0 = u.pm * 256 + wr * 64 + fr, c0 = u.pn * 256 + wc * 32 + 8 * fq;
#pragma unroll
    for (int ai = 0; ai < 2; ++ai)
#pragma unroll
      for (int m = 0; m < 4; ++m) {
        const int row = row0 + ai * 128 + m * 16;
#pragma unroll
        for (int bj = 0; bj < 2; ++bj) {
          const size_t idx = (size_t)row * 1024 + c0 + bj * 128;
          const float4 xa = *(const float4*)(X + idx), xb = *(const float4*)(X + idx + 4);
          float v[8] = {xa.x + acc[ai][bj][m][0][0], xa.y + acc[ai][bj][m][0][1], xa.z + acc[ai][bj][m][0][2], xa.w + acc[ai][bj][m][0][3],
                        xb.x + acc[ai][bj][m][1][0], xb.y + acc[ai][bj][m][1][1], xb.z + acc[ai][bj][m][1][2], xb.w + acc[ai][bj][m][1][3]};
          *(uint4*)(HB + idx) = pk8(v);
        }
      }
  }
};
struct EpiQ {
  static constexpr bool PERM = true, AFTER_DRAIN = false;
  u16* PQ;
  __device__ __forceinline__ void operator()(const pg8::f32x4 (&acc)[2][2][4][2], const pg8::Unit& u, int wr, int wc, int fr, int fq) const {
    const int row0 = u.pm * 256 + wr * 64 + fr, c0 = u.pn * 256 + wc * 32 + 8 * fq;
#pragma unroll
    for (int ai = 0; ai < 2; ++ai)
#pragma unroll
      for (int m = 0; m < 4; ++m) {
        const int row = row0 + ai * 128 + m * 16;
#pragma unroll
        for (int bj = 0; bj < 2; ++bj) {
          EPI_V8(v, acc[ai][bj][m], 1.f);
          *(uint4*)(PQ + (size_t)row * 2048 + c0 + bj * 128) = pk8(v);
        }
      }
  }
};
#define LDS3(p) ((__attribute__((address_space(3))) unsigned char*)(p))

__device__ __forceinline__ void quant_pair(const Params& p, int row0, int lane) {
  unsigned char* EU4 = (unsigned char*)(p.ws + OFF_EU);
  unsigned char* EV4 = (unsigned char*)(p.ws + OFF_EV);
  float* ESC = (float*)(p.ws + OFF_ESC);
  float4 g4[2][2];
#pragma unroll
  for (int j = 0; j < 2; ++j)
#pragma unroll
    for (int q = 0; q < 2; ++q) g4[j][q] = ((const float4*)p.ln_ffn_g)[j * 128 + lane * 2 + q];

      const bool isv = row0 >= 16384;
      float4 v[2][2][2];
#pragma unroll
      for (int r = 0; r < 2; ++r) {
        const float4* src = (const float4*)((isv ? p.peer_v : p.peer_u) + (size_t)((row0 + r) & 16383) * 1024);
#pragma unroll
        for (int j = 0; j < 2; ++j)
#pragma unroll
          for (int q = 0; q < 2; ++q) v[r][j][q] = src[j * 128 + lane * 2 + q];
      }
#pragma unroll
      for (int r = 0; r < 2; ++r) {
        const int e = (row0 + r) & 16383;
        float sq = 0.f, am = 0.f;
#pragma unroll
        for (int j = 0; j < 2; ++j)
#pragma unroll
          for (int q = 0; q < 2; ++q) {
            float4 t4 = v[r][j][q];
            if (!isv) { t4.x *= g4[j][q].x; t4.y *= g4[j][q].y; t4.z *= g4[j][q].z; t4.w *= g4[j][q].w; }
            sq += t4.x * t4.x + t4.y * t4.y + t4.z * t4.z + t4.w * t4.w;
            am = fmaxf(am, fmaxf(fmaxf(fabsf(t4.x), fabsf(t4.y)), fmaxf(fabsf(t4.z), fabsf(t4.w))));
            v[r][j][q] = t4;
          }
#pragma unroll
        for (int o = 1; o < 64; o <<= 1) { sq += __shfl_xor(sq, o); am = fmaxf(am, __shfl_xor(am, o)); }
        const float rng = isv ? am : 2.6f * sqrtf(sq * (1.f / 1024.f));
        const float qmax = isv ? 6.0f : 7.0f;
        const bool ok = (rng > 1e-30f);
        const float scale = ok ? qmax / rng : 0.f;
        const float inv = ok ? rng / qmax : 0.f;
        unsigned char* dst = (isv ? EV4 : EU4) + (size_t)e * 128 + (lane & 31) * 4;
#define Q4C(x, i) q4(fminf(fmaxf((x) * scale, -7.f), 7.f), (i))
#pragma unroll
        for (int j = 0; j < 2; ++j) {
          unsigned w = 0;
          if (isv) {
            w = __builtin_amdgcn_cvt_scalef32_pk_fp4_f32(w, v[r][j][0].x * scale, v[r][j][0].y * scale, 1.0f, 0);
            w = __builtin_amdgcn_cvt_scalef32_pk_fp4_f32(w, v[r][j][0].z * scale, v[r][j][0].w * scale, 1.0f, 1);
            w = __builtin_amdgcn_cvt_scalef32_pk_fp4_f32(w, v[r][j][1].x * scale, v[r][j][1].y * scale, 1.0f, 2);
            w = __builtin_amdgcn_cvt_scalef32_pk_fp4_f32(w, v[r][j][1].z * scale, v[r][j][1].w * scale, 1.0f, 3);
          } else {
            w = Q4C(v[r][j][0].x, 0) | Q4C(v[r][j][0].y, 1) | Q4C(v[r][j][0].z, 2) | Q4C(v[r][j][0].w, 3) |
                Q4C(v[r][j][1].x, 4) | Q4C(v[r][j][1].y, 5) | Q4C(v[r][j][1].z, 6) | Q4C(v[r][j][1].w, 7);
          }
          *(unsigned*)(dst + (size_t)(j * 2 + (lane >> 5)) * (2 * MiB)) = w;
        }
#undef Q4C
        if (lane == 0) ESC[row0 + r] = inv;
      }
    }

__device__ __forceinline__ void phase0(const Params& p, char* lds) {
  const int tid = tid_(), lane = tid & 63, wave = tid >> 6;
  const int nblk = gridDim.x, blk = bid_();
  u16* XB = (u16*)(p.ws + OFF_XB);
  float* RS = (float*)(p.ws + OFF_RS);
  float* VSS = (float*)(p.ws + OFF_VSS);
  for (int row0 = (blk * NWAVE + wave) * 4; row0 < T; row0 += nblk * NWAVE * 4) {
    float4 v[4][4];
#pragma unroll
    for (int r = 0; r < 4; ++r) {
      const float4* xr = (const float4*)(p.x + (size_t)(row0 + r) * DM);
#pragma unroll
      for (int j = 0; j < 2; ++j) { v[r][2 * j] = xr[j * 128 + lane * 2]; v[r][2 * j + 1] = xr[j * 128 + lane * 2 + 1]; }
    }
#pragma unroll
    for (int r = 0; r < 4; ++r) {
      float ss = 0.f;
#pragma unroll
      for (int i = 0; i < 4; ++i) ss += v[r][i].x * v[r][i].x + v[r][i].y * v[r][i].y + v[r][i].z * v[r][i].z + v[r][i].w * v[r][i].w;
      ss = wave_sum(ss);
      if (lane == 0) RS[row0 + r] = rsqrtf(ss * (1.f / 1024.f) + EPS);
#pragma unroll
      for (int j = 0; j < 2; ++j)
        *(uint4*)(XB + (size_t)(row0 + r) * DM + j * 512 + lane * 8) =
            make_uint4(pg8::cvt_pk_bf16(v[r][2 * j].x, v[r][2 * j].y), pg8::cvt_pk_bf16(v[r][2 * j].z, v[r][2 * j].w),
                       pg8::cvt_pk_bf16(v[r][2 * j + 1].x, v[r][2 * j + 1].y), pg8::cvt_pk_bf16(v[r][2 * j + 1].z, v[r][2 * j + 1].w));
    }
  }
  {
    const int half = wave >> 2, w4 = wave & 3;
    float* tile = (float*)lds + half * (64 * 65);
    for (int tp = blk; tp < 704; tp += nblk) {
      const int tl = tp * 2 + half;
      const float* W; const float* gain; u16* dst; int N, kt, nt, drow;
      if (tl < 640) {
        W = p.w_in; gain = p.ln_mix_g; N = 2560; kt = tl / 40; nt = tl % 40;
        const int n0 = nt * 64;
        if (n0 < 512) { dst = (u16*)(p.ws + OFF_WINT); drow = n0; }
        else if (n0 < 1024) { dst = (u16*)(p.ws + OFF_WB); drow = n0 - 512; }
        else if (n0 < 2048) { dst = (u16*)(p.ws + OFF_WINT); drow = n0 - 512; }
        else { dst = (u16*)(p.ws + OFF_WB); drow = n0 - 2048 + 512; }
      } else if (tl < 896) { int t2 = tl - 640; W = p.w_out; gain = nullptr; dst = (u16*)(p.ws + OFF_WOUTT); N = 1024; kt = t2 / 16; nt = t2 % 16; drow = nt * 64; }
      else { int t2 = tl - 896; W = p.w_query; gain = p.ln_ffn_g; dst = (u16*)(p.ws + OFF_WQT); N = 2048; kt = t2 / 32; nt = t2 % 32; drow = nt * 64; }
      __syncthreads();
#pragma unroll
      for (int i = 0; i < 16; ++i) {
        const int kk = i * 4 + w4;
        const float gk = gain ? gain[kt * 64 + kk] : 1.f;
        tile[kk * 65 + lane] = W[(size_t)(kt * 64 + kk) * N + nt * 64 + lane] * gk;
      }
      __syncthreads();
#pragma unroll 4
      for (int i = 0; i < 16; ++i) {
        const int nn = i * 4 + w4;
        dst[(size_t)(drow + nn) * 1024 + kt * 64 + lane] = f2bf(tile[lane * 65 + nn]);
      }
    }
    __syncthreads();
  }
  {
    u16* KEYS = (u16*)(p.ws + OFF_KEYS);
    for (int i = blk * NTHR + tid; i < 262144 / 4; i += nblk * NTHR) {
      float4 a = ((const float4*)p.sub_keys)[i];
      *(uint2*)(KEYS + (size_t)i * 4) = make_uint2(pack2(a.x, a.y), pack2(a.z, a.w));
    }
  }
  for (int i = blk * NTHR + tid; i < T; i += nblk * NTHR) VSS[i] = 0.f;

}

__device__ __forceinline__ void phase1(const Params& p, char* lds) {
  const u16* XB = (const u16*)(p.ws + OFF_XB);
  const float* RS = (const float*)(p.ws + OFF_RS);
  {
    pg8::Gemm g{XB, (const u16*)(p.ws + OFF_WINT), T, 1536, 1024};
    pg8::StaticOrder S; S.init(T, 1536, (int)gridDim.x, (int)blockIdx.x);
    EpiIn E{(u16*)(p.ws + OFF_U), (u16*)(p.ws + OFF_QK), RS};
    pg8::gemm_phase<EpiIn, pg8::StaticOrder, true, true>(LDS3(lds), g, S, E);
  }
  {
    pg8::Gemm g{(const u16*)(p.ws + OFF_WB), XB, 1024, T, 1024};
    pg8::StaticOrder S; S.init(1024, T, (int)gridDim.x, (int)blockIdx.x);
    EpiInT E{(u16*)(p.ws + OFF_GVT), (u16*)(p.ws + OFF_VT), RS, (float*)(p.ws + OFF_VSS)};
    pg8::gemm_phase<EpiInT, pg8::StaticOrder, true, true>(LDS3(lds), g, S, E);
  }
}

__device__ __forceinline__ void gmlp_item(const Params& p, int item) {
  const int tid = tid_() & 255, lane = tid & 63, wave = tid >> 6, l15 = lane & 15, g = lane >> 4;
  const int gr = item & 7, n = (item >> 3) & 31, b = item >> 8;
  const int t0 = b * SEQ + n * 128;
  const float* VSS = (const float*)(p.ws + OFF_VSS);
  const u16* GVT = (const u16*)(p.ws + OFF_GVT);
  const u16* U = (const u16*)(p.ws + OFF_U);
  u16* AB = (u16*)(p.ws + OFF_AB);
  f32x4 acc[2][4];
#pragma unroll
  for (int i = 0; i < 2; ++i)
#pragma unroll
    for (int j = 0; j < 4; ++j) acc[i][j] = f32x4{0.f, 0.f, 0.f, 0.f};
  const int i_base = wave * 32;
  const bool low = wave < 2;
#pragma unroll
  for (int ks = 0; ks < 4; ++ks) {
    if (ks >= 2 && low) continue;
    const int j0 = ks * 32 + g * 8;
    const float4 s0 = *(const float4*)(VSS + t0 + j0), s1 = *(const float4*)(VSS + t0 + j0 + 4);
    float r[8] = {s0.x, s0.y, s0.z, s0.w, s1.x, s1.y, s1.z, s1.w};
#pragma unroll
    for (int q = 0; q < 8; ++q) r[q] = rsqrtf(r[q] * (1.f / 512.f) + EPS);
    bf16x8 wf[2];
#pragma unroll
    for (int mi = 0; mi < 2; ++mi) {
      const int i = i_base + mi * 16 + l15;
      const float* wp = p.gmlp_w_s + ((size_t)(gr * 128 + i)) * 128 + j0;
      const float4 w0 = *(const float4*)wp, w1 = *(const float4*)(wp + 4);
      wf[mi] = mk8(pack2(w0.x * r[0], w0.y * r[1]), pack2(w0.z * r[2], w0.w * r[3]), pack2(w1.x * r[4], w1.y * r[5]),
                   pack2(w1.z * r[6], w1.w * r[7]));
    }
#pragma unroll
    for (int ni = 0; ni < 4; ++ni) {
      const int c = ni * 16 + l15;
      const bf16x8 gf = *(const bf16x8*)(GVT + ((size_t)b * 512 + gr * 64 + c) * SEQ + n * 128 + j0);
#pragma unroll
      for (int mi = 0; mi < 2; ++mi) acc[mi][ni] = mfma16(gf, wf[mi], acc[mi][ni]);
    }
  }
#pragma unroll
  for (int mi = 0; mi < 2; ++mi) {
    const int i = i_base + mi * 16 + l15;
    const size_t t = (size_t)t0 + i;
    const float bs = p.gmlp_b_s[gr * 128 + i];
#pragma unroll
    for (int ni = 0; ni < 4; ++ni) {
      const int ch = gr * 64 + ni * 16 + g * 4;
      const float4 ng = *(const float4*)(p.gmlp_norm_g + ch);
      const uint2 uu = *(const uint2*)(U + t * 512 + ch);
      const float o0 = bf_lo(uu.x) * (acc[mi][ni][0] * ng.x + bs), o1 = bf_hi(uu.x) * (acc[mi][ni][1] * ng.y + bs);
      const float o2 = bf_lo(uu.y) * (acc[mi][ni][2] * ng.z + bs), o3 = bf_hi(uu.y) * (acc[mi][ni][3] * ng.w + bs);
      *(uint2*)(AB + t * 1024 + ch) = make_uint2(pack2(o0, o1), pack2(o2, o3));
    }
  }
}

constexpr int ATT_BUF = 2 * 64 * LSTR + 256;
constexpr float LOG2E = 1.4426950408889634f;
__device__ __forceinline__ void attn_item(const Params& p, int item, char* lds) {
  const int tid = tid_() & 255, lane = tid & 63, wave = tid >> 6, l15 = lane & 15, g = lane >> 4;
  const int c = item & 63, h = (item >> 6) & 7, b = item >> 9;
  const u16* QK = (const u16*)(p.ws + OFF_QK);
  const u16* VT = (const u16*)(p.ws + OFF_VT);
  u16* AB = (u16*)(p.ws + OFF_AB);
  float* bias_s = (float*)(lds + 2 * ATT_BUF);
  __syncthreads();
  float bmax = 0.f;
  for (int i = tid; i < 257; i += 256) { const float bv = p.rel_bias[h * 257 + i] * LOG2E; bias_s[i] = bv; bmax = fmaxf(bmax, fabsf(bv)); }
#pragma unroll
  for (int o = 1; o < 64; o <<= 1) bmax = fmaxf(bmax, __shfl_xor(bmax, o));
  if (lane == 0) bias_s[260 + wave] = bmax;
  const size_t tq = (size_t)b * SEQ + c * 64 + wave * 16 + l15;
  bf16x8 qb0, qb1;
  float mfix;
  {
    const u16* qp = QK + tq * 1024 + h * 64 + g * 8;
    const uint4 q0 = *(const uint4*)qp, q1 = *(const uint4*)(qp + 32);
    float f[16] = {bf_lo(q0.x), bf_hi(q0.x), bf_lo(q0.y), bf_hi(q0.y), bf_lo(q0.z), bf_hi(q0.z), bf_lo(q0.w), bf_hi(q0.w),
                   bf_lo(q1.x), bf_hi(q1.x), bf_lo(q1.y), bf_hi(q1.y), bf_lo(q1.z), bf_hi(q1.z), bf_lo(q1.w), bf_hi(q1.w)};
    float ss = 0.f;
#pragma unroll
    for (int i = 0; i < 16; ++i) ss += f[i] * f[i];
    ss += __shfl_xor(ss, 16); ss += __shfl_xor(ss, 32);
    const float rq = rsqrtf(ss * (1.f / 64.f) + EPS) * (0.125f * LOG2E);
    const float4 ga = *(const float4*)(p.q_norm_g + g * 8), gb = *(const float4*)(p.q_norm_g + g * 8 + 4);
    const float4 gc = *(const float4*)(p.q_norm_g + 32 + g * 8), gd = *(const float4*)(p.q_norm_g + 32 + g * 8 + 4);
    const float4 ka = *(const float4*)(p.k_norm_g + g * 8), kb = *(const float4*)(p.k_norm_g + g * 8 + 4);
    const float4 kc4 = *(const float4*)(p.k_norm_g + 32 + g * 8), kd = *(const float4*)(p.k_norm_g + 32 + g * 8 + 4);
    const float gg[16] = {ga.x * ka.x, ga.y * ka.y, ga.z * ka.z, ga.w * ka.w, gb.x * kb.x, gb.y * kb.y, gb.z * kb.z, gb.w * kb.w,
                          gc.x * kc4.x, gc.y * kc4.y, gc.z * kc4.z, gc.w * kc4.w, gd.x * kd.x, gd.y * kd.y, gd.z * kd.z, gd.w * kd.w};
#pragma unroll
    for (int i = 0; i < 16; ++i) f[i] *= rq * gg[i];
    float qn = 0.f;
#pragma unroll
    for (int i = 0; i < 16; ++i) qn += f[i] * f[i];
    qn += __shfl_xor(qn, 16); qn += __shfl_xor(qn, 32);
    mfix = fminf(8.f * sqrtf(qn) * 1.01f + 1.f, 60.f);
    qb0 = mk8(pg8::cvt_pk_bf16(f[0], f[1]), pg8::cvt_pk_bf16(f[2], f[3]), pg8::cvt_pk_bf16(f[4], f[5]), pg8::cvt_pk_bf16(f[6], f[7]));
    qb1 = mk8(pg8::cvt_pk_bf16(f[8], f[9]), pg8::cvt_pk_bf16(f[10], f[11]), pg8::cvt_pk_bf16(f[12], f[13]), pg8::cvt_pk_bf16(f[14], f[15]));
  }
  f32x4 o[4];
#pragma unroll
  for (int i = 0; i < 4; ++i) o[i] = f32x4{0.f, 0.f, 0.f, 0.f};
  float l_run = 0.f;
  const int srow = tid >> 2, spart = tid & 3;
  const int kc_lo = (c >= 8) ? 0 : (8 - c);
  const u16* kbase = QK + ((size_t)b * SEQ + srow) * 1024 + 512 + h * 64 + spart * 16;
  const u16* vbase = VT + ((size_t)b * 512 + h * 64 + srow) * SEQ + spart * 16;
  uint4 k0, k1, v0, v1;
  {
    const int kchunk = c - 8 + kc_lo;
    const u16* kp = kbase + (size_t)kchunk * 64 * 1024;
    k0 = *(const uint4*)kp; k1 = *(const uint4*)(kp + 8);
    const u16* vp = vbase + kchunk * 64;
    v0 = *(const uint4*)vp; v1 = *(const uint4*)(vp + 8);
  }
  for (int kc = kc_lo; kc <= 8; ++kc) {
    char* Ks = lds + ((kc - kc_lo) & 1) * ATT_BUF;
    char* Vs = Ks + 64 * LSTR;
    float* rks = (float*)(Ks + 2 * 64 * LSTR);
    {
      float ss = 0.f;
      ss = dot2(k0.x, k0.x, ss); ss = dot2(k0.y, k0.y, ss); ss = dot2(k0.z, k0.z, ss); ss = dot2(k0.w, k0.w, ss);
      ss = dot2(k1.x, k1.x, ss); ss = dot2(k1.y, k1.y, ss); ss = dot2(k1.z, k1.z, ss); ss = dot2(k1.w, k1.w, ss);
      ss += dpp_f<DPP_X1>(ss); ss += dpp_f<DPP_X2>(ss);
      if (spart == 0) rks[srow] = rsqrtf(ss * (1.f / 64.f) + EPS);
      char* kd = Ks + srow * LSTR + spart * 32;
      *(uint4*)kd = k0;
      *(uint4*)(kd + 16) = k1;
      char* vd = Vs + srow * LSTR + spart * 32;
      *(uint4*)vd = v0;
      *(uint4*)(vd + 16) = v1;
    }
    __syncthreads();
    if (kc < 8) {
      const int kchunk = c - 8 + kc + 1;
      const u16* kp = kbase + (size_t)kchunk * 64 * 1024;
      k0 = *(const uint4*)kp; k1 = *(const uint4*)(kp + 8);
      const u16* vp = vbase + kchunk * 64;
      v0 = *(const uint4*)vp; v1 = *(const uint4*)(vp + 8);
    }
    f32x4 s[4];
#pragma unroll
    for (int mt = 0; mt < 4; ++mt) {
      const char* kr = Ks + (mt * 16 + l15) * LSTR + g * 16;
      const bf16x8 a0 = *(const bf16x8*)kr, a1 = *(const bf16x8*)(kr + 64);
      s[mt] = mfma16(a0, qb0, f32x4{0.f, 0.f, 0.f, 0.f});
      s[mt] = mfma16(a1, qb1, s[mt]);
    }
    if (kc == kc_lo) mfix += fmaxf(fmaxf(bias_s[260], bias_s[261]), fmaxf(bias_s[262], bias_s[263]));
    float ls = 0.f;
    if (kc <= 5) {
      const float bc = bias_s[256] - mfix;
#pragma unroll
      for (int mt = 0; mt < 4; ++mt) {
        const float4 rk4 = *(const float4*)(rks + mt * 16 + g * 4);
        s[mt][0] = __builtin_amdgcn_exp2f(s[mt][0] * rk4.x + bc); s[mt][1] = __builtin_amdgcn_exp2f(s[mt][1] * rk4.y + bc);
        s[mt][2] = __builtin_amdgcn_exp2f(s[mt][2] * rk4.z + bc); s[mt][3] = __builtin_amdgcn_exp2f(s[mt][3] * rk4.w + bc);
        ls += (s[mt][0] + s[mt][1]) + (s[mt][2] + s[mt][3]);
      }
    } else {
      const int qi = wave * 16 + l15 + 64 * (8 - kc);
#pragma unroll
      for (int mt = 0; mt < 4; ++mt) {
        const float4 rk4 = *(const float4*)(rks + mt * 16 + g * 4);
        const float rr[4] = {rk4.x, rk4.y, rk4.z, rk4.w};
#pragma unroll
        for (int j = 0; j < 4; ++j) {
          int rel = qi - (mt * 16 + g * 4 + j);
          rel = rel > 128 ? 128 : rel;
          s[mt][j] = __builtin_amdgcn_exp2f(s[mt][j] * rr[j] + (bias_s[rel + 128] - mfix));
          ls += s[mt][j];
        }
      }
    }
    l_run += ls;
#pragma unroll
    for (int k2 = 0; k2 < 2; ++k2) {
      const bf16x8 pb = mk8(pg8::cvt_pk_bf16(s[2 * k2][0], s[2 * k2][1]), pg8::cvt_pk_bf16(s[2 * k2][2], s[2 * k2][3]),
                            pg8::cvt_pk_bf16(s[2 * k2 + 1][0], s[2 * k2 + 1][1]), pg8::cvt_pk_bf16(s[2 * k2 + 1][2], s[2 * k2 + 1][3]));
#pragma unroll
      for (int mt = 0; mt < 4; ++mt) {
        const char* vr = Vs + (mt * 16 + l15) * LSTR + (32 * k2 + 4 * g) * 2;
        const uint2 va = *(const uint2*)vr, vb = *(const uint2*)(vr + 32);
        o[mt] = mfma16(mk8(va.x, va.y, vb.x, vb.y), pb, o[mt]);
      }
    }
  }
  float l = l_run;
  l += __shfl_xor(l, 16); l += __shfl_xor(l, 32);
  const float inv = 1.f / l;
#pragma unroll
  for (int mt = 0; mt < 4; ++mt) {
    *(uint2*)(AB + tq * 1024 + 512 + h * 64 + mt * 16 + g * 4) =
        make_uint2(pg8::cvt_pk_bf16(o[mt][0] * inv, o[mt][1] * inv), pg8::cvt_pk_bf16(o[mt][2] * inv, o[mt][3] * inv));
  }
}

__device__ __forceinline__ void phase2(const Params& p, char* lds) {
  const int sub = tid_() >> 8;
  for (int it = bid_(); it < 2048 + 1024; it += gridDim.x) {
    if (it < 2048) {
      const int b = it >> 8, hp = (it >> 6) & 3, c = ((it & 63) + 8 * b) & 63;
      attn_item(p, (b << 9) | ((hp * 2 + sub) << 6) | c, lds + sub * 38912);
    } else {
      gmlp_item(p, (it - 2048) * 2 + sub);
    }
  }
}

__device__ __forceinline__ void phase3(const Params& p, char* lds) {
  pg8::Gemm g{(const u16*)(p.ws + OFF_AB), (const u16*)(p.ws + OFF_WOUTT), T, 1024, 1024};
  pg8::StaticOrder S; S.init(T, 1024, (int)gridDim.x, (int)blockIdx.x);
  EpiOut E{p.x, p.out, (u16*)(p.ws + OFF_HB)};
  pg8::gemm_phase<EpiOut, pg8::StaticOrder, true, true>(LDS3(lds), g, S, E);
}
__device__ __forceinline__ void phase4(const Params& p, char* lds) {
  pg8::Gemm g{(const u16*)(p.ws + OFF_HB), (const u16*)(p.ws + OFF_WQT), T, 2048, 1024};
  pg8::StaticOrder S; S.init(T, 2048, (int)gridDim.x, (int)blockIdx.x);
  EpiQ E{(u16*)(p.ws + OFF_PQ)};
  pg8::gemm_phase<EpiQ, pg8::StaticOrder, true, true>(LDS3(lds), g, S, E);
}

__device__ __forceinline__ unsigned dpp_xor1(unsigned v) { return (unsigned)__builtin_amdgcn_mov_dpp((int)v, 0xB1, 0xF, 0xF, true); }
__device__ __forceinline__ unsigned dpp_xor2(unsigned v) { return (unsigned)__builtin_amdgcn_mov_dpp((int)v, 0x4E, 0xF, 0xF, true); }
__device__ __forceinline__ void sort16_desc(unsigned (&v)[16]) {
#pragma unroll
  for (int k = 2; k <= 16; k <<= 1)
#pragma unroll
    for (int j = k >> 1; j > 0; j >>= 1)
#pragma unroll
      for (int i = 0; i < 16; ++i) {
        const int l = i ^ j;
        if (l > i) {
          const unsigned hi = max(v[i], v[l]), lo = min(v[i], v[l]);
          if ((i & k) == 0) { v[i] = hi; v[l] = lo; } else { v[i] = lo; v[l] = hi; }
        }
      }
}
__device__ __forceinline__ void merge16_desc(unsigned (&a)[16], const unsigned (&b)[16]) {
#pragma unroll
  for (int i = 0; i < 16; ++i) a[i] = max(a[i], b[15 - i]);
#pragma unroll
  for (int j = 8; j > 0; j >>= 1)
#pragma unroll
    for (int i = 0; i < 16; ++i) {
      const int l = i ^ j;
      if (l > i) { const unsigned hi = max(a[i], a[l]), lo = min(a[i], a[l]); a[i] = hi; a[l] = lo; }
    }
}
constexpr int SC_STR = 385, LSTR17 = 17;
constexpr int P5_LV = 64 * SC_STR, P5_LI = P5_LV + 128 * LSTR17, P5_TAB = P5_LI + 128 * LSTR17;

__device__ __forceinline__ void select_item(const Params& p, int item, int next_item, int kiter, char* lds, const bf16x8 (&kf)[8][4], bf16x8 (&qf)[4]) {
  const int tid = tid_(), lane = tid & 63, wave = tid >> 6, l15 = lane & 15, g = lane >> 4;
  const int h = item & 7, t0 = (item >> 3) * 64;
  const u16* PQ = (const u16*)(p.ws + OFF_PQ);
  int* EIDX = (int*)(p.ws + OFF_EIDX);
  float* BEST = (float*)(p.ws + OFF_BEST);
  float* sc = (float*)lds;
  float* LV = sc + P5_LV;
  int* LI = (int*)lds + P5_LI;
  const int* tab = (const int*)lds + P5_TAB;
  __syncthreads();
  {
    const int pp = wave >> 2, wq = wave & 3;
#pragma unroll
    for (int nt = 0; nt < 8; ++nt) {
      f32x4 a = f32x4{0.f, 0.f, 0.f, 0.f};
#pragma unroll
      for (int ks = 0; ks < 4; ++ks) a = mfma16(qf[ks], kf[nt][ks], a);
#pragma unroll
      for (int j = 0; j < 4; ++j) sc[(wq * 16 + g * 4 + j) * SC_STR + pp * 192 + (nt >> 1) * 48 + (nt & 1) * 16 + l15] = a[j];
    }
    if (next_item < 512 * 8) {
      const u16* qp = PQ + (size_t)((next_item >> 3) * 64 + wq * 16 + l15) * 2048 + (next_item & 7) * 256 + pp * 128 + g * 8;
#pragma unroll
      for (int ks = 0; ks < 4; ++ks) qf[ks] = *(const bf16x8*)(qp + ks * 32);
    }
  }
  __syncthreads();
  {
    const int q = tid & 3, list = tid >> 2, row = list & 63, pp = list >> 6;
    const float* rowp = sc + row * SC_STR + pp * 192;
    const float* src = rowp + q * 48;
    unsigned A[16], B[16];
#pragma unroll
    for (int j = 0; j < 16; ++j) {
      A[j] = (okey(src[j]) & ~127u) | (unsigned)(127 - (q * 32 + j));
      B[j] = (okey(src[16 + j]) & ~127u) | (unsigned)(127 - (q * 32 + 16 + j));
    }
    sort16_desc(A);
    sort16_desc(B);
    merge16_desc(A, B);
#pragma unroll
    for (int i = 0; i < 16; ++i) B[i] = dpp_xor1(A[i]);
    merge16_desc(A, B);
#pragma unroll
    for (int i = 0; i < 16; ++i) B[i] = dpp_xor2(A[i]);
    merge16_desc(A, B);
#pragma unroll
    for (int r = 0; r < 16; ++r) {
      if ((r & 3) == q) {
        const int idx = 127 - (int)(A[r] & 127u);
        LV[list * LSTR17 + r] = rowp[(idx >> 5) * 48 + (idx & 31)];
        LI[list * LSTR17 + r] = idx;
      }
    }
  }
  __syncthreads();
  if (tid >= 256) {
    quant_pair(p, 2 * ((kiter * 4 + (wave - 4)) * (int)gridDim.x + bid_()), lane);
  } else {
    const int grp = tid & 3, row = tid >> 2;
    const float* v0 = LV + row * LSTR17;
    const float* v1 = LV + (64 + row) * LSTR17;
    unsigned A[16], B[16];
#pragma unroll
    for (int j = 0; j < 16; ++j) {
      const int code = tab[grp * 16 + j];
      const int cc = code & 255;
      const float s = v0[cc >> 4] + v1[cc & 15];
      A[j] = (code < 0) ? 0u : ((okey(s) & ~255u) | (unsigned)(255 - cc));
    }
    sort16_desc(A);
#pragma unroll
    for (int i = 0; i < 16; ++i) B[i] = dpp_xor1(A[i]);
    merge16_desc(A, B);
#pragma unroll
    for (int i = 0; i < 16; ++i) B[i] = dpp_xor2(A[i]);
    merge16_desc(A, B);
    const size_t ob = ((size_t)(t0 + row) * 8 + h) * 16 + grp * 4;
    const int* i0 = LI + row * LSTR17;
    const int* i1 = LI + (64 + row) * LSTR17;
    int e4[4];
    float b4[4];
#pragma unroll
    for (int j = 0; j < 4; ++j) {
      const unsigned sel = (grp == 0) ? A[j] : (grp == 1) ? A[4 + j] : (grp == 2) ? A[8 + j] : A[12 + j];
      const int cc = 255 - (int)(sel & 255u);
      const int a = cc >> 4, bq = cc & 15;
      e4[j] = i0[a] * 128 + i1[bq];
      b4[j] = v0[a] + v1[bq];
    }
    *(int4*)(EIDX + ob) = make_int4(e4[0], e4[1], e4[2], e4[3]);
    *(float4*)(BEST + ob) = make_float4(b4[0], b4[1], b4[2], b4[3]);
  }
}

__device__ __forceinline__ void phase5(const Params& p, char* lds) {
  {
    const int i = tid_();
    if (i < 64) {
      const int grp = i >> 4, j = i & 15;
      int code = -1;
      if (grp == 0) code = j;
      else if (grp == 1) { if (j < 8) code = 16 + j; else if (j < 13) code = 32 + (j - 8); }
      else if (grp == 2) { if (j < 4) code = 48 + j; else if (j < 7) code = 64 + (j - 4); else if (j < 9) code = 80 + (j - 7); else if (j < 11) code = 96 + (j - 9); else if (j < 13) code = 112 + (j - 11); }
      else { if (j < 8) code = (8 + j) * 16; }
      ((int*)lds)[P5_TAB + i] = code;
    }
  }
  const int tid = tid_(), lane = tid & 63, wave = tid >> 6, l15 = lane & 15, g = lane >> 4;
  const int pp = wave >> 2, wq = wave & 3;
  int it = bid_();
  if (it >= 512 * 8) return;
  const bool fixed_head = (gridDim.x & 7) == 0;
  bf16x8 kf[8][4];
  bf16x8 qf[4];
  {
    const u16* KEYS = (const u16*)(p.ws + OFF_KEYS);
#pragma unroll
    for (int nt = 0; nt < 8; ++nt) {
      const u16* kp = KEYS + ((size_t)(((it & 7) * 2 + pp) * 128 + nt * 16 + l15)) * 128 + g * 8;
#pragma unroll
      for (int ks = 0; ks < 4; ++ks) kf[nt][ks] = *(const bf16x8*)(kp + ks * 32);
    }
    const u16* qp = (const u16*)(p.ws + OFF_PQ) + (size_t)((it >> 3) * 64 + wq * 16 + l15) * 2048 + (it & 7) * 256 + pp * 128 + g * 8;
#pragma unroll
    for (int ks = 0; ks < 4; ++ks) qf[ks] = *(const bf16x8*)(qp + ks * 32);
  }
  int kiter = 0;
  for (; it < 512 * 8; it += gridDim.x, ++kiter) {
    if (!fixed_head) {
      const u16* KEYS = (const u16*)(p.ws + OFF_KEYS);
#pragma unroll
      for (int nt = 0; nt < 8; ++nt) {
        const u16* kp = KEYS + ((size_t)(((it & 7) * 2 + pp) * 128 + nt * 16 + l15)) * 128 + g * 8;
#pragma unroll
        for (int ks = 0; ks < 4; ++ks) kf[nt][ks] = *(const bf16x8*)(kp + ks * 32);
      }
    }
    select_item(p, it, it + (int)gridDim.x, kiter, lds, kf, qf);
  }
  {
    const int G = (int)gridDim.x, kmin = (512 * 8) / G;
    for (int pr = kmin * 4 * G + bid_() * NWAVE + wave; pr < 16384; pr += G * NWAVE) quant_pair(p, 2 * pr, lane);
  }
}

#define P4(w, i) __builtin_amdgcn_cvt_scalef32_pk_f32_fp4((w), 1.0f, (i))
#define B4(w, i) __builtin_amdgcn_cvt_scalef32_pk_bf16_fp4((w), 1.0f, (i))
__device__ __forceinline__ f32x2 hpair(unsigned w) { return f32x2{bf_lo(w), bf_hi(w)}; }
__device__ __forceinline__ float dot32_fp4(const u32x4 u, const u32x4 (&h)[4], float acc) {
  f32x2 s = f32x2{acc, 0.f};
  s = __builtin_elementwise_fma(P4(u.x, 0), hpair(h[0].x), s); s = __builtin_elementwise_fma(P4(u.x, 1), hpair(h[0].y), s);
  s = __builtin_elementwise_fma(P4(u.x, 2), hpair(h[0].z), s); s = __builtin_elementwise_fma(P4(u.x, 3), hpair(h[0].w), s);
  s = __builtin_elementwise_fma(P4(u.y, 0), hpair(h[1].x), s); s = __builtin_elementwise_fma(P4(u.y, 1), hpair(h[1].y), s);
  s = __builtin_elementwise_fma(P4(u.y, 2), hpair(h[1].z), s); s = __builtin_elementwise_fma(P4(u.y, 3), hpair(h[1].w), s);
  s = __builtin_elementwise_fma(P4(u.z, 0), hpair(h[2].x), s); s = __builtin_elementwise_fma(P4(u.z, 1), hpair(h[2].y), s);
  s = __builtin_elementwise_fma(P4(u.z, 2), hpair(h[2].z), s); s = __builtin_elementwise_fma(P4(u.z, 3), hpair(h[2].w), s);
  s = __builtin_elementwise_fma(P4(u.w, 0), hpair(h[3].x), s); s = __builtin_elementwise_fma(P4(u.w, 1), hpair(h[3].y), s);
  s = __builtin_elementwise_fma(P4(u.w, 2), hpair(h[3].z), s); s = __builtin_elementwise_fma(P4(u.w, 3), hpair(h[3].w), s);
  return s.x + s.y;
}
__device__ __forceinline__ void p6_gather(u32x4 (&buf)[16], const unsigned char* EXs  , unsigned loff  , int ea, int eb, int eg) {
#pragma unroll
  for (int it = 0; it < 16; ++it) {
    const int src = (it * 8 + eg) & 63;
    const unsigned e = (unsigned)__shfl((it < 8) ? ea : eb, src);
    buf[it] = *(const u32x4*)(EXs + (size_t)(e * 128u + loff));
  }
}
__device__ __forceinline__ void p6a_compute(const u32x4 (&buf)[16], const u32x4 (&h)[4], float* PART, int t, int part, int eg, bool b2, bool b1, bool b0) {
  float f[32];
#pragma unroll
  for (int i = 0; i < 4; ++i) {
    f[i * 8 + 0] = bf_lo(h[i].x); f[i * 8 + 1] = bf_hi(h[i].x); f[i * 8 + 2] = bf_lo(h[i].y); f[i * 8 + 3] = bf_hi(h[i].y);
    f[i * 8 + 4] = bf_lo(h[i].z); f[i * 8 + 5] = bf_hi(h[i].z); f[i * 8 + 6] = bf_lo(h[i].w); f[i * 8 + 7] = bf_hi(h[i].w);
  }
  float am = 0.f;
#pragma unroll
  for (int i = 0; i < 32; ++i) am = fmaxf(am, fabsf(f[i]));
  const bool ok = am > 1e-30f;
  const float sc = ok ? 7.0f / am : 0.f, inv = ok ? am * (1.f / 7.0f) : 0.f;
  int hq[4];
#pragma unroll
  for (int i = 0; i < 4; ++i)
    hq[i] = (int)(q4(f[i * 8 + 0] * sc, 0) | q4(f[i * 8 + 1] * sc, 1) | q4(f[i * 8 + 2] * sc, 2) | q4(f[i * 8 + 3] * sc, 3) |
                  q4(f[i * 8 + 4] * sc, 4) | q4(f[i * 8 + 5] * sc, 5) | q4(f[i * 8 + 6] * sc, 6) | q4(f[i * 8 + 7] * sc, 7));
  float d[16];
#pragma unroll
  for (int it = 0; it < 16; ++it) {
    int a = __builtin_amdgcn_sdot8((int)buf[it].x, hq[0], 0, false);
    a = __builtin_amdgcn_sdot8((int)buf[it].y, hq[1], a, false);
    a = __builtin_amdgcn_sdot8((int)buf[it].z, hq[2], a, false);
    a = __builtin_amdgcn_sdot8((int)buf[it].w, hq[3], a, false);
    d[it] = (float)a * inv;
  }
  float r[8];
#pragma unroll
  for (int i = 0; i < 8; ++i) r[i] = (b2 ? d[i + 8] : d[i]) + __shfl_xor(b2 ? d[i] : d[i + 8], 4);
  float s4[4];
#pragma unroll
  for (int i = 0; i < 4; ++i) s4[i] = (b1 ? r[i + 4] : r[i]) + dpp_f<DPP_X2>(b1 ? r[i] : r[i + 4]);
#pragma unroll
  for (int i = 0; i < 2; ++i) {
    const float u = (b0 ? s4[i + 2] : s4[i]) + dpp_f<DPP_X1>(b0 ? s4[i] : s4[i + 2]);
    PART[(size_t)t * 128 + (2 * part + i) * 8 + eg] = u;
  }
}
__device__ __forceinline__ void phase6a(const Params& p, char* lds) {
  const int tid = tid_(), lane = tid & 63, wave = tid >> 6, eg = lane >> 3, part = lane & 7;
  const int bid = bid_();
  const int x = bid & 7, xb = bid >> 3, ncb = ((int)gridDim.x + 7 - x) >> 3;
  const int sl = x >> 1, par = x & 1;
  const unsigned char* EUX = (const unsigned char*)(p.ws + OFF_EU) + (size_t)sl * (2 * MiB);
  const unsigned loff = (unsigned)part * 16u;
  const u16* HBX = (const u16*)(p.ws + OFF_HB) + sl * 256 + part * 32;
  const int* EIDX = (const int*)(p.ws + OFF_EIDX);
  float* PART = (float*)(p.ws + OFF_PART) + (size_t)sl * T * 128;
  const int tstep = ncb * NWAVE * 2;
  const bool b2 = (lane & 4) != 0, b1 = (lane & 2) != 0, b0 = (lane & 1) != 0;
  int t = (xb * NWAVE + wave) * 2 + par;
  if (t < T) {
    u32x4 A[16], B[16], hA[4], hB[4];
    int e0 = EIDX[(size_t)t * 128 + lane], e1 = EIDX[(size_t)t * 128 + 64 + lane];
    p6_gather(A, EUX, loff, e0, e1, eg);
#pragma unroll
    for (int i = 0; i < 4; ++i) hA[i] = *(const u32x4*)(HBX + (size_t)t * 1024 + i * 8);
    int tn = t + tstep;
    if (tn < T) { e0 = EIDX[(size_t)tn * 128 + lane]; e1 = EIDX[(size_t)tn * 128 + 64 + lane]; }
    for (;;) {
      int tnn = tn + tstep;
      if (tn < T) {
        p6_gather(B, EUX, loff, e0, e1, eg);
#pragma unroll
        for (int i = 0; i < 4; ++i) hB[i] = *(const u32x4*)(HBX + (size_t)tn * 1024 + i * 8);
        if (tnn < T) { e0 = EIDX[(size_t)tnn * 128 + lane]; e1 = EIDX[(size_t)tnn * 128 + 64 + lane]; }
      }
      p6a_compute(A, hA, PART, t, part, eg, b2, b1, b0);
      if (tn >= T) break;
      const int t3 = tnn + tstep;
      if (tnn < T) {
        p6_gather(A, EUX, loff, e0, e1, eg);
#pragma unroll
        for (int i = 0; i < 4; ++i) hA[i] = *(const u32x4*)(HBX + (size_t)tnn * 1024 + i * 8);
        if (t3 < T) { e0 = EIDX[(size_t)t3 * 128 + lane]; e1 = EIDX[(size_t)t3 * 128 + 64 + lane]; }
      }
      p6a_compute(B, hB, PART, tn, part, eg, b2, b1, b0);
      if (tnn >= T) break;
      t = tnn; tn = t3;
    }
  }
}

__device__ __forceinline__ void phase6m(const Params& p, char* lds) {
  const int tid = tid_(), lane = tid & 63, wave = tid >> 6;
  const u16* HB = (const u16*)(p.ws + OFF_HB);
  const float* ESC = (const float*)(p.ws + OFF_ESC);
  const int* EIDX = (const int*)(p.ws + OFF_EIDX);
  const float* BEST = (const float*)(p.ws + OFF_BEST);
  const float* PART = (const float*)(p.ws + OFF_PART);
  float* WGT = (float*)(p.ws + OFF_WGT);
  for (int t0 = (bid_() * NWAVE + wave) * 2; t0 < T; t0 += gridDim.x * NWAVE * 2) {
    uint4 ha[2], hb[2];
    float da[2], db[2], ba[2], bb[2];
    int ea[2], eb[2];
#pragma unroll
    for (int r = 0; r < 2; ++r) {
      const int t = t0 + r;
      ha[r] = *(const uint4*)(HB + (size_t)t * 1024 + lane * 16); hb[r] = *(const uint4*)(HB + (size_t)t * 1024 + lane * 16 + 8);
      const size_t i0 = (size_t)t * 128 + lane, i1 = i0 + 64;
      ea[r] = EIDX[i0]; eb[r] = EIDX[i1];
      ba[r] = BEST[i0]; bb[r] = BEST[i1];
      float sa = 0.f, sb = 0.f;
#pragma unroll
      for (int x = 0; x < 4; ++x) { sa += PART[(size_t)x * T * 128 + i0]; sb += PART[(size_t)x * T * 128 + i1]; }
      da[r] = sa; db[r] = sb;
    }
    float ua[2], ub[2], va[2], vb[2];
#pragma unroll
    for (int r = 0; r < 2; ++r) { ua[r] = ESC[ea[r]]; ub[r] = ESC[eb[r]]; va[r] = ESC[16384 + ea[r]]; vb[r] = ESC[16384 + eb[r]]; }
#pragma unroll
    for (int r = 0; r < 2; ++r) {
      const uint4 a = ha[r], b = hb[r];
      float ss = 0.f;
      ss = dot2(a.x, a.x, ss); ss = dot2(a.y, a.y, ss); ss = dot2(a.z, a.z, ss); ss = dot2(a.w, a.w, ss);
      ss = dot2(b.x, b.x, ss); ss = dot2(b.y, b.y, ss); ss = dot2(b.z, b.z, ss); ss = dot2(b.w, b.w, ss);
      ss = wave_sum(ss);
      const float rs2 = rsqrtf(ss * (1.f / 1024.f) + EPS);
      const float xa = ba[r] * rs2, xb = bb[r] * rs2;
      float ma = xa, mb = xb;
      ma = row16_max(ma); mb = row16_max(mb);
      const float pa = __expf(xa - ma), pb = __expf(xb - mb);
      float sa = pa, sb = pb;
      sa = row16_sum(sa); sb = row16_sum(sb);
      const size_t i0 = (size_t)(t0 + r) * 128 + lane;
      float* wrow = WGT + (size_t)(t0 + r) * 128 + (lane & 7) * 16 + (lane >> 3);
      wrow[0] = (pa / sa) * gelu_f(da[r] * rs2 * ua[r]) * va[r];
      wrow[8] = (pb / sb) * gelu_f(db[r] * rs2 * ub[r]) * vb[r];
    }
  }
}

__device__ __forceinline__ void p6b_compute(const u32x4 (&buf)[16], const f32x4 (&wv)[4], uint2 hr, float* orow, int eg, bool h5, bool h4, bool h3) {
  f32x2 acc[16];
#pragma unroll
  for (int i = 0; i < 16; ++i) acc[i] = f32x2{0.f, 0.f};
#pragma unroll
  for (int it = 0; it < 16; ++it) {
    const float w = wv[it >> 2][it & 3];
    const f32x2 w2 = f32x2{w, w};
    const u32x4 v = buf[it];
    acc[0] = __builtin_elementwise_fma(P4(v.x, 0), w2, acc[0]);   acc[1] = __builtin_elementwise_fma(P4(v.x, 1), w2, acc[1]);
    acc[2] = __builtin_elementwise_fma(P4(v.x, 2), w2, acc[2]);   acc[3] = __builtin_elementwise_fma(P4(v.x, 3), w2, acc[3]);
    acc[4] = __builtin_elementwise_fma(P4(v.y, 0), w2, acc[4]);   acc[5] = __builtin_elementwise_fma(P4(v.y, 1), w2, acc[5]);
    acc[6] = __builtin_elementwise_fma(P4(v.y, 2), w2, acc[6]);   acc[7] = __builtin_elementwise_fma(P4(v.y, 3), w2, acc[7]);
    acc[8] = __builtin_elementwise_fma(P4(v.z, 0), w2, acc[8]);   acc[9] = __builtin_elementwise_fma(P4(v.z, 1), w2, acc[9]);
    acc[10] = __builtin_elementwise_fma(P4(v.z, 2), w2, acc[10]); acc[11] = __builtin_elementwise_fma(P4(v.z, 3), w2, acc[11]);
    acc[12] = __builtin_elementwise_fma(P4(v.w, 0), w2, acc[12]); acc[13] = __builtin_elementwise_fma(P4(v.w, 1), w2, acc[13]);
    acc[14] = __builtin_elementwise_fma(P4(v.w, 2), w2, acc[14]); acc[15] = __builtin_elementwise_fma(P4(v.w, 3), w2, acc[15]);
  }
  f32x2 q1[8];
#pragma unroll
  for (int i = 0; i < 8; ++i) {
    const auto rx = __builtin_amdgcn_permlane32_swap(__float_as_uint(acc[i].x), __float_as_uint(acc[i + 8].x), false, false);
    const auto ry = __builtin_amdgcn_permlane32_swap(__float_as_uint(acc[i].y), __float_as_uint(acc[i + 8].y), false, false);
    q1[i] = f32x2{__uint_as_float(rx[0]) + __uint_as_float(rx[1]), __uint_as_float(ry[0]) + __uint_as_float(ry[1])};
  }
  f32x2 q2[4];
#pragma unroll
  for (int i = 0; i < 4; ++i) {
    const auto rx = __builtin_amdgcn_permlane16_swap(__float_as_uint(q1[i].x), __float_as_uint(q1[i + 4].x), false, false);
    const auto ry = __builtin_amdgcn_permlane16_swap(__float_as_uint(q1[i].y), __float_as_uint(q1[i + 4].y), false, false);
    q2[i] = f32x2{__uint_as_float(rx[0]) + __uint_as_float(rx[1]), __uint_as_float(ry[0]) + __uint_as_float(ry[1])};
  }
  f32x2 q3[2];
#pragma unroll
  for (int i = 0; i < 2; ++i) {
    const f32x2 sd = h3 ? q2[i] : q2[i + 2], kp = h3 ? q2[i + 2] : q2[i];
    q3[i] = f32x2{kp.x + dpp_f<DPP_R8>(sd.x), kp.y + dpp_f<DPP_R8>(sd.y)};
  }
  *(float4*)orow = make_float4(bf_lo(hr.x) + q3[0].x, bf_hi(hr.x) + q3[0].y, bf_lo(hr.y) + q3[1].x, bf_hi(hr.y) + q3[1].y);
}
__device__ __forceinline__ void phase6b(const Params& p, char* lds) {
  const int tid = tid_(), lane = tid & 63, wave = tid >> 6, eg = lane >> 3, part = lane & 7;
  const int bid = bid_();
  const int x = bid & 7, xb = bid >> 3, ncb = ((int)gridDim.x + 7 - x) >> 3;
  const int sl = x >> 1, par = x & 1;
  const unsigned char* EVX = (const unsigned char*)(p.ws + OFF_EV) + (size_t)sl * (2 * MiB);
  const unsigned loff = (unsigned)part * 16u;
  const int* EIDX = (const int*)(p.ws + OFF_EIDX);
  const float* WGT = (const float*)(p.ws + OFF_WGT);
  const int tstep = ncb * NWAVE * 2;
  const int pi = ((lane >> 5) & 1) * 4 + ((lane >> 4) & 1) * 2 + ((lane >> 3) & 1);
  const int ocol = sl * 256 + part * 32 + pi * 4;
  const u16* HB = (const u16*)(p.ws + OFF_HB) + ocol;
  float* OUT = p.out + ocol;
  const bool h5 = (lane & 32) != 0, h4 = (lane & 16) != 0, h3 = (lane & 8) != 0;
  int t = (xb * NWAVE + wave) * 2 + par;
  if (t < T) {
    u32x4 A[16], B[16];
    int e0 = EIDX[(size_t)t * 128 + lane], e1 = EIDX[(size_t)t * 128 + 64 + lane];
    f32x4 wA[4], wB[4];
#pragma unroll
    for (int i = 0; i < 4; ++i) { wA[i] = *(const f32x4*)(WGT + (size_t)t * 128 + eg * 16 + i * 4); wB[i] = wA[i]; }
    uint2 hA = *(const uint2*)(HB + (size_t)t * 1024), hB = make_uint2(0u, 0u);
    p6_gather(A, EVX, loff, e0, e1, eg);
    int tn = t + tstep;
    if (tn < T) { e0 = EIDX[(size_t)tn * 128 + lane]; e1 = EIDX[(size_t)tn * 128 + 64 + lane]; }
    for (;;) {
      int tnn = tn + tstep;
      if (tn < T) {
        p6_gather(B, EVX, loff, e0, e1, eg);
#pragma unroll
        for (int i = 0; i < 4; ++i) wB[i] = *(const f32x4*)(WGT + (size_t)tn * 128 + eg * 16 + i * 4);
        hB = *(const uint2*)(HB + (size_t)tn * 1024);
        if (tnn < T) { e0 = EIDX[(size_t)tnn * 128 + lane]; e1 = EIDX[(size_t)tnn * 128 + 64 + lane]; }
      }
      p6b_compute(A, wA, hA, OUT + (size_t)t * 1024, eg, h5, h4, h3);
      if (tn >= T) break;
      const int t3 = tnn + tstep;
      if (tnn < T) {
        p6_gather(A, EVX, loff, e0, e1, eg);
#pragma unroll
        for (int i = 0; i < 4; ++i) wA[i] = *(const f32x4*)(WGT + (size_t)tnn * 128 + eg * 16 + i * 4);
        hA = *(const uint2*)(HB + (size_t)tnn * 1024);
        if (t3 < T) { e0 = EIDX[(size_t)t3 * 128 + lane]; e1 = EIDX[(size_t)t3 * 128 + 64 + lane]; }
      }
      p6b_compute(B, wB, hB, OUT + (size_t)tn * 1024, eg, h5, h4, h3);
      if (tnn >= T) break;
      t = tnn; tn = t3;
    }
  }
}

#define LAS __attribute__((address_space(3)))
#define XB_TMO      128
#define XB_XCNT(j)  (256  + 64 * (j))
#define XB_XSUB(j)  (1280 + 64 * (j))
#define XB_XGEN(j)  (2304 + 64 * (j))
#define XB_TOP      3328
#define XB_TOPGEN   3392
#define XCD_BAR_WORDS 3456
#define XB_SPIN_CAP (1u << 18)

__device__ __forceinline__ unsigned xb_ld(unsigned* p)              { return __hip_atomic_load(p, __ATOMIC_RELAXED, __HIP_MEMORY_SCOPE_AGENT); }
__device__ __forceinline__ unsigned xb_add(unsigned* p, unsigned v) { return __hip_atomic_fetch_add(p, v, __ATOMIC_RELAXED, __HIP_MEMORY_SCOPE_AGENT); }
__device__ __forceinline__ unsigned xb_xcc_id() { return (unsigned)__builtin_amdgcn_s_getreg((3 << 11) | 20) & 0xFu; }
#define XB_SPIN(cond, bar) do { unsigned _sp = 0; while (cond) { __builtin_amdgcn_s_sleep(1); \
    if ((++_sp & 255u) == 0u) { if (xb_ld(&(bar)[XB_TMO])) break; if (_sp > XB_SPIN_CAP) { atomicAdd(&(bar)[XB_TMO], 1u); break; } } } } while (0)

struct XcdBarrier {
    unsigned* bar; unsigned x;
    volatile LAS unsigned* st;
};

__device__ __forceinline__ XcdBarrier xcd_barrier_post(unsigned* bar, volatile LAS unsigned* st) {
    XcdBarrier b; b.bar = bar; b.x = xb_xcc_id(); b.st = st;
    if (threadIdx.x == 0) (void)xb_add(&bar[XB_XCNT(b.x)], 1u);
    return b;
}
__device__ __forceinline__ void xcd_barrier_complete(unsigned* bar, unsigned x, unsigned& nloc, unsigned& nx) {
    const unsigned G = gridDim.x * gridDim.y * gridDim.z;
    unsigned sum, cnt, mine, sp = 0u;
    for (;;) {
        sum = 0u; cnt = 0u; mine = 0u;
#pragma unroll
        for (unsigned j = 0; j < 16; ++j) { const unsigned c = xb_ld(&bar[XB_XCNT(j)]); sum += c; cnt += (c > 0u) ? 1u : 0u; mine = (j == x) ? c : mine; }
        if (sum == G) break;
        __builtin_amdgcn_s_sleep(1);
        if ((++sp & 255u) == 0u) { if (xb_ld(&bar[XB_TMO])) break; if (sp > XB_SPIN_CAP) { atomicAdd(&bar[XB_TMO], 1u); break; } }
    }
    nloc = mine > 0u ? mine : 1u; nx = cnt > 0u ? cnt : 1u;
}

__device__ __forceinline__ void xcd_barrier(const XcdBarrier& b) {
    asm volatile("s_waitcnt vmcnt(0)" ::: "memory");
    __syncthreads();
    if (threadIdx.x == 0) {
        unsigned* bar = b.bar;
        __builtin_amdgcn_s_waitcnt(0);
        unsigned nloc = b.st[0], nx = b.st[1];
        if (nloc == 0u) { xcd_barrier_complete(bar, b.x, nloc, nx); b.st[0] = nloc; b.st[1] = nx; }
        const unsigned old = xb_add(&bar[XB_XSUB(b.x)], 1u);
        const unsigned gen = old / nloc;
        if (old + 1u == (gen + 1u) * nloc) {
            __builtin_amdgcn_fence(__ATOMIC_RELEASE, "agent");
            asm volatile("s_waitcnt vmcnt(0)" ::: "memory");
            const unsigned og = xb_add(&bar[XB_TOP], 1u);
            const unsigned tg = og / nx;
            if (og + 1u == (tg + 1u) * nx) xb_add(&bar[XB_TOPGEN], 1u);
            else XB_SPIN(xb_ld(&bar[XB_TOPGEN]) == tg, bar);
            __builtin_amdgcn_fence(__ATOMIC_ACQUIRE, "agent");
            xb_add(&bar[XB_XGEN(b.x)], 1u);
            asm volatile("s_waitcnt vmcnt(0)" ::: "memory");
        } else {
            XB_SPIN(xb_ld(&bar[XB_XGEN(b.x)]) == gen, bar);
            __builtin_amdgcn_fence(__ATOMIC_ACQUIRE, "agent");
            asm volatile("s_waitcnt vmcnt(0)" ::: "memory");
        }
    }
    __syncthreads();
}


__device__ __forceinline__ void seam_barrier(unsigned* ctr, unsigned nblk) {
  __syncthreads();
  if (threadIdx.x == 0) {
    __builtin_amdgcn_fence(__ATOMIC_RELEASE, "agent");
    asm volatile("s_waitcnt vmcnt(0)" ::: "memory");
    __hip_atomic_fetch_add(ctr, 1u, __ATOMIC_RELAXED, __HIP_MEMORY_SCOPE_AGENT);
    while (__hip_atomic_load(ctr, __ATOMIC_RELAXED, __HIP_MEMORY_SCOPE_AGENT) < nblk) __builtin_amdgcn_s_sleep(2);
    __builtin_amdgcn_fence(__ATOMIC_ACQUIRE, "agent");
    asm volatile("s_waitcnt vmcnt(0)" ::: "memory");
  }
  __syncthreads();
}
#ifndef PMASK
#define PMASK 127
#endif
#define PROG 0x6543210ull
#define NPROG 9
__global__ void __launch_bounds__(NTHR, 2) mega(Params p, int ph_lo, int ph_hi) {
  extern __shared__ __attribute__((aligned(16))) char lds[];
  cg::grid_group grid = cg::this_grid();
#ifndef REP_PHASE
#define REP_PHASE -1
#endif
#define IN(k) (ph_lo <= (k) && (k) < ph_hi)
  volatile LAS unsigned* xst = (volatile LAS unsigned*)(LDS3(lds) + (LDS_BYTES - 16));
  if (threadIdx.x == 0) { xst[0] = 0u; xst[1] = 0u; }
  XcdBarrier xbar; xbar.bar = (unsigned*)(p.ws + OFF_BAR); xbar.x = 0; xbar.st = xst;
  if (ph_hi - ph_lo > 1) {
    if (blockIdx.x == 0) for (int i = threadIdx.x; i < XCD_BAR_WORDS; i += NTHR) ((unsigned*)(p.ws + OFF_BAR))[i] = 0u;
    grid.sync();
    xbar = xcd_barrier_post((unsigned*)(p.ws + OFF_BAR), xst);
  }
#define SEAM(k) do { if (IN(k) && IN((k) + 1)) xcd_barrier(xbar); } while (0)
  if (IN(0)) { phase0(p, lds); if (REP_PHASE == 0) { grid.sync(); phase0(p, lds); } }
  SEAM(0);
  if (IN(1)) { phase1(p, lds); if (REP_PHASE == 1) { grid.sync(); phase1(p, lds); } }
  SEAM(1);
  if (IN(2)) { phase2(p, lds); if (REP_PHASE == 2) { grid.sync(); phase2(p, lds); } }
  SEAM(2);
  if (IN(3)) { phase3(p, lds); if (REP_PHASE == 3) { grid.sync(); phase3(p, lds); } }
  SEAM(3);
  if (IN(4)) { phase4(p, lds); if (REP_PHASE == 4) { grid.sync(); phase4(p, lds); } }
  SEAM(4);
  if (IN(5)) { phase5(p, lds); if (REP_PHASE == 5) { grid.sync(); phase5(p, lds); } }
  SEAM(5);
  if (IN(6)) { phase6a(p, lds); if (REP_PHASE == 6) { grid.sync(); phase6a(p, lds); } }
  SEAM(6);
  if (IN(7)) { phase6m(p, lds); if (REP_PHASE == 7) { grid.sync(); phase6m(p, lds); } }
  SEAM(7);
  if (IN(8)) phase6b(p, lds);
}

extern "C" void kernel_launch(void* const* d_in, const int* in_sizes, int n_in, void* d_out, int out_size, void* d_ws,
                              size_t ws_size, hipStream_t stream) {
  static int grid_blocks = 0;
  if (!grid_blocks) {
    int dev = 0, cus = 0, per_cu = 0;
    (void)hipGetDevice(&dev);
    (void)hipDeviceGetAttribute(&cus, hipDeviceAttributeMultiprocessorCount, dev);
    (void)hipFuncSetAttribute((const void*)mega, hipFuncAttributeMaxDynamicSharedMemorySize, LDS_BYTES);
    (void)hipOccupancyMaxActiveBlocksPerMultiprocessor(&per_cu, mega, NTHR, LDS_BYTES);
    if (per_cu > 1) per_cu = 1;
    grid_blocks = cus * per_cu;
  }
  Params p{};
  p.x = (const float*)d_in[0]; p.ln_mix_g = (const float*)d_in[1]; p.w_in = (const float*)d_in[2];
  p.gmlp_norm_g = (const float*)d_in[3]; p.gmlp_w_s = (const float*)d_in[4]; p.gmlp_b_s = (const float*)d_in[5];
  p.q_norm_g = (const float*)d_in[6]; p.k_norm_g = (const float*)d_in[7]; p.rel_bias = (const float*)d_in[8];
  p.w_out = (const float*)d_in[9]; p.ln_ffn_g = (const float*)d_in[10]; p.w_query = (const float*)d_in[11];
  p.sub_keys = (const float*)d_in[12]; p.peer_u = (const float*)d_in[13]; p.peer_v = (const float*)d_in[14];
  p.out = (float*)d_out; p.ws = (char*)d_ws;
#if FUSED
  int lo = 0, hi = NPROG;
  void* args[] = {&p, &lo, &hi};
  hipError_t e = hipLaunchCooperativeKernel((void*)mega, dim3(grid_blocks), dim3(NTHR), args, LDS_BYTES, stream);
  if (e != hipSuccess) fprintf(stderr, "cooperative launch failed: %s (grid %d)\n", hipGetErrorString(e), grid_blocks);
#else
  for (int ph = 0; ph < NPROG; ++ph) mega<<<dim3(grid_blocks), dim3(NTHR), LDS_BYTES, stream>>>(p, ph, ph + 1);
#endif
}
```

```cpp
#include <hip/hip_runtime.h>
#include <hip/hip_cooperative_groups.h>
#include <cstdio>
namespace cg = cooperative_groups;

#ifndef FUSED
#define FUSED 1
#endif

typedef unsigned short u16;
using bf16x8 = __attribute__((ext_vector_type(8))) short;
using s16x4 = __attribute__((ext_vector_type(4))) short;
using f32x4 = __attribute__((ext_vector_type(4))) float;
using bf16x2 = __attribute__((ext_vector_type(2))) __bf16;
using f32x2 = __attribute__((ext_vector_type(2))) float;
using u32x4 = __attribute__((ext_vector_type(4))) unsigned;
using u32x2 = __attribute__((ext_vector_type(2))) unsigned;

constexpr int T = 32768, DM = 1024, SEQ = 4096;
constexpr float EPS = 1e-6f;
constexpr size_t MiB = 1u << 20;
constexpr size_t OFF_XB = 0, OFF_WINT = 64 * MiB  , OFF_WB = 67 * MiB  , OFF_WOUTT = 69 * MiB, OFF_WQT = 71 * MiB, OFF_KEYS = 75 * MiB,
                 OFF_RS = 76 * MiB, OFF_VSS = 76 * MiB + 512 * 1024, OFF_EU = 77 * MiB, OFF_EV = 109 * MiB,
                 OFF_U = 141 * MiB, OFF_GVT = 173 * MiB, OFF_QK = 205 * MiB, OFF_VT = 269 * MiB, OFF_AB = 301 * MiB,
                 OFF_HB = 365 * MiB, OFF_PQ = 141 * MiB  , OFF_EIDX = 429 * MiB,
                 OFF_BEST = 445 * MiB, OFF_ESC = 461 * MiB  , OFF_WGT = 462 * MiB  , OFF_BAR = 480 * MiB  , OFF_PART = 141 * MiB  ;

struct Params {
  const float *x, *ln_mix_g, *w_in, *gmlp_norm_g, *gmlp_w_s, *gmlp_b_s, *q_norm_g, *k_norm_g, *rel_bias, *w_out,
      *ln_ffn_g, *w_query, *sub_keys, *peer_u, *peer_v;
  float* out;
  char* ws;
};

constexpr int LDS_BYTES = 131584;
constexpr int NTHR = 512, NWAVE = 8;
constexpr int LSTR = 144;
constexpr int OPER_BYTES = 128 * LSTR;

__device__ __forceinline__ u16 f2bf(float f) {
  unsigned u = __float_as_uint(f);
  u += 0x7fffu + ((u >> 16) & 1u);
  return (u16)(u >> 16);
}
__device__ __forceinline__ unsigned pack2(float lo, float hi) { return (unsigned)f2bf(lo) | ((unsigned)f2bf(hi) << 16); }
__device__ __forceinline__ float bf_lo(unsigned u) { return __uint_as_float(u << 16); }
__device__ __forceinline__ float bf_hi(unsigned u) { return __uint_as_float(u & 0xffff0000u); }
__device__ __forceinline__ float bf2f(u16 v) { return __uint_as_float(((unsigned)v) << 16); }
__device__ __forceinline__ float gelu_f(float x) {
  const float c1 = -2.f * 0.7978845608028654f * 1.4426950408889634f, c2 = c1 * 0.044715f;
  const float zp = x * __builtin_fmaf(x * x, c2, c1);
  return x * __builtin_amdgcn_rcpf(1.f + __builtin_amdgcn_exp2f(zp));
}
template <int CTRL> __device__ __forceinline__ float dpp_f(float v) { return __int_as_float(__builtin_amdgcn_mov_dpp(__float_as_int(v), CTRL, 0xF, 0xF, true)); }
constexpr int DPP_X1 = 0xB1  , DPP_X2 = 0x4E  , DPP_HM = 0x141  , DPP_R8 = 0x128  ;
__device__ __forceinline__ float dot2(unsigned a, unsigned b, float acc) {
  return __builtin_amdgcn_fdot2_f32_bf16(__builtin_bit_cast(bf16x2, a), __builtin_bit_cast(bf16x2, b), acc, false);
}
__device__ __forceinline__ f32x4 mfma16(bf16x8 a, bf16x8 b, f32x4 c) {
  return __builtin_amdgcn_mfma_f32_16x16x32_bf16(a, b, c, 0, 0, 0);
}
__device__ __forceinline__ bf16x8 mk8(unsigned a, unsigned b, unsigned c, unsigned d) {
  uint4 u = make_uint4(a, b, c, d);
  return __builtin_bit_cast(bf16x8, u);
}
__device__ __forceinline__ unsigned pack4_fp8(float a, float b, float c, float d) {
  int r = 0;
  r = __builtin_amdgcn_cvt_pk_fp8_f32(a, b, r, false);
  r = __builtin_amdgcn_cvt_pk_fp8_f32(c, d, r, true);
  return (unsigned)r;
}
__device__ __forceinline__ unsigned q4(float xs, int i) {
  return (__float_as_uint(xs + 12582912.f) & 15u) << (4 * i);
}
__device__ __forceinline__ unsigned okey(float x) {
  unsigned u = __float_as_uint(x);
  return (u & 0x80000000u) ? ~u : (u | 0x80000000u);
}


__device__ __forceinline__ int tid_() { int t = threadIdx.x; asm volatile("" : "+v"(t)); return t; }
__device__ __forceinline__ int bid_() { int b = blockIdx.x; asm volatile("" : "+s"(b)); return b; }
namespace pg8 {
#define PG8_LAS __attribute__((address_space(3)))
typedef unsigned short bf16_t;
typedef short bf16x8 __attribute__((ext_vector_type(8)));
typedef float f32x4 __attribute__((ext_vector_type(4)));
typedef unsigned u32x4 __attribute__((ext_vector_type(4)));
constexpr int BM = 256, BK = 64, HALF = 128, HTB = HALF * BK * 2  , STAGE_BYTES = 8 * HTB, NXCD = 8, WGM = 8;

__host__ __device__ __forceinline__ int lds_byte(int r, int c) { const int st = (r >> 4) * 2 + (c >> 5), rr = r & 15, cc = c & 31, ob = rr * 64 + cc * 2; return st * 1024 + (ob ^ (((ob >> 9) & 1) << 5)); }
__host__ __device__ __forceinline__ void stage_rc(int b, int& R, int& C) { const int st = b / 1024, sb = b % 1024, swz = sb ^ (((sb >> 9) & 1) << 5); R = (st >> 1) * 16 + swz / 64; C = (st & 1) * 32 + (swz % 64) / 2; }
__host__ __device__ __forceinline__ int perm32(int rho) { const int n = rho >> 4, i = rho & 15; return 8 * (i >> 2) + 4 * n + (i & 3); }

struct Unit { int pm, pn; };
struct Gemm { const bf16_t* A; const bf16_t* Bt; int M, N, K; };

struct StaticOrder {
    int nM, nN, nwg, G, c;
    __host__ __device__ void init(int M, int N, int G_, int c_) { nM = M / BM; nN = N / BM; nwg = nM * nN; G = G_; c = c_; }
    __host__ __device__ bool next(int i, Unit& u) const {
        const long L = (long)i * G + c; if (L >= nwg) return false;
        int wgid = (int)L; { const int q = nwg / NXCD, r = nwg % NXCD, xcd = wgid % NXCD, off = wgid / NXCD; wgid = (xcd < r ? xcd * (q + 1) : r * (q + 1) + (xcd - r) * q) + off; }
        const int nig = WGM * nN, gid = wgid / nig, fm = gid * WGM, gsz = (nM - fm) < WGM ? (nM - fm) : WGM;
        u.pm = fm + ((wgid % nig) % gsz); u.pn = (wgid % nig) / gsz; return true;
    }
    __device__ __forceinline__ void a_ready(const Unit&) const {}
    __device__ __forceinline__ void done(const Unit&) const {}
};

__device__ __forceinline__ unsigned cvt_pk_bf16(float lo, float hi) { unsigned r; asm volatile("v_cvt_pk_bf16_f32 %0, %1, %2" : "=v"(r) : "v"(lo), "v"(hi)); return r; }
template <class Epi, class Sched, bool ALIGN_EPI = false, bool SP2 = false>
__device__ __forceinline__ void gemm_phase(PG8_LAS unsigned char* lds, const Gemm g, const Sched& S, const Epi& E) {
    const int tid = threadIdx.x, wid = __builtin_amdgcn_readfirstlane(tid >> 6), lane = tid & 63, wr = wid >> 2, wc = wid & 3, fr = lane & 15, fq = lane >> 4;
    const int K = g.K, nt = K / BK;
    unsigned voffA[2], voffB[2];
#pragma unroll
    for (int i = 0; i < 2; ++i) { int R, C; stage_rc(tid * 16 + i * 8192, R, C); const int Rb = Epi::PERM ? ((R & ~31) + perm32(R & 31)) : R;
        voffA[i] = (unsigned)(R * K + C) * 2u; voffB[i] = (unsigned)(Rb * K + C) * 2u; }
    const size_t kstep = (size_t)(BK * 2);
    const size_t hstep = (size_t)HALF * K * 2;
    const size_t tstep = 2 * hstep;
    const unsigned ldsw = (unsigned)wid * 1024u;
    const int aoff = lds_byte(wr * 64 + fr, fq * 8), boff = lds_byte(wc * 32 + fr, fq * 8);
#define PG8_SA(b, h) (((b) * 2 + (h)) * HTB)
#define PG8_SB(b, h) ((4 + (b) * 2 + (h)) * HTB)
#define PG8_STAGE(bufoff, gbase, voff) do { _Pragma("unroll") for (int _i = 0; _i < 2; ++_i) \
        __builtin_amdgcn_global_load_lds((const unsigned*)((const char*)(gbase) + (voff)[_i]), (PG8_LAS unsigned*)(lds + (bufoff) + ldsw + _i * 8192), 16, 0, 0); } while (0)
#define PG8_LDA(dst, b, h) do { _Pragma("unroll") for (int m = 0; m < 4; ++m) _Pragma("unroll") for (int k = 0; k < 2; ++k) dst[m][k] = *(const PG8_LAS bf16x8*)(lds + PG8_SA(b, h) + aoff + m * 2048 + k * 1024); } while (0)
#define PG8_LDB(dst, b, h) do { _Pragma("unroll") for (int n = 0; n < 2; ++n) _Pragma("unroll") for (int k = 0; k < 2; ++k) dst[n][k] = *(const PG8_LAS bf16x8*)(lds + PG8_SB(b, h) + boff + n * 2048 + k * 1024); } while (0)
#define PG8_MMA(ai, bj, At, Bt) do { __builtin_amdgcn_s_setprio(1); _Pragma("unroll") for (int m = 0; m < 4; ++m) _Pragma("unroll") for (int n = 0; n < 2; ++n) _Pragma("unroll") for (int k = 0; k < 2; ++k) \
        acc[ai][bj][m][n] = __builtin_amdgcn_mfma_f32_16x16x32_bf16(Bt[n][k], At[m][k], acc[ai][bj][m][n], 0, 0, 0); __builtin_amdgcn_s_setprio(0); } while (0)
#define PG8_WAIT_V(n) asm volatile("s_waitcnt vmcnt(" #n ")" ::: "memory")
#define PG8_WAIT_L(n) asm volatile("s_waitcnt lgkmcnt(" #n ")" ::: "memory")
#define PG8_BAR __builtin_amdgcn_s_barrier()
#define PG8_SCHED __builtin_amdgcn_sched_barrier(0)
    Unit cur, nxt; int ui = 0;
    if (!S.next(0, cur)) return;
    f32x4 acc[2][2][4][2];
#pragma unroll
    for (int a = 0; a < 2; ++a)
#pragma unroll
        for (int b = 0; b < 2; ++b)
#pragma unroll
            for (int m = 0; m < 4; ++m)
#pragma unroll
                for (int n = 0; n < 2; ++n) acc[a][b][m][n] = (f32x4){0.f, 0.f, 0.f, 0.f};
    bf16x8 At[4][2], B0[2][2], B1[2][2];
    const char* cA = (const char*)g.A + (size_t)cur.pm * tstep; const char* cB = (const char*)g.Bt + (size_t)cur.pn * tstep;
    S.a_ready(cur);
    if constexpr (SP2) {
        PG8_STAGE(PG8_SB(0, 0), cB, voffB); PG8_STAGE(PG8_SB(0, 1), cB + hstep, voffB); PG8_STAGE(PG8_SA(0, 0), cA, voffA); PG8_STAGE(PG8_SA(0, 1), cA + hstep, voffA);
        if (wr == 1) PG8_BAR;
        PG8_WAIT_V(2); PG8_BAR;
        PG8_STAGE(PG8_SB(1, 0), cB + kstep, voffB); PG8_STAGE(PG8_SA(1, 0), cA + kstep, voffA); PG8_STAGE(PG8_SB(1, 1), cB + hstep + kstep, voffB);
        PG8_WAIT_V(6); PG8_BAR;
    } else {
        PG8_STAGE(PG8_SB(0, 0), cB, voffB); PG8_STAGE(PG8_SA(0, 0), cA, voffA); PG8_STAGE(PG8_SB(0, 1), cB + hstep, voffB); PG8_STAGE(PG8_SA(0, 1), cA + hstep, voffA);
        if (wr == 1) PG8_BAR;
        PG8_WAIT_V(4); PG8_BAR;
        PG8_STAGE(PG8_SB(1, 0), cB + kstep, voffB); PG8_STAGE(PG8_SA(1, 0), cA + kstep, voffA); PG8_STAGE(PG8_SB(1, 1), cB + hstep + kstep, voffB);
        PG8_WAIT_V(6); PG8_BAR;
    }
    for (;;) {
        const bool has_next = S.next(ui + 1, nxt);
        const char* nA = has_next ? (const char*)g.A + (size_t)nxt.pm * tstep : cA; const char* nB = has_next ? (const char*)g.Bt + (size_t)nxt.pn * tstep : cB;
        for (int t = 0; t < nt; t += 2) {
            const bool last = (t == nt - 2);
            const char* a1 = cA + (size_t)(t + 1) * kstep;
            const char* a2 = last ? nA : cA + (size_t)(t + 2) * kstep; const char* b2 = last ? nB : cB + (size_t)(t + 2) * kstep;
            const char* a3 = a2 + kstep; const char* b3 = b2 + kstep;
            if (last && has_next) S.a_ready(nxt);
            if constexpr (SP2) {
            PG8_LDB(B0, 0, 0); PG8_LDB(B1, 0, 1); PG8_SCHED; PG8_LDA(At, 0, 0); PG8_STAGE(PG8_SA(1, 1), a1 + hstep, voffA);
            PG8_WAIT_V(8); PG8_WAIT_L(0); PG8_BAR; PG8_MMA(0, 0, At, B0); PG8_MMA(0, 1, At, B1); PG8_BAR; PG8_SCHED;
            PG8_LDA(At, 0, 1); PG8_STAGE(PG8_SB(0, 0), b2, voffB); PG8_STAGE(PG8_SB(0, 1), b2 + hstep, voffB); PG8_STAGE(PG8_SA(0, 0), a2, voffA);
            PG8_WAIT_V(8); PG8_WAIT_L(0); PG8_BAR; PG8_MMA(1, 0, At, B0); PG8_MMA(1, 1, At, B1); PG8_BAR; PG8_SCHED;
            PG8_LDB(B0, 1, 0); PG8_LDB(B1, 1, 1); PG8_SCHED; PG8_LDA(At, 1, 0); PG8_STAGE(PG8_SA(0, 1), a2 + hstep, voffA);
            PG8_WAIT_V(8); PG8_WAIT_L(0); PG8_BAR; PG8_MMA(0, 0, At, B0); PG8_MMA(0, 1, At, B1); PG8_BAR; PG8_SCHED;
            PG8_LDA(At, 1, 1); PG8_STAGE(PG8_SB(1, 0), b3, voffB); PG8_STAGE(PG8_SB(1, 1), b3 + hstep, voffB); PG8_STAGE(PG8_SA(1, 0), a3, voffA);
            PG8_WAIT_V(8); PG8_WAIT_L(0); PG8_BAR; PG8_MMA(1, 0, At, B0); PG8_MMA(1, 1, At, B1); PG8_BAR; PG8_SCHED;
            } else {
            PG8_LDB(B0, 0, 0); PG8_SCHED; PG8_LDA(At, 0, 0); PG8_STAGE(PG8_SA(1, 1), a1 + hstep, voffA);
            PG8_WAIT_L(8); PG8_BAR; PG8_WAIT_L(0); PG8_MMA(0, 0, At, B0); PG8_BAR; PG8_SCHED;
            PG8_LDB(B1, 0, 1); PG8_STAGE(PG8_SB(0, 0), b2, voffB);
            PG8_BAR; PG8_WAIT_L(0); PG8_MMA(0, 1, At, B1); PG8_BAR;
            PG8_LDA(At, 0, 1); PG8_STAGE(PG8_SA(0, 0), a2, voffA);
            PG8_BAR; PG8_WAIT_L(0); PG8_MMA(1, 0, At, B0); PG8_BAR; PG8_SCHED;
            PG8_STAGE(PG8_SB(0, 1), b2 + hstep, voffB);
            PG8_WAIT_V(6); PG8_BAR; PG8_MMA(1, 1, At, B1); PG8_BAR;
            PG8_LDB(B0, 1, 0); PG8_SCHED; PG8_LDA(At, 1, 0); PG8_STAGE(PG8_SA(0, 1), a2 + hstep, voffA);
            PG8_WAIT_L(8); PG8_BAR; PG8_WAIT_L(0); PG8_MMA(0, 0, At, B0); PG8_BAR; PG8_SCHED;
            PG8_LDB(B1, 1, 1); PG8_STAGE(PG8_SB(1, 0), b3, voffB);
            PG8_BAR; PG8_WAIT_L(0); PG8_MMA(0, 1, At, B1); PG8_BAR;
            PG8_LDA(At, 1, 1); PG8_STAGE(PG8_SA(1, 0), a3, voffA);
            PG8_BAR; PG8_WAIT_L(0); PG8_MMA(1, 0, At, B0); PG8_BAR; PG8_SCHED;
            PG8_STAGE(PG8_SB(1, 1), b3 + hstep, voffB);
            PG8_WAIT_V(6); PG8_BAR; PG8_MMA(1, 1, At, B1); PG8_BAR;
            }
        }
        if constexpr (ALIGN_EPI) { if (wr == 0) PG8_BAR; }
        if constexpr (!Epi::AFTER_DRAIN) { E(acc, cur, wr, wc, fr, fq); S.done(cur); }
        if (!has_next) break;
#pragma unroll
        for (int a = 0; a < 2; ++a)
#pragma unroll
            for (int b = 0; b < 2; ++b)
#pragma unroll
                for (int m = 0; m < 4; ++m)
#pragma unroll
                    for (int n = 0; n < 2; ++n) acc[a][b][m][n] = (f32x4){0.f, 0.f, 0.f, 0.f};
        cur = nxt; cA = nA; cB = nB; ++ui;
        if constexpr (ALIGN_EPI) { if (wr == 1) PG8_BAR; }
    }
    PG8_WAIT_V(0);
    if constexpr (!ALIGN_EPI) { if (wr == 0) PG8_BAR; }
    PG8_BAR;
    if constexpr (Epi::AFTER_DRAIN) { E.fused(acc, cur, wr, wc, fr, fq, lds, wid, lane); S.done(cur); }
#undef PG8_SA
#undef PG8_SB
#undef PG8_STAGE
#undef PG8_LDA
#undef PG8_LDB
#undef PG8_MMA
#undef PG8_WAIT_V
#undef PG8_WAIT_L
#undef PG8_BAR
#undef PG8_SCHED
}
}

#define EPI_V8(v, A, s) float v[8] = {A[0][0] * (s), A[0][1] * (s), A[0][2] * (s), A[0][3] * (s), A[1][0] * (s), A[1][1] * (s), A[1][2] * (s), A[1][3] * (s)}
__device__ __forceinline__ uint4 pk8(const float (&v)[8]) {
  return make_uint4(pg8::cvt_pk_bf16(v[0], v[1]), pg8::cvt_pk_bf16(v[2], v[3]), pg8::cvt_pk_bf16(v[4], v[5]), pg8::cvt_pk_bf16(v[6], v[7]));
}
struct EpiIn {
  static constexpr bool PERM = true, AFTER_DRAIN = false;
  u16* U; u16* QK; const float* RS;
  __device__ __forceinline__ void operator()(const pg8::f32x4 (&acc)[2][2][4][2], const pg8::Unit& u, int wr, int wc, int fr, int fq) const {
    const int row0 = u.pm * 256 + wr * 64 + fr, colt = u.pn * 256, c0 = colt + wc * 32 + 8 * fq;
    const bool isu = colt < 512;
#pragma unroll
    for (int ai = 0; ai < 2; ++ai)
#pragma unroll
      for (int m = 0; m < 4; ++m) {
        const int row = row0 + ai * 128 + m * 16;
        const float r = RS[row];
#pragma unroll
        for (int bj = 0; bj < 2; ++bj) {
          const int col = c0 + bj * 128;
          EPI_V8(v, acc[ai][bj][m], r);
          if (isu) {
#pragma unroll
            for (int j = 0; j < 8; ++j) v[j] = gelu_f(v[j]);
            *(uint4*)(U + (size_t)row * 512 + col) = pk8(v);
          } else {
            *(uint4*)(QK + (size_t)row * 1024 + (col - 512)) = pk8(v);
          }
        }
      }
  }
};
struct EpiInT {
  static constexpr bool PERM = true, AFTER_DRAIN = false;
  u16* GVT; u16* VT; const float* RS; float* VSS;
  __device__ __forceinline__ void operator()(const pg8::f32x4 (&acc)[2][2][4][2], const pg8::Unit& u, int wr, int wc, int fr, int fq) const {
    const int ch0 = u.pm * 256 + wr * 64 + fr, t0 = u.pn * 256 + wc * 32 + 8 * fq;
    const bool isg = u.pm < 2;
#pragma unroll
    for (int bj = 0; bj < 2; ++bj) {
      const int t = t0 + bj * 128, b = t >> 12, s = t & 4095;
      const float4 ra = *(const float4*)(RS + t), rb = *(const float4*)(RS + t + 4);
      const float rr[8] = {ra.x, ra.y, ra.z, ra.w, rb.x, rb.y, rb.z, rb.w};
      float ss[8] = {0.f, 0.f, 0.f, 0.f, 0.f, 0.f, 0.f, 0.f};
#pragma unroll
      for (int ai = 0; ai < 2; ++ai)
#pragma unroll
        for (int m = 0; m < 4; ++m) {
          const int ch = ch0 + ai * 128 + m * 16;
          float v[8];
#pragma unroll
          for (int j = 0; j < 8; ++j) v[j] = acc[ai][bj][m][j >> 2][j & 3] * rr[j];
          if (isg) {
#pragma unroll
            for (int j = 0; j < 8; ++j) { v[j] = gelu_f(v[j]); ss[j] += v[j] * v[j]; }
            *(uint4*)(GVT + ((size_t)b * 512 + ch) * SEQ + s) = pk8(v);
          } else {
            *(uint4*)(VT + ((size_t)b * 512 + (ch - 512)) * SEQ + s) = pk8(v);
          }
        }
      if (isg) {
#pragma unroll
        for (int j = 0; j < 8; ++j) {
          float sv = ss[j];
          sv += dpp_f<DPP_X1>(sv); sv += dpp_f<DPP_X2>(sv); sv += dpp_f<DPP_HM>(sv); sv += dpp_f<DPP_R8>(sv);
          if (fr == 0) atomicAdd(VSS + t + j, sv);
        }
      }
    }
  }
};
struct EpiOut {
  static constexpr bool PERM = true, AFTER_DRAIN = false;
  const float* X; float* OUT; u16* HB;
  __device__ __forceinline__ void operator()(const pg8::f32x4 (&acc)[2][2][4][2], const pg8::Unit& u, int wr, int wc, int fr, int fq) const {
    const int row0 = u.pm * 256 + wr * 64 + fr, c0 = u.pn * 256 + wc * 32 + 8 * fq;
#pragma unroll
    for (int ai = 0; ai < 2; ++ai)
#pragma unroll
      for (int m = 0; m < 4; ++m) {
        const int row = row0 + ai * 128 + m * 16;
#pragma unroll
        for (int bj = 0; bj < 2; ++bj) {
          const size_t idx = (size_t)row * 1024 + c0 + bj * 128;
          const float4 xa = *(const float4*)(X + idx), xb = *(const float4*)(X + idx + 4);
          float v[8] = {xa.x + acc[ai][bj][m][0][0], xa.y + acc[ai][bj][m][0][1], xa.z + acc[ai][bj][m][0][2], xa.w + acc[ai][bj][m][0][3],
                        xb.x + acc[ai][bj][m][1][0], xb.y + acc[ai][bj][m][1][1], xb.z + acc[ai][bj][m][1][2], xb.w + acc[ai][bj][m][1][3]};
          *(uint4*)(HB + idx) = pk8(v);
        }
      }
  }
};
struct EpiQ {
  static constexpr bool PERM = true, AFTER_DRAIN = false;
  u16* PQ;
  __device__ __forceinline__ void operator()(const pg8::f32x4 (&acc)[2][2][4][2], const pg8::Unit& u, int wr, int wc, int fr, int fq) const {
    const int row0 = u.pm * 256 + wr * 64 + fr, c0 = u.pn * 256 + wc * 32 + 8 * fq;
#pragma unroll
    for (int ai = 0; ai < 2; ++ai)
#pragma unroll
      for (int m = 0; m < 4; ++m) {
        const int row = row0 + ai * 128 + m * 16;
#pragma unroll
        for (int bj = 0; bj < 2; ++bj) {
          EPI_V8(v, acc[ai][bj][m], 1.f);
          *(uint4*)(PQ + (size_t)row * 2048 + c0 + bj * 128) = pk8(v);
        }
      }
  }
};
#define LDS3(p) ((__attribute__((address_space(3))) unsigned char*)(p))

__device__ __forceinline__ void quant_pair(const Params& p, int row0, int lane) {
  unsigned char* EU4 = (unsigned char*)(p.ws + OFF_EU);
  unsigned char* EV4 = (unsigned char*)(p.ws + OFF_EV);
  float* ESC = (float*)(p.ws + OFF_ESC);
  float4 g4[2][2];
#pragma unroll
  for (int j = 0; j < 2; ++j)
#pragma unroll
    for (int q = 0; q < 2; ++q) g4[j][q] = ((const float4*)p.ln_ffn_g)[j * 128 + lane * 2 + q];

      const bool isv = row0 >= 16384;
      float4 v[2][2][2];
#pragma unroll
      for (int r = 0; r < 2; ++r) {
        const float4* src = (const float4*)((isv ? p.peer_v : p.peer_u) + (size_t)((row0 + r) & 16383) * 1024);
#pragma unroll
        for (int j = 0; j < 2; ++j)
#pragma unroll
          for (int q = 0; q < 2; ++q) v[r][j][q] = src[j * 128 + lane * 2 + q];
      }
#pragma unroll
      for (int r = 0; r < 2; ++r) {
        const int e = (row0 + r) & 16383;
        float sq = 0.f, am = 0.f;
#pragma unroll
        for (int j = 0; j < 2; ++j)
#pragma unroll
          for (int q = 0; q < 2; ++q) {
            float4 t4 = v[r][j][q];
            if (!isv) { t4.x *= g4[j][q].x; t4.y *= g4[j][q].y; t4.z *= g4[j][q].z; t4.w *= g4[j][q].w; }
            sq += t4.x * t4.x + t4.y * t4.y + t4.z * t4.z + t4.w * t4.w;
            am = fmaxf(am, fmaxf(fmaxf(fabsf(t4.x), fabsf(t4.y)), fmaxf(fabsf(t4.z), fabsf(t4.w))));
            v[r][j][q] = t4;
          }
#pragma unroll
        for (int o = 1; o < 64; o <<= 1) { sq += __shfl_xor(sq, o); am = fmaxf(am, __shfl_xor(am, o)); }
        const float rng = isv ? am : 2.6f * sqrtf(sq * (1.f / 1024.f));
        const float qmax = isv ? 6.0f : 7.0f;
        const bool ok = (rng > 1e-30f);
        const float scale = ok ? qmax / rng : 0.f;
        const float inv = ok ? rng / qmax : 0.f;
        unsigned char* dst = (isv ? EV4 : EU4) + (size_t)e * 128 + (lane & 31) * 4;
#define Q4C(x, i) q4(fminf(fmaxf((x) * scale, -7.f), 7.f), (i))
#pragma unroll
        for (int j = 0; j < 2; ++j) {
          unsigned w = 0;
          if (isv) {
            w = __builtin_amdgcn_cvt_scalef32_pk_fp4_f32(w, v[r][j][0].x * scale, v[r][j][0].y * scale, 1.0f, 0);
            w = __builtin_amdgcn_cvt_scalef32_pk_fp4_f32(w, v[r][j][0].z * scale, v[r][j][0].w * scale, 1.0f, 1);
            w = __builtin_amdgcn_cvt_scalef32_pk_fp4_f32(w, v[r][j][1].x * scale, v[r][j][1].y * scale, 1.0f, 2);
            w = __builtin_amdgcn_cvt_scalef32_pk_fp4_f32(w, v[r][j][1].z * scale, v[r][j][1].w * scale, 1.0f, 3);
          } else {
            w = Q4C(v[r][j][0].x, 0) | Q4C(v[r][j][0].y, 1) | Q4C(v[r][j][0].z, 2) | Q4C(v[r][j][0].w, 3) |
                Q4C(v[r][j][1].x, 4) | Q4C(v[r][j][1].y, 5) | Q4C(v[r][j][1].z, 6) | Q4C(v[r][j][1].w, 7);
          }
          *(unsigned*)(dst + (size_t)(j * 2 + (lane >> 5)) * (2 * MiB)) = w;
        }
#undef Q4C
        if (lane == 0) ESC[row0 + r] = inv;
      }
    }

__device__ __forceinline__ void phase0(const Params& p, char* lds) {
  const int tid = tid_(), lane = tid & 63, wave = tid >> 6;
  const int nblk = gridDim.x, blk = bid_();
  u16* XB = (u16*)(p.ws + OFF_XB);
  float* RS = (float*)(p.ws + OFF_RS);
  float* VSS = (float*)(p.ws + OFF_VSS);
  for (int row0 = (blk * NWAVE + wave) * 4; row0 < T; row0 += nblk * NWAVE * 4) {
    float4 v[4][4];
#pragma unroll
    for (int r = 0; r < 4; ++r) {
      const float4* xr = (const float4*)(p.x + (size_t)(row0 + r) * DM);
#pragma unroll
      for (int j = 0; j < 2; ++j) { v[r][2 * j] = xr[j * 128 + lane * 2]; v[r][2 * j + 1] = xr[j * 128 + lane * 2 + 1]; }
    }
#pragma unroll
    for (int r = 0; r < 4; ++r) {
      float ss = 0.f;
#pragma unroll
      for (int i = 0; i < 4; ++i) ss += v[r][i].x * v[r][i].x + v[r][i].y * v[r][i].y + v[r][i].z * v[r][i].z + v[r][i].w * v[r][i].w;
#pragma unroll
      for (int o = 1; o < 64; o <<= 1) ss += __shfl_xor(ss, o);
      if (lane == 0) RS[row0 + r] = rsqrtf(ss * (1.f / 1024.f) + EPS);
#pragma unroll
      for (int j = 0; j < 2; ++j)
        *(uint4*)(XB + (size_t)(row0 + r) * DM + j * 512 + lane * 8) =
            make_uint4(pg8::cvt_pk_bf16(v[r][2 * j].x, v[r][2 * j].y), pg8::cvt_pk_bf16(v[r][2 * j].z, v[r][2 * j].w),
                       pg8::cvt_pk_bf16(v[r][2 * j + 1].x, v[r][2 * j + 1].y), pg8::cvt_pk_bf16(v[r][2 * j + 1].z, v[r][2 * j + 1].w));
    }
  }
  {
    const int half = wave >> 2, w4 = wave & 3;
    float* tile = (float*)lds + half * (64 * 65);
    for (int tp = blk; tp < 704; tp += nblk) {
      const int tl = tp * 2 + half;
      const float* W; const float* gain; u16* dst; int N, kt, nt, drow;
      if (tl < 640) {
        W = p.w_in; gain = p.ln_mix_g; N = 2560; kt = tl / 40; nt = tl % 40;
        const int n0 = nt * 64;
        if (n0 < 512) { dst = (u16*)(p.ws + OFF_WINT); drow = n0; }
        else if (n0 < 1024) { dst = (u16*)(p.ws + OFF_WB); drow = n0 - 512; }
        else if (n0 < 2048) { dst = (u16*)(p.ws + OFF_WINT); drow = n0 - 512; }
        else { dst = (u16*)(p.ws + OFF_WB); drow = n0 - 2048 + 512; }
      } else if (tl < 896) { int t2 = tl - 640; W = p.w_out; gain = nullptr; dst = (u16*)(p.ws + OFF_WOUTT); N = 1024; kt = t2 / 16; nt = t2 % 16; drow = nt * 64; }
      else { int t2 = tl - 896; W = p.w_query; gain = p.ln_ffn_g; dst = (u16*)(p.ws + OFF_WQT); N = 2048; kt = t2 / 32; nt = t2 % 32; drow = nt * 64; }
      __syncthreads();
#pragma unroll
      for (int i = 0; i < 16; ++i) {
        const int kk = i * 4 + w4;
        const float gk = gain ? gain[kt * 64 + kk] : 1.f;
        tile[kk * 65 + lane] = W[(size_t)(kt * 64 + kk) * N + nt * 64 + lane] * gk;
      }
      __syncthreads();
#pragma unroll 4
      for (int i = 0; i < 16; ++i) {
        const int nn = i * 4 + w4;
        dst[(size_t)(drow + nn) * 1024 + kt * 64 + lane] = f2bf(tile[lane * 65 + nn]);
      }
    }
    __syncthreads();
  }
  {
    u16* KEYS = (u16*)(p.ws + OFF_KEYS);
    for (int i = blk * NTHR + tid; i < 262144 / 4; i += nblk * NTHR) {
      float4 a = ((const float4*)p.sub_keys)[i];
      *(uint2*)(KEYS + (size_t)i * 4) = make_uint2(pack2(a.x, a.y), pack2(a.z, a.w));
    }
  }
  for (int i = blk * NTHR + tid; i < T; i += nblk * NTHR) VSS[i] = 0.f;

}

__device__ __forceinline__ void phase1(const Params& p, char* lds) {
  const u16* XB = (const u16*)(p.ws + OFF_XB);
  const float* RS = (const float*)(p.ws + OFF_RS);
  {
    pg8::Gemm g{XB, (const u16*)(p.ws + OFF_WINT), T, 1536, 1024};
    pg8::StaticOrder S; S.init(T, 1536, (int)gridDim.x, (int)blockIdx.x);
    EpiIn E{(u16*)(p.ws + OFF_U), (u16*)(p.ws + OFF_QK), RS};
    pg8::gemm_phase<EpiIn, pg8::StaticOrder, true, true>(LDS3(lds), g, S, E);
  }
  {
    pg8::Gemm g{(const u16*)(p.ws + OFF_WB), XB, 1024, T, 1024};
    pg8::StaticOrder S; S.init(1024, T, (int)gridDim.x, (int)blockIdx.x);
    EpiInT E{(u16*)(p.ws + OFF_GVT), (u16*)(p.ws + OFF_VT), RS, (float*)(p.ws + OFF_VSS)};
    pg8::gemm_phase<EpiInT, pg8::StaticOrder, true, true>(LDS3(lds), g, S, E);
  }
}

__device__ __forceinline__ void gmlp_item(const Params& p, int item) {
  const int tid = tid_() & 255, lane = tid & 63, wave = tid >> 6, l15 = lane & 15, g = lane >> 4;
  const int gr = item & 7, n = (item >> 3) & 31, b = item >> 8;
  const int t0 = b * SEQ + n * 128;
  const float* VSS = (const float*)(p.ws + OFF_VSS);
  const u16* GVT = (const u16*)(p.ws + OFF_GVT);
  const u16* U = (const u16*)(p.ws + OFF_U);
  u16* AB = (u16*)(p.ws + OFF_AB);
  f32x4 acc[2][4];
#pragma unroll
  for (int i = 0; i < 2; ++i)
#pragma unroll
    for (int j = 0; j < 4; ++j) acc[i][j] = f32x4{0.f, 0.f, 0.f, 0.f};
  const int i_base = wave * 32;
  const bool low = wave < 2;
#pragma unroll
  for (int ks = 0; ks < 4; ++ks) {
    if (ks >= 2 && low) continue;
    const int j0 = ks * 32 + g * 8;
    const float4 s0 = *(const float4*)(VSS + t0 + j0), s1 = *(const float4*)(VSS + t0 + j0 + 4);
    float r[8] = {s0.x, s0.y, s0.z, s0.w, s1.x, s1.y, s1.z, s1.w};
#pragma unroll
    for (int q = 0; q < 8; ++q) r[q] = rsqrtf(r[q] * (1.f / 512.f) + EPS);
    bf16x8 wf[2];
#pragma unroll
    for (int mi = 0; mi < 2; ++mi) {
      const int i = i_base + mi * 16 + l15;
      const float* wp = p.gmlp_w_s + ((size_t)(gr * 128 + i)) * 128 + j0;
      const float4 w0 = *(const float4*)wp, w1 = *(const float4*)(wp + 4);
      wf[mi] = mk8(pack2(w0.x * r[0], w0.y * r[1]), pack2(w0.z * r[2], w0.w * r[3]), pack2(w1.x * r[4], w1.y * r[5]),
                   pack2(w1.z * r[6], w1.w * r[7]));
    }
#pragma unroll
    for (int ni = 0; ni < 4; ++ni) {
      const int c = ni * 16 + l15;
      const bf16x8 gf = *(const bf16x8*)(GVT + ((size_t)b * 512 + gr * 64 + c) * SEQ + n * 128 + j0);
#pragma unroll
      for (int mi = 0; mi < 2; ++mi) acc[mi][ni] = mfma16(gf, wf[mi], acc[mi][ni]);
    }
  }
#pragma unroll
  for (int mi = 0; mi < 2; ++mi) {
    const int i = i_base + mi * 16 + l15;
    const size_t t = (size_t)t0 + i;
    const float bs = p.gmlp_b_s[gr * 128 + i];
#pragma unroll
    for (int ni = 0; ni < 4; ++ni) {
      const int ch = gr * 64 + ni * 16 + g * 4;
      const float4 ng = *(const float4*)(p.gmlp_norm_g + ch);
      const uint2 uu = *(const uint2*)(U + t * 512 + ch);
      const float o0 = bf_lo(uu.x) * (acc[mi][ni][0] * ng.x + bs), o1 = bf_hi(uu.x) * (acc[mi][ni][1] * ng.y + bs);
      const float o2 = bf_lo(uu.y) * (acc[mi][ni][2] * ng.z + bs), o3 = bf_hi(uu.y) * (acc[mi][ni][3] * ng.w + bs);
      *(uint2*)(AB + t * 1024 + ch) = make_uint2(pack2(o0, o1), pack2(o2, o3));
    }
  }
}

constexpr int ATT_BUF = 2 * 64 * LSTR + 256;
constexpr float LOG2E = 1.4426950408889634f;
__device__ __forceinline__ void attn_item(const Params& p, int item, char* lds) {
  const int tid = tid_() & 255, lane = tid & 63, wave = tid >> 6, l15 = lane & 15, g = lane >> 4;
  const int c = item & 63, h = (item >> 6) & 7, b = item >> 9;
  const u16* QK = (const u16*)(p.ws + OFF_QK);
  const u16* VT = (const u16*)(p.ws + OFF_VT);
  u16* AB = (u16*)(p.ws + OFF_AB);
  float* bias_s = (float*)(lds + 2 * ATT_BUF);
  __syncthreads();
  float bmax = 0.f;
  for (int i = tid; i < 257; i += 256) { const float bv = p.rel_bias[h * 257 + i] * LOG2E; bias_s[i] = bv; bmax = fmaxf(bmax, fabsf(bv)); }
#pragma unroll
  for (int o = 1; o < 64; o <<= 1) bmax = fmaxf(bmax, __shfl_xor(bmax, o));
  if (lane == 0) bias_s[260 + wave] = bmax;
  const size_t tq = (size_t)b * SEQ + c * 64 + wave * 16 + l15;
  bf16x8 qb0, qb1;
  float mfix;
  {
    const u16* qp = QK + tq * 1024 + h * 64 + g * 8;
    const uint4 q0 = *(const uint4*)qp, q1 = *(const uint4*)(qp + 32);
    float f[16] = {bf_lo(q0.x), bf_hi(q0.x), bf_lo(q0.y), bf_hi(q0.y), bf_lo(q0.z), bf_hi(q0.z), bf_lo(q0.w), bf_hi(q0.w),
                   bf_lo(q1.x), bf_hi(q1.x), bf_lo(q1.y), bf_hi(q1.y), bf_lo(q1.z), bf_hi(q1.z), bf_lo(q1.w), bf_hi(q1.w)};
    float ss = 0.f;
#pragma unroll
    for (int i = 0; i < 16; ++i) ss += f[i] * f[i];
    ss += __shfl_xor(ss, 16); ss += __shfl_xor(ss, 32);
    const float rq = rsqrtf(ss * (1.f / 64.f) + EPS) * (0.125f * LOG2E);
    const float4 ga = *(const float4*)(p.q_norm_g + g * 8), gb = *(const float4*)(p.q_norm_g + g * 8 + 4);
    const float4 gc = *(const float4*)(p.q_norm_g + 32 + g * 8), gd = *(const float4*)(p.q_norm_g + 32 + g * 8 + 4);
    const float4 ka = *(const float4*)(p.k_norm_g + g * 8), kb = *(const float4*)(p.k_norm_g + g * 8 + 4);
    const float4 kc4 = *(const float4*)(p.k_norm_g + 32 + g * 8), kd = *(const float4*)(p.k_norm_g + 32 + g * 8 + 4);
    const float gg[16] = {ga.x * ka.x, ga.y * ka.y, ga.z * ka.z, ga.w * ka.w, gb.x * kb.x, gb.y * kb.y, gb.z * kb.z, gb.w * kb.w,
                          gc.x * kc4.x, gc.y * kc4.y, gc.z * kc4.z, gc.w * kc4.w, gd.x * kd.x, gd.y * kd.y, gd.z * kd.z, gd.w * kd.w};
#pragma unroll
    for (int i = 0; i < 16; ++i) f[i] *= rq * gg[i];
    float qn = 0.f;
#pragma unroll
    for (int i = 0; i < 16; ++i) qn += f[i] * f[i];
    qn += __shfl_xor(qn, 16); qn += __shfl_xor(qn, 32);
    mfix = fminf(8.f * sqrtf(qn) * 1.01f + 1.f, 60.f);
    qb0 = mk8(pg8::cvt_pk_bf16(f[0], f[1]), pg8::cvt_pk_bf16(f[2], f[3]), pg8::cvt_pk_bf16(f[4], f[5]), pg8::cvt_pk_bf16(f[6], f[7]));
    qb1 = mk8(pg8::cvt_pk_bf16(f[8], f[9]), pg8::cvt_pk_bf16(f[10], f[11]), pg8::cvt_pk_bf16(f[12], f[13]), pg8::cvt_pk_bf16(f[14], f[15]));
  }
  f32x4 o[4];
#pragma unroll
  for (int i = 0; i < 4; ++i) o[i] = f32x4{0.f, 0.f, 0.f, 0.f};
  float l_run = 0.f;
  const int srow = tid >> 2, spart = tid & 3;
  const int kc_lo = (c >= 8) ? 0 : (8 - c);
  const u16* kbase = QK + ((size_t)b * SEQ + srow) * 1024 + 512 + h * 64 + spart * 16;
  const u16* vbase = VT + ((size_t)b * 512 + h * 64 + srow) * SEQ + spart * 16;
  uint4 k0, k1, v0, v1;
  {
    const int kchunk = c - 8 + kc_lo;
    const u16* kp = kbase + (size_t)kchunk * 64 * 1024;
    k0 = *(const uint4*)kp; k1 = *(const uint4*)(kp + 8);
    const u16* vp = vbase + kchunk * 64;
    v0 = *(const uint4*)vp; v1 = *(const uint4*)(vp + 8);
  }
  for (int kc = kc_lo; kc <= 8; ++kc) {
    char* Ks = lds + ((kc - kc_lo) & 1) * ATT_BUF;
    char* Vs = Ks + 64 * LSTR;
    float* rks = (float*)(Ks + 2 * 64 * LSTR);
    {
      float ss = 0.f;
      ss = dot2(k0.x, k0.x, ss); ss = dot2(k0.y, k0.y, ss); ss = dot2(k0.z, k0.z, ss); ss = dot2(k0.w, k0.w, ss);
      ss = dot2(k1.x, k1.x, ss); ss = dot2(k1.y, k1.y, ss); ss = dot2(k1.z, k1.z, ss); ss = dot2(k1.w, k1.w, ss);
      ss += dpp_f<DPP_X1>(ss); ss += dpp_f<DPP_X2>(ss);
      if (spart == 0) rks[srow] = rsqrtf(ss * (1.f / 64.f) + EPS);
      char* kd = Ks + srow * LSTR + spart * 32;
      *(uint4*)kd = k0;
      *(uint4*)(kd + 16) = k1;
      char* vd = Vs + srow * LSTR + spart * 32;
      *(uint4*)vd = v0;
      *(uint4*)(vd + 16) = v1;
    }
    __syncthreads();
    if (kc < 8) {
      const int kchunk = c - 8 + kc + 1;
      const u16* kp = kbase + (size_t)kchunk * 64 * 1024;
      k0 = *(const uint4*)kp; k1 = *(const uint4*)(kp + 8);
      const u16* vp = vbase + kchunk * 64;
      v0 = *(const uint4*)vp; v1 = *(const uint4*)(vp + 8);
    }
    f32x4 s[4];
#pragma unroll
    for (int mt = 0; mt < 4; ++mt) {
      const char* kr = Ks + (mt * 16 + l15) * LSTR + g * 16;
      const bf16x8 a0 = *(const bf16x8*)kr, a1 = *(const bf16x8*)(kr + 64);
      s[mt] = mfma16(a0, qb0, f32x4{0.f, 0.f, 0.f, 0.f});
      s[mt] = mfma16(a1, qb1, s[mt]);
    }
    if (kc == kc_lo) mfix += fmaxf(fmaxf(bias_s[260], bias_s[261]), fmaxf(bias_s[262], bias_s[263]));
    float ls = 0.f;
    if (kc <= 5) {
      const float bc = bias_s[256] - mfix;
#pragma unroll
      for (int mt = 0; mt < 4; ++mt) {
        const float4 rk4 = *(const float4*)(rks + mt * 16 + g * 4);
        s[mt][0] = __builtin_amdgcn_exp2f(s[mt][0] * rk4.x + bc); s[mt][1] = __builtin_amdgcn_exp2f(s[mt][1] * rk4.y + bc);
        s[mt][2] = __builtin_amdgcn_exp2f(s[mt][2] * rk4.z + bc); s[mt][3] = __builtin_amdgcn_exp2f(s[mt][3] * rk4.w + bc);
        ls += (s[mt][0] + s[mt][1]) + (s[mt][2] + s[mt][3]);
      }
    } else {
      const int qi = wave * 16 + l15 + 64 * (8 - kc);
#pragma unroll
      for (int mt = 0; mt < 4; ++mt) {
        const float4 rk4 = *(const float4*)(rks + mt * 16 + g * 4);
        const float rr[4] = {rk4.x, rk4.y, rk4.z, rk4.w};
#pragma unroll
        for (int j = 0; j < 4; ++j) {
          int rel = qi - (mt * 16 + g * 4 + j);
          rel = rel > 128 ? 128 : rel;
          s[mt][j] = __builtin_amdgcn_exp2f(s[mt][j] * rr[j] + (bias_s[rel + 128] - mfix));
          ls += s[mt][j];
        }
      }
    }
    l_run += ls;
#pragma unroll
    for (int k2 = 0; k2 < 2; ++k2) {
      const bf16x8 pb = mk8(pg8::cvt_pk_bf16(s[2 * k2][0], s[2 * k2][1]), pg8::cvt_pk_bf16(s[2 * k2][2], s[2 * k2][3]),
                            pg8::cvt_pk_bf16(s[2 * k2 + 1][0], s[2 * k2 + 1][1]), pg8::cvt_pk_bf16(s[2 * k2 + 1][2], s[2 * k2 + 1][3]));
#pragma unroll
      for (int mt = 0; mt < 4; ++mt) {
        const char* vr = Vs + (mt * 16 + l15) * LSTR + (32 * k2 + 4 * g) * 2;
        const uint2 va = *(const uint2*)vr, vb = *(const uint2*)(vr + 32);
        o[mt] = mfma16(mk8(va.x, va.y, vb.x, vb.y), pb, o[mt]);
      }
    }
  }
  float l = l_run;
  l += __shfl_xor(l, 16); l += __shfl_xor(l, 32);
  const float inv = 1.f / l;
#pragma unroll
  for (int mt = 0; mt < 4; ++mt) {
    *(uint2*)(AB + tq * 1024 + 512 + h * 64 + mt * 16 + g * 4) =
        make_uint2(pg8::cvt_pk_bf16(o[mt][0] * inv, o[mt][1] * inv), pg8::cvt_pk_bf16(o[mt][2] * inv, o[mt][3] * inv));
  }
}

__device__ __forceinline__ void phase2(const Params& p, char* lds) {
  const int sub = tid_() >> 8;
  for (int it = bid_(); it < 2048 + 1024; it += gridDim.x) {
    if (it < 2048) {
      const int b = it >> 8, hp = (it >> 6) & 3, c = ((it & 63) + 8 * b) & 63;
      attn_item(p, (b << 9) | ((hp * 2 + sub) << 6) | c, lds + sub * 38912);
    } else {
      gmlp_item(p, (it - 2048) * 2 + sub);
    }
  }
}

__device__ __forceinline__ void phase3(const Params& p, char* lds) {
  pg8::Gemm g{(const u16*)(p.ws + OFF_AB), (const u16*)(p.ws + OFF_WOUTT), T, 1024, 1024};
  pg8::StaticOrder S; S.init(T, 1024, (int)gridDim.x, (int)blockIdx.x);
  EpiOut E{p.x, p.out, (u16*)(p.ws + OFF_HB)};
  pg8::gemm_phase<EpiOut, pg8::StaticOrder, true, true>(LDS3(lds), g, S, E);
}
__device__ __forceinline__ void phase4(const Params& p, char* lds) {
  pg8::Gemm g{(const u16*)(p.ws + OFF_HB), (const u16*)(p.ws + OFF_WQT), T, 2048, 1024};
  pg8::StaticOrder S; S.init(T, 2048, (int)gridDim.x, (int)blockIdx.x);
  EpiQ E{(u16*)(p.ws + OFF_PQ)};
  pg8::gemm_phase<EpiQ, pg8::StaticOrder, true, true>(LDS3(lds), g, S, E);
}

__device__ __forceinline__ unsigned dpp_xor1(unsigned v) { return (unsigned)__builtin_amdgcn_mov_dpp((int)v, 0xB1, 0xF, 0xF, true); }
__device__ __forceinline__ unsigned dpp_xor2(unsigned v) { return (unsigned)__builtin_amdgcn_mov_dpp((int)v, 0x4E, 0xF, 0xF, true); }
__device__ __forceinline__ void sort16_desc(unsigned (&v)[16]) {
#pragma unroll
  for (int k = 2; k <= 16; k <<= 1)
#pragma unroll
    for (int j = k >> 1; j > 0; j >>= 1)
#pragma unroll
      for (int i = 0; i < 16; ++i) {
        const int l = i ^ j;
        if (l > i) {
          const unsigned hi = max(v[i], v[l]), lo = min(v[i], v[l]);
          if ((i & k) == 0) { v[i] = hi; v[l] = lo; } else { v[i] = lo; v[l] = hi; }
        }
      }
}
__device__ __forceinline__ void merge16_desc(unsigned (&a)[16], const unsigned (&b)[16]) {
#pragma unroll
  for (int i = 0; i < 16; ++i) a[i] = max(a[i], b[15 - i]);
#pragma unroll
  for (int j = 8; j > 0; j >>= 1)
#pragma unroll
    for (int i = 0; i < 16; ++i) {
      const int l = i ^ j;
      if (l > i) { const unsigned hi = max(a[i], a[l]), lo = min(a[i], a[l]); a[i] = hi; a[l] = lo; }
    }
}
constexpr int SC_STR = 385, LSTR17 = 17;
constexpr int P5_LV = 64 * SC_STR, P5_LI = P5_LV + 128 * LSTR17, P5_TAB = P5_LI + 128 * LSTR17;

__device__ __forceinline__ void select_item(const Params& p, int item, int next_item, int kiter, char* lds, const bf16x8 (&kf)[8][4], bf16x8 (&qf)[4]) {
  const int tid = tid_(), lane = tid & 63, wave = tid >> 6, l15 = lane & 15, g = lane >> 4;
  const int h = item & 7, t0 = (item >> 3) * 64;
  const u16* PQ = (const u16*)(p.ws + OFF_PQ);
  int* EIDX = (int*)(p.ws + OFF_EIDX);
  float* BEST = (float*)(p.ws + OFF_BEST);
  float* sc = (float*)lds;
  float* LV = sc + P5_LV;
  int* LI = (int*)lds + P5_LI;
  const int* tab = (const int*)lds + P5_TAB;
  __syncthreads();
  {
    const int pp = wave >> 2, wq = wave & 3;
#pragma unroll
    for (int nt = 0; nt < 8; ++nt) {
      f32x4 a = f32x4{0.f, 0.f, 0.f, 0.f};
#pragma unroll
      for (int ks = 0; ks < 4; ++ks) a = mfma16(qf[ks], kf[nt][ks], a);
#pragma unroll
      for (int j = 0; j < 4; ++j) sc[(wq * 16 + g * 4 + j) * SC_STR + pp * 192 + (nt >> 1) * 48 + (nt & 1) * 16 + l15] = a[j];
    }
    if (next_item < 512 * 8) {
      const u16* qp = PQ + (size_t)((next_item >> 3) * 64 + wq * 16 + l15) * 2048 + (next_item & 7) * 256 + pp * 128 + g * 8;
#pragma unroll
      for (int ks = 0; ks < 4; ++ks) qf[ks] = *(const bf16x8*)(qp + ks * 32);
    }
  }
  __syncthreads();
  {
    const int q = tid & 3, list = tid >> 2, row = list & 63, pp = list >> 6;
    const float* rowp = sc + row * SC_STR + pp * 192;
    const float* src = rowp + q * 48;
    unsigned A[16], B[16];
#pragma unroll
    for (int j = 0; j < 16; ++j) {
      A[j] = (okey(src[j]) & ~127u) | (unsigned)(127 - (q * 32 + j));
      B[j] = (okey(src[16 + j]) & ~127u) | (unsigned)(127 - (q * 32 + 16 + j));
    }
    sort16_desc(A);
    sort16_desc(B);
    merge16_desc(A, B);
#pragma unroll
    for (int i = 0; i < 16; ++i) B[i] = dpp_xor1(A[i]);
    merge16_desc(A, B);
#pragma unroll
    for (int i = 0; i < 16; ++i) B[i] = dpp_xor2(A[i]);
    merge16_desc(A, B);
#pragma unroll
    for (int r = 0; r < 16; ++r) {
      if ((r & 3) == q) {
        const int idx = 127 - (int)(A[r] & 127u);
        LV[list * LSTR17 + r] = rowp[(idx >> 5) * 48 + (idx & 31)];
        LI[list * LSTR17 + r] = idx;
      }
    }
  }
  __syncthreads();
  if (tid >= 256) {
    quant_pair(p, 2 * ((kiter * 4 + (wave - 4)) * (int)gridDim.x + bid_()), lane);
  } else {
    const int grp = tid & 3, row = tid >> 2;
    const float* v0 = LV + row * LSTR17;
    const float* v1 = LV + (64 + row) * LSTR17;
    unsigned A[16], B[16];
#pragma unroll
    for (int j = 0; j < 16; ++j) {
      const int code = tab[grp * 16 + j];
      const int cc = code & 255;
      const float s = v0[cc >> 4] + v1[cc & 15];
      A[j] = (code < 0) ? 0u : ((okey(s) & ~255u) | (unsigned)(255 - cc));
    }
    sort16_desc(A);
#pragma unroll
    for (int i = 0; i < 16; ++i) B[i] = dpp_xor1(A[i]);
    merge16_desc(A, B);
#pragma unroll
    for (int i = 0; i < 16; ++i) B[i] = dpp_xor2(A[i]);
    merge16_desc(A, B);
    const size_t ob = ((size_t)(t0 + row) * 8 + h) * 16 + grp * 4;
    const int* i0 = LI + row * LSTR17;
    const int* i1 = LI + (64 + row) * LSTR17;
    int e4[4];
    float b4[4];
#pragma unroll
    for (int j = 0; j < 4; ++j) {
      const unsigned sel = (grp == 0) ? A[j] : (grp == 1) ? A[4 + j] : (grp == 2) ? A[8 + j] : A[12 + j];
      const int cc = 255 - (int)(sel & 255u);
      const int a = cc >> 4, bq = cc & 15;
      e4[j] = i0[a] * 128 + i1[bq];
      b4[j] = v0[a] + v1[bq];
    }
    *(int4*)(EIDX + ob) = make_int4(e4[0], e4[1], e4[2], e4[3]);
    *(float4*)(BEST + ob) = make_float4(b4[0], b4[1], b4[2], b4[3]);
  }
}

__device__ __forceinline__ void phase5(const Params& p, char* lds) {
  {
    const int i = tid_();
    if (i < 64) {
      const int grp = i >> 4, j = i & 15;
      int code = -1;
      if (grp == 0) code = j;
      else if (grp == 1) { if (j < 8) code = 16 + j; else if (j < 13) code = 32 + (j - 8); }
      else if (grp == 2) { if (j < 4) code = 48 + j; else if (j < 7) code = 64 + (j - 4); else if (j < 9) code = 80 + (j - 7); else if (j < 11) code = 96 + (j - 9); else if (j < 13) code = 112 + (j - 11); }
      else { if (j < 8) code = (8 + j) * 16; }
      ((int*)lds)[P5_TAB + i] = code;
    }
  }
  const int tid = tid_(), lane = tid & 63, wave = tid >> 6, l15 = lane & 15, g = lane >> 4;
  const int pp = wave >> 2, wq = wave & 3;
  int it = bid_();
  if (it >= 512 * 8) return;
  const bool fixed_head = (gridDim.x & 7) == 0;
  bf16x8 kf[8][4];
  bf16x8 qf[4];
  {
    const u16* KEYS = (const u16*)(p.ws + OFF_KEYS);
#pragma unroll
    for (int nt = 0; nt < 8; ++nt) {
      const u16* kp = KEYS + ((size_t)(((it & 7) * 2 + pp) * 128 + nt * 16 + l15)) * 128 + g * 8;
#pragma unroll
      for (int ks = 0; ks < 4; ++ks) kf[nt][ks] = *(const bf16x8*)(kp + ks * 32);
    }
    const u16* qp = (const u16*)(p.ws + OFF_PQ) + (size_t)((it >> 3) * 64 + wq * 16 + l15) * 2048 + (it & 7) * 256 + pp * 128 + g * 8;
#pragma unroll
    for (int ks = 0; ks < 4; ++ks) qf[ks] = *(const bf16x8*)(qp + ks * 32);
  }
  int kiter = 0;
  for (; it < 512 * 8; it += gridDim.x, ++kiter) {
    if (!fixed_head) {
      const u16* KEYS = (const u16*)(p.ws + OFF_KEYS);
#pragma unroll
      for (int nt = 0; nt < 8; ++nt) {
        const u16* kp = KEYS + ((size_t)(((it & 7) * 2 + pp) * 128 + nt * 16 + l15)) * 128 + g * 8;
#pragma unroll
        for (int ks = 0; ks < 4; ++ks) kf[nt][ks] = *(const bf16x8*)(kp + ks * 32);
      }
    }
    select_item(p, it, it + (int)gridDim.x, kiter, lds, kf, qf);
  }
  {
    const int G = (int)gridDim.x, kmin = (512 * 8) / G;
    for (int pr = kmin * 4 * G + bid_() * NWAVE + wave; pr < 16384; pr += G * NWAVE) quant_pair(p, 2 * pr, lane);
  }
}

#define P4(w, i) __builtin_amdgcn_cvt_scalef32_pk_f32_fp4((w), 1.0f, (i))
#define B4(w, i) __builtin_amdgcn_cvt_scalef32_pk_bf16_fp4((w), 1.0f, (i))
__device__ __forceinline__ f32x2 hpair(unsigned w) { return f32x2{bf_lo(w), bf_hi(w)}; }
__device__ __forceinline__ float dot32_fp4(const u32x4 u, const u32x4 (&h)[4], float acc) {
  f32x2 s = f32x2{acc, 0.f};
  s = __builtin_elementwise_fma(P4(u.x, 0), hpair(h[0].x), s); s = __builtin_elementwise_fma(P4(u.x, 1), hpair(h[0].y), s);
  s = __builtin_elementwise_fma(P4(u.x, 2), hpair(h[0].z), s); s = __builtin_elementwise_fma(P4(u.x, 3), hpair(h[0].w), s);
  s = __builtin_elementwise_fma(P4(u.y, 0), hpair(h[1].x), s); s = __builtin_elementwise_fma(P4(u.y, 1), hpair(h[1].y), s);
  s = __builtin_elementwise_fma(P4(u.y, 2), hpair(h[1].z), s); s = __builtin_elementwise_fma(P4(u.y, 3), hpair(h[1].w), s);
  s = __builtin_elementwise_fma(P4(u.z, 0), hpair(h[2].x), s); s = __builtin_elementwise_fma(P4(u.z, 1), hpair(h[2].y), s);
  s = __builtin_elementwise_fma(P4(u.z, 2), hpair(h[2].z), s); s = __builtin_elementwise_fma(P4(u.z, 3), hpair(h[2].w), s);
  s = __builtin_elementwise_fma(P4(u.w, 0), hpair(h[3].x), s); s = __builtin_elementwise_fma(P4(u.w, 1), hpair(h[3].y), s);
  s = __builtin_elementwise_fma(P4(u.w, 2), hpair(h[3].z), s); s = __builtin_elementwise_fma(P4(u.w, 3), hpair(h[3].w), s);
  return s.x + s.y;
}
__device__ __forceinline__ void p6_gather(u32x4 (&buf)[16], const unsigned char* EXs  , unsigned loff  , int ea, int eb, int eg) {
#pragma unroll
  for (int it = 0; it < 16; ++it) {
    const int src = (it * 8 + eg) & 63;
    const unsigned e = (unsigned)__shfl((it < 8) ? ea : eb, src);
    buf[it] = *(const u32x4*)(EXs + (size_t)(e * 128u + loff));
  }
}
__device__ __forceinline__ void p6a_compute(const u32x4 (&buf)[16], const u32x4 (&h)[4], float* PART, int t, int part, int eg, bool b2, bool b1, bool b0) {
  float f[32];
#pragma unroll
  for (int i = 0; i < 4; ++i) {
    f[i * 8 + 0] = bf_lo(h[i].x); f[i * 8 + 1] = bf_hi(h[i].x); f[i * 8 + 2] = bf_lo(h[i].y); f[i * 8 + 3] = bf_hi(h[i].y);
    f[i * 8 + 4] = bf_lo(h[i].z); f[i * 8 + 5] = bf_hi(h[i].z); f[i * 8 + 6] = bf_lo(h[i].w); f[i * 8 + 7] = bf_hi(h[i].w);
  }
  float am = 0.f;
#pragma unroll
  for (int i = 0; i < 32; ++i) am = fmaxf(am, fabsf(f[i]));
  const bool ok = am > 1e-30f;
  const float sc = ok ? 7.0f / am : 0.f, inv = ok ? am * (1.f / 7.0f) : 0.f;
  int hq[4];
#pragma unroll
  for (int i = 0; i < 4; ++i)
    hq[i] = (int)(q4(f[i * 8 + 0] * sc, 0) | q4(f[i * 8 + 1] * sc, 1) | q4(f[i * 8 + 2] * sc, 2) | q4(f[i * 8 + 3] * sc, 3) |
                  q4(f[i * 8 + 4] * sc, 4) | q4(f[i * 8 + 5] * sc, 5) | q4(f[i * 8 + 6] * sc, 6) | q4(f[i * 8 + 7] * sc, 7));
  float d[16];
#pragma unroll
  for (int it = 0; it < 16; ++it) {
    int a = __builtin_amdgcn_sdot8((int)buf[it].x, hq[0], 0, false);
    a = __builtin_amdgcn_sdot8((int)buf[it].y, hq[1], a, false);
    a = __builtin_amdgcn_sdot8((int)buf[it].z, hq[2], a, false);
    a = __builtin_amdgcn_sdot8((int)buf[it].w, hq[3], a, false);
    d[it] = (float)a * inv;
  }
  float r[8];
#pragma unroll
  for (int i = 0; i < 8; ++i) r[i] = (b2 ? d[i + 8] : d[i]) + __shfl_xor(b2 ? d[i] : d[i + 8], 4);
  float s4[4];
#pragma unroll
  for (int i = 0; i < 4; ++i) s4[i] = (b1 ? r[i + 4] : r[i]) + dpp_f<DPP_X2>(b1 ? r[i] : r[i + 4]);
  const float u0 = (b0 ? s4[2] : s4[0]) + dpp_f<DPP_X1>(b0 ? s4[0] : s4[2]);
  const float u1 = (b0 ? s4[3] : s4[1]) + dpp_f<DPP_X1>(b0 ? s4[1] : s4[3]);
  *(float2*)(PART + (size_t)t * 128 + (part * 8 + eg) * 2) = make_float2(u0, u1);
}
__device__ __forceinline__ void phase6a(const Params& p, char* lds) {
  const int tid = tid_(), lane = tid & 63, wave = tid >> 6, eg = lane >> 3, part = lane & 7;
  const int bid = bid_();
  const int x = bid & 7, xb = bid >> 3, ncb = ((int)gridDim.x + 7 - x) >> 3;
  const int sl = x >> 1, par = x & 1;
  const unsigned char* EUX = (const unsigned char*)(p.ws + OFF_EU) + (size_t)sl * (2 * MiB);
  const unsigned loff = (unsigned)part * 16u;
  const u16* HBX = (const u16*)(p.ws + OFF_HB) + sl * 256 + part * 32;
  const int* EIDX = (const int*)(p.ws + OFF_EIDX);
  float* PART = (float*)(p.ws + OFF_PART) + (size_t)sl * T * 128;
  const int tstep = ncb * NWAVE * 2;
  const bool b2 = (lane & 4) != 0, b1 = (lane & 2) != 0, b0 = (lane & 1) != 0;
  int t = (xb * NWAVE + wave) * 2 + par;
  if (t < T) {
    u32x4 A[16], B[16], hA[4], hB[4];
    int e0 = EIDX[(size_t)t * 128 + lane], e1 = EIDX[(size_t)t * 128 + 64 + lane];
    p6_gather(A, EUX, loff, e0, e1, eg);
#pragma unroll
    for (int i = 0; i < 4; ++i) hA[i] = *(const u32x4*)(HBX + (size_t)t * 1024 + i * 8);
    int tn = t + tstep;
    if (tn < T) { e0 = EIDX[(size_t)tn * 128 + lane]; e1 = EIDX[(size_t)tn * 128 + 64 + lane]; }
    for (;;) {
      int tnn = tn + tstep;
      if (tn < T) {
        p6_gather(B, EUX, loff, e0, e1, eg);
#pragma unroll
        for (int i = 0; i < 4; ++i) hB[i] = *(const u32x4*)(HBX + (size_t)tn * 1024 + i * 8);
        if (tnn < T) { e0 = EIDX[(size_t)tnn * 128 + lane]; e1 = EIDX[(size_t)tnn * 128 + 64 + lane]; }
      }
      p6a_compute(A, hA, PART, t, part, eg, b2, b1, b0);
      if (tn >= T) break;
      const int t3 = tnn + tstep;
      if (tnn < T) {
        p6_gather(A, EUX, loff, e0, e1, eg);
#pragma unroll
        for (int i = 0; i < 4; ++i) hA[i] = *(const u32x4*)(HBX + (size_t)tnn * 1024 + i * 8);
        if (t3 < T) { e0 = EIDX[(size_t)t3 * 128 + lane]; e1 = EIDX[(size_t)t3 * 128 + 64 + lane]; }
      }
      p6a_compute(B, hB, PART, tn, part, eg, b2, b1, b0);
      if (tnn >= T) break;
      t = tnn; tn = t3;
    }
  }
}

__device__ __forceinline__ void phase6m(const Params& p, char* lds) {
  const int tid = tid_(), lane = tid & 63, wave = tid >> 6;
  const u16* HB = (const u16*)(p.ws + OFF_HB);
  const float* ESC = (const float*)(p.ws + OFF_ESC);
  const int* EIDX = (const int*)(p.ws + OFF_EIDX);
  const float* BEST = (const float*)(p.ws + OFF_BEST);
  const float* PART = (const float*)(p.ws + OFF_PART);
  float* WGT = (float*)(p.ws + OFF_WGT);
  for (int t0 = (bid_() * NWAVE + wave) * 2; t0 < T; t0 += gridDim.x * NWAVE * 2) {
    uint4 ha[2], hb[2];
    float da[2], db[2], ba[2], bb[2];
    int ea[2], eb[2];
#pragma unroll
    for (int r = 0; r < 2; ++r) {
      const int t = t0 + r;
      ha[r] = *(const uint4*)(HB + (size_t)t * 1024 + lane * 16); hb[r] = *(const uint4*)(HB + (size_t)t * 1024 + lane * 16 + 8);
      const size_t i0 = (size_t)t * 128 + lane, i1 = i0 + 64;
      ea[r] = EIDX[i0]; eb[r] = EIDX[i1];
      ba[r] = BEST[i0]; bb[r] = BEST[i1];
      float sa = 0.f, sb = 0.f;
      const size_t pp = (size_t)t * 128 + (((lane >> 4) * 8 + (lane & 7)) * 2 + ((lane >> 3) & 1));
#pragma unroll
      for (int x = 0; x < 4; ++x) { sa += PART[(size_t)x * T * 128 + pp]; sb += PART[(size_t)x * T * 128 + pp + 64]; }
      da[r] = sa; db[r] = sb;
    }
    float ua[2], ub[2], va[2], vb[2];
#pragma unroll
    for (int r = 0; r < 2; ++r) { ua[r] = ESC[ea[r]]; ub[r] = ESC[eb[r]]; va[r] = ESC[16384 + ea[r]]; vb[r] = ESC[16384 + eb[r]]; }
#pragma unroll
    for (int r = 0; r < 2; ++r) {
      const uint4 a = ha[r], b = hb[r];
      float ss = 0.f;
      ss = dot2(a.x, a.x, ss); ss = dot2(a.y, a.y, ss); ss = dot2(a.z, a.z, ss); ss = dot2(a.w, a.w, ss);
      ss = dot2(b.x, b.x, ss); ss = dot2(b.y, b.y, ss); ss = dot2(b.z, b.z, ss); ss = dot2(b.w, b.w, ss);
#pragma unroll
      for (int o = 1; o < 64; o <<= 1) ss += __shfl_xor(ss, o);
      const float rs2 = rsqrtf(ss * (1.f / 1024.f) + EPS);
      const float xa = ba[r] * rs2, xb = bb[r] * rs2;
      float ma = xa, mb = xb;
#pragma unroll
      for (int o = 1; o < 16; o <<= 1) { ma = fmaxf(ma, __shfl_xor(ma, o)); mb = fmaxf(mb, __shfl_xor(mb, o)); }
      const float pa = __expf(xa - ma), pb = __expf(xb - mb);
      float sa = pa, sb = pb;
#pragma unroll
      for (int o = 1; o < 16; o <<= 1) { sa += __shfl_xor(sa, o); sb += __shfl_xor(sb, o); }
      const size_t i0 = (size_t)(t0 + r) * 128 + lane;
      float* wrow = WGT + (size_t)(t0 + r) * 128 + (lane & 7) * 16 + (lane >> 3);
      wrow[0] = (pa / sa) * gelu_f(da[r] * rs2 * ua[r]) * va[r];
      wrow[8] = (pb / sb) * gelu_f(db[r] * rs2 * ub[r]) * vb[r];
    }
  }
}

__device__ __forceinline__ void p6b_compute(const u32x4 (&buf)[16], const f32x4 (&wv)[4], uint2 hr, float* orow, int eg, bool h5, bool h4, bool h3) {
  f32x2 acc[16];
#pragma unroll
  for (int i = 0; i < 16; ++i) acc[i] = f32x2{0.f, 0.f};
#pragma unroll
  for (int it = 0; it < 16; ++it) {
    const float w = wv[it >> 2][it & 3];
    const f32x2 w2 = f32x2{w, w};
    const u32x4 v = buf[it];
    acc[0] = __builtin_elementwise_fma(P4(v.x, 0), w2, acc[0]);   acc[1] = __builtin_elementwise_fma(P4(v.x, 1), w2, acc[1]);
    acc[2] = __builtin_elementwise_fma(P4(v.x, 2), w2, acc[2]);   acc[3] = __builtin_elementwise_fma(P4(v.x, 3), w2, acc[3]);
    acc[4] = __builtin_elementwise_fma(P4(v.y, 0), w2, acc[4]);   acc[5] = __builtin_elementwise_fma(P4(v.y, 1), w2, acc[5]);
    acc[6] = __builtin_elementwise_fma(P4(v.y, 2), w2, acc[6]);   acc[7] = __builtin_elementwise_fma(P4(v.y, 3), w2, acc[7]);
    acc[8] = __builtin_elementwise_fma(P4(v.z, 0), w2, acc[8]);   acc[9] = __builtin_elementwise_fma(P4(v.z, 1), w2, acc[9]);
    acc[10] = __builtin_elementwise_fma(P4(v.z, 2), w2, acc[10]); acc[11] = __builtin_elementwise_fma(P4(v.z, 3), w2, acc[11]);
    acc[12] = __builtin_elementwise_fma(P4(v.w, 0), w2, acc[12]); acc[13] = __builtin_elementwise_fma(P4(v.w, 1), w2, acc[13]);
    acc[14] = __builtin_elementwise_fma(P4(v.w, 2), w2, acc[14]); acc[15] = __builtin_elementwise_fma(P4(v.w, 3), w2, acc[15]);
  }
  f32x2 q1[8];
#pragma unroll
  for (int i = 0; i < 8; ++i) {
    const auto rx = __builtin_amdgcn_permlane32_swap(__float_as_uint(acc[i].x), __float_as_uint(acc[i + 8].x), false, false);
    const auto ry = __builtin_amdgcn_permlane32_swap(__float_as_uint(acc[i].y), __float_as_uint(acc[i + 8].y), false, false);
    q1[i] = f32x2{__uint_as_float(rx[0]) + __uint_as_float(rx[1]), __uint_as_float(ry[0]) + __uint_as_float(ry[1])};
  }
  f32x2 q2[4];
#pragma unroll
  for (int i = 0; i < 4; ++i) {
    const auto rx = __builtin_amdgcn_permlane16_swap(__float_as_uint(q1[i].x), __float_as_uint(q1[i + 4].x), false, false);
    const auto ry = __builtin_amdgcn_permlane16_swap(__float_as_uint(q1[i].y), __float_as_uint(q1[i + 4].y), false, false);
    q2[i] = f32x2{__uint_as_float(rx[0]) + __uint_as_float(rx[1]), __uint_as_float(ry[0]) + __uint_as_float(ry[1])};
  }
  f32x2 q3[2];
#pragma unroll
  for (int i = 0; i < 2; ++i) {
    const f32x2 sd = h3 ? q2[i] : q2[i + 2], kp = h3 ? q2[i + 2] : q2[i];
    q3[i] = f32x2{kp.x + dpp_f<DPP_R8>(sd.x), kp.y + dpp_f<DPP_R8>(sd.y)};
  }
  *(float4*)orow = make_float4(bf_lo(hr.x) + q3[0].x, bf_hi(hr.x) + q3[0].y, bf_lo(hr.y) + q3[1].x, bf_hi(hr.y) + q3[1].y);
}
__device__ __forceinline__ void phase6b(const Params& p, char* lds) {
  const int tid = tid_(), lane = tid & 63, wave = tid >> 6, eg = lane >> 3, part = lane & 7;
  const int bid = bid_();
  const int x = bid & 7, xb = bid >> 3, ncb = ((int)gridDim.x + 7 - x) >> 3;
  const int sl = x >> 1, par = x & 1;
  const unsigned char* EVX = (const unsigned char*)(p.ws + OFF_EV) + (size_t)sl * (2 * MiB);
  const unsigned loff = (unsigned)part * 16u;
  const int* EIDX = (const int*)(p.ws + OFF_EIDX);
  const float* WGT = (const float*)(p.ws + OFF_WGT);
  const int tstep = ncb * NWAVE * 2;
  const int pi = ((lane >> 5) & 1) * 4 + ((lane >> 4) & 1) * 2 + ((lane >> 3) & 1);
  const int ocol = sl * 256 + part * 32 + pi * 4;
  const u16* HB = (const u16*)(p.ws + OFF_HB) + ocol;
  float* OUT = p.out + ocol;
  const bool h5 = (lane & 32) != 0, h4 = (lane & 16) != 0, h3 = (lane & 8) != 0;
  int t = (xb * NWAVE + wave) * 2 + par;
  if (t < T) {
    u32x4 A[16], B[16];
    int e0 = EIDX[(size_t)t * 128 + lane], e1 = EIDX[(size_t)t * 128 + 64 + lane];
    f32x4 wA[4], wB[4];
#pragma unroll
    for (int i = 0; i < 4; ++i) { wA[i] = *(const f32x4*)(WGT + (size_t)t * 128 + eg * 16 + i * 4); wB[i] = wA[i]; }
    uint2 hA = *(const uint2*)(HB + (size_t)t * 1024), hB = make_uint2(0u, 0u);
    p6_gather(A, EVX, loff, e0, e1, eg);
    int tn = t + tstep;
    if (tn < T) { e0 = EIDX[(size_t)tn * 128 + lane]; e1 = EIDX[(size_t)tn * 128 + 64 + lane]; }
    for (;;) {
      int tnn = tn + tstep;
      if (tn < T) {
        p6_gather(B, EVX, loff, e0, e1, eg);
#pragma unroll
        for (int i = 0; i < 4; ++i) wB[i] = *(const f32x4*)(WGT + (size_t)tn * 128 + eg * 16 + i * 4);
        hB = *(const uint2*)(HB + (size_t)tn * 1024);
        if (tnn < T) { e0 = EIDX[(size_t)tnn * 128 + lane]; e1 = EIDX[(size_t)tnn * 128 + 64 + lane]; }
      }
      p6b_compute(A, wA, hA, OUT + (size_t)t * 1024, eg, h5, h4, h3);
      if (tn >= T) break;
      const int t3 = tnn + tstep;
      if (tnn < T) {
        p6_gather(A, EVX, loff, e0, e1, eg);
#pragma unroll
        for (int i = 0; i < 4; ++i) wA[i] = *(const f32x4*)(WGT + (size_t)tnn * 128 + eg * 16 + i * 4);
        hA = *(const uint2*)(HB + (size_t)tnn * 1024);
        if (t3 < T) { e0 = EIDX[(size_t)t3 * 128 + lane]; e1 = EIDX[(size_t)t3 * 128 + 64 + lane]; }
      }
      p6b_compute(B, wB, hB, OUT + (size_t)tn * 1024, eg, h5, h4, h3);
      if (tnn >= T) break;
      t = tnn; tn = t3;
    }
  }
}

#define LAS __attribute__((address_space(3)))
#define XB_TMO      128
#define XB_XCNT(j)  (256  + 64 * (j))
#define XB_XSUB(j)  (1280 + 64 * (j))
#define XB_XGEN(j)  (2304 + 64 * (j))
#define XB_TOP      3328
#define XB_TOPGEN   3392
#define XCD_BAR_WORDS 3456
#define XB_SPIN_CAP (1u << 18)

__device__ __forceinline__ unsigned xb_ld(unsigned* p)              { return __hip_atomic_load(p, __ATOMIC_RELAXED, __HIP_MEMORY_SCOPE_AGENT); }
__device__ __forceinline__ unsigned xb_add(unsigned* p, unsigned v) { return __hip_atomic_fetch_add(p, v, __ATOMIC_RELAXED, __HIP_MEMORY_SCOPE_AGENT); }
__device__ __forceinline__ unsigned xb_xcc_id() { return (unsigned)__builtin_amdgcn_s_getreg((3 << 11) | 20) & 0xFu; }
#define XB_SPIN(cond, bar) do { unsigned _sp = 0; while (cond) { __builtin_amdgcn_s_sleep(1); \
    if ((++_sp & 255u) == 0u) { if (xb_ld(&(bar)[XB_TMO])) break; if (_sp > XB_SPIN_CAP) { atomicAdd(&(bar)[XB_TMO], 1u); break; } } } } while (0)

struct XcdBarrier {
    unsigned* bar; unsigned x;
    volatile LAS unsigned* st;
};

__device__ __forceinline__ XcdBarrier xcd_barrier_post(unsigned* bar, volatile LAS unsigned* st) {
    XcdBarrier b; b.bar = bar; b.x = xb_xcc_id(); b.st = st;
    if (threadIdx.x == 0) (void)xb_add(&bar[XB_XCNT(b.x)], 1u);
    return b;
}
__device__ __forceinline__ void xcd_barrier_complete(unsigned* bar, unsigned x, unsigned& nloc, unsigned& nx) {
    const unsigned G = gridDim.x * gridDim.y * gridDim.z;
    unsigned sum, cnt, mine, sp = 0u;
    for (;;) {
        sum = 0u; cnt = 0u; mine = 0u;
#pragma unroll
        for (unsigned j = 0; j < 16; ++j) { const unsigned c = xb_ld(&bar[XB_XCNT(j)]); sum += c; cnt += (c > 0u) ? 1u : 0u; mine = (j == x) ? c : mine; }
        if (sum == G) break;
        __builtin_amdgcn_s_sleep(1);
        if ((++sp & 255u) == 0u) { if (xb_ld(&bar[XB_TMO])) break; if (sp > XB_SPIN_CAP) { atomicAdd(&bar[XB_TMO], 1u); break; } }
    }
    nloc = mine > 0u ? mine : 1u; nx = cnt > 0u ? cnt : 1u;
}

__device__ __forceinline__ void xcd_barrier(const XcdBarrier& b) {
    asm volatile("s_waitcnt vmcnt(0)" ::: "memory");
    __syncthreads();
    if (threadIdx.x == 0) {
        unsigned* bar = b.bar;
        __builtin_amdgcn_s_waitcnt(0);
        unsigned nloc = b.st[0], nx = b.st[1];
        if (nloc == 0u) { xcd_barrier_complete(bar, b.x, nloc, nx); b.st[0] = nloc; b.st[1] = nx; }
        const unsigned old = xb_add(&bar[XB_XSUB(b.x)], 1u);
        const unsigned gen = old / nloc;
        if (old + 1u == (gen + 1u) * nloc) {
            __builtin_amdgcn_fence(__ATOMIC_RELEASE, "agent");
            asm volatile("s_waitcnt vmcnt(0)" ::: "memory");
            const unsigned og = xb_add(&bar[XB_TOP], 1u);
            const unsigned tg = og / nx;
            if (og + 1u == (tg + 1u) * nx) xb_add(&bar[XB_TOPGEN], 1u);
            else XB_SPIN(xb_ld(&bar[XB_TOPGEN]) == tg, bar);
            __builtin_amdgcn_fence(__ATOMIC_ACQUIRE, "agent");
            xb_add(&bar[XB_XGEN(b.x)], 1u);
            asm volatile("s_waitcnt vmcnt(0)" ::: "memory");
        } else {
            XB_SPIN(xb_ld(&bar[XB_XGEN(b.x)]) == gen, bar);
            __builtin_amdgcn_fence(__ATOMIC_ACQUIRE, "agent");
            asm volatile("s_waitcnt vmcnt(0)" ::: "memory");
        }
    }
    __syncthreads();
}


__device__ __forceinline__ void seam_barrier(unsigned* ctr, unsigned nblk) {
  __syncthreads();
  if (threadIdx.x == 0) {
    __builtin_amdgcn_fence(__ATOMIC_RELEASE, "agent");
    asm volatile("s_waitcnt vmcnt(0)" ::: "memory");
    __hip_atomic_fetch_add(ctr, 1u, __ATOMIC_RELAXED, __HIP_MEMORY_SCOPE_AGENT);
    while (__hip_atomic_load(ctr, __ATOMIC_RELAXED, __HIP_MEMORY_SCOPE_AGENT) < nblk) __builtin_amdgcn_s_sleep(2);
    __builtin_amdgcn_fence(__ATOMIC_ACQUIRE, "agent");
    asm volatile("s_waitcnt vmcnt(0)" ::: "memory");
  }
  __syncthreads();
}
#ifndef PMASK
#define PMASK 127
#endif
#define PROG 0x6543210ull
#define NPROG 9
__global__ void __launch_bounds__(NTHR, 2) mega(Params p, int ph_lo, int ph_hi) {
  extern __shared__ __attribute__((aligned(16))) char lds[];
  cg::grid_group grid = cg::this_grid();
#ifndef REP_PHASE
#define REP_PHASE -1
#endif
#define IN(k) (ph_lo <= (k) && (k) < ph_hi)
  volatile LAS unsigned* xst = (volatile LAS unsigned*)(LDS3(lds) + (LDS_BYTES - 16));
  if (threadIdx.x == 0) { xst[0] = 0u; xst[1] = 0u; }
  XcdBarrier xbar; xbar.bar = (unsigned*)(p.ws + OFF_BAR); xbar.x = 0; xbar.st = xst;
  if (ph_hi - ph_lo > 1) {
    if (blockIdx.x == 0) for (int i = threadIdx.x; i < XCD_BAR_WORDS; i += NTHR) ((unsigned*)(p.ws + OFF_BAR))[i] = 0u;
    grid.sync();
    xbar = xcd_barrier_post((unsigned*)(p.ws + OFF_BAR), xst);
  }
#define SEAM(k) do { if (IN(k) && IN((k) + 1)) xcd_barrier(xbar); } while (0)
  if (IN(0)) { phase0(p, lds); if (REP_PHASE == 0) { grid.sync(); phase0(p, lds); } }
  SEAM(0);
  if (IN(1)) { phase1(p, lds); if (REP_PHASE == 1) { grid.sync(); phase1(p, lds); } }
  SEAM(1);
  if (IN(2)) { phase2(p, lds); if (REP_PHASE == 2) { grid.sync(); phase2(p, lds); } }
  SEAM(2);
  if (IN(3)) { phase3(p, lds); if (REP_PHASE == 3) { grid.sync(); phase3(p, lds); } }
  SEAM(3);
  if (IN(4)) { phase4(p, lds); if (REP_PHASE == 4) { grid.sync(); phase4(p, lds); } }
  SEAM(4);
  if (IN(5)) { phase5(p, lds); if (REP_PHASE == 5) { grid.sync(); phase5(p, lds); } }
  SEAM(5);
  if (IN(6)) { phase6a(p, lds); if (REP_PHASE == 6) { grid.sync(); phase6a(p, lds); } }
  SEAM(6);
  if (IN(7)) { phase6m(p, lds); if (REP_PHASE == 7) { grid.sync(); phase6m(p, lds); } }
  SEAM(7);
  if (IN(8)) phase6b(p, lds);
}

extern "C" void kernel_launch(void* const* d_in, const int* in_sizes, int n_in, void* d_out, int out_size, void* d_ws,
                              size_t ws_size, hipStream_t stream) {
  static int grid_blocks = 0;
  if (!grid_blocks) {
    int dev = 0, cus = 0, per_cu = 0;
    (void)hipGetDevice(&dev);
    (void)hipDeviceGetAttribute(&cus, hipDeviceAttributeMultiprocessorCount, dev);
    (void)hipFuncSetAttribute((const void*)mega, hipFuncAttributeMaxDynamicSharedMemorySize, LDS_BYTES);
    (void)hipOccupancyMaxActiveBlocksPerMultiprocessor(&per_cu, mega, NTHR, LDS_BYTES);
    if (per_cu > 1) per_cu = 1;
    grid_blocks = cus * per_cu;
  }
  Params p{};
  p.x = (const float*)d_in[0]; p.ln_mix_g = (const float*)d_in[1]; p.w_in = (const float*)d_in[2];
  p.gmlp_norm_g = (const float*)d_in[3]; p.gmlp_w_s = (const float*)d_in[4]; p.gmlp_b_s = (const float*)d_in[5];
  p.q_norm_g = (const float*)d_in[6]; p.k_norm_g = (const float*)d_in[7]; p.rel_bias = (const float*)d_in[8];
  p.w_out = (const float*)d_in[9]; p.ln_ffn_g = (const float*)d_in[10]; p.w_query = (const float*)d_in[11];
  p.sub_keys = (const float*)d_in[12]; p.peer_u = (const float*)d_in[13]; p.peer_v = (const float*)d_in[14];
  p.out = (float*)d_out; p.ws = (char*)d_ws;
#if FUSED
  int lo = 0, hi = NPROG;
  void* args[] = {&p, &lo, &hi};
  hipError_t e = hipLaunchCooperativeKernel((void*)mega, dim3(grid_blocks), dim3(NTHR), args, LDS_BYTES, stream);
  if (e != hipSuccess) fprintf(stderr, "cooperative launch failed: %s (grid %d)\n", hipGetErrorString(e), grid_blocks);
#else
  for (int ph = 0; ph < NPROG; ++ph) mega<<<dim3(grid_blocks), dim3(NTHR), LDS_BYTES, stream>>>(p, ph, ph + 1);
#endif
}
```

```cpp
#include <hip/hip_runtime.h>
#include <hip/hip_cooperative_groups.h>
#include <cstdio>
namespace cg = cooperative_groups;

#ifndef FUSED
#define FUSED 1
#endif

typedef unsigned short u16;
using bf16x8 = __attribute__((ext_vector_type(8))) short;
using s16x4 = __attribute__((ext_vector_type(4))) short;
using f32x4 = __attribute__((ext_vector_type(4))) float;
using bf16x2 = __attribute__((ext_vector_type(2))) __bf16;
using f32x2 = __attribute__((ext_vector_type(2))) float;
using u32x4 = __attribute__((ext_vector_type(4))) unsigned;
using u32x2 = __attribute__((ext_vector_type(2))) unsigned;

constexpr int T = 32768, DM = 1024, SEQ = 4096;
constexpr float EPS = 1e-6f;
constexpr size_t MiB = 1u << 20;
constexpr size_t OFF_XB = 0, OFF_WINT = 64 * MiB  , OFF_WB = 67 * MiB  , OFF_WOUTT = 69 * MiB, OFF_WQT = 71 * MiB, OFF_KEYS = 75 * MiB,
                 OFF_RS = 76 * MiB, OFF_VSS = 76 * MiB + 512 * 1024, OFF_EU = 77 * MiB, OFF_EV = 109 * MiB,
                 OFF_U = 141 * MiB, OFF_GVT = 173 * MiB, OFF_QK = 205 * MiB, OFF_VT = 269 * MiB, OFF_AB = 301 * MiB,
                 OFF_HB = 365 * MiB, OFF_PQ = 141 * MiB  , OFF_EIDX = 429 * MiB,
                 OFF_BEST = 445 * MiB, OFF_ESC = 461 * MiB  , OFF_WGT = 462 * MiB  , OFF_BAR = 480 * MiB  , OFF_PART = 141 * MiB  ;

struct Params {
  const float *x, *ln_mix_g, *w_in, *gmlp_norm_g, *gmlp_w_s, *gmlp_b_s, *q_norm_g, *k_norm_g, *rel_bias, *w_out,
      *ln_ffn_g, *w_query, *sub_keys, *peer_u, *peer_v;
  float* out;
  char* ws;
};

constexpr int LDS_BYTES = 131584;
constexpr int NTHR = 512, NWAVE = 8;
constexpr int LSTR = 144;
constexpr int OPER_BYTES = 128 * LSTR;

__device__ __forceinline__ u16 f2bf(float f) {
  unsigned u = __float_as_uint(f);
  u += 0x7fffu + ((u >> 16) & 1u);
  return (u16)(u >> 16);
}
__device__ __forceinline__ unsigned pack2(float lo, float hi) { return (unsigned)f2bf(lo) | ((unsigned)f2bf(hi) << 16); }
__device__ __forceinline__ float bf_lo(unsigned u) { return __uint_as_float(u << 16); }
__device__ __forceinline__ float bf_hi(unsigned u) { return __uint_as_float(u & 0xffff0000u); }
__device__ __forceinline__ float bf2f(u16 v) { return __uint_as_float(((unsigned)v) << 16); }
__device__ __forceinline__ float gelu_f(float x) {
  const float c1 = -2.f * 0.7978845608028654f * 1.4426950408889634f, c2 = c1 * 0.044715f;
  const float zp = x * __builtin_fmaf(x * x, c2, c1);
  return x * __builtin_amdgcn_rcpf(1.f + __builtin_amdgcn_exp2f(zp));
}
template <int CTRL> __device__ __forceinline__ float dpp_f(float v) { return __int_as_float(__builtin_amdgcn_mov_dpp(__float_as_int(v), CTRL, 0xF, 0xF, true)); }
constexpr int DPP_X1 = 0xB1  , DPP_X2 = 0x4E  , DPP_HM = 0x141  , DPP_R8 = 0x128  ;
__device__ __forceinline__ float dot2(unsigned a, unsigned b, float acc) {
  return __builtin_amdgcn_fdot2_f32_bf16(__builtin_bit_cast(bf16x2, a), __builtin_bit_cast(bf16x2, b), acc, false);
}
__device__ __forceinline__ f32x4 mfma16(bf16x8 a, bf16x8 b, f32x4 c) {
  return __builtin_amdgcn_mfma_f32_16x16x32_bf16(a, b, c, 0, 0, 0);
}
__device__ __forceinline__ bf16x8 mk8(unsigned a, unsigned b, unsigned c, unsigned d) {
  uint4 u = make_uint4(a, b, c, d);
  return __builtin_bit_cast(bf16x8, u);
}
__device__ __forceinline__ unsigned pack4_fp8(float a, float b, float c, float d) {
  int r = 0;
  r = __builtin_amdgcn_cvt_pk_fp8_f32(a, b, r, false);
  r = __builtin_amdgcn_cvt_pk_fp8_f32(c, d, r, true);
  return (unsigned)r;
}
__device__ __forceinline__ unsigned q4(float xs, int i) {
  return (__float_as_uint(xs + 12582912.f) & 15u) << (4 * i);
}
__device__ __forceinline__ unsigned okey(float x) {
  unsigned u = __float_as_uint(x);
  return (u & 0x80000000u) ? ~u : (u | 0x80000000u);
}


__device__ __forceinline__ int tid_() { int t = threadIdx.x; asm volatile("" : "+v"(t)); return t; }
__device__ __forceinline__ int bid_() { int b = blockIdx.x; asm volatile("" : "+s"(b)); return b; }
namespace pg8 {
#define PG8_LAS __attribute__((address_space(3)))
typedef unsigned short bf16_t;
typedef short bf16x8 __attribute__((ext_vector_type(8)));
typedef float f32x4 __attribute__((ext_vector_type(4)));
typedef unsigned u32x4 __attribute__((ext_vector_type(4)));
constexpr int BM = 256, BK = 64, HALF = 128, HTB = HALF * BK * 2  , STAGE_BYTES = 8 * HTB, NXCD = 8, WGM = 8;

__host__ __device__ __forceinline__ int lds_byte(int r, int c) { const int st = (r >> 4) * 2 + (c >> 5), rr = r & 15, cc = c & 31, ob = rr * 64 + cc * 2; return st * 1024 + (ob ^ (((ob >> 9) & 1) << 5)); }
__host__ __device__ __forceinline__ void stage_rc(int b, int& R, int& C) { const int st = b / 1024, sb = b % 1024, swz = sb ^ (((sb >> 9) & 1) << 5); R = (st >> 1) * 16 + swz / 64; C = (st & 1) * 32 + (swz % 64) / 2; }
__host__ __device__ __forceinline__ int perm32(int rho) { const int n = rho >> 4, i = rho & 15; return 8 * (i >> 2) + 4 * n + (i & 3); }

struct Unit { int pm, pn; };
struct Gemm { const bf16_t* A; const bf16_t* Bt; int M, N, K; };

struct StaticOrder {
    int nM, nN, nwg, G, c;
    __host__ __device__ void init(int M, int N, int G_, int c_) { nM = M / BM; nN = N / BM; nwg = nM * nN; G = G_; c = c_; }
    __host__ __device__ bool next(int i, Unit& u) const {
        const long L = (long)i * G + c; if (L >= nwg) return false;
        int wgid = (int)L; { const int q = nwg / NXCD, r = nwg % NXCD, xcd = wgid % NXCD, off = wgid / NXCD; wgid = (xcd < r ? xcd * (q + 1) : r * (q + 1) + (xcd - r) * q) + off; }
        const int nig = WGM * nN, gid = wgid / nig, fm = gid * WGM, gsz = (nM - fm) < WGM ? (nM - fm) : WGM;
        u.pm = fm + ((wgid % nig) % gsz); u.pn = (wgid % nig) / gsz; return true;
    }
    __device__ __forceinline__ void a_ready(const Unit&) const {}
    __device__ __forceinline__ void done(const Unit&) const {}
};

__device__ __forceinline__ unsigned cvt_pk_bf16(float lo, float hi) { unsigned r; asm volatile("v_cvt_pk_bf16_f32 %0, %1, %2" : "=v"(r) : "v"(lo), "v"(hi)); return r; }
template <class Epi, class Sched, bool ALIGN_EPI = false, bool SP2 = false>
__device__ __forceinline__ void gemm_phase(PG8_LAS unsigned char* lds, const Gemm g, const Sched& S, const Epi& E) {
    const int tid = threadIdx.x, wid = __builtin_amdgcn_readfirstlane(tid >> 6), lane = tid & 63, wr = wid >> 2, wc = wid & 3, fr = lane & 15, fq = lane >> 4;
    const int K = g.K, nt = K / BK;
    unsigned voffA[2], voffB[2];
#pragma unroll
    for (int i = 0; i < 2; ++i) { int R, C; stage_rc(tid * 16 + i * 8192, R, C); const int Rb = Epi::PERM ? ((R & ~31) + perm32(R & 31)) : R;
        voffA[i] = (unsigned)(R * K + C) * 2u; voffB[i] = (unsigned)(Rb * K + C) * 2u; }
    const size_t kstep = (size_t)(BK * 2);
    const size_t hstep = (size_t)HALF * K * 2;
    const size_t tstep = 2 * hstep;
    const unsigned ldsw = (unsigned)wid * 1024u;
    const int aoff = lds_byte(wr * 64 + fr, fq * 8), boff = lds_byte(wc * 32 + fr, fq * 8);
#define PG8_SA(b, h) (((b) * 2 + (h)) * HTB)
#define PG8_SB(b, h) ((4 + (b) * 2 + (h)) * HTB)
#define PG8_STAGE(bufoff, gbase, voff) do { _Pragma("unroll") for (int _i = 0; _i < 2; ++_i) \
        __builtin_amdgcn_global_load_lds((const unsigned*)((const char*)(gbase) + (voff)[_i]), (PG8_LAS unsigned*)(lds + (bufoff) + ldsw + _i * 8192), 16, 0, 0); } while (0)
#define PG8_LDA(dst, b, h) do { _Pragma("unroll") for (int m = 0; m < 4; ++m) _Pragma("unroll") for (int k = 0; k < 2; ++k) dst[m][k] = *(const PG8_LAS bf16x8*)(lds + PG8_SA(b, h) + aoff + m * 2048 + k * 1024); } while (0)
#define PG8_LDB(dst, b, h) do { _Pragma("unroll") for (int n = 0; n < 2; ++n) _Pragma("unroll") for (int k = 0; k < 2; ++k) dst[n][k] = *(const PG8_LAS bf16x8*)(lds + PG8_SB(b, h) + boff + n * 2048 + k * 1024); } while (0)
#define PG8_MMA(ai, bj, At, Bt) do { __builtin_amdgcn_s_setprio(1); _Pragma("unroll") for (int m = 0; m < 4; ++m) _Pragma("unroll") for (int n = 0; n < 2; ++n) _Pragma("unroll") for (int k = 0; k < 2; ++k) \
        acc[ai][bj][m][n] = __builtin_amdgcn_mfma_f32_16x16x32_bf16(Bt[n][k], At[m][k], acc[ai][bj][m][n], 0, 0, 0); __builtin_amdgcn_s_setprio(0); } while (0)
#define PG8_WAIT_V(n) asm volatile("s_waitcnt vmcnt(" #n ")" ::: "memory")
#define PG8_WAIT_L(n) asm volatile("s_waitcnt lgkmcnt(" #n ")" ::: "memory")
#define PG8_BAR __builtin_amdgcn_s_barrier()
#define PG8_SCHED __builtin_amdgcn_sched_barrier(0)
    Unit cur, nxt; int ui = 0;
    if (!S.next(0, cur)) return;
    f32x4 acc[2][2][4][2];
#pragma unroll
    for (int a = 0; a < 2; ++a)
#pragma unroll
        for (int b = 0; b < 2; ++b)
#pragma unroll
            for (int m = 0; m < 4; ++m)
#pragma unroll
                for (int n = 0; n < 2; ++n) acc[a][b][m][n] = (f32x4){0.f, 0.f, 0.f, 0.f};
    bf16x8 At[4][2], B0[2][2], B1[2][2];
    const char* cA = (const char*)g.A + (size_t)cur.pm * tstep; const char* cB = (const char*)g.Bt + (size_t)cur.pn * tstep;
    S.a_ready(cur);
    if constexpr (SP2) {
        PG8_STAGE(PG8_SB(0, 0), cB, voffB); PG8_STAGE(PG8_SB(0, 1), cB + hstep, voffB); PG8_STAGE(PG8_SA(0, 0), cA, voffA); PG8_STAGE(PG8_SA(0, 1), cA + hstep, voffA);
        if (wr == 1) PG8_BAR;
        PG8_WAIT_V(2); PG8_BAR;
        PG8_STAGE(PG8_SB(1, 0), cB + kstep, voffB); PG8_STAGE(PG8_SA(1, 0), cA + kstep, voffA); PG8_STAGE(PG8_SB(1, 1), cB + hstep + kstep, voffB);
        PG8_WAIT_V(6); PG8_BAR;
    } else {
        PG8_STAGE(PG8_SB(0, 0), cB, voffB); PG8_STAGE(PG8_SA(0, 0), cA, voffA); PG8_STAGE(PG8_SB(0, 1), cB + hstep, voffB); PG8_STAGE(PG8_SA(0, 1), cA + hstep, voffA);
        if (wr == 1) PG8_BAR;
        PG8_WAIT_V(4); PG8_BAR;
        PG8_STAGE(PG8_SB(1, 0), cB + kstep, voffB); PG8_STAGE(PG8_SA(1, 0), cA + kstep, voffA); PG8_STAGE(PG8_SB(1, 1), cB + hstep + kstep, voffB);
        PG8_WAIT_V(6); PG8_BAR;
    }
    for (;;) {
        const bool has_next = S.next(ui + 1, nxt);
        const char* nA = has_next ? (const char*)g.A + (size_t)nxt.pm * tstep : cA; const char* nB = has_next ? (const char*)g.Bt + (size_t)nxt.pn * tstep : cB;
        for (int t = 0; t < nt; t += 2) {
            const bool last = (t == nt - 2);
            const char* a1 = cA + (size_t)(t + 1) * kstep;
            const char* a2 = last ? nA : cA + (size_t)(t + 2) * kstep; const char* b2 = last ? nB : cB + (size_t)(t + 2) * kstep;
            const char* a3 = a2 + kstep; const char* b3 = b2 + kstep;
            if (last && has_next) S.a_ready(nxt);
            if constexpr (SP2) {
            PG8_LDB(B0, 0, 0); PG8_LDB(B1, 0, 1); PG8_SCHED; PG8_LDA(At, 0, 0); PG8_STAGE(PG8_SA(1, 1), a1 + hstep, voffA);
            PG8_WAIT_V(8); PG8_WAIT_L(0); PG8_BAR; PG8_MMA(0, 0, At, B0); PG8_MMA(0, 1, At, B1); PG8_BAR; PG8_SCHED;
            PG8_LDA(At, 0, 1); PG8_STAGE(PG8_SB(0, 0), b2, voffB); PG8_STAGE(PG8_SB(0, 1), b2 + hstep, voffB); PG8_STAGE(PG8_SA(0, 0), a2, voffA);
            PG8_WAIT_V(8); PG8_WAIT_L(0); PG8_BAR; PG8_MMA(1, 0, At, B0); PG8_MMA(1, 1, At, B1); PG8_BAR; PG8_SCHED;
            PG8_LDB(B0, 1, 0); PG8_LDB(B1, 1, 1); PG8_SCHED; PG8_LDA(At, 1, 0); PG8_STAGE(PG8_SA(0, 1), a2 + hstep, voffA);
            PG8_WAIT_V(8); PG8_WAIT_L(0); PG8_BAR; PG8_MMA(0, 0, At, B0); PG8_MMA(0, 1, At, B1); PG8_BAR; PG8_SCHED;
            PG8_LDA(At, 1, 1); PG8_STAGE(PG8_SB(1, 0), b3, voffB); PG8_STAGE(PG8_SB(1, 1), b3 + hstep, voffB); PG8_STAGE(PG8_SA(1, 0), a3, voffA);
            PG8_WAIT_V(8); PG8_WAIT_L(0); PG8_BAR; PG8_MMA(1, 0, At, B0); PG8_MMA(1, 1, At, B1); PG8_BAR; PG8_SCHED;
            } else {
            PG8_LDB(B0, 0, 0); PG8_SCHED; PG8_LDA(At, 0, 0); PG8_STAGE(PG8_SA(1, 1), a1 + hstep, voffA);
            PG8_WAIT_L(8); PG8_BAR; PG8_WAIT_L(0); PG8_MMA(0, 0, At, B0); PG8_BAR; PG8_SCHED;
            PG8_LDB(B1, 0, 1); PG8_STAGE(PG8_SB(0, 0), b2, voffB);
            PG8_BAR; PG8_WAIT_L(0); PG8_MMA(0, 1, At, B1); PG8_BAR;
            PG8_LDA(At, 0, 1); PG8_STAGE(PG8_SA(0, 0), a2, voffA);
            PG8_BAR; PG8_WAIT_L(0); PG8_MMA(1, 0, At, B0); PG8_BAR; PG8_SCHED;
            PG8_STAGE(PG8_SB(0, 1), b2 + hstep, voffB);
            PG8_WAIT_V(6); PG8_BAR; PG8_MMA(1, 1, At, B1); PG8_BAR;
            PG8_LDB(B0, 1, 0); PG8_SCHED; PG8_LDA(At, 1, 0); PG8_STAGE(PG8_SA(0, 1), a2 + hstep, voffA);
            PG8_WAIT_L(8); PG8_BAR; PG8_WAIT_L(0); PG8_MMA(0, 0, At, B0); PG8_BAR; PG8_SCHED;
            PG8_LDB(B1, 1, 1); PG8_STAGE(PG8_SB(1, 0), b3, voffB);
            PG8_BAR; PG8_WAIT_L(0); PG8_MMA(0, 1, At, B1); PG8_BAR;
            PG8_LDA(At, 1, 1); PG8_STAGE(PG8_SA(1, 0), a3, voffA);
            PG8_BAR; PG8_WAIT_L(0); PG8_MMA(1, 0, At, B0); PG8_BAR; PG8_SCHED;
            PG8_STAGE(PG8_SB(1, 1), b3 + hstep, voffB);
            PG8_WAIT_V(6); PG8_BAR; PG8_MMA(1, 1, At, B1); PG8_BAR;
            }
        }
        if constexpr (ALIGN_EPI) { if (wr == 0) PG8_BAR; }
        if constexpr (!Epi::AFTER_DRAIN) { E(acc, cur, wr, wc, fr, fq); S.done(cur); }
        if (!has_next) break;
#pragma unroll
        for (int a = 0; a < 2; ++a)
#pragma unroll
            for (int b = 0; b < 2; ++b)
#pragma unroll
                for (int m = 0; m < 4; ++m)
#pragma unroll
                    for (int n = 0; n < 2; ++n) acc[a][b][m][n] = (f32x4){0.f, 0.f, 0.f, 0.f};
        cur = nxt; cA = nA; cB = nB; ++ui;
        if constexpr (ALIGN_EPI) { if (wr == 1) PG8_BAR; }
    }
    PG8_WAIT_V(0);
    if constexpr (!ALIGN_EPI) { if (wr == 0) PG8_BAR; }
    PG8_BAR;
    if constexpr (Epi::AFTER_DRAIN) { E.fused(acc, cur, wr, wc, fr, fq, lds, wid, lane); S.done(cur); }
#undef PG8_SA
#undef PG8_SB
#undef PG8_STAGE
#undef PG8_LDA
#undef PG8_LDB
#undef PG8_MMA
#undef PG8_WAIT_V
#undef PG8_WAIT_L
#undef PG8_BAR
#undef PG8_SCHED
}
}

#define EPI_V8(v, A, s) float v[8] = {A[0][0] * (s), A[0][1] * (s), A[0][2] * (s), A[0][3] * (s), A[1][0] * (s), A[1][1] * (s), A[1][2] * (s), A[1][3] * (s)}
__device__ __forceinline__ uint4 pk8(const float (&v)[8]) {
  return make_uint4(pg8::cvt_pk_bf16(v[0], v[1]), pg8::cvt_pk_bf16(v[2], v[3]), pg8::cvt_pk_bf16(v[4], v[5]), pg8::cvt_pk_bf16(v[6], v[7]));
}
struct EpiIn {
  static constexpr bool PERM = true, AFTER_DRAIN = false;
  u16* U; u16* QK; const float* RS;
  __device__ __forceinline__ void operator()(const pg8::f32x4 (&acc)[2][2][4][2], const pg8::Unit& u, int wr, int wc, int fr, int fq) const {
    const int row0 = u.pm * 256 + wr * 64 + fr, colt = u.pn * 256, c0 = colt + wc * 32 + 8 * fq;
    const bool isu = colt < 512;
#pragma unroll
    for (int ai = 0; ai < 2; ++ai)
#pragma unroll
      for (int m = 0; m < 4; ++m) {
        const int row = row0 + ai * 128 + m * 16;
        const float r = RS[row];
#pragma unroll
        for (int bj = 0; bj < 2; ++bj) {
          const int col = c0 + bj * 128;
          EPI_V8(v, acc[ai][bj][m], r);
          if (isu) {
#pragma unroll
            for (int j = 0; j < 8; ++j) v[j] = gelu_f(v[j]);
            *(uint4*)(U + (size_t)row * 512 + col) = pk8(v);
          } else {
            *(uint4*)(QK + (size_t)row * 1024 + (col - 512)) = pk8(v);
          }
        }
      }
  }
};
struct EpiInT {
  static constexpr bool PERM = true, AFTER_DRAIN = false;
  u16* GVT; u16* VT; const float* RS; float* VSS;
  __device__ __forceinline__ void operator()(const pg8::f32x4 (&acc)[2][2][4][2], const pg8::Unit& u, int wr, int wc, int fr, int fq) const {
    const int ch0 = u.pm * 256 + wr * 64 + fr, t0 = u.pn * 256 + wc * 32 + 8 * fq;
    const bool isg = u.pm < 2;
#pragma unroll
    for (int bj = 0; bj < 2; ++bj) {
      const int t = t0 + bj * 128, b = t >> 12, s = t & 4095;
      const float4 ra = *(const float4*)(RS + t), rb = *(const float4*)(RS + t + 4);
      const float rr[8] = {ra.x, ra.y, ra.z, ra.w, rb.x, rb.y, rb.z, rb.w};
      float ss[8] = {0.f, 0.f, 0.f, 0.f, 0.f, 0.f, 0.f, 0.f};
#pragma unroll
      for (int ai = 0; ai < 2; ++ai)
#pragma unroll
        for (int m = 0; m < 4; ++m) {
          const int ch = ch0 + ai * 128 + m * 16;
          float v[8];
#pragma unroll
          for (int j = 0; j < 8; ++j) v[j] = acc[ai][bj][m][j >> 2][j & 3] * rr[j];
          if (isg) {
#pragma unroll
            for (int j = 0; j < 8; ++j) { v[j] = gelu_f(v[j]); ss[j] += v[j] * v[j]; }
            *(uint4*)(GVT + ((size_t)b * 512 + ch) * SEQ + s) = pk8(v);
          } else {
            *(uint4*)(VT + ((size_t)b * 512 + (ch - 512)) * SEQ + s) = pk8(v);
          }
        }
      if (isg) {
#pragma unroll
        for (int j = 0; j < 8; ++j) {
          float sv = ss[j];
          sv += dpp_f<DPP_X1>(sv); sv += dpp_f<DPP_X2>(sv); sv += dpp_f<DPP_HM>(sv); sv += dpp_f<DPP_R8>(sv);
          if (fr == 0) atomicAdd(VSS + t + j, sv);
        }
      }
    }
  }
};
struct EpiOut {
  static constexpr bool PERM = true, AFTER_DRAIN = false;
  const float* X; float* OUT; u16* HB;
  __device__ __forceinline__ void operator()(const pg8::f32x4 (&acc)[2][2][4][2], const pg8::Unit& u, int wr, int wc, int fr, int fq) const {
    const int row0 = u.pm * 256 + wr * 64 + fr, c0 = u.pn * 256 + wc * 32 + 8 * fq;
#pragma unroll
    for (int ai = 0; ai < 2; ++ai)
#pragma unroll
      for (int m = 0; m < 4; ++m) {
        const int row = row0 + ai * 128 + m * 16;
#pragma unroll
        for (int bj = 0; bj < 2; ++bj) {
          const size_t idx = (size_t)row * 1024 + c0 + bj * 128;
          const float4 xa = *(const float4*)(X + idx), xb = *(const float4*)(X + idx + 4);
          float v[8] = {xa.x + acc[ai][bj][m][0][0], xa.y + acc[ai][bj][m][0][1], xa.z + acc[ai][bj][m][0][2], xa.w + acc[ai][bj][m][0][3],
                        xb.x + acc[ai][bj][m][1][0], xb.y + acc[ai][bj][m][1][1], xb.z + acc[ai][bj][m][1][2], xb.w + acc[ai][bj][m][1][3]};
          *(uint4*)(HB + idx) = pk8(v);
        }
      }
  }
};
struct EpiQ {
  static constexpr bool PERM = true, AFTER_DRAIN = false;
  u16* PQ;
  __device__ __forceinline__ void operator()(const pg8::f32x4 (&acc)[2][2][4][2], const pg8::Unit& u, int wr, int wc, int fr, int fq) const {
    const int row0 = u.pm * 256 + wr * 64 + fr, c0 = u.pn * 256 + wc * 32 + 8 * fq;
#pragma unroll
    for (int ai = 0; ai < 2; ++ai)
#pragma unroll
      for (int m = 0; m < 4; ++m) {
        const int row = row0 + ai * 128 + m * 16;
#pragma unroll
        for (int bj = 0; bj < 2; ++bj) {
          EPI_V8(v, acc[ai][bj][m], 1.f);
          *(uint4*)(PQ + (size_t)row * 2048 + c0 + bj * 128) = pk8(v);
        }
      }
  }
};
#define LDS3(p) ((__attribute__((address_space(3))) unsigned char*)(p))

__device__ __forceinline__ void quant_pair(const Params& p, int row0, int lane) {
  unsigned char* EU4 = (unsigned char*)(p.ws + OFF_EU);
  unsigned char* EV4 = (unsigned char*)(p.ws + OFF_EV);
  float* ESC = (float*)(p.ws + OFF_ESC);
  float4 g4[2][2];
#pragma unroll
  for (int j = 0; j < 2; ++j)
#pragma unroll
    for (int q = 0; q < 2; ++q) g4[j][q] = ((const float4*)p.ln_ffn_g)[j * 128 + lane * 2 + q];

      const bool isv = row0 >= 16384;
      float4 v[2][2][2];
#pragma unroll
      for (int r = 0; r < 2; ++r) {
        const float4* src = (const float4*)((isv ? p.peer_v : p.peer_u) + (size_t)((row0 + r) & 16383) * 1024);
#pragma unroll
        for (int j = 0; j < 2; ++j)
#pragma unroll
          for (int q = 0; q < 2; ++q) v[r][j][q] = src[j * 128 + lane * 2 + q];
      }
#pragma unroll
      for (int r = 0; r < 2; ++r) {
        const int e = (row0 + r) & 16383;
        float sq = 0.f, am = 0.f;
#pragma unroll
        for (int j = 0; j < 2; ++j)
#pragma unroll
          for (int q = 0; q < 2; ++q) {
            float4 t4 = v[r][j][q];
            if (!isv) { t4.x *= g4[j][q].x; t4.y *= g4[j][q].y; t4.z *= g4[j][q].z; t4.w *= g4[j][q].w; }
            sq += t4.x * t4.x + t4.y * t4.y + t4.z * t4.z + t4.w * t4.w;
            am = fmaxf(am, fmaxf(fmaxf(fabsf(t4.x), fabsf(t4.y)), fmaxf(fabsf(t4.z), fabsf(t4.w))));
            v[r][j][q] = t4;
          }
#pragma unroll
        for (int o = 1; o < 64; o <<= 1) { sq += __shfl_xor(sq, o); am = fmaxf(am, __shfl_xor(am, o)); }
        const float rng = isv ? am : 2.6f * sqrtf(sq * (1.f / 1024.f));
        const float qmax = isv ? 6.0f : 7.0f;
        const bool ok = (rng > 1e-30f);
        const float scale = ok ? qmax / rng : 0.f;
        const float inv = ok ? rng / qmax : 0.f;
        unsigned char* dst = (isv ? EV4 : EU4) + (size_t)e * 128 + (lane & 31) * 4;
#define Q4C(x, i) q4(fminf(fmaxf((x) * scale, -7.f), 7.f), (i))
#pragma unroll
        for (int j = 0; j < 2; ++j) {
          unsigned w = 0;
          if (isv) {
            w = __builtin_amdgcn_cvt_scalef32_pk_fp4_f32(w, v[r][j][0].x * scale, v[r][j][0].y * scale, 1.0f, 0);
            w = __builtin_amdgcn_cvt_scalef32_pk_fp4_f32(w, v[r][j][0].z * scale, v[r][j][0].w * scale, 1.0f, 1);
            w = __builtin_amdgcn_cvt_scalef32_pk_fp4_f32(w, v[r][j][1].x * scale, v[r][j][1].y * scale, 1.0f, 2);
            w = __builtin_amdgcn_cvt_scalef32_pk_fp4_f32(w, v[r][j][1].z * scale, v[r][j][1].w * scale, 1.0f, 3);
          } else {
            w = Q4C(v[r][j][0].x, 0) | Q4C(v[r][j][0].y, 1) | Q4C(v[r][j][0].z, 2) | Q4C(v[r][j][0].w, 3) |
                Q4C(v[r][j][1].x, 4) | Q4C(v[r][j][1].y, 5) | Q4C(v[r][j][1].z, 6) | Q4C(v[r][j][1].w, 7);
          }
          *(unsigned*)(dst + (size_t)(j * 2 + (lane >> 5)) * (2 * MiB)) = w;
        }
#undef Q4C
        if (lane == 0) ESC[row0 + r] = inv;
      }
    }

__device__ __forceinline__ void phase0(const Params& p, char* lds) {
  const int tid = tid_(), lane = tid & 63, wave = tid >> 6;
  const int nblk = gridDim.x, blk = bid_();
  u16* XB = (u16*)(p.ws + OFF_XB);
  float* RS = (float*)(p.ws + OFF_RS);
  float* VSS = (float*)(p.ws + OFF_VSS);
  for (int row0 = (blk * NWAVE + wave) * 4; row0 < T; row0 += nblk * NWAVE * 4) {
    float4 v[4][4];
#pragma unroll
    for (int r = 0; r < 4; ++r) {
      const float4* xr = (const float4*)(p.x + (size_t)(row0 + r) * DM);
#pragma unroll
      for (int j = 0; j < 2; ++j) { v[r][2 * j] = xr[j * 128 + lane * 2]; v[r][2 * j + 1] = xr[j * 128 + lane * 2 + 1]; }
    }
#pragma unroll
    for (int r = 0; r < 4; ++r) {
      float ss = 0.f;
#pragma unroll
      for (int i = 0; i < 4; ++i) ss += v[r][i].x * v[r][i].x + v[r][i].y * v[r][i].y + v[r][i].z * v[r][i].z + v[r][i].w * v[r][i].w;
#pragma unroll
      for (int o = 1; o < 64; o <<= 1) ss += __shfl_xor(ss, o);
      if (lane == 0) RS[row0 + r] = rsqrtf(ss * (1.f / 1024.f) + EPS);
#pragma unroll
      for (int j = 0; j < 2; ++j)
        *(uint4*)(XB + (size_t)(row0 + r) * DM + j * 512 + lane * 8) =
            make_uint4(pg8::cvt_pk_bf16(v[r][2 * j].x, v[r][2 * j].y), pg8::cvt_pk_bf16(v[r][2 * j].z, v[r][2 * j].w),
                       pg8::cvt_pk_bf16(v[r][2 * j + 1].x, v[r][2 * j + 1].y), pg8::cvt_pk_bf16(v[r][2 * j + 1].z, v[r][2 * j + 1].w));
    }
  }
  {
    const int half = wave >> 2, w4 = wave & 3;
    float* tile = (float*)lds + half * (64 * 65);
    for (int tp = blk; tp < 704; tp += nblk) {
      const int tl = tp * 2 + half;
      const float* W; const float* gain; u16* dst; int N, kt, nt, drow;
      if (tl < 640) {
        W = p.w_in; gain = p.ln_mix_g; N = 2560; kt = tl / 40; nt = tl % 40;
        const int n0 = nt * 64;
        if (n0 < 512) { dst = (u16*)(p.ws + OFF_WINT); drow = n0; }
        else if (n0 < 1024) { dst = (u16*)(p.ws + OFF_WB); drow = n0 - 512; }
        else if (n0 < 2048) { dst = (u16*)(p.ws + OFF_WINT); drow = n0 - 512; }
        else { dst = (u16*)(p.ws + OFF_WB); drow = n0 - 2048 + 512; }
      } else if (tl < 896) { int t2 = tl - 640; W = p.w_out; gain = nullptr; dst = (u16*)(p.ws + OFF_WOUTT); N = 1024; kt = t2 / 16; nt = t2 % 16; drow = nt * 64; }
      else { int t2 = tl - 896; W = p.w_query; gain = p.ln_ffn_g; dst = (u16*)(p.ws + OFF_WQT); N = 2048; kt = t2 / 32; nt = t2 % 32; drow = nt * 64; }
      __syncthreads();
#pragma unroll
      for (int i = 0; i < 16; ++i) {
        const int kk = i * 4 + w4;
        const float gk = gain ? gain[kt * 64 + kk] : 1.f;
        tile[kk * 65 + lane] = W[(size_t)(kt * 64 + kk) * N + nt * 64 + lane] * gk;
      }
      __syncthreads();
#pragma unroll 4
      for (int i = 0; i < 16; ++i) {
        const int nn = i * 4 + w4;
        dst[(size_t)(drow + nn) * 1024 + kt * 64 + lane] = f2bf(tile[lane * 65 + nn]);
      }
    }
    __syncthreads();
  }
  {
    u16* KEYS = (u16*)(p.ws + OFF_KEYS);
    for (int i = blk * NTHR + tid; i < 262144 / 4; i += nblk * NTHR) {
      float4 a = ((const float4*)p.sub_keys)[i];
      *(uint2*)(KEYS + (size_t)i * 4) = make_uint2(pack2(a.x, a.y), pack2(a.z, a.w));
    }
  }
  for (int i = blk * NTHR + tid; i < T; i += nblk * NTHR) VSS[i] = 0.f;

}

__device__ __forceinline__ void phase1(const Params& p, char* lds) {
  const u16* XB = (const u16*)(p.ws + OFF_XB);
  const float* RS = (const float*)(p.ws + OFF_RS);
  {
    pg8::Gemm g{XB, (const u16*)(p.ws + OFF_WINT), T, 1536, 1024};
    pg8::StaticOrder S; S.init(T, 1536, (int)gridDim.x, (int)blockIdx.x);
    EpiIn E{(u16*)(p.ws + OFF_U), (u16*)(p.ws + OFF_QK), RS};
    pg8::gemm_phase<EpiIn, pg8::StaticOrder, true, true>(LDS3(lds), g, S, E);
  }
  {
    pg8::Gemm g{(const u16*)(p.ws + OFF_WB), XB, 1024, T, 1024};
    pg8::StaticOrder S; S.init(1024, T, (int)gridDim.x, (int)blockIdx.x);
    EpiInT E{(u16*)(p.ws + OFF_GVT), (u16*)(p.ws + OFF_VT), RS, (float*)(p.ws + OFF_VSS)};
    pg8::gemm_phase<EpiInT, pg8::StaticOrder, true, true>(LDS3(lds), g, S, E);
  }
}

__device__ __forceinline__ void gmlp_item(const Params& p, int item) {
  const int tid = tid_() & 255, lane = tid & 63, wave = tid >> 6, l15 = lane & 15, g = lane >> 4;
  const int gr = item & 7, n = (item >> 3) & 31, b = item >> 8;
  const int t0 = b * SEQ + n * 128;
  const float* VSS = (const float*)(p.ws + OFF_VSS);
  const u16* GVT = (const u16*)(p.ws + OFF_GVT);
  const u16* U = (const u16*)(p.ws + OFF_U);
  u16* AB = (u16*)(p.ws + OFF_AB);
  f32x4 acc[2][4];
#pragma unroll
  for (int i = 0; i < 2; ++i)
#pragma unroll
    for (int j = 0; j < 4; ++j) acc[i][j] = f32x4{0.f, 0.f, 0.f, 0.f};
  const int i_base = wave * 32;
  const bool low = wave < 2;
#pragma unroll
  for (int ks = 0; ks < 4; ++ks) {
    if (ks >= 2 && low) continue;
    const int j0 = ks * 32 + g * 8;
    const float4 s0 = *(const float4*)(VSS + t0 + j0), s1 = *(const float4*)(VSS + t0 + j0 + 4);
    float r[8] = {s0.x, s0.y, s0.z, s0.w, s1.x, s1.y, s1.z, s1.w};
#pragma unroll
    for (int q = 0; q < 8; ++q) r[q] = rsqrtf(r[q] * (1.f / 512.f) + EPS);
    bf16x8 wf[2];
#pragma unroll
    for (int mi = 0; mi < 2; ++mi) {
      const int i = i_base + mi * 16 + l15;
      const float* wp = p.gmlp_w_s + ((size_t)(gr * 128 + i)) * 128 + j0;
      const float4 w0 = *(const float4*)wp, w1 = *(const float4*)(wp + 4);
      wf[mi] = mk8(pack2(w0.x * r[0], w0.y * r[1]), pack2(w0.z * r[2], w0.w * r[3]), pack2(w1.x * r[4], w1.y * r[5]),
                   pack2(w1.z * r[6], w1.w * r[7]));
    }
#pragma unroll
    for (int ni = 0; ni < 4; ++ni) {
      const int c = ni * 16 + l15;
      const bf16x8 gf = *(const bf16x8*)(GVT + ((size_t)b * 512 + gr * 64 + c) * SEQ + n * 128 + j0);
#pragma unroll
      for (int mi = 0; mi < 2; ++mi) acc[mi][ni] = mfma16(gf, wf[mi], acc[mi][ni]);
    }
  }
#pragma unroll
  for (int mi = 0; mi < 2; ++mi) {
    const int i = i_base + mi * 16 + l15;
    const size_t t = (size_t)t0 + i;
    const float bs = p.gmlp_b_s[gr * 128 + i];
#pragma unroll
    for (int ni = 0; ni < 4; ++ni) {
      const int ch = gr * 64 + ni * 16 + g * 4;
      const float4 ng = *(const float4*)(p.gmlp_norm_g + ch);
      const uint2 uu = *(const uint2*)(U + t * 512 + ch);
      const float o0 = bf_lo(uu.x) * (acc[mi][ni][0] * ng.x + bs), o1 = bf_hi(uu.x) * (acc[mi][ni][1] * ng.y + bs);
      const float o2 = bf_lo(uu.y) * (acc[mi][ni][2] * ng.z + bs), o3 = bf_hi(uu.y) * (acc[mi][ni][3] * ng.w + bs);
      *(uint2*)(AB + t * 1024 + ch) = make_uint2(pack2(o0, o1), pack2(o2, o3));
    }
  }
}

constexpr int ATT_BUF = 2 * 64 * LSTR + 256;
constexpr float LOG2E = 1.4426950408889634f;
__device__ __forceinline__ void attn_item(const Params& p, int item, char* lds) {
  const int tid = tid_() & 255, lane = tid & 63, wave = tid >> 6, l15 = lane & 15, g = lane >> 4;
  const int c = item & 63, h = (item >> 6) & 7, b = item >> 9;
  const u16* QK = (const u16*)(p.ws + OFF_QK);
  const u16* VT = (const u16*)(p.ws + OFF_VT);
  u16* AB = (u16*)(p.ws + OFF_AB);
  float* bias_s = (float*)(lds + 2 * ATT_BUF);
  __syncthreads();
  float bmax = 0.f;
  for (int i = tid; i < 257; i += 256) { const float bv = p.rel_bias[h * 257 + i] * LOG2E; bias_s[i] = bv; bmax = fmaxf(bmax, fabsf(bv)); }
#pragma unroll
  for (int o = 1; o < 64; o <<= 1) bmax = fmaxf(bmax, __shfl_xor(bmax, o));
  if (lane == 0) bias_s[260 + wave] = bmax;
  const size_t tq = (size_t)b * SEQ + c * 64 + wave * 16 + l15;
  bf16x8 qb0, qb1;
  float mfix;
  {
    const u16* qp = QK + tq * 1024 + h * 64 + g * 8;
    const uint4 q0 = *(const uint4*)qp, q1 = *(const uint4*)(qp + 32);
    float f[16] = {bf_lo(q0.x), bf_hi(q0.x), bf_lo(q0.y), bf_hi(q0.y), bf_lo(q0.z), bf_hi(q0.z), bf_lo(q0.w), bf_hi(q0.w),
                   bf_lo(q1.x), bf_hi(q1.x), bf_lo(q1.y), bf_hi(q1.y), bf_lo(q1.z), bf_hi(q1.z), bf_lo(q1.w), bf_hi(q1.w)};
    float ss = 0.f;
#pragma unroll
    for (int i = 0; i < 16; ++i) ss += f[i] * f[i];
    ss += __shfl_xor(ss, 16); ss += __shfl_xor(ss, 32);
    const float rq = rsqrtf(ss * (1.f / 64.f) + EPS) * (0.125f * LOG2E);
    const float4 ga = *(const float4*)(p.q_norm_g + g * 8), gb = *(const float4*)(p.q_norm_g + g * 8 + 4);
    const float4 gc = *(const float4*)(p.q_norm_g + 32 + g * 8), gd = *(const float4*)(p.q_norm_g + 32 + g * 8 + 4);
    const float4 ka = *(const float4*)(p.k_norm_g + g * 8), kb = *(const float4*)(p.k_norm_g + g * 8 + 4);
    const float4 kc4 = *(const float4*)(p.k_norm_g + 32 + g * 8), kd = *(const float4*)(p.k_norm_g + 32 + g * 8 + 4);
    const float gg[16] = {ga.x * ka.x, ga.y * ka.y, ga.z * ka.z, ga.w * ka.w, gb.x * kb.x, gb.y * kb.y, gb.z * kb.z, gb.w * kb.w,
                          gc.x * kc4.x, gc.y * kc4.y, gc.z * kc4.z, gc.w * kc4.w, gd.x * kd.x, gd.y * kd.y, gd.z * kd.z, gd.w * kd.w};
#pragma unroll
    for (int i = 0; i < 16; ++i) f[i] *= rq * gg[i];
    float qn = 0.f;
#pragma unroll
    for (int i = 0; i < 16; ++i) qn += f[i] * f[i];
    qn += __shfl_xor(qn, 16); qn += __shfl_xor(qn, 32);
    mfix = fminf(8.f * sqrtf(qn) * 1.01f + 1.f, 60.f);
    qb0 = mk8(pg8::cvt_pk_bf16(f[0], f[1]), pg8::cvt_pk_bf16(f[2], f[3]), pg8::cvt_pk_bf16(f[4], f[5]), pg8::cvt_pk_bf16(f[6], f[7]));
    qb1 = mk8(pg8::cvt_pk_bf16(f[8], f[9]), pg8::cvt_pk_bf16(f[10], f[11]), pg8::cvt_pk_bf16(f[12], f[13]), pg8::cvt_pk_bf16(f[14], f[15]));
  }
  f32x4 o[4];
#pragma unroll
  for (int i = 0; i < 4; ++i) o[i] = f32x4{0.f, 0.f, 0.f, 0.f};
  float l_run = 0.f;
  const int srow = tid >> 2, spart = tid & 3;
  const int kc_lo = (c >= 8) ? 0 : (8 - c);
  const u16* kbase = QK + ((size_t)b * SEQ + srow) * 1024 + 512 + h * 64 + spart * 16;
  const u16* vbase = VT + ((size_t)b * 512 + h * 64 + srow) * SEQ + spart * 16;
  uint4 k0, k1, v0, v1;
  {
    const int kchunk = c - 8 + kc_lo;
    const u16* kp = kbase + (size_t)kchunk * 64 * 1024;
    k0 = *(const uint4*)kp; k1 = *(const uint4*)(kp + 8);
    const u16* vp = vbase + kchunk * 64;
    v0 = *(const uint4*)vp; v1 = *(const uint4*)(vp + 8);
  }
  for (int kc = kc_lo; kc <= 8; ++kc) {
    char* Ks = lds + ((kc - kc_lo) & 1) * ATT_BUF;
    char* Vs = Ks + 64 * LSTR;
    float* rks = (float*)(Ks + 2 * 64 * LSTR);
    {
      float ss = 0.f;
      ss = dot2(k0.x, k0.x, ss); ss = dot2(k0.y, k0.y, ss); ss = dot2(k0.z, k0.z, ss); ss = dot2(k0.w, k0.w, ss);
      ss = dot2(k1.x, k1.x, ss); ss = dot2(k1.y, k1.y, ss); ss = dot2(k1.z, k1.z, ss); ss = dot2(k1.w, k1.w, ss);
      ss += dpp_f<DPP_X1>(ss); ss += dpp_f<DPP_X2>(ss);
      if (spart == 0) rks[srow] = rsqrtf(ss * (1.f / 64.f) + EPS);
      char* kd = Ks + srow * LSTR + spart * 32;
      *(uint4*)kd = k0;
      *(uint4*)(kd + 16) = k1;
      char* vd = Vs + srow * LSTR + spart * 32;
      *(uint4*)vd = v0;
      *(uint4*)(vd + 16) = v1;
    }
    __syncthreads();
    if (kc < 8) {
      const int kchunk = c - 8 + kc + 1;
      const u16* kp = kbase + (size_t)kchunk * 64 * 1024;
      k0 = *(const uint4*)kp; k1 = *(const uint4*)(kp + 8);
      const u16* vp = vbase + kchunk * 64;
      v0 = *(const uint4*)vp; v1 = *(const uint4*)(vp + 8);
    }
    f32x4 s[4];
    __builtin_amdgcn_s_setprio(1);
#pragma unroll
    for (int mt = 0; mt < 4; ++mt) {
      const char* kr = Ks + (mt * 16 + l15) * LSTR + g * 16;
      const bf16x8 a0 = *(const bf16x8*)kr, a1 = *(const bf16x8*)(kr + 64);
      s[mt] = mfma16(a0, qb0, f32x4{0.f, 0.f, 0.f, 0.f});
      s[mt] = mfma16(a1, qb1, s[mt]);
    }
    __builtin_amdgcn_s_setprio(0);
    if (kc == kc_lo) mfix += fmaxf(fmaxf(bias_s[260], bias_s[261]), fmaxf(bias_s[262], bias_s[263]));
    float ls = 0.f;
    if (kc <= 5) {
      const float bc = bias_s[256] - mfix;
#pragma unroll
      for (int mt = 0; mt < 4; ++mt) {
        const float4 rk4 = *(const float4*)(rks + mt * 16 + g * 4);
        s[mt][0] = __builtin_amdgcn_exp2f(s[mt][0] * rk4.x + bc); s[mt][1] = __builtin_amdgcn_exp2f(s[mt][1] * rk4.y + bc);
        s[mt][2] = __builtin_amdgcn_exp2f(s[mt][2] * rk4.z + bc); s[mt][3] = __builtin_amdgcn_exp2f(s[mt][3] * rk4.w + bc);
        ls += (s[mt][0] + s[mt][1]) + (s[mt][2] + s[mt][3]);
      }
    } else {
      const int qi = wave * 16 + l15 + 64 * (8 - kc);
#pragma unroll
      for (int mt = 0; mt < 4; ++mt) {
        const float4 rk4 = *(const float4*)(rks + mt * 16 + g * 4);
        const float rr[4] = {rk4.x, rk4.y, rk4.z, rk4.w};
#pragma unroll
        for (int j = 0; j < 4; ++j) {
          int rel = qi - (mt * 16 + g * 4 + j);
          rel = rel > 128 ? 128 : rel;
          s[mt][j] = __builtin_amdgcn_exp2f(s[mt][j] * rr[j] + (bias_s[rel + 128] - mfix));
          ls += s[mt][j];
        }
      }
    }
    l_run += ls;
    __builtin_amdgcn_s_setprio(1);
#pragma unroll
    for (int k2 = 0; k2 < 2; ++k2) {
      const bf16x8 pb = mk8(pg8::cvt_pk_bf16(s[2 * k2][0], s[2 * k2][1]), pg8::cvt_pk_bf16(s[2 * k2][2], s[2 * k2][3]),
                            pg8::cvt_pk_bf16(s[2 * k2 + 1][0], s[2 * k2 + 1][1]), pg8::cvt_pk_bf16(s[2 * k2 + 1][2], s[2 * k2 + 1][3]));
#pragma unroll
      for (int mt = 0; mt < 4; ++mt) {
        const char* vr = Vs + (mt * 16 + l15) * LSTR + (32 * k2 + 4 * g) * 2;
        const uint2 va = *(const uint2*)vr, vb = *(const uint2*)(vr + 32);
        o[mt] = mfma16(mk8(va.x, va.y, vb.x, vb.y), pb, o[mt]);
      }
    }
    __builtin_amdgcn_s_setprio(0);
  }
  float l = l_run;
  l += __shfl_xor(l, 16); l += __shfl_xor(l, 32);
  const float inv = 1.f / l;
#pragma unroll
  for (int mt = 0; mt < 4; ++mt) {
    *(uint2*)(AB + tq * 1024 + 512 + h * 64 + mt * 16 + g * 4) =
        make_uint2(pg8::cvt_pk_bf16(o[mt][0] * inv, o[mt][1] * inv), pg8::cvt_pk_bf16(o[mt][2] * inv, o[mt][3] * inv));
  }
}

__device__ __forceinline__ void phase2(const Params& p, char* lds) {
  const int sub = tid_() >> 8;
  for (int it = bid_(); it < 2048 + 1024; it += gridDim.x) {
    if (it < 2048) {
      const int b = it >> 8, hp = (it >> 6) & 3, c = ((it & 63) + 8 * b) & 63;
      attn_item(p, (b << 9) | ((hp * 2 + sub) << 6) | c, lds + sub * 38912);
    } else {
      gmlp_item(p, (it - 2048) * 2 + sub);
    }
  }
}

__device__ __forceinline__ void phase3(const Params& p, char* lds) {
  pg8::Gemm g{(const u16*)(p.ws + OFF_AB), (const u16*)(p.ws + OFF_WOUTT), T, 1024, 1024};
  pg8::StaticOrder S; S.init(T, 1024, (int)gridDim.x, (int)blockIdx.x);
  EpiOut E{p.x, p.out, (u16*)(p.ws + OFF_HB)};
  pg8::gemm_phase<EpiOut, pg8::StaticOrder, true, true>(LDS3(lds), g, S, E);
}
__device__ __forceinline__ void phase4(const Params& p, char* lds) {
  pg8::Gemm g{(const u16*)(p.ws + OFF_HB), (const u16*)(p.ws + OFF_WQT), T, 2048, 1024};
  pg8::StaticOrder S; S.init(T, 2048, (int)gridDim.x, (int)blockIdx.x);
  EpiQ E{(u16*)(p.ws + OFF_PQ)};
  pg8::gemm_phase<EpiQ, pg8::StaticOrder, true, true>(LDS3(lds), g, S, E);
}

__device__ __forceinline__ unsigned dpp_xor1(unsigned v) { return (unsigned)__builtin_amdgcn_mov_dpp((int)v, 0xB1, 0xF, 0xF, true); }
__device__ __forceinline__ unsigned dpp_xor2(unsigned v) { return (unsigned)__builtin_amdgcn_mov_dpp((int)v, 0x4E, 0xF, 0xF, true); }
__device__ __forceinline__ void sort16_desc(unsigned (&v)[16]) {
#pragma unroll
  for (int k = 2; k <= 16; k <<= 1)
#pragma unroll
    for (int j = k >> 1; j > 0; j >>= 1)
#pragma unroll
      for (int i = 0; i < 16; ++i) {
        const int l = i ^ j;
        if (l > i) {
          const unsigned hi = max(v[i], v[l]), lo = min(v[i], v[l]);
          if ((i & k) == 0) { v[i] = hi; v[l] = lo; } else { v[i] = lo; v[l] = hi; }
        }
      }
}
__device__ __forceinline__ void merge16_desc(unsigned (&a)[16], const unsigned (&b)[16]) {
#pragma unroll
  for (int i = 0; i < 16; ++i) a[i] = max(a[i], b[15 - i]);
#pragma unroll
  for (int j = 8; j > 0; j >>= 1)
#pragma unroll
    for (int i = 0; i < 16; ++i) {
      const int l = i ^ j;
      if (l > i) { const unsigned hi = max(a[i], a[l]), lo = min(a[i], a[l]); a[i] = hi; a[l] = lo; }
    }
}
constexpr int SC_STR = 385, LSTR17 = 17;
constexpr int P5_LV = 64 * SC_STR, P5_LI = P5_LV + 128 * LSTR17, P5_TAB = P5_LI + 128 * LSTR17;

__device__ __forceinline__ void select_item(const Params& p, int item, int next_item, int kiter, char* lds, const bf16x8 (&kf)[8][4], bf16x8 (&qf)[4]) {
  const int tid = tid_(), lane = tid & 63, wave = tid >> 6, l15 = lane & 15, g = lane >> 4;
  const int h = item & 7, t0 = (item >> 3) * 64;
  const u16* PQ = (const u16*)(p.ws + OFF_PQ);
  int* EIDX = (int*)(p.ws + OFF_EIDX);
  float* BEST = (float*)(p.ws + OFF_BEST);
  float* sc = (float*)lds;
  float* LV = sc + P5_LV;
  int* LI = (int*)lds + P5_LI;
  const int* tab = (const int*)lds + P5_TAB;
  __syncthreads();
  {
    const int pp = wave >> 2, wq = wave & 3;
#pragma unroll
    for (int nt = 0; nt < 8; ++nt) {
      f32x4 a = f32x4{0.f, 0.f, 0.f, 0.f};
#pragma unroll
      for (int ks = 0; ks < 4; ++ks) a = mfma16(qf[ks], kf[nt][ks], a);
#pragma unroll
      for (int j = 0; j < 4; ++j) sc[(wq * 16 + g * 4 + j) * SC_STR + pp * 192 + (nt >> 1) * 48 + (nt & 1) * 16 + l15] = a[j];
    }
    if (next_item < 512 * 8) {
      const u16* qp = PQ + (size_t)((next_item >> 3) * 64 + wq * 16 + l15) * 2048 + (next_item & 7) * 256 + pp * 128 + g * 8;
#pragma unroll
      for (int ks = 0; ks < 4; ++ks) qf[ks] = *(const bf16x8*)(qp + ks * 32);
    }
  }
  __syncthreads();
  {
    const int q = tid & 3, list = tid >> 2, row = list & 63, pp = list >> 6;
    const float* rowp = sc + row * SC_STR + pp * 192;
    const float* src = rowp + q * 48;
    unsigned A[16], B[16];
#pragma unroll
    for (int j = 0; j < 16; ++j) {
      A[j] = (okey(src[j]) & ~127u) | (unsigned)(127 - (q * 32 + j));
      B[j] = (okey(src[16 + j]) & ~127u) | (unsigned)(127 - (q * 32 + 16 + j));
    }
    sort16_desc(A);
    sort16_desc(B);
    merge16_desc(A, B);
#pragma unroll
    for (int i = 0; i < 16; ++i) B[i] = dpp_xor1(A[i]);
    merge16_desc(A, B);
#pragma unroll
    for (int i = 0; i < 16; ++i) B[i] = dpp_xor2(A[i]);
    merge16_desc(A, B);
#pragma unroll
    for (int r = 0; r < 16; ++r) {
      if ((r & 3) == q) {
        const int idx = 127 - (int)(A[r] & 127u);
        LV[list * LSTR17 + r] = rowp[(idx >> 5) * 48 + (idx & 31)];
        LI[list * LSTR17 + r] = idx;
      }
    }
  }
  __syncthreads();
  if (tid >= 256) {
    quant_pair(p, 2 * ((kiter * 4 + (wave - 4)) * (int)gridDim.x + bid_()), lane);
  } else {
    const int grp = tid & 3, row = tid >> 2;
    const float* v0 = LV + row * LSTR17;
    const float* v1 = LV + (64 + row) * LSTR17;
    unsigned A[16], B[16];
#pragma unroll
    for (int j = 0; j < 16; ++j) {
      const int code = tab[grp * 16 + j];
      const int cc = code & 255;
      const float s = v0[cc >> 4] + v1[cc & 15];
      A[j] = (code < 0) ? 0u : ((okey(s) & ~255u) | (unsigned)(255 - cc));
    }
    sort16_desc(A);
#pragma unroll
    for (int i = 0; i < 16; ++i) B[i] = dpp_xor1(A[i]);
    merge16_desc(A, B);
#pragma unroll
    for (int i = 0; i < 16; ++i) B[i] = dpp_xor2(A[i]);
    merge16_desc(A, B);
    const size_t ob = ((size_t)(t0 + row) * 8 + h) * 16 + grp * 4;
    const int* i0 = LI + row * LSTR17;
    const int* i1 = LI + (64 + row) * LSTR17;
    int e4[4];
    float b4[4];
#pragma unroll
    for (int j = 0; j < 4; ++j) {
      const unsigned sel = (grp == 0) ? A[j] : (grp == 1) ? A[4 + j] : (grp == 2) ? A[8 + j] : A[12 + j];
      const int cc = 255 - (int)(sel & 255u);
      const int a = cc >> 4, bq = cc & 15;
      e4[j] = i0[a] * 128 + i1[bq];
      b4[j] = v0[a] + v1[bq];
    }
    *(int4*)(EIDX + ob) = make_int4(e4[0], e4[1], e4[2], e4[3]);
    *(float4*)(BEST + ob) = make_float4(b4[0], b4[1], b4[2], b4[3]);
  }
}

__device__ __forceinline__ void phase5(const Params& p, char* lds) {
  {
    const int i = tid_();
    if (i < 64) {
      const int grp = i >> 4, j = i & 15;
      int code = -1;
      if (grp == 0) code = j;
      else if (grp == 1) { if (j < 8) code = 16 + j; else if (j < 13) code = 32 + (j - 8); }
      else if (grp == 2) { if (j < 4) code = 48 + j; else if (j < 7) code = 64 + (j - 4); else if (j < 9) code = 80 + (j - 7); else if (j < 11) code = 96 + (j - 9); else if (j < 13) code = 112 + (j - 11); }
      else { if (j < 8) code = (8 + j) * 16; }
      ((int*)lds)[P5_TAB + i] = code;
    }
  }
  const int tid = tid_(), lane = tid & 63, wave = tid >> 6, l15 = lane & 15, g = lane >> 4;
  const int pp = wave >> 2, wq = wave & 3;
  int it = bid_();
  if (it >= 512 * 8) return;
  const bool fixed_head = (gridDim.x & 7) == 0;
  bf16x8 kf[8][4];
  bf16x8 qf[4];
  {
    const u16* KEYS = (const u16*)(p.ws + OFF_KEYS);
#pragma unroll
    for (int nt = 0; nt < 8; ++nt) {
      const u16* kp = KEYS + ((size_t)(((it & 7) * 2 + pp) * 128 + nt * 16 + l15)) * 128 + g * 8;
#pragma unroll
      for (int ks = 0; ks < 4; ++ks) kf[nt][ks] = *(const bf16x8*)(kp + ks * 32);
    }
    const u16* qp = (const u16*)(p.ws + OFF_PQ) + (size_t)((it >> 3) * 64 + wq * 16 + l15) * 2048 + (it & 7) * 256 + pp * 128 + g * 8;
#pragma unroll
    for (int ks = 0; ks < 4; ++ks) qf[ks] = *(const bf16x8*)(qp + ks * 32);
  }
  int kiter = 0;
  for (; it < 512 * 8; it += gridDim.x, ++kiter) {
    if (!fixed_head) {
      const u16* KEYS = (const u16*)(p.ws + OFF_KEYS);
#pragma unroll
      for (int nt = 0; nt < 8; ++nt) {
        const u16* kp = KEYS + ((size_t)(((it & 7) * 2 + pp) * 128 + nt * 16 + l15)) * 128 + g * 8;
#pragma unroll
        for (int ks = 0; ks < 4; ++ks) kf[nt][ks] = *(const bf16x8*)(kp + ks * 32);
      }
    }
    select_item(p, it, it + (int)gridDim.x, kiter, lds, kf, qf);
  }
  {
    const int G = (int)gridDim.x, kmin = (512 * 8) / G;
    for (int pr = kmin * 4 * G + bid_() * NWAVE + wave; pr < 16384; pr += G * NWAVE) quant_pair(p, 2 * pr, lane);
  }
}

#define P4(w, i) __builtin_amdgcn_cvt_scalef32_pk_f32_fp4((w), 1.0f, (i))
#define B4(w, i) __builtin_amdgcn_cvt_scalef32_pk_bf16_fp4((w), 1.0f, (i))
__device__ __forceinline__ f32x2 hpair(unsigned w) { return f32x2{bf_lo(w), bf_hi(w)}; }
__device__ __forceinline__ float dot32_fp4(const u32x4 u, const u32x4 (&h)[4], float acc) {
  f32x2 s = f32x2{acc, 0.f};
  s = __builtin_elementwise_fma(P4(u.x, 0), hpair(h[0].x), s); s = __builtin_elementwise_fma(P4(u.x, 1), hpair(h[0].y), s);
  s = __builtin_elementwise_fma(P4(u.x, 2), hpair(h[0].z), s); s = __builtin_elementwise_fma(P4(u.x, 3), hpair(h[0].w), s);
  s = __builtin_elementwise_fma(P4(u.y, 0), hpair(h[1].x), s); s = __builtin_elementwise_fma(P4(u.y, 1), hpair(h[1].y), s);
  s = __builtin_elementwise_fma(P4(u.y, 2), hpair(h[1].z), s); s = __builtin_elementwise_fma(P4(u.y, 3), hpair(h[1].w), s);
  s = __builtin_elementwise_fma(P4(u.z, 0), hpair(h[2].x), s); s = __builtin_elementwise_fma(P4(u.z, 1), hpair(h[2].y), s);
  s = __builtin_elementwise_fma(P4(u.z, 2), hpair(h[2].z), s); s = __builtin_elementwise_fma(P4(u.z, 3), hpair(h[2].w), s);
  s = __builtin_elementwise_fma(P4(u.w, 0), hpair(h[3].x), s); s = __builtin_elementwise_fma(P4(u.w, 1), hpair(h[3].y), s);
  s = __builtin_elementwise_fma(P4(u.w, 2), hpair(h[3].z), s); s = __builtin_elementwise_fma(P4(u.w, 3), hpair(h[3].w), s);
  return s.x + s.y;
}
__device__ __forceinline__ void p6_gather(u32x4 (&buf)[16], const unsigned char* EXs  , unsigned loff  , int ea, int eb, int eg) {
#pragma unroll
  for (int it = 0; it < 16; ++it) {
    const int src = (it * 8 + eg) & 63;
    const unsigned e = (unsigned)__shfl((it < 8) ? ea : eb, src);
    buf[it] = *(const u32x4*)(EXs + (size_t)(e * 128u + loff));
  }
}
__device__ __forceinline__ void p6a_compute(const u32x4 (&buf)[16], const u32x4 (&h)[4], float* PART, int t, int part, int eg, bool b2, bool b1, bool b0) {
  float f[32];
#pragma unroll
  for (int i = 0; i < 4; ++i) {
    f[i * 8 + 0] = bf_lo(h[i].x); f[i * 8 + 1] = bf_hi(h[i].x); f[i * 8 + 2] = bf_lo(h[i].y); f[i * 8 + 3] = bf_hi(h[i].y);
    f[i * 8 + 4] = bf_lo(h[i].z); f[i * 8 + 5] = bf_hi(h[i].z); f[i * 8 + 6] = bf_lo(h[i].w); f[i * 8 + 7] = bf_hi(h[i].w);
  }
  float am = 0.f;
#pragma unroll
  for (int i = 0; i < 32; ++i) am = fmaxf(am, fabsf(f[i]));
  const bool ok = am > 1e-30f;
  const float sc = ok ? 7.0f / am : 0.f, inv = ok ? am * (1.f / 7.0f) : 0.f;
  int hq[4];
#pragma unroll
  for (int i = 0; i < 4; ++i)
    hq[i] = (int)(q4(f[i * 8 + 0] * sc, 0) | q4(f[i * 8 + 1] * sc, 1) | q4(f[i * 8 + 2] * sc, 2) | q4(f[i * 8 + 3] * sc, 3) |
                  q4(f[i * 8 + 4] * sc, 4) | q4(f[i * 8 + 5] * sc, 5) | q4(f[i * 8 + 6] * sc, 6) | q4(f[i * 8 + 7] * sc, 7));
  float d[16];
#pragma unroll
  for (int it = 0; it < 16; ++it) {
    int a = __builtin_amdgcn_sdot8((int)buf[it].x, hq[0], 0, false);
    a = __builtin_amdgcn_sdot8((int)buf[it].y, hq[1], a, false);
    a = __builtin_amdgcn_sdot8((int)buf[it].z, hq[2], a, false);
    a = __builtin_amdgcn_sdot8((int)buf[it].w, hq[3], a, false);
    d[it] = (float)a * inv;
  }
  float r[8];
#pragma unroll
  for (int i = 0; i < 8; ++i) r[i] = (b2 ? d[i + 8] : d[i]) + __shfl_xor(b2 ? d[i] : d[i + 8], 4);
  float s4[4];
#pragma unroll
  for (int i = 0; i < 4; ++i) s4[i] = (b1 ? r[i + 4] : r[i]) + dpp_f<DPP_X2>(b1 ? r[i] : r[i + 4]);
#pragma unroll
  for (int i = 0; i < 2; ++i) {
    const float u = (b0 ? s4[i + 2] : s4[i]) + dpp_f<DPP_X1>(b0 ? s4[i] : s4[i + 2]);
    PART[(size_t)t * 128 + (2 * part + i) * 8 + eg] = u;
  }
}
__device__ __forceinline__ void phase6a(const Params& p, char* lds) {
  const int tid = tid_(), lane = tid & 63, wave = tid >> 6, eg = lane >> 3, part = lane & 7;
  const int bid = bid_();
  const int x = bid & 7, xb = bid >> 3, ncb = ((int)gridDim.x + 7 - x) >> 3;
  const int sl = x >> 1, par = x & 1;
  const unsigned char* EUX = (const unsigned char*)(p.ws + OFF_EU) + (size_t)sl * (2 * MiB);
  const unsigned loff = (unsigned)part * 16u;
  const u16* HBX = (const u16*)(p.ws + OFF_HB) + sl * 256 + part * 32;
  const int* EIDX = (const int*)(p.ws + OFF_EIDX);
  float* PART = (float*)(p.ws + OFF_PART) + (size_t)sl * T * 128;
  const int tstep = ncb * NWAVE * 2;
  const bool b2 = (lane & 4) != 0, b1 = (lane & 2) != 0, b0 = (lane & 1) != 0;
  int t = (xb * NWAVE + wave) * 2 + par;
  if (t < T) {
    u32x4 A[16], B[16], hA[4], hB[4];
    int e0 = EIDX[(size_t)t * 128 + lane], e1 = EIDX[(size_t)t * 128 + 64 + lane];
    p6_gather(A, EUX, loff, e0, e1, eg);
#pragma unroll
    for (int i = 0; i < 4; ++i) hA[i] = *(const u32x4*)(HBX + (size_t)t * 1024 + i * 8);
    int tn = t + tstep;
    if (tn < T) { e0 = EIDX[(size_t)tn * 128 + lane]; e1 = EIDX[(size_t)tn * 128 + 64 + lane]; }
    for (;;) {
      int tnn = tn + tstep;
      if (tn < T) {
        p6_gather(B, EUX, loff, e0, e1, eg);
#pragma unroll
        for (int i = 0; i < 4; ++i) hB[i] = *(const u32x4*)(HBX + (size_t)tn * 1024 + i * 8);
        if (tnn < T) { e0 = EIDX[(size_t)tnn * 128 + lane]; e1 = EIDX[(size_t)tnn * 128 + 64 + lane]; }
      }
      p6a_compute(A, hA, PART, t, part, eg, b2, b1, b0);
      if (tn >= T) break;
      const int t3 = tnn + tstep;
      if (tnn < T) {
        p6_gather(A, EUX, loff, e0, e1, eg);
#pragma unroll
        for (int i = 0; i < 4; ++i) hA[i] = *(const u32x4*)(HBX + (size_t)tnn * 1024 + i * 8);
        if (t3 < T) { e0 = EIDX[(size_t)t3 * 128 + lane]; e1 = EIDX[(size_t)t3 * 128 + 64 + lane]; }
      }
      p6a_compute(B, hB, PART, tn, part, eg, b2, b1, b0);
      if (tnn >= T) break;
      t = tnn; tn = t3;
    }
  }
}

__device__ __forceinline__ void phase6m(const Params& p, char* lds) {
  const int tid = tid_(), lane = tid & 63, wave = tid >> 6;
  const u16* HB = (const u16*)(p.ws + OFF_HB);
  const float* ESC = (const float*)(p.ws + OFF_ESC);
  const int* EIDX = (const int*)(p.ws + OFF_EIDX);
  const float* BEST = (const float*)(p.ws + OFF_BEST);
  const float* PART = (const float*)(p.ws + OFF_PART);
  float* WGT = (float*)(p.ws + OFF_WGT);
  for (int t0 = (bid_() * NWAVE + wave) * 2; t0 < T; t0 += gridDim.x * NWAVE * 2) {
    uint4 ha[2], hb[2];
    float da[2], db[2], ba[2], bb[2];
    int ea[2], eb[2];
#pragma unroll
    for (int r = 0; r < 2; ++r) {
      const int t = t0 + r;
      ha[r] = *(const uint4*)(HB + (size_t)t * 1024 + lane * 16); hb[r] = *(const uint4*)(HB + (size_t)t * 1024 + lane * 16 + 8);
      const size_t i0 = (size_t)t * 128 + lane, i1 = i0 + 64;
      ea[r] = EIDX[i0]; eb[r] = EIDX[i1];
      ba[r] = BEST[i0]; bb[r] = BEST[i1];
      float sa = 0.f, sb = 0.f;
#pragma unroll
      for (int x = 0; x < 4; ++x) { sa += PART[(size_t)x * T * 128 + i0]; sb += PART[(size_t)x * T * 128 + i1]; }
      da[r] = sa; db[r] = sb;
    }
    float ua[2], ub[2], va[2], vb[2];
#pragma unroll
    for (int r = 0; r < 2; ++r) { ua[r] = ESC[ea[r]]; ub[r] = ESC[eb[r]]; va[r] = ESC[16384 + ea[r]]; vb[r] = ESC[16384 + eb[r]]; }
#pragma unroll
    for (int r = 0; r < 2; ++r) {
      const uint4 a = ha[r], b = hb[r];
      float ss = 0.f;
      ss = dot2(a.x, a.x, ss); ss = dot2(a.y, a.y, ss); ss = dot2(a.z, a.z, ss); ss = dot2(a.w, a.w, ss);
      ss = dot2(b.x, b.x, ss); ss = dot2(b.y, b.y, ss); ss = dot2(b.z, b.z, ss); ss = dot2(b.w, b.w, ss);
#pragma unroll
      for (int o = 1; o < 64; o <<= 1) ss += __shfl_xor(ss, o);
      const float rs2 = rsqrtf(ss * (1.f / 1024.f) + EPS);
      const float xa = ba[r] * rs2, xb = bb[r] * rs2;
      float ma = xa, mb = xb;
#pragma unroll
      for (int o = 1; o < 16; o <<= 1) { ma = fmaxf(ma, __shfl_xor(ma, o)); mb = fmaxf(mb, __shfl_xor(mb, o)); }
      const float pa = __expf(xa - ma), pb = __expf(xb - mb);
      float sa = pa, sb = pb;
#pragma unroll
      for (int o = 1; o < 16; o <<= 1) { sa += __shfl_xor(sa, o); sb += __shfl_xor(sb, o); }
      const size_t i0 = (size_t)(t0 + r) * 128 + lane;
      float* wrow = WGT + (size_t)(t0 + r) * 128 + (lane & 7) * 16 + (lane >> 3);
      wrow[0] = (pa / sa) * gelu_f(da[r] * rs2 * ua[r]) * va[r];
      wrow[8] = (pb / sb) * gelu_f(db[r] * rs2 * ub[r]) * vb[r];
    }
  }
}

__device__ __forceinline__ void p6b_compute(const u32x4 (&buf)[16], const f32x4 (&wv)[4], uint2 hr, float* orow, int eg, bool h5, bool h4, bool h3) {
  f32x2 acc[16];
#pragma unroll
  for (int i = 0; i < 16; ++i) acc[i] = f32x2{0.f, 0.f};
#pragma unroll
  for (int it = 0; it < 16; ++it) {
    const float w = wv[it >> 2][it & 3];
    const f32x2 w2 = f32x2{w, w};
    const u32x4 v = buf[it];
    acc[0] = __builtin_elementwise_fma(P4(v.x, 0), w2, acc[0]);   acc[1] = __builtin_elementwise_fma(P4(v.x, 1), w2, acc[1]);
    acc[2] = __builtin_elementwise_fma(P4(v.x, 2), w2, acc[2]);   acc[3] = __builtin_elementwise_fma(P4(v.x, 3), w2, acc[3]);
    acc[4] = __builtin_elementwise_fma(P4(v.y, 0), w2, acc[4]);   acc[5] = __builtin_elementwise_fma(P4(v.y, 1), w2, acc[5]);
    acc[6] = __builtin_elementwise_fma(P4(v.y, 2), w2, acc[6]);   acc[7] = __builtin_elementwise_fma(P4(v.y, 3), w2, acc[7]);
    acc[8] = __builtin_elementwise_fma(P4(v.z, 0), w2, acc[8]);   acc[9] = __builtin_elementwise_fma(P4(v.z, 1), w2, acc[9]);
    acc[10] = __builtin_elementwise_fma(P4(v.z, 2), w2, acc[10]); acc[11] = __builtin_elementwise_fma(P4(v.z, 3), w2, acc[11]);
    acc[12] = __builtin_elementwise_fma(P4(v.w, 0), w2, acc[12]); acc[13] = __builtin_elementwise_fma(P4(v.w, 1), w2, acc[13]);
    acc[14] = __builtin_elementwise_fma(P4(v.w, 2), w2, acc[14]); acc[15] = __builtin_elementwise_fma(P4(v.w, 3), w2, acc[15]);
  }
  f32x2 q1[8];
#pragma unroll
  for (int i = 0; i < 8; ++i) {
    const auto rx = __builtin_amdgcn_permlane32_swap(__float_as_uint(acc[i].x), __float_as_uint(acc[i + 8].x), false, false);
    const auto ry = __builtin_amdgcn_permlane32_swap(__float_as_uint(acc[i].y), __float_as_uint(acc[i + 8].y), false, false);
    q1[i] = f32x2{__uint_as_float(rx[0]) + __uint_as_float(rx[1]), __uint_as_float(ry[0]) + __uint_as_float(ry[1])};
  }
  f32x2 q2[4];
#pragma unroll
  for (int i = 0; i < 4; ++i) {
    const auto rx = __builtin_amdgcn_permlane16_swap(__float_as_uint(q1[i].x), __float_as_uint(q1[i + 4].x), false, false);
    const auto ry = __builtin_amdgcn_permlane16_swap(__float_as_uint(q1[i].y), __float_as_uint(q1[i + 4].y), false, false);
    q2[i] = f32x2{__uint_as_float(rx[0]) + __uint_as_float(rx[1]), __uint_as_float(ry[0]) + __uint_as_float(ry[1])};
  }
  f32x2 q3[2];
#pragma unroll
  for (int i = 0; i < 2; ++i) {
    const f32x2 sd = h3 ? q2[i] : q2[i + 2], kp = h3 ? q2[i + 2] : q2[i];
    q3[i] = f32x2{kp.x + dpp_f<DPP_R8>(sd.x), kp.y + dpp_f<DPP_R8>(sd.y)};
  }
  *(float4*)orow = make_float4(bf_lo(hr.x) + q3[0].x, bf_hi(hr.x) + q3[0].y, bf_lo(hr.y) + q3[1].x, bf_hi(hr.y) + q3[1].y);
}
__device__ __forceinline__ void phase6b(const Params& p, char* lds) {
  const int tid = tid_(), lane = tid & 63, wave = tid >> 6, eg = lane >> 3, part = lane & 7;
  const int bid = bid_();
  const int x = bid & 7, xb = bid >> 3, ncb = ((int)gridDim.x + 7 - x) >> 3;
  const int sl = x >> 1, par = x & 1;
  const unsigned char* EVX = (const unsigned char*)(p.ws + OFF_EV) + (size_t)sl * (2 * MiB);
  const unsigned loff = (unsigned)part * 16u;
  const int* EIDX = (const int*)(p.ws + OFF_EIDX);
  const float* WGT = (const float*)(p.ws + OFF_WGT);
  const int tstep = ncb * NWAVE * 2;
  const int pi = ((lane >> 5) & 1) * 4 + ((lane >> 4) & 1) * 2 + ((lane >> 3) & 1);
  const int ocol = sl * 256 + part * 32 + pi * 4;
  const u16* HB = (const u16*)(p.ws + OFF_HB) + ocol;
  float* OUT = p.out + ocol;
  const bool h5 = (lane & 32) != 0, h4 = (lane & 16) != 0, h3 = (lane & 8) != 0;
  int t = (xb * NWAVE + wave) * 2 + par;
  if (t < T) {
    u32x4 A[16], B[16];
    int e0 = EIDX[(size_t)t * 128 + lane], e1 = EIDX[(size_t)t * 128 + 64 + lane];
    f32x4 wA[4], wB[4];
#pragma unroll
    for (int i = 0; i < 4; ++i) { wA[i] = *(const f32x4*)(WGT + (size_t)t * 128 + eg * 16 + i * 4); wB[i] = wA[i]; }
    uint2 hA = *(const uint2*)(HB + (size_t)t * 1024), hB = make_uint2(0u, 0u);
    p6_gather(A, EVX, loff, e0, e1, eg);
    int tn = t + tstep;
    if (tn < T) { e0 = EIDX[(size_t)tn * 128 + lane]; e1 = EIDX[(size_t)tn * 128 + 64 + lane]; }
    for (;;) {
      int tnn = tn + tstep;
      if (tn < T) {
        p6_gather(B, EVX, loff, e0, e1, eg);
#pragma unroll
        for (int i = 0; i < 4; ++i) wB[i] = *(const f32x4*)(WGT + (size_t)tn * 128 + eg * 16 + i * 4);
        hB = *(const uint2*)(HB + (size_t)tn * 1024);
        if (tnn < T) { e0 = EIDX[(size_t)tnn * 128 + lane]; e1 = EIDX[(size_t)tnn * 128 + 64 + lane]; }
      }
      p6b_compute(A, wA, hA, OUT + (size_t)t * 1024, eg, h5, h4, h3);
      if (tn >= T) break;
      const int t3 = tnn + tstep;
      if (tnn < T) {
        p6_gather(A, EVX, loff, e0, e1, eg);
#pragma unroll
        for (int i = 0; i < 4; ++i) wA[i] = *(const f32x4*)(WGT + (size_t)tnn * 128 + eg * 16 + i * 4);
        hA = *(const uint2*)(HB + (size_t)tnn * 1024);
        if (t3 < T) { e0 = EIDX[(size_t)t3 * 128 + lane]; e1 = EIDX[(size_t)t3 * 128 + 64 + lane]; }
      }
      p6b_compute(B, wB, hB, OUT + (size_t)tn * 1024, eg, h5, h4, h3);
      if (tnn >= T) break;
      t = tnn; tn = t3;
    }
  }
}

#define LAS __attribute__((address_space(3)))
#define XB_TMO      128
#define XB_XCNT(j)  (256  + 64 * (j))
#define XB_XSUB(j)  (1280 + 64 * (j))
#define XB_XGEN(j)  (2304 + 64 * (j))
#define XB_TOP      3328
#define XB_TOPGEN   3392
#define XCD_BAR_WORDS 3456
#define XB_SPIN_CAP (1u << 18)

__device__ __forceinline__ unsigned xb_ld(unsigned* p)              { return __hip_atomic_load(p, __ATOMIC_RELAXED, __HIP_MEMORY_SCOPE_AGENT); }
__device__ __forceinline__ unsigned xb_add(unsigned* p, unsigned v) { return __hip_atomic_fetch_add(p, v, __ATOMIC_RELAXED, __HIP_MEMORY_SCOPE_AGENT); }
__device__ __forceinline__ unsigned xb_xcc_id() { return (unsigned)__builtin_amdgcn_s_getreg((3 << 11) | 20) & 0xFu; }
#define XB_SPIN(cond, bar) do { unsigned _sp = 0; while (cond) { __builtin_amdgcn_s_sleep(1); \
    if ((++_sp & 255u) == 0u) { if (xb_ld(&(bar)[XB_TMO])) break; if (_sp > XB_SPIN_CAP) { atomicAdd(&(bar)[XB_TMO], 1u); break; } } } } while (0)

struct XcdBarrier {
    unsigned* bar; unsigned x;
    volatile LAS unsigned* st;
};

__device__ __forceinline__ XcdBarrier xcd_barrier_post(unsigned* bar, volatile LAS unsigned* st) {
    XcdBarrier b; b.bar = bar; b.x = xb_xcc_id(); b.st = st;
    if (threadIdx.x == 0) (void)xb_add(&bar[XB_XCNT(b.x)], 1u);
    return b;
}
__device__ __forceinline__ void xcd_barrier_complete(unsigned* bar, unsigned x, unsigned& nloc, unsigned& nx) {
    const unsigned G = gridDim.x * gridDim.y * gridDim.z;
    unsigned sum, cnt, mine, sp = 0u;
    for (;;) {
        sum = 0u; cnt = 0u; mine = 0u;
#pragma unroll
        for (unsigned j = 0; j < 16; ++j) { const unsigned c = xb_ld(&bar[XB_XCNT(j)]); sum += c; cnt += (c > 0u) ? 1u : 0u; mine = (j == x) ? c : mine; }
        if (sum == G) break;
        __builtin_amdgcn_s_sleep(1);
        if ((++sp & 255u) == 0u) { if (xb_ld(&bar[XB_TMO])) break; if (sp > XB_SPIN_CAP) { atomicAdd(&bar[XB_TMO], 1u); break; } }
    }
    nloc = mine > 0u ? mine : 1u; nx = cnt > 0u ? cnt : 1u;
}

__device__ __forceinline__ void xcd_barrier(const XcdBarrier& b) {
    asm volatile("s_waitcnt vmcnt(0)" ::: "memory");
    __syncthreads();
    if (threadIdx.x == 0) {
        unsigned* bar = b.bar;
        __builtin_amdgcn_s_waitcnt(0);
        unsigned nloc = b.st[0], nx = b.st[1];
        if (nloc == 0u) { xcd_barrier_complete(bar, b.x, nloc, nx); b.st[0] = nloc; b.st[1] = nx; }
        const unsigned old = xb_add(&bar[XB_XSUB(b.x)], 1u);
        const unsigned gen = old / nloc;
        if (old + 1u == (gen + 1u) * nloc) {
            __builtin_amdgcn_fence(__ATOMIC_RELEASE, "agent");
            asm volatile("s_waitcnt vmcnt(0)" ::: "memory");
            const unsigned og = xb_add(&bar[XB_TOP], 1u);
            const unsigned tg = og / nx;
            if (og + 1u == (tg + 1u) * nx) xb_add(&bar[XB_TOPGEN], 1u);
            else XB_SPIN(xb_ld(&bar[XB_TOPGEN]) == tg, bar);
            __builtin_amdgcn_fence(__ATOMIC_ACQUIRE, "agent");
            xb_add(&bar[XB_XGEN(b.x)], 1u);
            asm volatile("s_waitcnt vmcnt(0)" ::: "memory");
        } else {
            XB_SPIN(xb_ld(&bar[XB_XGEN(b.x)]) == gen, bar);
            __builtin_amdgcn_fence(__ATOMIC_ACQUIRE, "agent");
            asm volatile("s_waitcnt vmcnt(0)" ::: "memory");
        }
    }
    __syncthreads();
}


__device__ __forceinline__ void seam_barrier(unsigned* ctr, unsigned nblk) {
  __syncthreads();
  if (threadIdx.x == 0) {
    __builtin_amdgcn_fence(__ATOMIC_RELEASE, "agent");
    asm volatile("s_waitcnt vmcnt(0)" ::: "memory");
    __hip_atomic_fetch_add(ctr, 1u, __ATOMIC_RELAXED, __HIP_MEMORY_SCOPE_AGENT);
    while (__hip_atomic_load(ctr, __ATOMIC_RELAXED, __HIP_MEMORY_SCOPE_AGENT) < nblk) __builtin_amdgcn_s_sleep(2);
    __builtin_amdgcn_fence(__ATOMIC_ACQUIRE, "agent");
    asm volatile("s_waitcnt vmcnt(0)" ::: "memory");
  }
  __syncthreads();
}
#ifndef PMASK
#define PMASK 127
#endif
#define PROG 0x6543210ull
#define NPROG 9
__global__ void __launch_bounds__(NTHR, 2) mega(Params p, int ph_lo, int ph_hi) {
  extern __shared__ __attribute__((aligned(16))) char lds[];
  cg::grid_group grid = cg::this_grid();
#ifndef REP_PHASE
#define REP_PHASE -1
#endif
#define IN(k) (ph_lo <= (k) && (k) < ph_hi)
  volatile LAS unsigned* xst = (volatile LAS unsigned*)(LDS3(lds) + (LDS_BYTES - 16));
  if (threadIdx.x == 0) { xst[0] = 0u; xst[1] = 0u; }
  XcdBarrier xbar; xbar.bar = (unsigned*)(p.ws + OFF_BAR); xbar.x = 0; xbar.st = xst;
  if (ph_hi - ph_lo > 1) {
    if (blockIdx.x == 0) for (int i = threadIdx.x; i < XCD_BAR_WORDS; i += NTHR) ((unsigned*)(p.ws + OFF_BAR))[i] = 0u;
    grid.sync();
    xbar = xcd_barrier_post((unsigned*)(p.ws + OFF_BAR), xst);
  }
#define SEAM(k) do { if (IN(k) && IN((k) + 1)) xcd_barrier(xbar); } while (0)
  if (IN(0)) { phase0(p, lds); if (REP_PHASE == 0) { grid.sync(); phase0(p, lds); } }
  SEAM(0);
  if (IN(1)) { phase1(p, lds); if (REP_PHASE == 1) { grid.sync(); phase1(p, lds); } }
  SEAM(1);
  if (IN(2)) { phase2(p, lds); if (REP_PHASE == 2) { grid.sync(); phase2(p, lds); } }
  SEAM(2);
  if (IN(3)) { phase3(p, lds); if (REP_PHASE == 3) { grid.sync(); phase3(p, lds); } }
  SEAM(3);
  if (IN(4)) { phase4(p, lds); if (REP_PHASE == 4) { grid.sync(); phase4(p, lds); } }
  SEAM(4);
  if (IN(5)) { phase5(p, lds); if (REP_PHASE == 5) { grid.sync(); phase5(p, lds); } }
  SEAM(5);
  if (IN(6)) { phase6a(p, lds); if (REP_PHASE == 6) { grid.sync(); phase6a(p, lds); } }
  SEAM(6);
  if (IN(7)) { phase6m(p, lds); if (REP_PHASE == 7) { grid.sync(); phase6m(p, lds); } }
  SEAM(7);
  if (IN(8)) phase6b(p, lds);
}

extern "C" void kernel_launch(void* const* d_in, const int* in_sizes, int n_in, void* d_out, int out_size, void* d_ws,
                              size_t ws_size, hipStream_t stream) {
  static int grid_blocks = 0;
  if (!grid_blocks) {
    int dev = 0, cus = 0, per_cu = 0;
    (void)hipGetDevice(&dev);
    (void)hipDeviceGetAttribute(&cus, hipDeviceAttributeMultiprocessorCount, dev);
    (void)hipFuncSetAttribute((const void*)mega, hipFuncAttributeMaxDynamicSharedMemorySize, LDS_BYTES);
    (void)hipOccupancyMaxActiveBlocksPerMultiprocessor(&per_cu, mega, NTHR, LDS_BYTES);
    if (per_cu > 1) per_cu = 1;
    grid_blocks = cus * per_cu;
  }
  Params p{};
  p.x = (const float*)d_in[0]; p.ln_mix_g = (const float*)d_in[1]; p.w_in = (const float*)d_in[2];
  p.gmlp_norm_g = (const float*)d_in[3]; p.gmlp_w_s = (const float*)d_in[4]; p.gmlp_b_s = (const float*)d_in[5];
  p.q_norm_g = (const float*)d_in[6]; p.k_norm_g = (const float*)d_in[7]; p.rel_bias = (const float*)d_in[8];
  p.w_out = (const float*)d_in[9]; p.ln_ffn_g = (const float*)d_in[10]; p.w_query = (const float*)d_in[11];
  p.sub_keys = (const float*)d_in[12]; p.peer_u = (const float*)d_in[13]; p.peer_v = (const float*)d_in[14];
  p.out = (float*)d_out; p.ws = (char*)d_ws;
#if FUSED
  int lo = 0, hi = NPROG;
  void* args[] = {&p, &lo, &hi};
  hipError_t e = hipLaunchCooperativeKernel((void*)mega, dim3(grid_blocks), dim3(NTHR), args, LDS_BYTES, stream);
  if (e != hipSuccess) fprintf(stderr, "cooperative launch failed: %s (grid %d)\n", hipGetErrorString(e), grid_blocks);
#else
  for (int ph = 0; ph < NPROG; ++ph) mega<<<dim3(grid_blocks), dim3(NTHR), LDS_BYTES, stream>>>(p, ph, ph + 1);
#endif
}
```

```cpp
#include <hip/hip_runtime.h>
#include <hip/hip_cooperative_groups.h>
#include <cstdio>
namespace cg = cooperative_groups;

#ifndef FUSED
#define FUSED 1
#endif

typedef unsigned short u16;
using bf16x8 = __attribute__((ext_vector_type(8))) short;
using s16x4 = __attribute__((ext_vector_type(4))) short;
using f32x4 = __attribute__((ext_vector_type(4))) float;
using bf16x2 = __attribute__((ext_vector_type(2))) __bf16;
using f32x2 = __attribute__((ext_vector_type(2))) float;
using u32x4 = __attribute__((ext_vector_type(4))) unsigned;
using u32x2 = __attribute__((ext_vector_type(2))) unsigned;

constexpr int T = 32768, DM = 1024, SEQ = 4096;
constexpr float EPS = 1e-6f;
constexpr size_t MiB = 1u << 20;
constexpr size_t OFF_XB = 0, OFF_WINT = 64 * MiB  , OFF_WB = 67 * MiB  , OFF_WOUTT = 69 * MiB, OFF_WQT = 71 * MiB, OFF_KEYS = 75 * MiB,
                 OFF_RS = 76 * MiB, OFF_VSS = 76 * MiB + 512 * 1024, OFF_EU = 77 * MiB, OFF_EV = 109 * MiB,
                 OFF_U = 141 * MiB, OFF_GVT = 173 * MiB, OFF_QK = 205 * MiB, OFF_VT = 269 * MiB, OFF_AB = 301 * MiB,
                 OFF_HB = 365 * MiB, OFF_PQ = 141 * MiB  , OFF_EIDX = 429 * MiB,
                 OFF_BEST = 445 * MiB, OFF_ESC = 461 * MiB  , OFF_WGT = 462 * MiB  , OFF_BAR = 480 * MiB  , OFF_PART = 141 * MiB  ;

struct Params {
  const float *x, *ln_mix_g, *w_in, *gmlp_norm_g, *gmlp_w_s, *gmlp_b_s, *q_norm_g, *k_norm_g, *rel_bias, *w_out,
      *ln_ffn_g, *w_query, *sub_keys, *peer_u, *peer_v;
  float* out;
  char* ws;
};

constexpr int LDS_BYTES = 131584;
constexpr int NTHR = 512, NWAVE = 8;
constexpr int LSTR = 144;
constexpr int OPER_BYTES = 128 * LSTR;

__device__ __forceinline__ u16 f2bf(float f) {
  unsigned u = __float_as_uint(f);
  u += 0x7fffu + ((u >> 16) & 1u);
  return (u16)(u >> 16);
}
__device__ __forceinline__ unsigned pack2(float lo, float hi) { return (unsigned)f2bf(lo) | ((unsigned)f2bf(hi) << 16); }
__device__ __forceinline__ float bf_lo(unsigned u) { return __uint_as_float(u << 16); }
__device__ __forceinline__ float bf_hi(unsigned u) { return __uint_as_float(u & 0xffff0000u); }
__device__ __forceinline__ float bf2f(u16 v) { return __uint_as_float(((unsigned)v) << 16); }
__device__ __forceinline__ float gelu_f(float x) {
  const float c1 = -2.f * 0.7978845608028654f * 1.4426950408889634f, c2 = c1 * 0.044715f;
  const float zp = x * __builtin_fmaf(x * x, c2, c1);
  return x * __builtin_amdgcn_rcpf(1.f + __builtin_amdgcn_exp2f(zp));
}
template <int CTRL> __device__ __forceinline__ float dpp_f(float v) { return __int_as_float(__builtin_amdgcn_mov_dpp(__float_as_int(v), CTRL, 0xF, 0xF, true)); }
constexpr int DPP_X1 = 0xB1  , DPP_X2 = 0x4E  , DPP_HM = 0x141  , DPP_R8 = 0x128  ;
__device__ __forceinline__ float dot2(unsigned a, unsigned b, float acc) {
  return __builtin_amdgcn_fdot2_f32_bf16(__builtin_bit_cast(bf16x2, a), __builtin_bit_cast(bf16x2, b), acc, false);
}
__device__ __forceinline__ f32x4 mfma16(bf16x8 a, bf16x8 b, f32x4 c) {
  return __builtin_amdgcn_mfma_f32_16x16x32_bf16(a, b, c, 0, 0, 0);
}
__device__ __forceinline__ bf16x8 mk8(unsigned a, unsigned b, unsigned c, unsigned d) {
  uint4 u = make_uint4(a, b, c, d);
  return __builtin_bit_cast(bf16x8, u);
}
__device__ __forceinline__ unsigned pack4_fp8(float a, float b, float c, float d) {
  int r = 0;
  r = __builtin_amdgcn_cvt_pk_fp8_f32(a, b, r, false);
  r = __builtin_amdgcn_cvt_pk_fp8_f32(c, d, r, true);
  return (unsigned)r;
}
__device__ __forceinline__ unsigned q4(float xs, int i) {
  return (__float_as_uint(xs + 12582912.f) & 15u) << (4 * i);
}
__device__ __forceinline__ unsigned okey(float x) {
  unsigned u = __float_as_uint(x);
  return (u & 0x80000000u) ? ~u : (u | 0x80000000u);
}


__device__ __forceinline__ int tid_() { int t = threadIdx.x; asm volatile("" : "+v"(t)); return t; }
__device__ __forceinline__ int bid_() { int b = blockIdx.x; asm volatile("" : "+s"(b)); return b; }
namespace pg8 {
#define PG8_LAS __attribute__((address_space(3)))
typedef unsigned short bf16_t;
typedef short bf16x8 __attribute__((ext_vector_type(8)));
typedef float f32x4 __attribute__((ext_vector_type(4)));
typedef unsigned u32x4 __attribute__((ext_vector_type(4)));
constexpr int BM = 256, BK = 64, HALF = 128, HTB = HALF * BK * 2  , STAGE_BYTES = 8 * HTB, NXCD = 8, WGM = 8;

__host__ __device__ __forceinline__ int lds_byte(int r, int c) { const int st = (r >> 4) * 2 + (c >> 5), rr = r & 15, cc = c & 31, ob = rr * 64 + cc * 2; return st * 1024 + (ob ^ (((ob >> 9) & 1) << 5)); }
__host__ __device__ __forceinline__ void stage_rc(int b, int& R, int& C) { const int st = b / 1024, sb = b % 1024, swz = sb ^ (((sb >> 9) & 1) << 5); R = (st >> 1) * 16 + swz / 64; C = (st & 1) * 32 + (swz % 64) / 2; }
__host__ __device__ __forceinline__ int perm32(int rho) { const int n = rho >> 4, i = rho & 15; return 8 * (i >> 2) + 4 * n + (i & 3); }

struct Unit { int pm, pn; };
struct Gemm { const bf16_t* A; const bf16_t* Bt; int M, N, K; };

struct StaticOrder {
    int nM, nN, nwg, G, c;
    __host__ __device__ void init(int M, int N, int G_, int c_) { nM = M / BM; nN = N / BM; nwg = nM * nN; G = G_; c = c_; }
    __host__ __device__ bool next(int i, Unit& u) const {
        const long L = (long)i * G + c; if (L >= nwg) return false;
        int wgid = (int)L; { const int q = nwg / NXCD, r = nwg % NXCD, xcd = wgid % NXCD, off = wgid / NXCD; wgid = (xcd < r ? xcd * (q + 1) : r * (q + 1) + (xcd - r) * q) + off; }
        const int nig = WGM * nN, gid = wgid / nig, fm = gid * WGM, gsz = (nM - fm) < WGM ? (nM - fm) : WGM;
        u.pm = fm + ((wgid % nig) % gsz); u.pn = (wgid % nig) / gsz; return true;
    }
    __device__ __forceinline__ void a_ready(const Unit&) const {}
    __device__ __forceinline__ void done(const Unit&) const {}
};

__device__ __forceinline__ unsigned cvt_pk_bf16(float lo, float hi) { unsigned r; asm volatile("v_cvt_pk_bf16_f32 %0, %1, %2" : "=v"(r) : "v"(lo), "v"(hi)); return r; }
template <class Epi, class Sched, bool ALIGN_EPI = false, bool SP2 = false>
__device__ __forceinline__ void gemm_phase(PG8_LAS unsigned char* lds, const Gemm g, const Sched& S, const Epi& E) {
    const int tid = threadIdx.x, wid = __builtin_amdgcn_readfirstlane(tid >> 6), lane = tid & 63, wr = wid >> 2, wc = wid & 3, fr = lane & 15, fq = lane >> 4;
    const int K = g.K, nt = K / BK;
    unsigned voffA[2], voffB[2];
#pragma unroll
    for (int i = 0; i < 2; ++i) { int R, C; stage_rc(tid * 16 + i * 8192, R, C); const int Rb = Epi::PERM ? ((R & ~31) + perm32(R & 31)) : R;
        voffA[i] = (unsigned)(R * K + C) * 2u; voffB[i] = (unsigned)(Rb * K + C) * 2u; }
    const size_t kstep = (size_t)(BK * 2);
    const size_t hstep = (size_t)HALF * K * 2;
    const size_t tstep = 2 * hstep;
    const unsigned ldsw = (unsigned)wid * 1024u;
    const int aoff = lds_byte(wr * 64 + fr, fq * 8), boff = lds_byte(wc * 32 + fr, fq * 8);
#define PG8_SA(b, h) (((b) * 2 + (h)) * HTB)
#define PG8_SB(b, h) ((4 + (b) * 2 + (h)) * HTB)
#define PG8_STAGE(bufoff, gbase, voff) do { _Pragma("unroll") for (int _i = 0; _i < 2; ++_i) \
        __builtin_amdgcn_global_load_lds((const unsigned*)((const char*)(gbase) + (voff)[_i]), (PG8_LAS unsigned*)(lds + (bufoff) + ldsw + _i * 8192), 16, 0, 0); } while (0)
#define PG8_LDA(dst, b, h) do { _Pragma("unroll") for (int m = 0; m < 4; ++m) _Pragma("unroll") for (int k = 0; k < 2; ++k) dst[m][k] = *(const PG8_LAS bf16x8*)(lds + PG8_SA(b, h) + aoff + m * 2048 + k * 1024); } while (0)
#define PG8_LDB(dst, b, h) do { _Pragma("unroll") for (int n = 0; n < 2; ++n) _Pragma("unroll") for (int k = 0; k < 2; ++k) dst[n][k] = *(const PG8_LAS bf16x8*)(lds + PG8_SB(b, h) + boff + n * 2048 + k * 1024); } while (0)
#define PG8_MMA(ai, bj, At, Bt) do { __builtin_amdgcn_s_setprio(1); _Pragma("unroll") for (int m = 0; m < 4; ++m) _Pragma("unroll") for (int n = 0; n < 2; ++n) _Pragma("unroll") for (int k = 0; k < 2; ++k) \
        acc[ai][bj][m][n] = __builtin_amdgcn_mfma_f32_16x16x32_bf16(Bt[n][k], At[m][k], acc[ai][bj][m][n], 0, 0, 0); __builtin_amdgcn_s_setprio(0); } while (0)
#define PG8_WAIT_V(n) asm volatile("s_waitcnt vmcnt(" #n ")" ::: "memory")
#define PG8_WAIT_L(n) asm volatile("s_waitcnt lgkmcnt(" #n ")" ::: "memory")
#define PG8_BAR __builtin_amdgcn_s_barrier()
#define PG8_SCHED __builtin_amdgcn_sched_barrier(0)
    Unit cur, nxt; int ui = 0;
    if (!S.next(0, cur)) return;
    f32x4 acc[2][2][4][2];
#pragma unroll
    for (int a = 0; a < 2; ++a)
#pragma unroll
        for (int b = 0; b < 2; ++b)
#pragma unroll
            for (int m = 0; m < 4; ++m)
#pragma unroll
                for (int n = 0; n < 2; ++n) acc[a][b][m][n] = (f32x4){0.f, 0.f, 0.f, 0.f};
    bf16x8 At[4][2], B0[2][2], B1[2][2];
    const char* cA = (const char*)g.A + (size_t)cur.pm * tstep; const char* cB = (const char*)g.Bt + (size_t)cur.pn * tstep;
    S.a_ready(cur);
    if constexpr (SP2) {
        PG8_STAGE(PG8_SB(0, 0), cB, voffB); PG8_STAGE(PG8_SB(0, 1), cB + hstep, voffB); PG8_STAGE(PG8_SA(0, 0), cA, voffA); PG8_STAGE(PG8_SA(0, 1), cA + hstep, voffA);
        if (wr == 1) PG8_BAR;
        PG8_WAIT_V(2); PG8_BAR;
        PG8_STAGE(PG8_SB(1, 0), cB + kstep, voffB); PG8_STAGE(PG8_SA(1, 0), cA + kstep, voffA); PG8_STAGE(PG8_SB(1, 1), cB + hstep + kstep, voffB);
        PG8_WAIT_V(6); PG8_BAR;
    } else {
        PG8_STAGE(PG8_SB(0, 0), cB, voffB); PG8_STAGE(PG8_SA(0, 0), cA, voffA); PG8_STAGE(PG8_SB(0, 1), cB + hstep, voffB); PG8_STAGE(PG8_SA(0, 1), cA + hstep, voffA);
        if (wr == 1) PG8_BAR;
        PG8_WAIT_V(4); PG8_BAR;
        PG8_STAGE(PG8_SB(1, 0), cB + kstep, voffB); PG8_STAGE(PG8_SA(1, 0), cA + kstep, voffA); PG8_STAGE(PG8_SB(1, 1), cB + hstep + kstep, voffB);
        PG8_WAIT_V(6); PG8_BAR;
    }
    for (;;) {
        const bool has_next = S.next(ui + 1, nxt);
        const char* nA = has_next ? (const char*)g.A + (size_t)nxt.pm * tstep : cA; const char* nB = has_next ? (const char*)g.Bt + (size_t)nxt.pn * tstep : cB;
        for (int t = 0; t < nt; t += 2) {
            const bool last = (t == nt - 2);
            const char* a1 = cA + (size_t)(t + 1) * kstep;
            const char* a2 = last ? nA : cA + (size_t)(t + 2) * kstep; const char* b2 = last ? nB : cB + (size_t)(t + 2) * kstep;
            const char* a3 = a2 + kstep; const char* b3 = b2 + kstep;
            if (last && has_next) S.a_ready(nxt);
            if constexpr (SP2) {
            PG8_LDB(B0, 0, 0); PG8_LDB(B1, 0, 1); PG8_SCHED; PG8_LDA(At, 0, 0); PG8_STAGE(PG8_SA(1, 1), a1 + hstep, voffA);
            PG8_WAIT_V(8); PG8_WAIT_L(0); PG8_BAR; PG8_MMA(0, 0, At, B0); PG8_MMA(0, 1, At, B1); PG8_BAR; PG8_SCHED;
            PG8_LDA(At, 0, 1); PG8_STAGE(PG8_SB(0, 0), b2, voffB); PG8_STAGE(PG8_SB(0, 1), b2 + hstep, voffB); PG8_STAGE(PG8_SA(0, 0), a2, voffA);
            PG8_WAIT_V(8); PG8_WAIT_L(0); PG8_BAR; PG8_MMA(1, 0, At, B0); PG8_MMA(1, 1, At, B1); PG8_BAR; PG8_SCHED;
            PG8_LDB(B0, 1, 0); PG8_LDB(B1, 1, 1); PG8_SCHED; PG8_LDA(At, 1, 0); PG8_STAGE(PG8_SA(0, 1), a2 + hstep, voffA);
            PG8_WAIT_V(8); PG8_WAIT_L(0); PG8_BAR; PG8_MMA(0, 0, At, B0); PG8_MMA(0, 1, At, B1); PG8_BAR; PG8_SCHED;
            PG8_LDA(At, 1, 1); PG8_STAGE(PG8_SB(1, 0), b3, voffB); PG8_STAGE(PG8_SB(1, 1), b3 + hstep, voffB); PG8_STAGE(PG8_SA(1, 0), a3, voffA);
            PG8_WAIT_V(8); PG8_WAIT_L(0); PG8_BAR; PG8_MMA(1, 0, At, B0); PG8_MMA(1, 1, At, B1); PG8_BAR; PG8_SCHED;
            } else {
            PG8_LDB(B0, 0, 0); PG8_SCHED; PG8_LDA(At, 0, 0); PG8_STAGE(PG8_SA(1, 1), a1 + hstep, voffA);
            PG8_WAIT_L(8); PG8_BAR; PG8_WAIT_L(0); PG8_MMA(0, 0, At, B0); PG8_BAR; PG8_SCHED;
            PG8_LDB(B1, 0, 1); PG8_STAGE(PG8_SB(0, 0), b2, voffB);
            PG8_BAR; PG8_WAIT_L(0); PG8_MMA(0, 1, At, B1); PG8_BAR;
            PG8_LDA(At, 0, 1); PG8_STAGE(PG8_SA(0, 0), a2, voffA);
            PG8_BAR; PG8_WAIT_L(0); PG8_MMA(1, 0, At, B0); PG8_BAR; PG8_SCHED;
            PG8_STAGE(PG8_SB(0, 1), b2 + hstep, voffB);
            PG8_WAIT_V(6); PG8_BAR; PG8_MMA(1, 1, At, B1); PG8_BAR;
            PG8_LDB(B0, 1, 0); PG8_SCHED; PG8_LDA(At, 1, 0); PG8_STAGE(PG8_SA(0, 1), a2 + hstep, voffA);
            PG8_WAIT_L(8); PG8_BAR; PG8_WAIT_L(0); PG8_MMA(0, 0, At, B0); PG8_BAR; PG8_SCHED;
            PG8_LDB(B1, 1, 1); PG8_STAGE(PG8_SB(1, 0), b3, voffB);
            PG8_BAR; PG8_WAIT_L(0); PG8_MMA(0, 1, At, B1); PG8_BAR;
            PG8_LDA(At, 1, 1); PG8_STAGE(PG8_SA(1, 0), a3, voffA);
            PG8_BAR; PG8_WAIT_L(0); PG8_MMA(1, 0, At, B0); PG8_BAR; PG8_SCHED;
            PG8_STAGE(PG8_SB(1, 1), b3 + hstep, voffB);
            PG8_WAIT_V(6); PG8_BAR; PG8_MMA(1, 1, At, B1); PG8_BAR;
            }
        }
        if constexpr (ALIGN_EPI) { if (wr == 0) PG8_BAR; }
        if constexpr (!Epi::AFTER_DRAIN) { E(acc, cur, wr, wc, fr, fq); S.done(cur); }
        if (!has_next) break;
#pragma unroll
        for (int a = 0; a < 2; ++a)
#pragma unroll
            for (int b = 0; b < 2; ++b)
#pragma unroll
                for (int m = 0; m < 4; ++m)
#pragma unroll
                    for (int n = 0; n < 2; ++n) acc[a][b][m][n] = (f32x4){0.f, 0.f, 0.f, 0.f};
        cur = nxt; cA = nA; cB = nB; ++ui;
        if constexpr (ALIGN_EPI) { if (wr == 1) PG8_BAR; }
    }
    PG8_WAIT_V(0);
    if constexpr (!ALIGN_EPI) { if (wr == 0) PG8_BAR; }
    PG8_BAR;
    if constexpr (Epi::AFTER_DRAIN) { E.fused(acc, cur, wr, wc, fr, fq, lds, wid, lane); S.done(cur); }
#undef PG8_SA
#undef PG8_SB
#undef PG8_STAGE
#undef PG8_LDA
#undef PG8_LDB
#undef PG8_MMA
#undef PG8_WAIT_V
#undef PG8_WAIT_L
#undef PG8_BAR
#undef PG8_SCHED
}
}

#define EPI_V8(v, A, s) float v[8] = {A[0][0] * (s), A[0][1] * (s), A[0][2] * (s), A[0][3] * (s), A[1][0] * (s), A[1][1] * (s), A[1][2] * (s), A[1][3] * (s)}
__device__ __forceinline__ uint4 pk8(const float (&v)[8]) {
  return make_uint4(pg8::cvt_pk_bf16(v[0], v[1]), pg8::cvt_pk_bf16(v[2], v[3]), pg8::cvt_pk_bf16(v[4], v[5]), pg8::cvt_pk_bf16(v[6], v[7]));
}
struct EpiIn {
  static constexpr bool PERM = true, AFTER_DRAIN = false;
  u16* U; u16* QK; const float* RS;
  __device__ __forceinline__ void operator()(const pg8::f32x4 (&acc)[2][2][4][2], const pg8::Unit& u, int wr, int wc, int fr, int fq) const {
    const int row0 = u.pm * 256 + wr * 64 + fr, colt = u.pn * 256, c0 = colt + wc * 32 + 8 * fq;
    const bool isu = colt < 512;
#pragma unroll
    for (int ai = 0; ai < 2; ++ai)
#pragma unroll
      for (int m = 0; m < 4; ++m) {
        const int row = row0 + ai * 128 + m * 16;
        const float r = RS[row];
#pragma unroll
        for (int bj = 0; bj < 2; ++bj) {
          const int col = c0 + bj * 128;
          EPI_V8(v, acc[ai][bj][m], r);
          if (isu) {
#pragma unroll
            for (int j = 0; j < 8; ++j) v[j] = gelu_f(v[j]);
            *(uint4*)(U + (size_t)row * 512 + col) = pk8(v);
          } else {
            *(uint4*)(QK + (size_t)row * 1024 + (col - 512)) = pk8(v);
          }
        }
      }
  }
};
struct EpiInT {
  static constexpr bool PERM = true, AFTER_DRAIN = false;
  u16* GVT; u16* VT; const float* RS; float* VSS;
  __device__ __forceinline__ void operator()(const pg8::f32x4 (&acc)[2][2][4][2], const pg8::Unit& u, int wr, int wc, int fr, int fq) const {
    const int ch0 = u.pm * 256 + wr * 64 + fr, t0 = u.pn * 256 + wc * 32 + 8 * fq;
    const bool isg = u.pm < 2;
#pragma unroll
    for (int bj = 0; bj < 2; ++bj) {
      const int t = t0 + bj * 128, b = t >> 12, s = t & 4095;
      const float4 ra = *(const float4*)(RS + t), rb = *(const float4*)(RS + t + 4);
      const float rr[8] = {ra.x, ra.y, ra.z, ra.w, rb.x, rb.y, rb.z, rb.w};
      float ss[8] = {0.f, 0.f, 0.f, 0.f, 0.f, 0.f, 0.f, 0.f};
#pragma unroll
      for (int ai = 0; ai < 2; ++ai)
#pragma unroll
        for (int m = 0; m < 4; ++m) {
          const int ch = ch0 + ai * 128 + m * 16;
          float v[8];
#pragma unroll
          for (int j = 0; j < 8; ++j) v[j] = acc[ai][bj][m][j >> 2][j & 3] * rr[j];
          if (isg) {
#pragma unroll
            for (int j = 0; j < 8; ++j) { v[j] = gelu_f(v[j]); ss[j] += v[j] * v[j]; }
            *(uint4*)(GVT + ((size_t)b * 512 + ch) * SEQ + s) = pk8(v);
          } else {
            *(uint4*)(VT + ((size_t)b * 512 + (ch - 512)) * SEQ + s) = pk8(v);
          }
        }
      if (isg) {
#pragma unroll
        for (int j = 0; j < 8; ++j) {
          float sv = ss[j];
          sv += dpp_f<DPP_X1>(sv); sv += dpp_f<DPP_X2>(sv); sv += dpp_f<DPP_HM>(sv); sv += dpp_f<DPP_R8>(sv);
          if (fr == 0) atomicAdd(VSS + t + j, sv);
        }
      }
    }
  }
};
struct EpiOut {
  static constexpr bool PERM = true, AFTER_DRAIN = false;
  const float* X; float* OUT; u16* HB;
  __device__ __forceinline__ void operator()(const pg8::f32x4 (&acc)[2][2][4][2], const pg8::Unit& u, int wr, int wc, int fr, int fq) const {
    const int row0 = u.pm * 256 + wr * 64 + fr, c0 = u.pn * 256 + wc * 32 + 8 * fq;
#pragma unroll
    for (int ai = 0; ai < 2; ++ai)
#pragma unroll
      for (int m = 0; m < 4; ++m) {
        const int row = row0 + ai * 128 + m * 16;
#pragma unroll
        for (int bj = 0; bj < 2; ++bj) {
          const size_t idx = (size_t)row * 1024 + c0 + bj * 128;
          const float4 xa = *(const float4*)(X + idx), xb = *(const float4*)(X + idx + 4);
          float v[8] = {xa.x + acc[ai][bj][m][0][0], xa.y + acc[ai][bj][m][0][1], xa.z + acc[ai][bj][m][0][2], xa.w + acc[ai][bj][m][0][3],
                        xb.x + acc[ai][bj][m][1][0], xb.y + acc[ai][bj][m][1][1], xb.z + acc[ai][bj][m][1][2], xb.w + acc[ai][bj][m][1][3]};
          *(uint4*)(HB + idx) = pk8(v);
        }
      }
  }
};
struct EpiQ {
  static constexpr bool PERM = true, AFTER_DRAIN = false;
  u16* PQ;
  __device__ __forceinline__ void operator()(const pg8::f32x4 (&acc)[2][2][4][2], const pg8::Unit& u, int wr, int wc, int fr, int fq) const {
    const int row0 = u.pm * 256 + wr * 64 + fr, c0 = u.pn * 256 + wc * 32 + 8 * fq;
#pragma unroll
    for (int ai = 0; ai < 2; ++ai)
#pragma unroll
      for (int m = 0; m < 4; ++m) {
        const int row = row0 + ai * 128 + m * 16;
#pragma unroll
        for (int bj = 0; bj < 2; ++bj) {
          EPI_V8(v, acc[ai][bj][m], 1.f);
          *(uint4*)(PQ + (size_t)row * 2048 + c0 + bj * 128) = pk8(v);
        }
      }
  }
};
#define LDS3(p) ((__attribute__((address_space(3))) unsigned char*)(p))

__device__ __forceinline__ void quant_pair(const Params& p, int row0, int lane) {
  unsigned char* EU4 = (unsigned char*)(p.ws + OFF_EU);
  unsigned char* EV4 = (unsigned char*)(p.ws + OFF_EV);
  float* ESC = (float*)(p.ws + OFF_ESC);
  float4 g4[2][2];
#pragma unroll
  for (int j = 0; j < 2; ++j)
#pragma unroll
    for (int q = 0; q < 2; ++q) g4[j][q] = ((const float4*)p.ln_ffn_g)[j * 128 + lane * 2 + q];

      const bool isv = row0 >= 16384;
      float4 v[2][2][2];
#pragma unroll
      for (int r = 0; r < 2; ++r) {
        const float4* src = (const float4*)((isv ? p.peer_v : p.peer_u) + (size_t)((row0 + r) & 16383) * 1024);
#pragma unroll
        for (int j = 0; j < 2; ++j)
#pragma unroll
          for (int q = 0; q < 2; ++q) v[r][j][q] = src[j * 128 + lane * 2 + q];
      }
#pragma unroll
      for (int r = 0; r < 2; ++r) {
        const int e = (row0 + r) & 16383;
        float sq = 0.f, am = 0.f;
#pragma unroll
        for (int j = 0; j < 2; ++j)
#pragma unroll
          for (int q = 0; q < 2; ++q) {
            float4 t4 = v[r][j][q];
            if (!isv) { t4.x *= g4[j][q].x; t4.y *= g4[j][q].y; t4.z *= g4[j][q].z; t4.w *= g4[j][q].w; }
            sq += t4.x * t4.x + t4.y * t4.y + t4.z * t4.z + t4.w * t4.w;
            am = fmaxf(am, fmaxf(fmaxf(fabsf(t4.x), fabsf(t4.y)), fmaxf(fabsf(t4.z), fabsf(t4.w))));
            v[r][j][q] = t4;
          }
#pragma unroll
        for (int o = 1; o < 64; o <<= 1) { sq += __shfl_xor(sq, o); am = fmaxf(am, __shfl_xor(am, o)); }
        const float rng = isv ? am : 2.6f * sqrtf(sq * (1.f / 1024.f));
        const float qmax = isv ? 6.0f : 7.0f;
        const bool ok = (rng > 1e-30f);
        const float scale = ok ? qmax / rng : 0.f;
        const float inv = ok ? rng / qmax : 0.f;
        unsigned char* dst = (isv ? EV4 : EU4) + (size_t)e * 128 + (lane & 31) * 4;
#define Q4C(x, i) q4(fminf(fmaxf((x) * scale, -7.f), 7.f), (i))
#pragma unroll
        for (int j = 0; j < 2; ++j) {
          unsigned w = 0;
          if (isv) {
            w = __builtin_amdgcn_cvt_scalef32_pk_fp4_f32(w, v[r][j][0].x * scale, v[r][j][0].y * scale, 1.0f, 0);
            w = __builtin_amdgcn_cvt_scalef32_pk_fp4_f32(w, v[r][j][0].z * scale, v[r][j][0].w * scale, 1.0f, 1);
            w = __builtin_amdgcn_cvt_scalef32_pk_fp4_f32(w, v[r][j][1].x * scale, v[r][j][1].y * scale, 1.0f, 2);
            w = __builtin_amdgcn_cvt_scalef32_pk_fp4_f32(w, v[r][j][1].z * scale, v[r][j][1].w * scale, 1.0f, 3);
          } else {
            w = Q4C(v[r][j][0].x, 0) | Q4C(v[r][j][0].y, 1) | Q4C(v[r][j][0].z, 2) | Q4C(v[r][j][0].w, 3) |
                Q4C(v[r][j][1].x, 4) | Q4C(v[r][j][1].y, 5) | Q4C(v[r][j][1].z, 6) | Q4C(v[r][j][1].w, 7);
          }
          *(unsigned*)(dst + (size_t)(j * 2 + (lane >> 5)) * (2 * MiB)) = w;
        }
#undef Q4C
        if (lane == 0) ESC[row0 + r] = inv;
      }
    }

__device__ __forceinline__ void phase0(const Params& p, char* lds) {
  const int tid = tid_(), lane = tid & 63, wave = tid >> 6;
  const int nblk = gridDim.x, blk = bid_();
  u16* XB = (u16*)(p.ws + OFF_XB);
  float* RS = (float*)(p.ws + OFF_RS);
  float* VSS = (float*)(p.ws + OFF_VSS);
  for (int row0 = (blk * NWAVE + wave) * 4; row0 < T; row0 += nblk * NWAVE * 4) {
    float4 v[4][4];
#pragma unroll
    for (int r = 0; r < 4; ++r) {
      const float4* xr = (const float4*)(p.x + (size_t)(row0 + r) * DM);
#pragma unroll
      for (int j = 0; j < 2; ++j) { v[r][2 * j] = xr[j * 128 + lane * 2]; v[r][2 * j + 1] = xr[j * 128 + lane * 2 + 1]; }
    }
#pragma unroll
    for (int r = 0; r < 4; ++r) {
      float ss = 0.f;
#pragma unroll
      for (int i = 0; i < 4; ++i) ss += v[r][i].x * v[r][i].x + v[r][i].y * v[r][i].y + v[r][i].z * v[r][i].z + v[r][i].w * v[r][i].w;
#pragma unroll
      for (int o = 1; o < 64; o <<= 1) ss += __shfl_xor(ss, o);
      if (lane == 0) RS[row0 + r] = rsqrtf(ss * (1.f / 1024.f) + EPS);
#pragma unroll
      for (int j = 0; j < 2; ++j)
        *(uint4*)(XB + (size_t)(row0 + r) * DM + j * 512 + lane * 8) =
            make_uint4(pg8::cvt_pk_bf16(v[r][2 * j].x, v[r][2 * j].y), pg8::cvt_pk_bf16(v[r][2 * j].z, v[r][2 * j].w),
                       pg8::cvt_pk_bf16(v[r][2 * j + 1].x, v[r][2 * j + 1].y), pg8::cvt_pk_bf16(v[r][2 * j + 1].z, v[r][2 * j + 1].w));
    }
  }
  {
    const int half = wave >> 2, w4 = wave & 3;
    float* tile = (float*)lds + half * (64 * 65);
    for (int tp = blk; tp < 704; tp += nblk) {
      const int tl = tp * 2 + half;
      const float* W; const float* gain; u16* dst; int N, kt, nt, drow;
      if (tl < 640) {
        W = p.w_in; gain = p.ln_mix_g; N = 2560; kt = tl / 40; nt = tl % 40;
        const int n0 = nt * 64;
        if (n0 < 512) { dst = (u16*)(p.ws + OFF_WINT); drow = n0; }
        else if (n0 < 1024) { dst = (u16*)(p.ws + OFF_WB); drow = n0 - 512; }
        else if (n0 < 2048) { dst = (u16*)(p.ws + OFF_WINT); drow = n0 - 512; }
        else { dst = (u16*)(p.ws + OFF_WB); drow = n0 - 2048 + 512; }
      } else if (tl < 896) { int t2 = tl - 640; W = p.w_out; gain = nullptr; dst = (u16*)(p.ws + OFF_WOUTT); N = 1024; kt = t2 / 16; nt = t2 % 16; drow = nt * 64; }
      else { int t2 = tl - 896; W = p.w_query; gain = p.ln_ffn_g; dst = (u16*)(p.ws + OFF_WQT); N = 2048; kt = t2 / 32; nt = t2 % 32; drow = nt * 64; }
      __syncthreads();
#pragma unroll
      for (int i = 0; i < 16; ++i) {
        const int kk = i * 4 + w4;
        const float gk = gain ? gain[kt * 64 + kk] : 1.f;
        tile[kk * 65 + lane] = W[(size_t)(kt * 64 + kk) * N + nt * 64 + lane] * gk;
      }
      __syncthreads();
#pragma unroll 4
      for (int i = 0; i < 16; ++i) {
        const int nn = i * 4 + w4;
        dst[(size_t)(drow + nn) * 1024 + kt * 64 + lane] = f2bf(tile[lane * 65 + nn]);
      }
    }
    __syncthreads();
  }
  {
    u16* KEYS = (u16*)(p.ws + OFF_KEYS);
    for (int i = blk * NTHR + tid; i < 262144 / 4; i += nblk * NTHR) {
      float4 a = ((const float4*)p.sub_keys)[i];
      *(uint2*)(KEYS + (size_t)i * 4) = make_uint2(pack2(a.x, a.y), pack2(a.z, a.w));
    }
  }
  for (int i = blk * NTHR + tid; i < T; i += nblk * NTHR) VSS[i] = 0.f;

}

__device__ __forceinline__ void phase1(const Params& p, char* lds) {
  const u16* XB = (const u16*)(p.ws + OFF_XB);
  const float* RS = (const float*)(p.ws + OFF_RS);
  {
    pg8::Gemm g{XB, (const u16*)(p.ws + OFF_WINT), T, 1536, 1024};
    pg8::StaticOrder S; S.init(T, 1536, (int)gridDim.x, (int)blockIdx.x);
    EpiIn E{(u16*)(p.ws + OFF_U), (u16*)(p.ws + OFF_QK), RS};
    pg8::gemm_phase<EpiIn, pg8::StaticOrder, true, true>(LDS3(lds), g, S, E);
  }
  {
    pg8::Gemm g{(const u16*)(p.ws + OFF_WB), XB, 1024, T, 1024};
    pg8::StaticOrder S; S.init(1024, T, (int)gridDim.x, (int)blockIdx.x);
    EpiInT E{(u16*)(p.ws + OFF_GVT), (u16*)(p.ws + OFF_VT), RS, (float*)(p.ws + OFF_VSS)};
    pg8::gemm_phase<EpiInT, pg8::StaticOrder, true, true>(LDS3(lds), g, S, E);
  }
}

__device__ __forceinline__ void gmlp_item(const Params& p, int item) {
  const int tid = tid_() & 255, lane = tid & 63, wave = tid >> 6, l15 = lane & 15, g = lane >> 4;
  const int gr = item & 7, n = (item >> 3) & 31, b = item >> 8;
  const int t0 = b * SEQ + n * 128;
  const float* VSS = (const float*)(p.ws + OFF_VSS);
  const u16* GVT = (const u16*)(p.ws + OFF_GVT);
  const u16* U = (const u16*)(p.ws + OFF_U);
  u16* AB = (u16*)(p.ws + OFF_AB);
  f32x4 acc[2][4];
#pragma unroll
  for (int i = 0; i < 2; ++i)
#pragma unroll
    for (int j = 0; j < 4; ++j) acc[i][j] = f32x4{0.f, 0.f, 0.f, 0.f};
  const int i_base = wave * 32;
  const bool low = wave < 2;
#pragma unroll
  for (int ks = 0; ks < 4; ++ks) {
    if (ks >= 2 && low) continue;
    const int j0 = ks * 32 + g * 8;
    const float4 s0 = *(const float4*)(VSS + t0 + j0), s1 = *(const float4*)(VSS + t0 + j0 + 4);
    float r[8] = {s0.x, s0.y, s0.z, s0.w, s1.x, s1.y, s1.z, s1.w};
#pragma unroll
    for (int q = 0; q < 8; ++q) r[q] = rsqrtf(r[q] * (1.f / 512.f) + EPS);
    bf16x8 wf[2];
#pragma unroll
    for (int mi = 0; mi < 2; ++mi) {
      const int i = i_base + mi * 16 + l15;
      const float* wp = p.gmlp_w_s + ((size_t)(gr * 128 + i)) * 128 + j0;
      const float4 w0 = *(const float4*)wp, w1 = *(const float4*)(wp + 4);
      wf[mi] = mk8(pack2(w0.x * r[0], w0.y * r[1]), pack2(w0.z * r[2], w0.w * r[3]), pack2(w1.x * r[4], w1.y * r[5]),
                   pack2(w1.z * r[6], w1.w * r[7]));
    }
#pragma unroll
    for (int ni = 0; ni < 4; ++ni) {
      const int c = ni * 16 + l15;
      const bf16x8 gf = *(const bf16x8*)(GVT + ((size_t)b * 512 + gr * 64 + c) * SEQ + n * 128 + j0);
#pragma unroll
      for (int mi = 0; mi < 2; ++mi) acc[mi][ni] = mfma16(gf, wf[mi], acc[mi][ni]);
    }
  }
#pragma unroll
  for (int mi = 0; mi < 2; ++mi) {
    const int i = i_base + mi * 16 + l15;
    const size_t t = (size_t)t0 + i;
    const float bs = p.gmlp_b_s[gr * 128 + i];
#pragma unroll
    for (int ni = 0; ni < 4; ++ni) {
      const int ch = gr * 64 + ni * 16 + g * 4;
      const float4 ng = *(const float4*)(p.gmlp_norm_g + ch);
      const uint2 uu = *(const uint2*)(U + t * 512 + ch);
      const float o0 = bf_lo(uu.x) * (acc[mi][ni][0] * ng.x + bs), o1 = bf_hi(uu.x) * (acc[mi][ni][1] * ng.y + bs);
      const float o2 = bf_lo(uu.y) * (acc[mi][ni][2] * ng.z + bs), o3 = bf_hi(uu.y) * (acc[mi][ni][3] * ng.w + bs);
      *(uint2*)(AB + t * 1024 + ch) = make_uint2(pack2(o0, o1), pack2(o2, o3));
    }
  }
}

constexpr int ATT_BUF = 2 * 64 * LSTR + 256;
constexpr float LOG2E = 1.4426950408889634f;
__device__ __forceinline__ void attn_item(const Params& p, int item, char* lds) {
  const int tid = tid_() & 255, lane = tid & 63, wave = tid >> 6, l15 = lane & 15, g = lane >> 4;
  const int c = item & 63, h = (item >> 6) & 7, b = item >> 9;
  const u16* QK = (const u16*)(p.ws + OFF_QK);
  const u16* VT = (const u16*)(p.ws + OFF_VT);
  u16* AB = (u16*)(p.ws + OFF_AB);
  float* bias_s = (float*)(lds + 2 * ATT_BUF);
  __syncthreads();
  float bmax = 0.f;
  for (int i = tid; i < 257; i += 256) { const float bv = p.rel_bias[h * 257 + i] * LOG2E; bias_s[i] = bv; bmax = fmaxf(bmax, fabsf(bv)); }
#pragma unroll
  for (int o = 1; o < 64; o <<= 1) bmax = fmaxf(bmax, __shfl_xor(bmax, o));
  if (lane == 0) bias_s[260 + wave] = bmax;
  const size_t tq = (size_t)b * SEQ + c * 64 + wave * 16 + l15;
  bf16x8 qb0, qb1;
  float mfix;
  {
    const u16* qp = QK + tq * 1024 + h * 64 + g * 8;
    const uint4 q0 = *(const uint4*)qp, q1 = *(const uint4*)(qp + 32);
    float f[16] = {bf_lo(q0.x), bf_hi(q0.x), bf_lo(q0.y), bf_hi(q0.y), bf_lo(q0.z), bf_hi(q0.z), bf_lo(q0.w), bf_hi(q0.w),
                   bf_lo(q1.x), bf_hi(q1.x), bf_lo(q1.y), bf_hi(q1.y), bf_lo(q1.z), bf_hi(q1.z), bf_lo(q1.w), bf_hi(q1.w)};
    float ss = 0.f;
#pragma unroll
    for (int i = 0; i < 16; ++i) ss += f[i] * f[i];
    ss += __shfl_xor(ss, 16); ss += __shfl_xor(ss, 32);
    const float rq = rsqrtf(ss * (1.f / 64.f) + EPS) * (0.125f * LOG2E);
    const float4 ga = *(const float4*)(p.q_norm_g + g * 8), gb = *(const float4*)(p.q_norm_g + g * 8 + 4);
    const float4 gc = *(const float4*)(p.q_norm_g + 32 + g * 8), gd = *(const float4*)(p.q_norm_g + 32 + g * 8 + 4);
    const float4 ka = *(const float4*)(p.k_norm_g + g * 8), kb = *(const float4*)(p.k_norm_g + g * 8 + 4);
    const float4 kc4 = *(const float4*)(p.k_norm_g + 32 + g * 8), kd = *(const float4*)(p.k_norm_g + 32 + g * 8 + 4);
    const float gg[16] = {ga.x * ka.x, ga.y * ka.y, ga.z * ka.z, ga.w * ka.w, gb.x * kb.x, gb.y * kb.y, gb.z * kb.z, gb.w * kb.w,
                          gc.x * kc4.x, gc.y * kc4.y, gc.z * kc4.z, gc.w * kc4.w, gd.x * kd.x, gd.y * kd.y, gd.z * kd.z, gd.w * kd.w};
#pragma unroll
    for (int i = 0; i < 16; ++i) f[i] *= rq * gg[i];
    float qn = 0.f;
#pragma unroll
    for (int i = 0; i < 16; ++i) qn += f[i] * f[i];
    qn += __shfl_xor(qn, 16); qn += __shfl_xor(qn, 32);
    mfix = fminf(8.f * sqrtf(qn) * 1.01f + 1.f, 60.f);
    qb0 = mk8(pg8::cvt_pk_bf16(f[0], f[1]), pg8::cvt_pk_bf16(f[2], f[3]), pg8::cvt_pk_bf16(f[4], f[5]), pg8::cvt_pk_bf16(f[6], f[7]));
    qb1 = mk8(pg8::cvt_pk_bf16(f[8], f[9]), pg8::cvt_pk_bf16(f[10], f[11]), pg8::cvt_pk_bf16(f[12], f[13]), pg8::cvt_pk_bf16(f[14], f[15]));
  }
  f32x4 o[4];
#pragma unroll
  for (int i = 0; i < 4; ++i) o[i] = f32x4{0.f, 0.f, 0.f, 0.f};
  float l_run = 0.f;
  const int srow = tid >> 2, spart = tid & 3;
  const int kc_lo = (c >= 8) ? 0 : (8 - c);
  const u16* kbase = QK + ((size_t)b * SEQ + srow) * 1024 + 512 + h * 64 + spart * 16;
  const u16* vbase = VT + ((size_t)b * 512 + h * 64 + srow) * SEQ + spart * 16;
  uint4 k0, k1, v0, v1;
  {
    const int kchunk = c - 8 + kc_lo;
    const u16* kp = kbase + (size_t)kchunk * 64 * 1024;
    k0 = *(const uint4*)kp; k1 = *(const uint4*)(kp + 8);
    const u16* vp = vbase + kchunk * 64;
    v0 = *(const uint4*)vp; v1 = *(const uint4*)(vp + 8);
  }
  for (int kc = kc_lo; kc <= 8; ++kc) {
    char* Ks = lds + ((kc - kc_lo) & 1) * ATT_BUF;
    char* Vs = Ks + 64 * LSTR;
    float* rks = (float*)(Ks + 2 * 64 * LSTR);
    {
      float ss = 0.f;
      ss = dot2(k0.x, k0.x, ss); ss = dot2(k0.y, k0.y, ss); ss = dot2(k0.z, k0.z, ss); ss = dot2(k0.w, k0.w, ss);
      ss = dot2(k1.x, k1.x, ss); ss = dot2(k1.y, k1.y, ss); ss = dot2(k1.z, k1.z, ss); ss = dot2(k1.w, k1.w, ss);
      ss += dpp_f<DPP_X1>(ss); ss += dpp_f<DPP_X2>(ss);
      if (spart == 0) rks[srow] = rsqrtf(ss * (1.f / 64.f) + EPS);
      char* kd = Ks + srow * LSTR + spart * 32;
      *(uint4*)kd = k0;
      *(uint4*)(kd + 16) = k1;
      char* vd = Vs + srow * LSTR + spart * 32;
      *(uint4*)vd = v0;
      *(uint4*)(vd + 16) = v1;
    }
    __syncthreads();
    if (kc < 8) {
      const int kchunk = c - 8 + kc + 1;
      const u16* kp = kbase + (size_t)kchunk * 64 * 1024;
      k0 = *(const uint4*)kp; k1 = *(const uint4*)(kp + 8);
      const u16* vp = vbase + kchunk * 64;
      v0 = *(const uint4*)vp; v1 = *(const uint4*)(vp + 8);
    }
    f32x4 s[4];
#pragma unroll
    for (int mt = 0; mt < 4; ++mt) {
      const char* kr = Ks + (mt * 16 + l15) * LSTR + g * 16;
      const bf16x8 a0 = *(const bf16x8*)kr, a1 = *(const bf16x8*)(kr + 64);
      s[mt] = mfma16(a0, qb0, f32x4{0.f, 0.f, 0.f, 0.f});
      s[mt] = mfma16(a1, qb1, s[mt]);
    }
    if (kc == kc_lo) mfix += fmaxf(fmaxf(bias_s[260], bias_s[261]), fmaxf(bias_s[262], bias_s[263]));
    float ls = 0.f;
    if (kc <= 5) {
      const float bc = bias_s[256] - mfix;
#pragma unroll
      for (int mt = 0; mt < 4; ++mt) {
        const float4 rk4 = *(const float4*)(rks + mt * 16 + g * 4);
        s[mt][0] = __builtin_amdgcn_exp2f(s[mt][0] * rk4.x + bc); s[mt][1] = __builtin_amdgcn_exp2f(s[mt][1] * rk4.y + bc);
        s[mt][2] = __builtin_amdgcn_exp2f(s[mt][2] * rk4.z + bc); s[mt][3] = __builtin_amdgcn_exp2f(s[mt][3] * rk4.w + bc);
        ls += (s[mt][0] + s[mt][1]) + (s[mt][2] + s[mt][3]);
      }
    } else {
      const int qi = wave * 16 + l15 + 64 * (8 - kc);
#pragma unroll
      for (int mt = 0; mt < 4; ++mt) {
        const float4 rk4 = *(const float4*)(rks + mt * 16 + g * 4);
        const float rr[4] = {rk4.x, rk4.y, rk4.z, rk4.w};
#pragma unroll
        for (int j = 0; j < 4; ++j) {
          int rel = qi - (mt * 16 + g * 4 + j);
          rel = rel > 128 ? 128 : rel;
          s[mt][j] = __builtin_amdgcn_exp2f(s[mt][j] * rr[j] + (bias_s[rel + 128] - mfix));
          ls += s[mt][j];
        }
      }
    }
    l_run += ls;
#pragma unroll
    for (int k2 = 0; k2 < 2; ++k2) {
      const bf16x8 pb = mk8(pg8::cvt_pk_bf16(s[2 * k2][0], s[2 * k2][1]), pg8::cvt_pk_bf16(s[2 * k2][2], s[2 * k2][3]),
                            pg8::cvt_pk_bf16(s[2 * k2 + 1][0], s[2 * k2 + 1][1]), pg8::cvt_pk_bf16(s[2 * k2 + 1][2], s[2 * k2 + 1][3]));
#pragma unroll
      for (int mt = 0; mt < 4; ++mt) {
        const char* vr = Vs + (mt * 16 + l15) * LSTR + (32 * k2 + 4 * g) * 2;
        const uint2 va = *(const uint2*)vr, vb = *(const uint2*)(vr + 32);
        o[mt] = mfma16(mk8(va.x, va.y, vb.x, vb.y), pb, o[mt]);
      }
    }
  }
  float l = l_run;
  l += __shfl_xor(l, 16); l += __shfl_xor(l, 32);
  const float inv = 1.f / l;
#pragma unroll
  for (int mt = 0; mt < 4; ++mt) {
    *(uint2*)(AB + tq * 1024 + 512 + h * 64 + mt * 16 + g * 4) =
        make_uint2(pg8::cvt_pk_bf16(o[mt][0] * inv, o[mt][1] * inv), pg8::cvt_pk_bf16(o[mt][2] * inv, o[mt][3] * inv));
  }
}

__device__ __forceinline__ void phase2(const Params& p, char* lds) {
  const int sub = tid_() >> 8;
  for (int it = bid_(); it < 2048 + 1024; it += gridDim.x) {
    if (it < 2048) {
      const int b = it >> 8, hp = (it >> 6) & 3, c = ((it & 63) + 8 * b) & 63;
      attn_item(p, (b << 9) | ((hp * 2 + sub) << 6) | c, lds + sub * 38912);
    } else {
      gmlp_item(p, (it - 2048) * 2 + sub);
    }
  }
}

__device__ __forceinline__ void phase3(const Params& p, char* lds) {
  pg8::Gemm g{(const u16*)(p.ws + OFF_AB), (const u16*)(p.ws + OFF_WOUTT), T, 1024, 1024};
  pg8::StaticOrder S; S.init(T, 1024, (int)gridDim.x, (int)blockIdx.x);
  EpiOut E{p.x, p.out, (u16*)(p.ws + OFF_HB)};
  pg8::gemm_phase<EpiOut, pg8::StaticOrder, true, true>(LDS3(lds), g, S, E);
}
__device__ __forceinline__ void phase4(const Params& p, char* lds) {
  pg8::Gemm g{(const u16*)(p.ws + OFF_HB), (const u16*)(p.ws + OFF_WQT), T, 2048, 1024};
  pg8::StaticOrder S; S.init(T, 2048, (int)gridDim.x, (int)blockIdx.x);
  EpiQ E{(u16*)(p.ws + OFF_PQ)};
  pg8::gemm_phase<EpiQ, pg8::StaticOrder, true, true>(LDS3(lds), g, S, E);
}

__device__ __forceinline__ unsigned dpp_xor1(unsigned v) { return (unsigned)__builtin_amdgcn_mov_dpp((int)v, 0xB1, 0xF, 0xF, true); }
__device__ __forceinline__ unsigned dpp_xor2(unsigned v) { return (unsigned)__builtin_amdgcn_mov_dpp((int)v, 0x4E, 0xF, 0xF, true); }
__device__ __forceinline__ void sort16_desc(unsigned (&v)[16]) {
#pragma unroll
  for (int k = 2; k <= 16; k <<= 1)
#pragma unroll
    for (int j = k >> 1; j > 0; j >>= 1)
#pragma unroll
      for (int i = 0; i < 16; ++i) {
        const int l = i ^ j;
        if (l > i) {
          const unsigned hi = max(v[i], v[l]), lo = min(v[i], v[l]);
          if ((i & k) == 0) { v[i] = hi; v[l] = lo; } else { v[i] = lo; v[l] = hi; }
        }
      }
}
__device__ __forceinline__ void merge16_desc(unsigned (&a)[16], const unsigned (&b)[16]) {
#pragma unroll
  for (int i = 0; i < 16; ++i) a[i] = max(a[i], b[15 - i]);
#pragma unroll
  for (int j = 8; j > 0; j >>= 1)
#pragma unroll
    for (int i = 0; i < 16; ++i) {
      const int l = i ^ j;
      if (l > i) { const unsigned hi = max(a[i], a[l]), lo = min(a[i], a[l]); a[i] = hi; a[l] = lo; }
    }
}
constexpr int SC_STR = 385, LSTR17 = 17;
constexpr int P5_LV = 64 * SC_STR, P5_LI = P5_LV + 128 * LSTR17, P5_TAB = P5_LI + 128 * LSTR17;

__device__ __forceinline__ void select_item(const Params& p, int item, int next_item, int kiter, char* lds, const bf16x8 (&kf)[8][4], bf16x8 (&qf)[4]) {
  const int tid = tid_(), lane = tid & 63, wave = tid >> 6, l15 = lane & 15, g = lane >> 4;
  const int h = item & 7, t0 = (item >> 3) * 64;
  const u16* PQ = (const u16*)(p.ws + OFF_PQ);
  int* EIDX = (int*)(p.ws + OFF_EIDX);
  float* BEST = (float*)(p.ws + OFF_BEST);
  float* sc = (float*)lds;
  float* LV = sc + P5_LV;
  int* LI = (int*)lds + P5_LI;
  const int* tab = (const int*)lds + P5_TAB;
  __syncthreads();
  {
    const int pp = wave >> 2, wq = wave & 3;
    __builtin_amdgcn_s_setprio(1);
#pragma unroll
    for (int nt = 0; nt < 8; ++nt) {
      f32x4 a = f32x4{0.f, 0.f, 0.f, 0.f};
#pragma unroll
      for (int ks = 0; ks < 4; ++ks) a = mfma16(qf[ks], kf[nt][ks], a);
#pragma unroll
      for (int j = 0; j < 4; ++j) sc[(wq * 16 + g * 4 + j) * SC_STR + pp * 192 + (nt >> 1) * 48 + (nt & 1) * 16 + l15] = a[j];
    }
    __builtin_amdgcn_s_setprio(0);
    if (next_item < 512 * 8) {
      const u16* qp = PQ + (size_t)((next_item >> 3) * 64 + wq * 16 + l15) * 2048 + (next_item & 7) * 256 + pp * 128 + g * 8;
#pragma unroll
      for (int ks = 0; ks < 4; ++ks) qf[ks] = *(const bf16x8*)(qp + ks * 32);
    }
  }
  __syncthreads();
  {
    const int q = tid & 3, list = tid >> 2, row = list & 63, pp = list >> 6;
    const float* rowp = sc + row * SC_STR + pp * 192;
    const float* src = rowp + q * 48;
    unsigned A[16], B[16];
#pragma unroll
    for (int j = 0; j < 16; ++j) {
      A[j] = (okey(src[j]) & ~127u) | (unsigned)(127 - (q * 32 + j));
      B[j] = (okey(src[16 + j]) & ~127u) | (unsigned)(127 - (q * 32 + 16 + j));
    }
    sort16_desc(A);
    sort16_desc(B);
    merge16_desc(A, B);
#pragma unroll
    for (int i = 0; i < 16; ++i) B[i] = dpp_xor1(A[i]);
    merge16_desc(A, B);
#pragma unroll
    for (int i = 0; i < 16; ++i) B[i] = dpp_xor2(A[i]);
    merge16_desc(A, B);
#pragma unroll
    for (int r = 0; r < 16; ++r) {
      if ((r & 3) == q) {
        const int idx = 127 - (int)(A[r] & 127u);
        LV[list * LSTR17 + r] = rowp[(idx >> 5) * 48 + (idx & 31)];
        LI[list * LSTR17 + r] = idx;
      }
    }
  }
  __syncthreads();
  if (tid >= 256) {
    quant_pair(p, 2 * ((kiter * 4 + (wave - 4)) * (int)gridDim.x + bid_()), lane);
  } else {
    const int grp = tid & 3, row = tid >> 2;
    const float* v0 = LV + row * LSTR17;
    const float* v1 = LV + (64 + row) * LSTR17;
    unsigned A[16], B[16];
#pragma unroll
    for (int j = 0; j < 16; ++j) {
      const int code = tab[grp * 16 + j];
      const int cc = code & 255;
      const float s = v0[cc >> 4] + v1[cc & 15];
      A[j] = (code < 0) ? 0u : ((okey(s) & ~255u) | (unsigned)(255 - cc));
    }
    sort16_desc(A);
#pragma unroll
    for (int i = 0; i < 16; ++i) B[i] = dpp_xor1(A[i]);
    merge16_desc(A, B);
#pragma unroll
    for (int i = 0; i < 16; ++i) B[i] = dpp_xor2(A[i]);
    merge16_desc(A, B);
    const size_t ob = ((size_t)(t0 + row) * 8 + h) * 16 + grp * 4;
    const int* i0 = LI + row * LSTR17;
    const int* i1 = LI + (64 + row) * LSTR17;
    int e4[4];
    float b4[4];
#pragma unroll
    for (int j = 0; j < 4; ++j) {
      const unsigned sel = (grp == 0) ? A[j] : (grp == 1) ? A[4 + j] : (grp == 2) ? A[8 + j] : A[12 + j];
      const int cc = 255 - (int)(sel & 255u);
      const int a = cc >> 4, bq = cc & 15;
      e4[j] = i0[a] * 128 + i1[bq];
      b4[j] = v0[a] + v1[bq];
    }
    *(int4*)(EIDX + ob) = make_int4(e4[0], e4[1], e4[2], e4[3]);
    *(float4*)(BEST + ob) = make_float4(b4[0], b4[1], b4[2], b4[3]);
  }
}

__device__ __forceinline__ void phase5(const Params& p, char* lds) {
  {
    const int i = tid_();
    if (i < 64) {
      const int grp = i >> 4, j = i & 15;
      int code = -1;
      if (grp == 0) code = j;
      else if (grp == 1) { if (j < 8) code = 16 + j; else if (j < 13) code = 32 + (j - 8); }
      else if (grp == 2) { if (j < 4) code = 48 + j; else if (j < 7) code = 64 + (j - 4); else if (j < 9) code = 80 + (j - 7); else if (j < 11) code = 96 + (j - 9); else if (j < 13) code = 112 + (j - 11); }
      else { if (j < 8) code = (8 + j) * 16; }
      ((int*)lds)[P5_TAB + i] = code;
    }
  }
  const int tid = tid_(), lane = tid & 63, wave = tid >> 6, l15 = lane & 15, g = lane >> 4;
  const int pp = wave >> 2, wq = wave & 3;
  int it = bid_();
  if (it >= 512 * 8) return;
  const bool fixed_head = (gridDim.x & 7) == 0;
  bf16x8 kf[8][4];
  bf16x8 qf[4];
  {
    const u16* KEYS = (const u16*)(p.ws + OFF_KEYS);
#pragma unroll
    for (int nt = 0; nt < 8; ++nt) {
      const u16* kp = KEYS + ((size_t)(((it & 7) * 2 + pp) * 128 + nt * 16 + l15)) * 128 + g * 8;
#pragma unroll
      for (int ks = 0; ks < 4; ++ks) kf[nt][ks] = *(const bf16x8*)(kp + ks * 32);
    }
    const u16* qp = (const u16*)(p.ws + OFF_PQ) + (size_t)((it >> 3) * 64 + wq * 16 + l15) * 2048 + (it & 7) * 256 + pp * 128 + g * 8;
#pragma unroll
    for (int ks = 0; ks < 4; ++ks) qf[ks] = *(const bf16x8*)(qp + ks * 32);
  }
  int kiter = 0;
  for (; it < 512 * 8; it += gridDim.x, ++kiter) {
    if (!fixed_head) {
      const u16* KEYS = (const u16*)(p.ws + OFF_KEYS);
#pragma unroll
      for (int nt = 0; nt < 8; ++nt) {
        const u16* kp = KEYS + ((size_t)(((it & 7) * 2 + pp) * 128 + nt * 16 + l15)) * 128 + g * 8;
#pragma unroll
        for (int ks = 0; ks < 4; ++ks) kf[nt][ks] = *(const bf16x8*)(kp + ks * 32);
      }
    }
    select_item(p, it, it + (int)gridDim.x, kiter, lds, kf, qf);
  }
  {
    const int G = (int)gridDim.x, kmin = (512 * 8) / G;
    for (int pr = kmin * 4 * G + bid_() * NWAVE + wave; pr < 16384; pr += G * NWAVE) quant_pair(p, 2 * pr, lane);
  }
}

#define P4(w, i) __builtin_amdgcn_cvt_scalef32_pk_f32_fp4((w), 1.0f, (i))
#define B4(w, i) __builtin_amdgcn_cvt_scalef32_pk_bf16_fp4((w), 1.0f, (i))
__device__ __forceinline__ f32x2 hpair(unsigned w) { return f32x2{bf_lo(w), bf_hi(w)}; }
__device__ __forceinline__ float dot32_fp4(const u32x4 u, const u32x4 (&h)[4], float acc) {
  f32x2 s = f32x2{acc, 0.f};
  s = __builtin_elementwise_fma(P4(u.x, 0), hpair(h[0].x), s); s = __builtin_elementwise_fma(P4(u.x, 1), hpair(h[0].y), s);
  s = __builtin_elementwise_fma(P4(u.x, 2), hpair(h[0].z), s); s = __builtin_elementwise_fma(P4(u.x, 3), hpair(h[0].w), s);
  s = __builtin_elementwise_fma(P4(u.y, 0), hpair(h[1].x), s); s = __builtin_elementwise_fma(P4(u.y, 1), hpair(h[1].y), s);
  s = __builtin_elementwise_fma(P4(u.y, 2), hpair(h[1].z), s); s = __builtin_elementwise_fma(P4(u.y, 3), hpair(h[1].w), s);
  s = __builtin_elementwise_fma(P4(u.z, 0), hpair(h[2].x), s); s = __builtin_elementwise_fma(P4(u.z, 1), hpair(h[2].y), s);
  s = __builtin_elementwise_fma(P4(u.z, 2), hpair(h[2].z), s); s = __builtin_elementwise_fma(P4(u.z, 3), hpair(h[2].w), s);
  s = __builtin_elementwise_fma(P4(u.w, 0), hpair(h[3].x), s); s = __builtin_elementwise_fma(P4(u.w, 1), hpair(h[3].y), s);
  s = __builtin_elementwise_fma(P4(u.w, 2), hpair(h[3].z), s); s = __builtin_elementwise_fma(P4(u.w, 3), hpair(h[3].w), s);
  return s.x + s.y;
}
__device__ __forceinline__ void p6_gather(u32x4 (&buf)[16], const unsigned char* EXs  , unsigned loff  , int ea, int eb, int eg) {
#pragma unroll
  for (int it = 0; it < 16; ++it) {
    const int src = (it * 8 + eg) & 63;
    const unsigned e = (unsigned)__shfl((it < 8) ? ea : eb, src);
    buf[it] = *(const u32x4*)(EXs + (size_t)(e * 128u + loff));
  }
}
__device__ __forceinline__ void p6a_compute(const u32x4 (&buf)[16], const u32x4 (&h)[4], float* PART, int t, int part, int eg, bool b2, bool b1, bool b0) {
  float f[32];
#pragma unroll
  for (int i = 0; i < 4; ++i) {
    f[i * 8 + 0] = bf_lo(h[i].x); f[i * 8 + 1] = bf_hi(h[i].x); f[i * 8 + 2] = bf_lo(h[i].y); f[i * 8 + 3] = bf_hi(h[i].y);
    f[i * 8 + 4] = bf_lo(h[i].z); f[i * 8 + 5] = bf_hi(h[i].z); f[i * 8 + 6] = bf_lo(h[i].w); f[i * 8 + 7] = bf_hi(h[i].w);
  }
  float am = 0.f;
#pragma unroll
  for (int i = 0; i < 32; ++i) am = fmaxf(am, fabsf(f[i]));
  const bool ok = am > 1e-30f;
  const float sc = ok ? 7.0f / am : 0.f, inv = ok ? am * (1.f / 7.0f) : 0.f;
  int hq[4];
#pragma unroll
  for (int i = 0; i < 4; ++i)
    hq[i] = (int)(q4(f[i * 8 + 0] * sc, 0) | q4(f[i * 8 + 1] * sc, 1) | q4(f[i * 8 + 2] * sc, 2) | q4(f[i * 8 + 3] * sc, 3) |
                  q4(f[i * 8 + 4] * sc, 4) | q4(f[i * 8 + 5] * sc, 5) | q4(f[i * 8 + 6] * sc, 6) | q4(f[i * 8 + 7] * sc, 7));
  float d[16];
#pragma unroll
  for (int it = 0; it < 16; ++it) {
    int a = __builtin_amdgcn_sdot8((int)buf[it].x, hq[0], 0, false);
    a = __builtin_amdgcn_sdot8((int)buf[it].y, hq[1], a, false);
    a = __builtin_amdgcn_sdot8((int)buf[it].z, hq[2], a, false);
    a = __builtin_amdgcn_sdot8((int)buf[it].w, hq[3], a, false);
    d[it] = (float)a * inv;
  }
  float r[8];
#pragma unroll
  for (int i = 0; i < 8; ++i) r[i] = (b2 ? d[i + 8] : d[i]) + __shfl_xor(b2 ? d[i] : d[i + 8], 4);
  float s4[4];
#pragma unroll
  for (int i = 0; i < 4; ++i) s4[i] = (b1 ? r[i + 4] : r[i]) + dpp_f<DPP_X2>(b1 ? r[i] : r[i + 4]);
#pragma unroll
  for (int i = 0; i < 2; ++i) {
    const float u = (b0 ? s4[i + 2] : s4[i]) + dpp_f<DPP_X1>(b0 ? s4[i] : s4[i + 2]);
    PART[(size_t)t * 128 + (2 * part + i) * 8 + eg] = u;
  }
}
__device__ __forceinline__ void phase6a(const Params& p, char* lds) {
  const int tid = tid_(), lane = tid & 63, wave = tid >> 6, eg = lane >> 3, part = lane & 7;
  const int bid = bid_();
  const int x = bid & 7, xb = bid >> 3, ncb = ((int)gridDim.x + 7 - x) >> 3;
  const int sl = x >> 1, par = x & 1;
  const unsigned char* EUX = (const unsigned char*)(p.ws + OFF_EU) + (size_t)sl * (2 * MiB);
  const unsigned loff = (unsigned)part * 16u;
  const u16* HBX = (const u16*)(p.ws + OFF_HB) + sl * 256 + part * 32;
  const int* EIDX = (const int*)(p.ws + OFF_EIDX);
  float* PART = (float*)(p.ws + OFF_PART) + (size_t)sl * T * 128;
  const int tstep = ncb * NWAVE * 2;
  const bool b2 = (lane & 4) != 0, b1 = (lane & 2) != 0, b0 = (lane & 1) != 0;
  int t = (xb * NWAVE + wave) * 2 + par;
  if (t < T) {
    u32x4 A[16], B[16], hA[4], hB[4];
    int e0 = EIDX[(size_t)t * 128 + lane], e1 = EIDX[(size_t)t * 128 + 64 + lane];
    p6_gather(A, EUX, loff, e0, e1, eg);
#pragma unroll
    for (int i = 0; i < 4; ++i) hA[i] = *(const u32x4*)(HBX + (size_t)t * 1024 + i * 8);
    int tn = t + tstep;
    if (tn < T) { e0 = EIDX[(size_t)tn * 128 + lane]; e1 = EIDX[(size_t)tn * 128 + 64 + lane]; }
    for (;;) {
      int tnn = tn + tstep;
      if (tn < T) {
        p6_gather(B, EUX, loff, e0, e1, eg);
#pragma unroll
        for (int i = 0; i < 4; ++i) hB[i] = *(const u32x4*)(HBX + (size_t)tn * 1024 + i * 8);
        if (tnn < T) { e0 = EIDX[(size_t)tnn * 128 + lane]; e1 = EIDX[(size_t)tnn * 128 + 64 + lane]; }
      }
      p6a_compute(A, hA, PART, t, part, eg, b2, b1, b0);
      if (tn >= T) break;
      const int t3 = tnn + tstep;
      if (tnn < T) {
        p6_gather(A, EUX, loff, e0, e1, eg);
#pragma unroll
        for (int i = 0; i < 4; ++i) hA[i] = *(const u32x4*)(HBX + (size_t)tnn * 1024 + i * 8);
        if (t3 < T) { e0 = EIDX[(size_t)t3 * 128 + lane]; e1 = EIDX[(size_t)t3 * 128 + 64 + lane]; }
      }
      p6a_compute(B, hB, PART, tn, part, eg, b2, b1, b0);
      if (tnn >= T) break;
      t = tnn; tn = t3;
    }
  }
}

__device__ __forceinline__ void phase6m(const Params& p, char* lds) {
  const int tid = tid_(), lane = tid & 63, wave = tid >> 6;
  const u16* HB = (const u16*)(p.ws + OFF_HB);
  const float* ESC = (const float*)(p.ws + OFF_ESC);
  const int* EIDX = (const int*)(p.ws + OFF_EIDX);
  const float* BEST = (const float*)(p.ws + OFF_BEST);
  const float* PART = (const float*)(p.ws + OFF_PART);
  float* WGT = (float*)(p.ws + OFF_WGT);
  for (int t0 = (bid_() * NWAVE + wave) * 2; t0 < T; t0 += gridDim.x * NWAVE * 2) {
    uint4 ha[2], hb[2];
    float da[2], db[2], ba[2], bb[2];
    int ea[2], eb[2];
#pragma unroll
    for (int r = 0; r < 2; ++r) {
      const int t = t0 + r;
      ha[r] = *(const uint4*)(HB + (size_t)t * 1024 + lane * 16); hb[r] = *(const uint4*)(HB + (size_t)t * 1024 + lane * 16 + 8);
      const size_t i0 = (size_t)t * 128 + lane, i1 = i0 + 64;
      ea[r] = EIDX[i0]; eb[r] = EIDX[i1];
      ba[r] = BEST[i0]; bb[r] = BEST[i1];
      float sa = 0.f, sb = 0.f;
#pragma unroll
      for (int x = 0; x < 4; ++x) { sa += PART[(size_t)x * T * 128 + i0]; sb += PART[(size_t)x * T * 128 + i1]; }
      da[r] = sa; db[r] = sb;
    }
    float ua[2], ub[2], va[2], vb[2];
#pragma unroll
    for (int r = 0; r < 2; ++r) { ua[r] = ESC[ea[r]]; ub[r] = ESC[eb[r]]; va[r] = ESC[16384 + ea[r]]; vb[r] = ESC[16384 + eb[r]]; }
#pragma unroll
    for (int r = 0; r < 2; ++r) {
      const uint4 a = ha[r], b = hb[r];
      float ss = 0.f;
      ss = dot2(a.x, a.x, ss); ss = dot2(a.y, a.y, ss); ss = dot2(a.z, a.z, ss); ss = dot2(a.w, a.w, ss);
      ss = dot2(b.x, b.x, ss); ss = dot2(b.y, b.y, ss); ss = dot2(b.z, b.z, ss); ss = dot2(b.w, b.w, ss);
#pragma unroll
      for (int o = 1; o < 64; o <<= 1) ss += __shfl_xor(ss, o);
      const float rs2 = rsqrtf(ss * (1.f / 1024.f) + EPS);
      const float xa = ba[r] * rs2, xb = bb[r] * rs2;
      float ma = xa, mb = xb;
#pragma unroll
      for (int o = 1; o < 16; o <<= 1) { ma = fmaxf(ma, __shfl_xor(ma, o)); mb = fmaxf(mb, __shfl_xor(mb, o)); }
      const float pa = __expf(xa - ma), pb = __expf(xb - mb);
      float sa = pa, sb = pb;
#pragma unroll
      for (int o = 1; o < 16; o <<= 1) { sa += __shfl_xor(sa, o); sb += __shfl_xor(sb, o); }
      const size_t i0 = (size_t)(t0 + r) * 128 + lane;
      float* wrow = WGT + (size_t)(t0 + r) * 128 + (lane & 7) * 16 + (lane >> 3);
      wrow[0] = (pa / sa) * gelu_f(da[r] * rs2 * ua[r]) * va[r];
      wrow[8] = (pb / sb) * gelu_f(db[r] * rs2 * ub[r]) * vb[r];
    }
  }
}

__device__ __forceinline__ void p6b_compute(const u32x4 (&buf)[16], const f32x4 (&wv)[4], uint2 hr, float* orow, int eg, bool h5, bool h4, bool h3) {
  f32x2 acc[16];
#pragma unroll
  for (int i = 0; i < 16; ++i) acc[i] = f32x2{0.f, 0.f};
#pragma unroll
  for (int it = 0; it < 16; ++it) {
    const float w = wv[it >> 2][it & 3];
    const f32x2 w2 = f32x2{w, w};
    const u32x4 v = buf[it];
    acc[0] = __builtin_elementwise_fma(P4(v.x, 0), w2, acc[0]);   acc[1] = __builtin_elementwise_fma(P4(v.x, 1), w2, acc[1]);
    acc[2] = __builtin_elementwise_fma(P4(v.x, 2), w2, acc[2]);   acc[3] = __builtin_elementwise_fma(P4(v.x, 3), w2, acc[3]);
    acc[4] = __builtin_elementwise_fma(P4(v.y, 0), w2, acc[4]);   acc[5] = __builtin_elementwise_fma(P4(v.y, 1), w2, acc[5]);
    acc[6] = __builtin_elementwise_fma(P4(v.y, 2), w2, acc[6]);   acc[7] = __builtin_elementwise_fma(P4(v.y, 3), w2, acc[7]);
    acc[8] = __builtin_elementwise_fma(P4(v.z, 0), w2, acc[8]);   acc[9] = __builtin_elementwise_fma(P4(v.z, 1), w2, acc[9]);
    acc[10] = __builtin_elementwise_fma(P4(v.z, 2), w2, acc[10]); acc[11] = __builtin_elementwise_fma(P4(v.z, 3), w2, acc[11]);
    acc[12] = __builtin_elementwise_fma(P4(v.w, 0), w2, acc[12]); acc[13] = __builtin_elementwise_fma(P4(v.w, 1), w2, acc[13]);
    acc[14] = __builtin_elementwise_fma(P4(v.w, 2), w2, acc[14]); acc[15] = __builtin_elementwise_fma(P4(v.w, 3), w2, acc[15]);
  }
  f32x2 q1[8];
#pragma unroll
  for (int i = 0; i < 8; ++i) {
    const auto rx = __builtin_amdgcn_permlane32_swap(__float_as_uint(acc[i].x), __float_as_uint(acc[i + 8].x), false, false);
    const auto ry = __builtin_amdgcn_permlane32_swap(__float_as_uint(acc[i].y), __float_as_uint(acc[i + 8].y), false, false);
    q1[i] = f32x2{__uint_as_float(rx[0]) + __uint_as_float(rx[1]), __uint_as_float(ry[0]) + __uint_as_float(ry[1])};
  }
  f32x2 q2[4];
#pragma unroll
  for (int i = 0; i < 4; ++i) {
    const auto rx = __builtin_amdgcn_permlane16_swap(__float_as_uint(q1[i].x), __float_as_uint(q1[i + 4].x), false, false);
    const auto ry = __builtin_amdgcn_permlane16_swap(__float_as_uint(q1[i].y), __float_as_uint(q1[i + 4].y), false, false);
    q2[i] = f32x2{__uint_as_float(rx[0]) + __uint_as_float(rx[1]), __uint_as_float(ry[0]) + __uint_as_float(ry[1])};
  }
  f32x2 q3[2];
#pragma unroll
  for (int i = 0; i < 2; ++i) {
    const f32x2 sd = h3 ? q2[i] : q2[i + 2], kp = h3 ? q2[i + 2] : q2[i];
    q3[i] = f32x2{kp.x + dpp_f<DPP_R8>(sd.x), kp.y + dpp_f<DPP_R8>(sd.y)};
  }
  *(float4*)orow = make_float4(bf_lo(hr.x) + q3[0].x, bf_hi(hr.x) + q3[0].y, bf_lo(hr.y) + q3[1].x, bf_hi(hr.y) + q3[1].y);
}
__device__ __forceinline__ void phase6b(const Params& p, char* lds) {
  const int tid = tid_(), lane = tid & 63, wave = tid >> 6, eg = lane >> 3, part = lane & 7;
  const int bid = bid_();
  const int x = bid & 7, xb = bid >> 3, ncb = ((int)gridDim.x + 7 - x) >> 3;
  const int sl = x >> 1, par = x & 1;
  const unsigned char* EVX = (const unsigned char*)(p.ws + OFF_EV) + (size_t)sl * (2 * MiB);
  const unsigned loff = (unsigned)part * 16u;
  const int* EIDX = (const int*)(p.ws + OFF_EIDX);
  const float* WGT = (const float*)(p.ws + OFF_WGT);
  const int tstep = ncb * NWAVE * 2;
  const int pi = ((lane >> 5) & 1) * 4 + ((lane >> 4) & 1) * 2 + ((lane >> 3) & 1);
  const int ocol = sl * 256 + part * 32 + pi * 4;
  const u16* HB = (const u16*)(p.ws + OFF_HB) + ocol;
  float* OUT = p.out + ocol;
  const bool h5 = (lane & 32) != 0, h4 = (lane & 16) != 0, h3 = (lane & 8) != 0;
  int t = (xb * NWAVE + wave) * 2 + par;
  if (t < T) {
    u32x4 A[16], B[16];
    int e0 = EIDX[(size_t)t * 128 + lane], e1 = EIDX[(size_t)t * 128 + 64 + lane];
    f32x4 wA[4], wB[4];
#pragma unroll
    for (int i = 0; i < 4; ++i) { wA[i] = *(const f32x4*)(WGT + (size_t)t * 128 + eg * 16 + i * 4); wB[i] = wA[i]; }
    uint2 hA = *(const uint2*)(HB + (size_t)t * 1024), hB = make_uint2(0u, 0u);
    p6_gather(A, EVX, loff, e0, e1, eg);
    int tn = t + tstep;
    if (tn < T) { e0 = EIDX[(size_t)tn * 128 + lane]; e1 = EIDX[(size_t)tn * 128 + 64 + lane]; }
    for (;;) {
      int tnn = tn + tstep;
      if (tn < T) {
        p6_gather(B, EVX, loff, e0, e1, eg);
#pragma unroll
        for (int i = 0; i < 4; ++i) wB[i] = *(const f32x4*)(WGT + (size_t)tn * 128 + eg * 16 + i * 4);
        hB = *(const uint2*)(HB + (size_t)tn * 1024);
        if (tnn < T) { e0 = EIDX[(size_t)tnn * 128 + lane]; e1 = EIDX[(size_t)tnn * 128 + 64 + lane]; }
      }
      p6b_compute(A, wA, hA, OUT + (size_t)t * 1024, eg, h5, h4, h3);
      if (tn >= T) break;
      const int t3 = tnn + tstep;
      if (tnn < T) {
        p6_gather(A, EVX, loff, e0, e1, eg);
#pragma unroll
        for (int i = 0; i < 4; ++i) wA[i] = *(const f32x4*)(WGT + (size_t)tnn * 128 + eg * 16 + i * 4);
        hA = *(const uint2*)(HB + (size_t)tnn * 1024);
        if (t3 < T) { e0 = EIDX[(size_t)t3 * 128 + lane]; e1 = EIDX[(size_t)t3 * 128 + 64 + lane]; }
      }
      p6b_compute(B, wB, hB, OUT + (size_t)tn * 1024, eg, h5, h4, h3);
      if (tnn >= T) break;
      t = tnn; tn = t3;
    }
  }
}

#define LAS __attribute__((address_space(3)))
#define XB_TMO      128
#define XB_XCNT(j)  (256  + 64 * (j))
#define XB_XSUB(j)  (1280 + 64 * (j))
#define XB_XGEN(j)  (2304 + 64 * (j))
#define XB_TOP      3328
#define XB_TOPGEN   3392
#define XCD_BAR_WORDS 3456
#define XB_SPIN_CAP (1u << 18)

__device__ __forceinline__ unsigned xb_ld(unsigned* p)              { return __hip_atomic_load(p, __ATOMIC_RELAXED, __HIP_MEMORY_SCOPE_AGENT); }
__device__ __forceinline__ unsigned xb_add(unsigned* p, unsigned v) { return __hip_atomic_fetch_add(p, v, __ATOMIC_RELAXED, __HIP_MEMORY_SCOPE_AGENT); }
__device__ __forceinline__ unsigned xb_xcc_id() { return (unsigned)__builtin_amdgcn_s_getreg((3 << 11) | 20) & 0xFu; }
#define XB_SPIN(cond, bar) do { unsigned _sp = 0; while (cond) { __builtin_amdgcn_s_sleep(1); \
    if ((++_sp & 255u) == 0u) { if (xb_ld(&(bar)[XB_TMO])) break; if (_sp > XB_SPIN_CAP) { atomicAdd(&(bar)[XB_TMO], 1u); break; } } } } while (0)

struct XcdBarrier {
    unsigned* bar; unsigned x;
    volatile LAS unsigned* st;
};

__device__ __forceinline__ XcdBarrier xcd_barrier_post(unsigned* bar, volatile LAS unsigned* st) {
    XcdBarrier b; b.bar = bar; b.x = xb_xcc_id(); b.st = st;
    if (threadIdx.x == 0) (void)xb_add(&bar[XB_XCNT(b.x)], 1u);
    return b;
}
__device__ __forceinline__ void xcd_barrier_complete(unsigned* bar, unsigned x, unsigned& nloc, unsigned& nx) {
    const unsigned G = gridDim.x * gridDim.y * gridDim.z;
    unsigned sum, cnt, mine, sp = 0u;
    for (;;) {
        sum = 0u; cnt = 0u; mine = 0u;
#pragma unroll
        for (unsigned j = 0; j < 16; ++j) { const unsigned c = xb_ld(&bar[XB_XCNT(j)]); sum += c; cnt += (c > 0u) ? 1u : 0u; mine = (j == x) ? c : mine; }
        if (sum == G) break;
        __builtin_amdgcn_s_sleep(1);
        if ((++sp & 255u) == 0u) { if (xb_ld(&bar[XB_TMO])) break; if (sp > XB_SPIN_CAP) { atomicAdd(&bar[XB_TMO], 1u); break; } }
    }
    nloc = mine > 0u ? mine : 1u; nx = cnt > 0u ? cnt : 1u;
}

__device__ __forceinline__ void xcd_barrier(const XcdBarrier& b) {
    asm volatile("s_waitcnt vmcnt(0)" ::: "memory");
    __syncthreads();
    if (threadIdx.x == 0) {
        unsigned* bar = b.bar;
        __builtin_amdgcn_s_waitcnt(0);
        unsigned nloc = b.st[0], nx = b.st[1];
        if (nloc == 0u) { xcd_barrier_complete(bar, b.x, nloc, nx); b.st[0] = nloc; b.st[1] = nx; }
        const unsigned old = xb_add(&bar[XB_XSUB(b.x)], 1u);
        const unsigned gen = old / nloc;
        if (old + 1u == (gen + 1u) * nloc) {
            __builtin_amdgcn_fence(__ATOMIC_RELEASE, "agent");
            asm volatile("s_waitcnt vmcnt(0)" ::: "memory");
            const unsigned og = xb_add(&bar[XB_TOP], 1u);
            const unsigned tg = og / nx;
            if (og + 1u == (tg + 1u) * nx) xb_add(&bar[XB_TOPGEN], 1u);
            else XB_SPIN(xb_ld(&bar[XB_TOPGEN]) == tg, bar);
            __builtin_amdgcn_fence(__ATOMIC_ACQUIRE, "agent");
            xb_add(&bar[XB_XGEN(b.x)], 1u);
            asm volatile("s_waitcnt vmcnt(0)" ::: "memory");
        } else {
            XB_SPIN(xb_ld(&bar[XB_XGEN(b.x)]) == gen, bar);
            __builtin_amdgcn_fence(__ATOMIC_ACQUIRE, "agent");
            asm volatile("s_waitcnt vmcnt(0)" ::: "memory");
        }
    }
    __syncthreads();
}


__device__ __forceinline__ void seam_barrier(unsigned* ctr, unsigned nblk) {
  __syncthreads();
  if (threadIdx.x == 0) {
    __builtin_amdgcn_fence(__ATOMIC_RELEASE, "agent");
    asm volatile("s_waitcnt vmcnt(0)" ::: "memory");
    __hip_atomic_fetch_add(ctr, 1u, __ATOMIC_RELAXED, __HIP_MEMORY_SCOPE_AGENT);
    while (__hip_atomic_load(ctr, __ATOMIC_RELAXED, __HIP_MEMORY_SCOPE_AGENT) < nblk) __builtin_amdgcn_s_sleep(2);
    __builtin_amdgcn_fence(__ATOMIC_ACQUIRE, "agent");
    asm volatile("s_waitcnt vmcnt(0)" ::: "memory");
  }
  __syncthreads();
}
#ifndef PMASK
#define PMASK 127
#endif
#define PROG 0x6543210ull
#define NPROG 9
__global__ void __launch_bounds__(NTHR, 2) mega(Params p, int ph_lo, int ph_hi) {
  extern __shared__ __attribute__((aligned(16))) char lds[];
  cg::grid_group grid = cg::this_grid();
#ifndef REP_PHASE
#define REP_PHASE -1
#endif
#define IN(k) (ph_lo <= (k) && (k) < ph_hi)
  volatile LAS unsigned* xst = (volatile LAS unsigned*)(LDS3(lds) + (LDS_BYTES - 16));
  if (threadIdx.x == 0) { xst[0] = 0u; xst[1] = 0u; }
  XcdBarrier xbar; xbar.bar = (unsigned*)(p.ws + OFF_BAR); xbar.x = 0; xbar.st = xst;
  if (ph_hi - ph_lo > 1) {
    if (blockIdx.x == 0) for (int i = threadIdx.x; i < XCD_BAR_WORDS; i += NTHR) ((unsigned*)(p.ws + OFF_BAR))[i] = 0u;
    grid.sync();
    xbar = xcd_barrier_post((unsigned*)(p.ws + OFF_BAR), xst);
  }
#define SEAM(k) do { if (IN(k) && IN((k) + 1)) xcd_barrier(xbar); } while (0)
  if (IN(0)) { phase0(p, lds); if (REP_PHASE == 0) { grid.sync(); phase0(p, lds); } }
  SEAM(0);
  if (IN(1)) { phase1(p, lds); if (REP_PHASE == 1) { grid.sync(); phase1(p, lds); } }
  SEAM(1);
  if (IN(2)) { phase2(p, lds); if (REP_PHASE == 2) { grid.sync(); phase2(p, lds); } }
  SEAM(2);
  if (IN(3)) { phase3(p, lds); if (REP_PHASE == 3) { grid.sync(); phase3(p, lds); } }
  SEAM(3);
  if (IN(4)) { phase4(p, lds); if (REP_PHASE == 4) { grid.sync(); phase4(p, lds); } }
  SEAM(4);
  if (IN(5)) { phase5(p, lds); if (REP_PHASE == 5) { grid.sync(); phase5(p, lds); } }
  SEAM(5);
  if (IN(6)) { phase6a(p, lds); if (REP_PHASE == 6) { grid.sync(); phase6a(p, lds); } }
  SEAM(6);
  if (IN(7)) { phase6m(p, lds); if (REP_PHASE == 7) { grid.sync(); phase6m(p, lds); } }
  SEAM(7);
  if (IN(8)) phase6b(p, lds);
}

extern "C" void kernel_launch(void* const* d_in, const int* in_sizes, int n_in, void* d_out, int out_size, void* d_ws,
                              size_t ws_size, hipStream_t stream) {
  static int grid_blocks = 0;
  if (!grid_blocks) {
    int dev = 0, cus = 0, per_cu = 0;
    (void)hipGetDevice(&dev);
    (void)hipDeviceGetAttribute(&cus, hipDeviceAttributeMultiprocessorCount, dev);
    (void)hipFuncSetAttribute((const void*)mega, hipFuncAttributeMaxDynamicSharedMemorySize, LDS_BYTES);
    (void)hipOccupancyMaxActiveBlocksPerMultiprocessor(&per_cu, mega, NTHR, LDS_BYTES);
    if (per_cu > 1) per_cu = 1;
    grid_blocks = cus * per_cu;
  }
  Params p{};
  p.x = (const float*)d_in[0]; p.ln_mix_g = (const float*)d_in[1]; p.w_in = (const float*)d_in[2];
  p.gmlp_norm_g = (const float*)d_in[3]; p.gmlp_w_s = (const float*)d_in[4]; p.gmlp_b_s = (const float*)d_in[5];
  p.q_norm_g = (const float*)d_in[6]; p.k_norm_g = (const float*)d_in[7]; p.rel_bias = (const float*)d_in[8];
  p.w_out = (const float*)d_in[9]; p.ln_ffn_g = (const float*)d_in[10]; p.w_query = (const float*)d_in[11];
  p.sub_keys = (const float*)d_in[12]; p.peer_u = (const float*)d_in[13]; p.peer_v = (const float*)d_in[14];
  p.out = (float*)d_out; p.ws = (char*)d_ws;
#if FUSED
  int lo = 0, hi = NPROG;
  void* args[] = {&p, &lo, &hi};
  hipError_t e = hipLaunchCooperativeKernel((void*)mega, dim3(grid_blocks), dim3(NTHR), args, LDS_BYTES, stream);
  if (e != hipSuccess) fprintf(stderr, "cooperative launch failed: %s (grid %d)\n", hipGetErrorString(e), grid_blocks);
#else
  for (int ph = 0; ph < NPROG; ++ph) mega<<<dim3(grid_blocks), dim3(NTHR), LDS_BYTES, stream>>>(p, ph, ph + 1);
#endif
}
```
